# Optimizing an MI355X kernel written in HIP

```python
import math
import jax, jax.numpy as jnp
from jax import lax
import numpy as np

D_MODEL = 1024
BATCH = 4
SEQ = 4096
DEPTH = 4
DEC_BATCH = 8
DEC_SEQ = 2048
PAST_LEN = 128

N_META = 16
D_MIX = D_MODEL
A_WIDTH = 3 * D_MIX // 8
A_HEADS = 6
A_BLOCK = A_WIDTH // A_HEADS
CONV_WIDTH = 4
CONV_LEFT = 2
RG_C = 8.0
B_WIDTH = 3 * D_MIX // 8
B_HEADS = 6
B_HEAD_DIM = B_WIDTH // B_HEADS
HGRN_CHUNK = 64
C_WIDTH = D_MIX - A_WIDTH - B_WIDTH
C_GROUP = 16
C_GROUPS = C_WIDTH // C_GROUP
C_STATE = 64
D_FF = 4 * D_MODEL
EPS = 1e-6
IN_WIDTHS = (A_WIDTH, A_WIDTH, B_WIDTH, B_WIDTH, B_WIDTH, B_WIDTH, B_WIDTH, C_WIDTH)
D_IN = 2 * A_WIDTH + 5 * B_WIDTH + C_WIDTH

kernel_name = "hybrid_bidir_rglru_hgrn2_s5_encoder"


def rms_norm(x, gain=None):
    x32 = x.astype(jnp.float32)
    y = x32 * lax.rsqrt(jnp.mean(x32 * x32, axis=-1, keepdims=True) + EPS)
    if gain is not None:
        y = y * gain.astype(jnp.float32)
    return y.astype(x.dtype)


def linear_scan(a, b, reverse):
    def combine(left, right):
        a_l, b_l = left
        a_r, b_r = right
        return a_l * a_r, a_r * b_l + b_r
    _, h = lax.associative_scan(combine, (a, b), axis=1, reverse=reverse)
    return h


def rglru_branch(xa, ga, conv_w, conv_b, wr, br, wi, bi, lam):
    Bn, T, _ = xa.shape
    xp = jnp.pad(xa.astype(jnp.float32), ((0, 0), (CONV_LEFT, CONV_WIDTH - 1 - CONV_LEFT), (0, 0)))
    xc = conv_b.astype(jnp.float32)
    for j in range(CONV_WIDTH):
        xc = xc + xp[:, j:j + T] * conv_w[j].astype(jnp.float32)
    xh = xc.reshape(Bn, T, A_HEADS, A_BLOCK)
    h_sum = jnp.zeros_like(xc)
    for d in range(2):
        r = jax.nn.sigmoid(jnp.einsum('btni,nij->btnj', xh, wr[d].astype(jnp.float32)).reshape(Bn, T, A_WIDTH) + br[d].astype(jnp.float32))
        i = jax.nn.sigmoid(jnp.einsum('btni,nij->btnj', xh, wi[d].astype(jnp.float32)).reshape(Bn, T, A_WIDTH) + bi[d].astype(jnp.float32))
        log_a = -RG_C * r * jax.nn.softplus(-lam[d].astype(jnp.float32))
        a = jnp.exp(log_a)
        b = jnp.sqrt(-jnp.expm1(2.0 * log_a)) * (i * xc)
        h_sum = h_sum + linear_scan(a, b, reverse=(d == 1))
    y = h_sum * jax.nn.gelu(ga.astype(jnp.float32))
    return y.astype(xa.dtype)


def hgrn2_chunk_scan(q, k, v, log_f):
    Bn, T, H, dk = q.shape
    dv = v.shape[-1]
    n_chunks = T // HGRN_CHUNK

    def to_chunks(z):
        return z.reshape(Bn, n_chunks, HGRN_CHUNK, H, z.shape[-1]).transpose(1, 0, 3, 2, 4)

    mask = jnp.tril(jnp.ones((HGRN_CHUNK, HGRN_CHUNK), dtype=bool))[:, :, None]

    def step(S, inp):
        qb, kb, vb, gb = inp
        b = jnp.cumsum(gb, axis=2)
        o_inter = jnp.einsum('bhck,bhkv->bhcv', qb * jnp.exp(b), S)
        rel = b[:, :, :, None, :] - b[:, :, None, :, :]
        decay = jnp.exp(jnp.where(mask, rel, -jnp.inf))
        scores = jnp.einsum('bhtk,bhsk,bhtsk->bhts', qb, kb, decay)
        o_intra = jnp.einsum('bhts,bhsv->bhtv', scores, vb)
        b_last = b[:, :, -1:, :]
        S_new = jnp.exp(b_last[:, :, 0, :])[..., None] * S + jnp.einsum('bhsk,bhsv->bhkv', kb * jnp.exp(b_last - b), vb)
        return S_new, o_inter + o_intra

    S0 = jnp.zeros((Bn, H, dk, dv), jnp.float32)
    _, o = lax.scan(step, S0, (to_chunks(q), to_chunks(k), to_chunks(v), to_chunks(log_f)))
    return o.transpose(1, 0, 3, 2, 4).reshape(Bn, T, H, dv)


def hgrn2_branch(xq, xi, xf_fwd, xf_bwd, xg, lower_bound):
    Bn, T, _ = xq.shape
    pad = (-T) % HGRN_CHUNK

    def heads(z):
        return jnp.pad(z, ((0, 0), (pad, 0), (0, 0))).reshape(Bn, T + pad, B_HEADS, B_HEAD_DIM)

    q = heads(jax.nn.silu(xq.astype(jnp.float32)))
    v = heads(xi.astype(jnp.float32))
    o = jnp.zeros((Bn, T, B_HEADS, B_HEAD_DIM), jnp.float32)
    for d, xf in enumerate((xf_fwd, xf_bwd)):
        lb = lower_bound[d].astype(jnp.float32)
        log_f = jnp.logaddexp(jnp.log(lb), jnp.log1p(-lb) + jax.nn.log_sigmoid(xf.astype(jnp.float32)))
        k = -jnp.expm1(log_f)
        lf, kk = heads(log_f), heads(k)
        if d == 0:
            o_d = hgrn2_chunk_scan(q, kk, v, lf)
        else:
            o_d = jnp.flip(hgrn2_chunk_scan(jnp.flip(q, 1), jnp.flip(kk, 1), jnp.flip(v, 1), jnp.flip(lf, 1)), 1)
        o = o + o_d[:, pad:]
    o = rms_norm(o).reshape(Bn, T, B_WIDTH) * jax.nn.silu(xg.astype(jnp.float32))
    return o.astype(xq.dtype)


def s5_branch(u, a_re, a_im, log_dt, b_re, b_im, c_re, c_im, d_skip, glu_w, glu_b):
    Bn, T, _ = u.shape
    u32 = u.astype(jnp.float32)
    ug = u32.reshape(Bn, T, C_GROUPS, C_GROUP).astype(jnp.complex64)
    y = jnp.zeros((Bn, T, C_GROUPS, C_GROUP), jnp.float32)
    for d in range(2):
        lam = lax.complex(a_re[d].astype(jnp.float32), a_im[d].astype(jnp.float32))
        dt = jnp.exp(log_dt[d].astype(jnp.float32))[:, None]
        a_bar = jnp.exp(lam * dt)
        b_bar = ((a_bar - 1.0) / lam)[..., None] * lax.complex(b_re[d].astype(jnp.float32), b_im[d].astype(jnp.float32))
        bu = jnp.einsum('btgh,gph->btgp', ug, b_bar)
        h = linear_scan(jnp.broadcast_to(a_bar, bu.shape), bu, reverse=(d == 1))
        c = lax.complex(c_re[d].astype(jnp.float32), c_im[d].astype(jnp.float32))
        y = y + jnp.real(jnp.einsum('btgp,ghp->btgh', h, c))
    y = y.reshape(Bn, T, C_WIDTH) + d_skip.astype(jnp.float32) * u32
    z = jax.nn.gelu(y)
    out = z * jax.nn.sigmoid(z @ glu_w.astype(jnp.float32) + glu_b.astype(jnp.float32))
    return out.astype(u.dtype)


def _trunk(x, meta_tokens, norm_mix, w_in, conv_w, conv_b, rg_wr, rg_br, rg_wi, rg_bi, rg_lambda,
           hgrn_lb_logits, s5_a_re, s5_a_im, s5_log_dt, s5_b_re, s5_b_im, s5_c_re, s5_c_im, s5_d,
           s5_glu_w, s5_glu_b, mix_gain, w_out, norm_mlp, w_up, w_down, norm_final):
    Bn = x.shape[0]
    meta = jnp.broadcast_to(meta_tokens.astype(x.dtype)[None], (Bn, N_META, D_MODEL))
    h = jnp.concatenate([meta, x], axis=1)
    lb_c = jnp.cumsum(jax.nn.softmax(hgrn_lb_logits.astype(jnp.float32), axis=1), axis=1)
    lower_bounds = lb_c - lb_c[:, :1]
    split_points = [int(s) for s in np.cumsum(IN_WIDTHS)[:-1]]
    for l in range(DEPTH):
        hn = rms_norm(h, norm_mix[l])
        proj = hn @ w_in[l]
        xa, ga, xq, xi, xff, xfb, xg, xu = jnp.split(proj, split_points, axis=-1)
        ya = rglru_branch(xa, ga, conv_w[l], conv_b[l], rg_wr[l], rg_br[l], rg_wi[l], rg_bi[l], rg_lambda[l])
        yb = hgrn2_branch(xq, xi, xff, xfb, xg, lower_bounds[:, l])
        yc = s5_branch(xu, s5_a_re[l], s5_a_im[l], s5_log_dt[l], s5_b_re[l], s5_b_im[l],
                       s5_c_re[l], s5_c_im[l], s5_d[l], s5_glu_w[l], s5_glu_b[l])
        ym = jnp.concatenate([rms_norm(ya), rms_norm(yb), rms_norm(yc)], axis=-1) * mix_gain[l]
        h = h + (ym @ w_out[l]).astype(h.dtype)
        hn = rms_norm(h, norm_mlp[l])
        h = h + (jnp.square(jax.nn.relu(hn @ w_up[l])) @ w_down[l]).astype(h.dtype)
    return rms_norm(h[:, N_META:], norm_final)


def setup_inputs(seed: int = 0) -> dict:
    key = jax.random.key(seed)
    ks = jax.random.split(key, 29)
    f32 = jnp.float32
    nrm = lambda k, shape, s: jax.random.normal(k, shape, f32) * s
    a0 = jax.random.uniform(ks[11], (DEPTH, 2, A_WIDTH), f32, minval=0.9, maxval=0.999)
    p = a0 ** (1.0 / RG_C)
    rg_lambda = jnp.log(p) - jnp.log1p(-p)
    a_im_base = jnp.broadcast_to(math.pi * jnp.arange(C_STATE, dtype=f32), (DEPTH, 2, C_GROUPS, C_STATE))
    return {
        "x_prompt": nrm(ks[0], (BATCH, SEQ, D_MODEL), 1.0),
        "x_sample": nrm(ks[1], (DEC_BATCH, DEC_SEQ, D_MODEL), 1.0),
        "meta_tokens": nrm(ks[2], (N_META, D_MODEL), 1.0),
        "norm_mix": 1.0 + nrm(ks[3], (DEPTH, D_MODEL), 0.02),
        "w_in": nrm(ks[4], (DEPTH, D_MODEL, D_IN), D_MODEL ** -0.5),
        "conv_w": nrm(ks[5], (DEPTH, CONV_WIDTH, A_WIDTH), 0.5),
        "conv_b": nrm(ks[6], (DEPTH, A_WIDTH), 0.01),
        "rg_wr": nrm(ks[7], (DEPTH, 2, A_HEADS, A_BLOCK, A_BLOCK), A_BLOCK ** -0.5),
        "rg_br": nrm(ks[8], (DEPTH, 2, A_WIDTH), 0.01),
        "rg_wi": nrm(ks[9], (DEPTH, 2, A_HEADS, A_BLOCK, A_BLOCK), A_BLOCK ** -0.5),
        "rg_bi": nrm(ks[10], (DEPTH, 2, A_WIDTH), 0.01),
        "rg_lambda": rg_lambda,
        "hgrn_lb_logits": nrm(ks[12], (2, DEPTH, B_WIDTH), 0.1),
        "s5_a_re": -0.5 + nrm(ks[13], (DEPTH, 2, C_GROUPS, C_STATE), 0.01),
        "s5_a_im": a_im_base + nrm(ks[14], (DEPTH, 2, C_GROUPS, C_STATE), 0.01),
        "s5_log_dt": jax.random.uniform(ks[15], (DEPTH, 2, C_GROUPS), f32, minval=math.log(1e-3), maxval=math.log(1e-1)),
        "s5_b_re": nrm(ks[16], (DEPTH, 2, C_GROUPS, C_STATE, C_GROUP), (2.0 * C_GROUP) ** -0.5),
        "s5_b_im": nrm(ks[17], (DEPTH, 2, C_GROUPS, C_STATE, C_GROUP), (2.0 * C_GROUP) ** -0.5),
        "s5_c_re": nrm(ks[18], (DEPTH, 2, C_GROUPS, C_GROUP, C_STATE), (2.0 * C_STATE) ** -0.5),
        "s5_c_im": nrm(ks[19], (DEPTH, 2, C_GROUPS, C_GROUP, C_STATE), (2.0 * C_STATE) ** -0.5),
        "s5_d": nrm(ks[20], (DEPTH, C_WIDTH), 0.1),
        "s5_glu_w": nrm(ks[21], (DEPTH, C_WIDTH, C_WIDTH), C_WIDTH ** -0.5),
        "s5_glu_b": nrm(ks[22], (DEPTH, C_WIDTH), 0.01),
        "mix_gain": 1.0 + nrm(ks[23], (DEPTH, D_MIX), 0.02),
        "w_out": nrm(ks[24], (DEPTH, D_MIX, D_MODEL), D_MIX ** -0.5),
        "norm_mlp": 1.0 + nrm(ks[25], (DEPTH, D_MODEL), 0.02),
        "w_up": nrm(ks[26], (DEPTH, D_MODEL, D_FF), D_MODEL ** -0.5),
        "w_down": nrm(ks[27], (DEPTH, D_FF, D_MODEL), D_FF ** -0.5),
        "norm_final": 1.0 + nrm(ks[28], (D_MODEL,), 0.02),
    }


def reference(x_prompt, x_sample, meta_tokens, norm_mix, w_in, conv_w, conv_b, rg_wr, rg_br, rg_wi, rg_bi,
              rg_lambda, hgrn_lb_logits, s5_a_re, s5_a_im, s5_log_dt, s5_b_re, s5_b_im, s5_c_re, s5_c_im,
              s5_d, s5_glu_w, s5_glu_b, mix_gain, w_out, norm_mlp, w_up, w_down, norm_final):
    params = (meta_tokens, norm_mix, w_in, conv_w, conv_b, rg_wr, rg_br, rg_wi, rg_bi, rg_lambda,
              hgrn_lb_logits, s5_a_re, s5_a_im, s5_log_dt, s5_b_re, s5_b_im, s5_c_re, s5_c_im, s5_d,
              s5_glu_w, s5_glu_b, mix_gain, w_out, norm_mlp, w_up, w_down, norm_final)
    y_prompt = _trunk(x_prompt, *params)
    y_sample = _trunk(x_sample, *params)
    return (y_prompt, y_sample)
```

```cpp
#include <hip/hip_runtime.h>
#include <hip/hip_cooperative_groups.h>
#include <cstdio>
namespace cg = cooperative_groups;

#define DI __device__ __forceinline__
#define LAS __attribute__((address_space(3)))
typedef unsigned short bf16_t;
typedef short bf16x8 __attribute__((ext_vector_type(8)));
typedef float f32x4 __attribute__((ext_vector_type(4)));
typedef unsigned u32x4 __attribute__((ext_vector_type(4)));
typedef unsigned u32x2 __attribute__((ext_vector_type(2)));

constexpr int D = 1024, DEPTH = 4, DFF = 4096;
constexpr int PADR = 48;
constexpr int LP = 4160, LS = 2112;
constexpr int ROWS_P = 4 * LP;
constexpr int MP = ROWS_P + 8 * LS;
constexpr int NCH64 = MP / 64;
constexpr int NCH32 = MP / 32;
constexpr int U2ROWS = 1280;
constexpr int U2LD = 768;
constexpr int PLD = 2816;
constexpr int OFF_AX = 0, OFF_AG = 384, OFF_BQ = 768, OFF_BI = 1152, OFF_BFF = 1536, OFF_BFB = 1920, OFF_BG = 2304;
constexpr float EPS = 1e-6f;
constexpr int LDS_BYTES = 147456;

constexpr size_t al256(size_t x) { return (x + 255) & ~(size_t)255; }
constexpr size_t WS_H     = 0;
constexpr size_t WS_ACT   = WS_H + (size_t)MP * D * 4;
constexpr size_t WS_BIG   = WS_ACT + (size_t)MP * D * 2;
constexpr size_t BIG_SIZE = (size_t)MP * DFF * 2;
constexpr size_t WS_PROJ  = WS_BIG;
constexpr size_t WS_U2    = WS_PROJ + (size_t)MP * PLD * 2;
constexpr size_t WS_Z     = WS_U2 + (size_t)16 * U2ROWS * U2LD * 2;
static_assert(WS_Z + (size_t)MP * 256 * 2 <= WS_BIG + BIG_SIZE, "BIG overflow");
constexpr size_t WS_FF    = WS_BIG;
constexpr size_t WS_WIN   = WS_BIG + BIG_SIZE;
constexpr size_t WS_WOUT  = WS_WIN + (size_t)3072 * 1024 * 2;
constexpr size_t WS_WUP   = WS_WOUT + (size_t)1024 * 1024 * 2;
constexpr size_t WS_WDN   = WS_WUP + (size_t)4096 * 1024 * 2;
constexpr size_t WS_WG    = WS_WDN + (size_t)1024 * 4096 * 2;
constexpr size_t WS_GLU   = WS_WG + (size_t)6 * 256 * 64 * 2;
constexpr size_t WS_T2    = WS_GLU + (size_t)256 * 256 * 2;
constexpr size_t WS_M1    = WS_T2 + (size_t)16 * 512 * 768 * 2;
constexpr size_t WS_SS    = WS_M1 + (size_t)16 * 256 * 512 * 2;
constexpr size_t WS_HGD   = WS_SS + (size_t)MP * 16 * 4;
constexpr size_t WS_LB    = WS_HGD + (size_t)NCH64 * 6 * 2 * 64 * 4;
constexpr size_t WS_PAR   = WS_LB + al256((size_t)2 * 4 * 384 * 4);
constexpr size_t WS_END   = WS_PAR + (size_t)4 * 2 * 16 * 64 * 2 * 4;
constexpr size_t DO_HGS   = 0;
constexpr size_t DO_S5E   = DO_HGS + (size_t)NCH64 * 6 * 2 * 4096 * 4;
constexpr size_t DO_KTAB  = DO_S5E + (size_t)16 * U2ROWS * 256 * 4;
constexpr size_t DO_BBAR  = DO_KTAB + (size_t)4 * 16 * 2 * 32 * 256 * 4;
constexpr size_t DO_RGC   = DO_BBAR + (size_t)4 * 2 * 16 * 64 * 16 * 2 * 4;
constexpr size_t DO_END   = DO_RGC + (size_t)NCH64 * 2 * 384 * 2 * 4;
static_assert(DO_END <= (size_t)33554432 * 4, "d_out scratch overflow");

struct Params {
    const float* in[29];
    float* out;
    unsigned char* ws;
    int ph_lo, ph_hi;
};
enum { I_XP = 0, I_XS, I_META, I_NMIX, I_WIN, I_CONVW, I_CONVB, I_WR, I_BR, I_WI, I_BI, I_LAM, I_LBL, I_ARE, I_AIM, I_LDT, I_BRE, I_BIM, I_CRE, I_CIM,
       I_S5D, I_GLUW, I_GLUB, I_MGAIN, I_WOUT, I_NMLP, I_WUP, I_WDN, I_NFIN };

DI int ltid() { int t = threadIdx.x; asm volatile("" : "+v"(t)); return t; }
DI int lbid() { int t = blockIdx.x; asm volatile("" : "+s"(t)); return t; }
DI int lgdim() { int t = gridDim.x; asm volatile("" : "+s"(t)); return t; }
DI unsigned short f2bf(float f) { unsigned u = __float_as_uint(f); u += 0x7FFFu + ((u >> 16) & 1u); return (unsigned short)(u >> 16); }
DI float bf2f(unsigned short b) { return __uint_as_float(((unsigned)b) << 16); }
DI unsigned pack2(float lo, float hi) { return (unsigned)f2bf(lo) | ((unsigned)f2bf(hi) << 16); }
DI float bflo(unsigned w) { return __uint_as_float(w << 16); }
DI float bfhi(unsigned w) { return __uint_as_float(w & 0xFFFF0000u); }
DI float sigmoidf_(float x) { return 1.0f / (1.0f + __expf(-x)); }
DI float siluf_(float x) { return x * sigmoidf_(x); }
DI float gelu_tanh(float x) { const float u = 0.7978845608028654f * (x + 0.044715f * x * x * x); return x * sigmoidf_(2.0f * u); }
DI void unpack8(const u32x4& w, float* f) { f[0] = bflo(w.x); f[1] = bfhi(w.x); f[2] = bflo(w.y); f[3] = bfhi(w.y); f[4] = bflo(w.z); f[5] = bfhi(w.z); f[6] = bflo(w.w); f[7] = bfhi(w.w); }
DI u32x4 pack8(const float* f) { u32x4 w; w.x = pack2(f[0], f[1]); w.y = pack2(f[2], f[3]); w.z = pack2(f[4], f[5]); w.w = pack2(f[6], f[7]); return w; }

DI void row_info(int R, int& seq, int& pos) {
    if (R < ROWS_P) { seq = R / LP; pos = R - seq * LP; }
    else { const int r = R - ROWS_P; const int s = r / LS; seq = 4 + s; pos = r - s * LS; }
}
DI void seq_chunks64(int seq, int& c0, int& nc) { if (seq < 4) { c0 = seq * 65; nc = 65; } else { c0 = 260 + (seq - 4) * 33; nc = 33; } }
DI void seq_chunks32(int seq, int& c0, int& nc) { if (seq < 4) { c0 = seq * 130; nc = 130; } else { c0 = 520 + (seq - 4) * 66; nc = 66; } }
DI int chunk64_pos0(int j) { if (j < 260) return (j % 65) * 64; return ((j - 260) % 33) * 64; }
DI int chunk64_len(int j) { return j < 260 ? LP : LS; }

namespace pg8 {
constexpr int BM = 256, BK = 64, HALF = 128, HTB = HALF * BK * 2, STAGE_BYTES = 8 * HTB, NXCD = 8, WGM = 8;
__host__ __device__ __forceinline__ int lds_byte(int r, int c) { const int st = (r >> 4) * 2 + (c >> 5), rr = r & 15, cc = c & 31, ob = rr * 64 + cc * 2; return st * 1024 + (ob ^ (((ob >> 9) & 1) << 5)); }
__host__ __device__ __forceinline__ void stage_rc(int b, int& R, int& C) { const int st = b / 1024, sb = b % 1024, swz = sb ^ (((sb >> 9) & 1) << 5); R = (st >> 1) * 16 + swz / 64; C = (st & 1) * 32 + (swz % 64) / 2; }
__host__ __device__ __forceinline__ int perm32(int rho) { const int n = rho >> 4, i = rho & 15; return 8 * (i >> 2) + 4 * n + (i & 3); }
struct Unit { int pm, pn; };
struct Gemm { const bf16_t* A; const bf16_t* Bt; int K, lda, ldb;
              int mode, perm, sched, M, N;
              void* o0; void* o1; const void* i0; const void* i1; };

struct StaticOrder {
    int nM, nN, nwg, G, c;
    DI void init(int M, int N, int G_, int c_) { nM = M / BM; nN = N / BM; nwg = nM * nN; G = G_; c = c_; }
    DI bool next(int i, Unit& u) const {
        const long L = (long)i * G + c; if (L >= nwg) return false;
        int wgid = (int)L; { const int q = nwg / NXCD, r = nwg % NXCD, xcd = wgid % NXCD, off = wgid / NXCD; wgid = (xcd < r ? xcd * (q + 1) : r * (q + 1) + (xcd - r) * q) + off; }
        const int nig = WGM * nN, gid = wgid / nig, fm = gid * WGM, gsz = (nM - fm) < WGM ? (nM - fm) : WGM;
        u.pm = fm + ((wgid % nig) % gsz); u.pn = (wgid % nig) / gsz; return true;
    }
    DI void a_ready(const Unit&) const {}
    DI void done(const Unit&) const {}
};
template <int NPN> struct GroupOrder {
    int G, c;
    DI bool next(int i, Unit& u) const {
        const int L = i * G + c; if (L >= 16 * 5 * NPN) return false;
        const int g = L / (5 * NPN), r = L % (5 * NPN); u.pm = g * 5 + (r % 5); u.pn = g * NPN + (r / 5); return true;
    }
    DI void a_ready(const Unit&) const {}
    DI void done(const Unit&) const {}
};

DI unsigned cvt_pk_bf16(float lo, float hi) { unsigned r; asm volatile("v_cvt_pk_bf16_f32 %0, %1, %2" : "=v"(r) : "v"(lo), "v"(hi)); return r; }

struct AnyOrder {
    StaticOrder so; int kind, G, c;
    DI bool next(int i, Unit& u) const {
        if (kind == 0) return so.next(i, u);
        if (kind == 1) { GroupOrder<1> o{G, c}; return o.next(i, u); }
        GroupOrder<2> o{G, c}; return o.next(i, u);
    }
};
template <class EpiFn>
DI void gemm_phase(LAS unsigned char* lds, const Gemm& g, const AnyOrder& S, const EpiFn& E) {
    int tid_ = ltid();
    const int tid = tid_, wid = __builtin_amdgcn_readfirstlane(tid >> 6), lane = tid & 63, wr = wid >> 2, wc = wid & 3, fr = lane & 15, fq = lane >> 4;
    const int K = g.K, nt = K / BK;
    unsigned voffA[2], voffB[2];
#pragma unroll
    for (int i = 0; i < 2; ++i) { int R, C; stage_rc(tid * 16 + i * 8192, R, C); const int Rb = g.perm ? ((R & ~31) + perm32(R & 31)) : R;
        voffA[i] = (unsigned)(R * g.lda + C) * 2u; voffB[i] = (unsigned)(Rb * g.ldb + C) * 2u; }
    const size_t kstep = (size_t)(BK * 2);
    const size_t hstepA = (size_t)HALF * g.lda * 2, hstepB = (size_t)HALF * g.ldb * 2;
    const size_t tstepA = 2 * hstepA, tstepB = 2 * hstepB;
    const unsigned ldsw = (unsigned)wid * 1024u;
    const int aoff = lds_byte(wr * 64 + fr, fq * 8), boff = lds_byte(wc * 32 + fr, fq * 8);
#define PG8_SA(b, h) (((b) * 2 + (h)) * HTB)
#define PG8_SB(b, h) ((4 + (b) * 2 + (h)) * HTB)
#define PG8_STAGE(bufoff, gbase, voff) do { _Pragma("unroll") for (int _i = 0; _i < 2; ++_i) \
        __builtin_amdgcn_global_load_lds((const unsigned*)((const char*)(gbase) + (voff)[_i]), (LAS unsigned*)(lds + (bufoff) + ldsw + _i * 8192), 16, 0, 0); } while (0)
#define PG8_LDA(dst, b, h) do { _Pragma("unroll") for (int m = 0; m < 4; ++m) _Pragma("unroll") for (int k = 0; k < 2; ++k) dst[m][k] = *(const LAS bf16x8*)(lds + PG8_SA(b, h) + aoff + m * 2048 + k * 1024); } while (0)
#define PG8_LDB(dst, b, h) do { _Pragma("unroll") for (int n = 0; n < 2; ++n) _Pragma("unroll") for (int k = 0; k < 2; ++k) dst[n][k] = *(const LAS bf16x8*)(lds + PG8_SB(b, h) + boff + n * 2048 + k * 1024); } while (0)
#define PG8_MMA(ai, bj, At, Bt) do { __builtin_amdgcn_s_setprio(1); _Pragma("unroll") for (int m = 0; m < 4; ++m) _Pragma("unroll") for (int n = 0; n < 2; ++n) _Pragma("unroll") for (int k = 0; k < 2; ++k) \
        acc[ai][bj][m][n] = __builtin_amdgcn_mfma_f32_16x16x32_bf16(Bt[n][k], At[m][k], acc[ai][bj][m][n], 0, 0, 0); __builtin_amdgcn_s_setprio(0); } while (0)
#define PG8_WAIT_V(n) asm volatile("s_waitcnt vmcnt(" #n ")" ::: "memory")
#define PG8_WAIT_L(n) asm volatile("s_waitcnt lgkmcnt(" #n ")" ::: "memory")
#define PG8_BAR __builtin_amdgcn_s_barrier()
#define PG8_SCHED __builtin_amdgcn_sched_barrier(0)
    Unit cur, nxt; int ui = 0;
    if (!S.next(0, cur)) return;
    f32x4 acc[2][2][4][2];
#pragma unroll
    for (int a = 0; a < 2; ++a)
#pragma unroll
        for (int b = 0; b < 2; ++b)
#pragma unroll
            for (int m = 0; m < 4; ++m)
#pragma unroll
                for (int n = 0; n < 2; ++n) acc[a][b][m][n] = (f32x4){0.f, 0.f, 0.f, 0.f};
    bf16x8 At[4][2], B0[2][2], B1[2][2];
    const char* cA = (const char*)g.A + (size_t)cur.pm * tstepA; const char* cB = (const char*)g.Bt + (size_t)cur.pn * tstepB;
    PG8_STAGE(PG8_SB(0, 0), cB, voffB); PG8_STAGE(PG8_SA(0, 0), cA, voffA); PG8_STAGE(PG8_SB(0, 1), cB + hstepB, voffB); PG8_STAGE(PG8_SA(0, 1), cA + hstepA, voffA);
    if (wr == 1) PG8_BAR;
    PG8_WAIT_V(4); PG8_BAR;
    PG8_STAGE(PG8_SB(1, 0), cB + kstep, voffB); PG8_STAGE(PG8_SA(1, 0), cA + kstep, voffA); PG8_STAGE(PG8_SB(1, 1), cB + hstepB + kstep, voffB);
    PG8_WAIT_V(6); PG8_BAR;
    for (;;) {
        const bool has_next = S.next(ui + 1, nxt);
        const char* nA = has_next ? (const char*)g.A + (size_t)nxt.pm * tstepA : cA; const char* nB = has_next ? (const char*)g.Bt + (size_t)nxt.pn * tstepB : cB;
        for (int t = 0; t < nt; t += 2) {
            const bool last = (t == nt - 2);
            const char* a1 = cA + (size_t)(t + 1) * kstep;
            const char* a2 = last ? nA : cA + (size_t)(t + 2) * kstep; const char* b2 = last ? nB : cB + (size_t)(t + 2) * kstep;
            const char* a3 = a2 + kstep; const char* b3 = b2 + kstep;
            PG8_LDB(B0, 0, 0); PG8_SCHED; PG8_LDA(At, 0, 0); PG8_STAGE(PG8_SA(1, 1), a1 + hstepA, voffA);
            PG8_WAIT_L(8); PG8_BAR; PG8_WAIT_L(0); PG8_MMA(0, 0, At, B0); PG8_BAR; PG8_SCHED;
            PG8_LDB(B1, 0, 1); PG8_STAGE(PG8_SB(0, 0), b2, voffB);
            PG8_BAR; PG8_WAIT_L(0); PG8_MMA(0, 1, At, B1); PG8_BAR;
            PG8_LDA(At, 0, 1); PG8_STAGE(PG8_SA(0, 0), a2, voffA);
            PG8_BAR; PG8_WAIT_L(0); PG8_MMA(1, 0, At, B0); PG8_BAR; PG8_SCHED;
            PG8_STAGE(PG8_SB(0, 1), b2 + hstepB, voffB);
            PG8_WAIT_V(6); PG8_BAR; PG8_MMA(1, 1, At, B1); PG8_BAR;
            PG8_LDB(B0, 1, 0); PG8_SCHED; PG8_LDA(At, 1, 0); PG8_STAGE(PG8_SA(0, 1), a2 + hstepA, voffA);
            PG8_WAIT_L(8); PG8_BAR; PG8_WAIT_L(0); PG8_MMA(0, 0, At, B0); PG8_BAR; PG8_SCHED;
            PG8_LDB(B1, 1, 1); PG8_STAGE(PG8_SB(1, 0), b3, voffB);
            PG8_BAR; PG8_WAIT_L(0); PG8_MMA(0, 1, At, B1); PG8_BAR;
            PG8_LDA(At, 1, 1); PG8_STAGE(PG8_SA(1, 0), a3, voffA);
            PG8_BAR; PG8_WAIT_L(0); PG8_MMA(1, 0, At, B0); PG8_BAR; PG8_SCHED;
            PG8_STAGE(PG8_SB(1, 1), b3 + hstepB, voffB);
            PG8_WAIT_V(6); PG8_BAR; PG8_MMA(1, 1, At, B1); PG8_BAR;
        }
        E(acc, cur, wr, wc, fr, fq);
        if (!has_next) break;
#pragma unroll
        for (int a = 0; a < 2; ++a)
#pragma unroll
            for (int b = 0; b < 2; ++b)
#pragma unroll
                for (int m = 0; m < 4; ++m)
#pragma unroll
                    for (int n = 0; n < 2; ++n) acc[a][b][m][n] = (f32x4){0.f, 0.f, 0.f, 0.f};
        cur = nxt; cA = nA; cB = nB; ++ui;
    }
    PG8_WAIT_V(0);
    if (wr == 0) PG8_BAR;
    PG8_BAR;
#undef PG8_SA
#undef PG8_SB
#undef PG8_STAGE
#undef PG8_LDA
#undef PG8_LDB
#undef PG8_MMA
#undef PG8_WAIT_V
#undef PG8_WAIT_L
#undef PG8_BAR
#undef PG8_SCHED
}
}
using pg8::Unit;

struct EpiInProj {
    static constexpr bool PERM = true;
    bf16_t* PROJ; bf16_t* U2;
    DI void operator()(const f32x4 (&acc)[2][2][4][2], const Unit& u, int wr, int wc, int fr, int fq) const {
        const int row0 = u.pm * 256 + wr * 64 + fr;
#pragma unroll
        for (int ai = 0; ai < 2; ++ai)
#pragma unroll
            for (int m = 0; m < 4; ++m) {
                const int r = row0 + ai * 128 + m * 16;
#pragma unroll
                for (int bj = 0; bj < 2; ++bj) {
                    const f32x4 v0 = acc[ai][bj][m][0], v1 = acc[ai][bj][m][1];
                    u32x4 w; w.x = pg8::cvt_pk_bf16(v0[0], v0[1]); w.y = pg8::cvt_pk_bf16(v0[2], v0[3]); w.z = pg8::cvt_pk_bf16(v1[0], v1[1]); w.w = pg8::cvt_pk_bf16(v1[2], v1[3]);
                    const int cl = bj * 128 + wc * 32 + 8 * fq;
                    if (u.pn == 0) { const int g = cl >> 4, h = cl & 15; *(u32x4*)(U2 + ((size_t)(g * U2ROWS + (r >> 5)) * U2LD + (r & 31) * 16 + h)) = w; }
                    else *(u32x4*)(PROJ + (size_t)r * PLD + (u.pn - 1) * 256 + cl) = w;
                }
                __builtin_amdgcn_sched_barrier(0);
            }
    }
};
struct EpiResAdd {
    static constexpr bool PERM = false;
    float* H;
    DI void operator()(const f32x4 (&acc)[2][2][4][2], const Unit& u, int wr, int wc, int fr, int fq) const {
        const int row0 = u.pm * 256 + wr * 64 + fr, col0 = u.pn * 256 + wc * 32 + 4 * fq;
#pragma unroll
        for (int ai = 0; ai < 2; ++ai)
#pragma unroll
            for (int m = 0; m < 4; ++m) { float* rowp = H + (size_t)(row0 + ai * 128 + m * 16) * D + col0;
#pragma unroll
                for (int bj = 0; bj < 2; ++bj)
#pragma unroll
                    for (int n = 0; n < 2; ++n) { f32x4* q = (f32x4*)(rowp + bj * 128 + n * 16); *q = *q + acc[ai][bj][m][n]; } }
    }
};
struct EpiRelu2 {
    static constexpr bool PERM = true;
    bf16_t* FF;
    DI void operator()(const f32x4 (&acc)[2][2][4][2], const Unit& u, int wr, int wc, int fr, int fq) const {
        const int row0 = u.pm * 256 + wr * 64 + fr, col0 = u.pn * 256 + wc * 32 + 8 * fq;
#pragma unroll
        for (int ai = 0; ai < 2; ++ai)
#pragma unroll
            for (int m = 0; m < 4; ++m) { bf16_t* rowp = FF + (size_t)(row0 + ai * 128 + m * 16) * DFF + col0;
#pragma unroll
                for (int bj = 0; bj < 2; ++bj) { f32x4 v0 = acc[ai][bj][m][0], v1 = acc[ai][bj][m][1];
#pragma unroll
                    for (int j = 0; j < 4; ++j) { const float a = fmaxf(v0[j], 0.f), b = fmaxf(v1[j], 0.f); v0[j] = a * a; v1[j] = b * b; }
                    u32x4 w; w.x = pg8::cvt_pk_bf16(v0[0], v0[1]); w.y = pg8::cvt_pk_bf16(v0[2], v0[3]); w.z = pg8::cvt_pk_bf16(v1[0], v1[1]); w.w = pg8::cvt_pk_bf16(v1[2], v1[3]);
                    *(u32x4*)(rowp + bj * 128) = w; } }
    }
};
struct EpiS5E {
    static constexpr bool PERM = false;
    float* E;
    DI void operator()(const f32x4 (&acc)[2][2][4][2], const Unit& u, int wr, int wc, int fr, int fq) const {
        const int row0 = u.pm * 256 + wr * 64 + fr, col0 = wc * 32 + 4 * fq;
#pragma unroll
        for (int ai = 0; ai < 2; ++ai)
#pragma unroll
            for (int m = 0; m < 4; ++m) { float* rowp = E + (size_t)(row0 + ai * 128 + m * 16) * 256 + col0;
#pragma unroll
                for (int bj = 0; bj < 2; ++bj)
#pragma unroll
                    for (int n = 0; n < 2; ++n) *(f32x4*)(rowp + bj * 128 + n * 16) = acc[ai][bj][m][n]; }
    }
};
struct EpiS5Y {
    static constexpr bool PERM = true;
    const bf16_t* U2; bf16_t* Z; const float* dskip;
    DI void operator()(const f32x4 (&acc)[2][2][4][2], const Unit& u, int wr, int wc, int fr, int fq) const {
        const int g = u.pm / 5, pml = u.pm - g * 5, pnl = u.pn - g * 2;
#pragma unroll
        for (int ai = 0; ai < 2; ++ai)
#pragma unroll
            for (int m = 0; m < 4; ++m) {
                const int chunk = pml * 256 + ai * 128 + wr * 64 + m * 16 + fr;
                if (chunk < NCH32) {
#pragma unroll
                    for (int bj = 0; bj < 2; ++bj) {
                        const int n0 = pnl * 256 + bj * 128 + wc * 32 + 8 * fq;
                        const int t = n0 >> 4, h0 = n0 & 15;
                        const u32x4 uw = *(const u32x4*)(U2 + ((size_t)(g * U2ROWS + chunk) * U2LD + n0));
                        float uf[8]; unpack8(uw, uf);
                        const f32x4 v0 = acc[ai][bj][m][0], v1 = acc[ai][bj][m][1];
                        float y[8];
#pragma unroll
                        for (int j = 0; j < 4; ++j) { y[j] = v0[j]; y[4 + j] = v1[j]; }
#pragma unroll
                        for (int j = 0; j < 8; ++j) y[j] = gelu_tanh(y[j] + dskip[g * 16 + h0 + j] * uf[j]);
                        *(u32x4*)(Z + ((size_t)(chunk * 32 + t) * 256 + g * 16 + h0)) = pack8(y);
                        __builtin_amdgcn_sched_barrier(0);
                    }
                }
            }
    }
};
struct EpiGlu {
    static constexpr bool PERM = true;
    const bf16_t* Z; bf16_t* YM; float* SS; const float* glub;
    DI void operator()(const f32x4 (&acc)[2][2][4][2], const Unit& u, int wr, int wc, int fr, int fq) const {
        const int row0 = u.pm * 256 + wr * 64 + fr;
#pragma unroll
        for (int ai = 0; ai < 2; ++ai)
#pragma unroll
            for (int m = 0; m < 4; ++m) {
                const int r = row0 + ai * 128 + m * 16;
                int seq, pos; row_info(r, seq, pos);
                const bool valid = pos >= PADR;
                float ssum = 0.f;
#pragma unroll
                for (int bj = 0; bj < 2; ++bj) {
                    const int c0 = bj * 128 + wc * 32 + 8 * fq;
                    const u32x4 zw = *(const u32x4*)(Z + (size_t)r * 256 + c0);
                    float zf[8]; unpack8(zw, zf);
                    const f32x4 v0 = acc[ai][bj][m][0], v1 = acc[ai][bj][m][1];
                    float y[8];
#pragma unroll
                    for (int j = 0; j < 4; ++j) { y[j] = v0[j]; y[4 + j] = v1[j]; }
#pragma unroll
                    for (int j = 0; j < 8; ++j) { const float o = valid ? zf[j] * sigmoidf_(y[j] + glub[c0 + j]) : 0.f; y[j] = o; ssum += o * o; }
                    *(u32x4*)(YM + (size_t)r * D + 768 + c0) = pack8(y);
                    __builtin_amdgcn_sched_barrier(0);
                }
                ssum += __shfl_xor(ssum, 16); ssum += __shfl_xor(ssum, 32);
                if (fq == 0) SS[(size_t)r * 16 + 12 + wc] = ssum;
            }
    }
};

DI f32x4 mma_tile64(const bf16_t* A, const bf16_t* Bt, int ld, int lane, f32x4 acc) {
    const int r = lane & 15, q = lane >> 4;
#pragma unroll
    for (int ks = 0; ks < 2; ++ks) {
        const bf16x8 a = *(const bf16x8*)(A + r * ld + ks * 32 + q * 8);
        const bf16x8 b = *(const bf16x8*)(Bt + r * ld + ks * 32 + q * 8);
        acc = __builtin_amdgcn_mfma_f32_16x16x32_bf16(a, b, acc, 0, 0, 0);
    }
    return acc;
}

DI void phase_prep(const Params& p, unsigned char* lds) {
    const int tid = ltid();
    float* LB = (float*)(p.ws + WS_LB);
    for (int i = lbid() * 512 + tid; i < 2 * 384; i += lgdim() * 512) {
        const int d = i / 384, c = i % 384;
        float lg[4], mx = -1e30f;
#pragma unroll
        for (int l = 0; l < 4; ++l) { lg[l] = p.in[I_LBL][(d * 4 + l) * 384 + c]; mx = fmaxf(mx, lg[l]); }
        float s = 0.f;
#pragma unroll
        for (int l = 0; l < 4; ++l) { lg[l] = expf(lg[l] - mx); s += lg[l]; }
        float cum = 0.f;
#pragma unroll
        for (int l = 0; l < 4; ++l) { if (l > 0) cum += lg[l] / s; LB[(d * 4 + l) * 384 + c] = cum; }
    }
    float* PAR = (float*)(p.ws + WS_PAR);
    float* KTAB = (float*)((unsigned char*)p.out + DO_KTAB);
    float* BBAR = (float*)((unsigned char*)p.out + DO_BBAR);
    float* sAR = (float*)lds;
    float* sAI = sAR + 64;
    float* sBB = sAI + 64;
    float* sC  = sBB + 2048;
    float* sW  = sC + 2048;
    for (int item = lbid(); item < 4 * 16 * 2; item += lgdim()) {
        const int l = item / 32, g = (item / 2) % 16, d = item % 2;
        const int base = ((l * 2 + d) * 16 + g);
        const float dt = expf(p.in[I_LDT][base]);
        __syncthreads();
        if (tid < 64) {
            const float lr = p.in[I_ARE][base * 64 + tid], li = p.in[I_AIM][base * 64 + tid];
            const float ar = lr * dt, ai = li * dt;
            sAR[tid] = ar; sAI[tid] = ai;
            PAR[(base * 64 + tid) * 2 + 0] = ar; PAR[(base * 64 + tid) * 2 + 1] = ai;
        }
        __syncthreads();
        for (int e = tid; e < 1024; e += 512) {
            const int pp = e >> 4, h = e & 15;
            const float ar = sAR[pp], ai = sAI[pp];
            const float lr = p.in[I_ARE][base * 64 + pp], li = p.in[I_AIM][base * 64 + pp];
            float sn, cs; sincosf(ai, &sn, &cs);
            const float em1 = expm1f(ar), ex = em1 + 1.0f;
            const float sh = sinf(0.5f * ai);
            const float x = em1 * cs - 2.0f * sh * sh, y = ex * sn;
            const float den = lr * lr + li * li;
            const float cr = (x * lr + y * li) / den, ci = (y * lr - x * li) / den;
            const float br = p.in[I_BRE][(size_t)(base * 64 + pp) * 16 + h], bi = p.in[I_BIM][(size_t)(base * 64 + pp) * 16 + h];
            const float rr = cr * br - ci * bi, ri = cr * bi + ci * br;
            sBB[e * 2] = rr; sBB[e * 2 + 1] = ri;
            BBAR[((size_t)(base * 64 + pp) * 16 + h) * 2] = rr; BBAR[((size_t)(base * 64 + pp) * 16 + h) * 2 + 1] = ri;
        }
        for (int e = tid; e < 1024; e += 512) {
            sC[e * 2] = p.in[I_CRE][(size_t)base * 1024 + e]; sC[e * 2 + 1] = p.in[I_CIM][(size_t)base * 1024 + e];
        }
        __syncthreads();
_Pragma("nounroll")
        for (int tau = 0; tau < 32; ++tau) {
            if (tid < 64) { const float mg = expf(tau * sAR[tid]); float sn, cs; sincosf(tau * sAI[tid], &sn, &cs); sW[tid * 2] = mg * cs; sW[tid * 2 + 1] = mg * sn; }
            __syncthreads();
            if (tid < 256) {
                const int hp = tid >> 4, h = tid & 15;
                float s = 0.f;
_Pragma("unroll 4")
                for (int pp = 0; pp < 64; ++pp) {
                    const float wr_ = sW[pp * 2], wi_ = sW[pp * 2 + 1];
                    const float br = sBB[(pp * 16 + h) * 2], bi = sBB[(pp * 16 + h) * 2 + 1];
                    const float tr = wr_ * br - wi_ * bi, ti = wr_ * bi + wi_ * br;
                    const float cr = sC[(hp * 64 + pp) * 2], ci = sC[(hp * 64 + pp) * 2 + 1];
                    s += cr * tr - ci * ti;
                }
                KTAB[((size_t)((l * 16 + g) * 2 + d) * 32 + tau) * 256 + tid] = s;
            }
            __syncthreads();
        }
    }
}

DI void norm_rows(const Params& p, bool zero_ss, bool build, const float* gain) {
    const int tid = ltid(); const int lane = tid & 63, wave = tid >> 6;
    float* H = (float*)(p.ws + WS_H); bf16_t* ACT = (bf16_t*)(p.ws + WS_ACT); float* SS = (float*)(p.ws + WS_SS);
    for (int R = lbid() * 8 + wave; R < MP; R += lgdim() * 8) {
        f32x4 v[4];
        float* hr = H + (size_t)R * D;
        if (build) {
            int seq, pos; row_info(R, seq, pos);
            const int t = pos - PADR;
            const float* src = nullptr;
            if (t >= 0) { if (t < 16) src = p.in[I_META] + (size_t)t * D; else src = (seq < 4) ? p.in[I_XP] + ((size_t)seq * 4096 + (t - 16)) * D : p.in[I_XS] + ((size_t)(seq - 4) * 2048 + (t - 16)) * D; }
#pragma unroll
            for (int i = 0; i < 4; ++i) { v[i] = src ? *(const f32x4*)(src + (lane + 64 * i) * 4) : (f32x4){0.f, 0.f, 0.f, 0.f}; *(f32x4*)(hr + (lane + 64 * i) * 4) = v[i]; }
        } else {
#pragma unroll
            for (int i = 0; i < 4; ++i) v[i] = *(const f32x4*)(hr + (lane + 64 * i) * 4);
        }
        float ss = 0.f;
#pragma unroll
        for (int i = 0; i < 4; ++i) ss += v[i][0] * v[i][0] + v[i][1] * v[i][1] + v[i][2] * v[i][2] + v[i][3] * v[i][3];
#pragma unroll
        for (int o = 1; o < 64; o <<= 1) ss += __shfl_xor(ss, o);
        const float rn = rsqrtf(ss * (1.0f / D) + EPS);
#pragma unroll
        for (int i = 0; i < 4; ++i) {
            const f32x4 gg = *(const f32x4*)(gain + (lane + 64 * i) * 4);
            u32x2 w; w.x = pack2(v[i][0] * rn * gg[0], v[i][1] * rn * gg[1]); w.y = pack2(v[i][2] * rn * gg[2], v[i][3] * rn * gg[3]);
            *(u32x2*)(ACT + (size_t)R * D + (lane + 64 * i) * 4) = w;
        }
    }
}

DI void tr_tile(const float* src, int lds_, bf16_t* dst, int ldd, float* tile) {
    const int tid = ltid();
    __syncthreads();
    { const int r = tid >> 4, c4 = (tid & 15) * 4;
#pragma unroll
      for (int rr = 0; rr < 64; rr += 32) { const f32x4 v = *(const f32x4*)(src + (size_t)(r + rr) * lds_ + c4); float* tp = tile + (r + rr) * 65 + c4; tp[0] = v[0]; tp[1] = v[1]; tp[2] = v[2]; tp[3] = v[3]; } }
    __syncthreads();
    { const int n = tid >> 3, k8 = (tid & 7) * 8; float f[8];
#pragma unroll
      for (int i = 0; i < 8; ++i) f[i] = tile[(k8 + i) * 65 + n];
      *(u32x4*)(dst + (size_t)n * ldd + k8) = pack8(f); }
}

DI void convert_weights(const Params& p, int l, unsigned char* lds) {
    float* tile = (float*)lds;
    bf16_t* WIN = (bf16_t*)(p.ws + WS_WIN); bf16_t* WOUT = (bf16_t*)(p.ws + WS_WOUT); bf16_t* WUP = (bf16_t*)(p.ws + WS_WUP); bf16_t* WDN = (bf16_t*)(p.ws + WS_WDN);
    bf16_t* WG = (bf16_t*)(p.ws + WS_WG); bf16_t* GLU = (bf16_t*)(p.ws + WS_GLU);
    const int T_IN = 16 * 46, T_OUT = 16 * 16, T_UP = 16 * 64, T_DN = 64 * 16, T_WG = 24, T_GLU = 16;
    const int total = T_IN + T_OUT + T_UP + T_DN + T_WG + T_GLU;
    for (int it = lbid(); it < total; it += lgdim()) {
        int i = it;
        if (i < T_IN) { const int kt = i / 46, nt = i % 46;
            const int n0 = nt * 64; const int nd = (n0 >= 2688) ? n0 - 2688 : n0 + 256;
            tr_tile(p.in[I_WIN] + (size_t)l * 1024 * 2944 + (size_t)kt * 64 * 2944 + n0, 2944, WIN + (size_t)nd * 1024 + kt * 64, 1024, tile); continue; }
        i -= T_IN;
        if (i < T_OUT) { const int kt = i / 16, nt = i % 16;
            tr_tile(p.in[I_WOUT] + (size_t)l * 1024 * 1024 + (size_t)kt * 64 * 1024 + nt * 64, 1024, WOUT + (size_t)nt * 64 * 1024 + kt * 64, 1024, tile); continue; }
        i -= T_OUT;
        if (i < T_UP) { const int kt = i / 64, nt = i % 64;
            tr_tile(p.in[I_WUP] + (size_t)l * 1024 * 4096 + (size_t)kt * 64 * 4096 + nt * 64, 4096, WUP + (size_t)nt * 64 * 1024 + kt * 64, 1024, tile); continue; }
        i -= T_UP;
        if (i < T_DN) { const int kt = i / 16, nt = i % 16;
            tr_tile(p.in[I_WDN] + (size_t)l * 4096 * 1024 + (size_t)kt * 64 * 1024 + nt * 64, 1024, WDN + (size_t)nt * 64 * 4096 + kt * 64, 4096, tile); continue; }
        i -= T_DN;
        if (i < T_WG) { const int n = i / 4, gi = i % 4, d = gi >> 1;
            const float* src = ((gi & 1) ? p.in[I_WI] : p.in[I_WR]) + ((size_t)((l * 2 + d) * 6 + n)) * 4096;
            tr_tile(src, 64, WG + (size_t)(n * 256 + gi * 64) * 64, 64, tile); continue; }
        i -= T_WG;
        { const int kt = i / 4, nt = i % 4;
          tr_tile(p.in[I_GLUW] + (size_t)l * 65536 + (size_t)kt * 64 * 256 + nt * 64, 256, GLU + (size_t)nt * 64 * 256 + kt * 64, 256, tile); }
    }
    for (size_t e = (size_t)lbid() * 512 + ltid(); e < (size_t)128 * 1024 / 8; e += (size_t)lgdim() * 512) *(u32x4*)(WIN + (size_t)2944 * 1024 + e * 8) = (u32x4){0u, 0u, 0u, 0u};
}

DI void build_s5_mats(const Params& p, int l) {
    const float* KTAB = (const float*)((const unsigned char*)p.out + DO_KTAB);
    const float* BBAR = (const float*)((const unsigned char*)p.out + DO_BBAR);
    const float* PAR = (const float*)(p.ws + WS_PAR);
    bf16_t* T2 = (bf16_t*)(p.ws + WS_T2); bf16_t* M1 = (bf16_t*)(p.ws + WS_M1);
    const size_t nT2 = (size_t)16 * 512 * 96, nM1 = (size_t)16 * 256 * 64;
    for (size_t e = (size_t)lbid() * 512 + ltid(); e < nT2 + nM1; e += (size_t)lgdim() * 512) {
        float f[8];
        if (e < nT2) {
            const int g = (int)(e / (512 * 96)), rem = (int)(e % (512 * 96)), n = rem / 96, k0 = (rem % 96) * 8;
            const int t = n >> 4, hp = n & 15;
            if (k0 < 512) {
                const int s = k0 >> 4, h0 = k0 & 15;
#pragma unroll
                for (int j = 0; j < 8; ++j) {
                    float v = 0.f;
                    if (s <= t) v += KTAB[((size_t)((l * 16 + g) * 2 + 0) * 32 + (t - s)) * 256 + hp * 16 + h0 + j];
                    if (s >= t) v += KTAB[((size_t)((l * 16 + g) * 2 + 1) * 32 + (s - t)) * 256 + hp * 16 + h0 + j];
                    f[j] = v;
                }
            } else {
                const int kk = k0 - 512, d = kk >> 7, part = (kk >> 6) & 1, p0 = kk & 63;
                const int base = (l * 2 + d) * 16 + g;
                const float pw = d == 0 ? (float)(t + 1) : (float)(32 - t);
#pragma unroll
                for (int j = 0; j < 8; ++j) {
                    const int pp = p0 + j;
                    const float ar = PAR[(base * 64 + pp) * 2], ai = PAR[(base * 64 + pp) * 2 + 1];
                    const float mg = expf(pw * ar); float sn, cs; sincosf(pw * ai, &sn, &cs);
                    const float wr_ = mg * cs, wi_ = mg * sn;
                    const float cr = p.in[I_CRE][(size_t)base * 1024 + hp * 64 + pp], ci = p.in[I_CIM][(size_t)base * 1024 + hp * 64 + pp];
                    f[j] = part == 0 ? (cr * wr_ - ci * wi_) : -(cr * wi_ + ci * wr_);
                }
            }
            *(u32x4*)(T2 + ((size_t)(g * 512 + n) * 768 + k0)) = pack8(f);
        } else {
            const size_t e2 = e - nT2;
            const int g = (int)(e2 / (256 * 64)), rem = (int)(e2 % (256 * 64)), n = rem / 64, k0 = (rem % 64) * 8;
            const int d = n >> 7, part = (n >> 6) & 1, pp = n & 63;
            const int s = k0 >> 4, h0 = k0 & 15;
            const int base = (l * 2 + d) * 16 + g;
            const float pw = d == 0 ? (float)(31 - s) : (float)s;
            const float ar = PAR[(base * 64 + pp) * 2], ai = PAR[(base * 64 + pp) * 2 + 1];
            const float mg = expf(pw * ar); float sn, cs; sincosf(pw * ai, &sn, &cs);
            const float wr_ = mg * cs, wi_ = mg * sn;
#pragma unroll
            for (int j = 0; j < 8; ++j) {
                const float br = BBAR[((size_t)(base * 64 + pp) * 16 + h0 + j) * 2], bi = BBAR[((size_t)(base * 64 + pp) * 16 + h0 + j) * 2 + 1];
                f[j] = part == 0 ? (wr_ * br - wi_ * bi) : (wr_ * bi + wi_ * br);
            }
            *(u32x4*)(M1 + ((size_t)(g * 256 + n) * 512 + k0)) = pack8(f);
        }
    }
}

DI void rg_item(const Params& p, int l, int item, bool fin, unsigned char* lds) {
    const int tid = ltid(), lane = tid & 63, wave = tid >> 6;
    const int j = item / 6, n = item % 6;
    const int row0 = j * 64, pos0 = chunk64_pos0(j), L = chunk64_len(j);
    const bf16_t* PROJ = (const bf16_t*)(p.ws + WS_PROJ);
    float* XCF = (float*)lds;
    float* AB = (float*)(lds + 16384);
    bf16_t* WGs = (bf16_t*)(lds + 16384);
    bf16_t* XCB = (bf16_t*)(lds + 16384 + 36864);
    bf16_t* XA = (bf16_t*)(lds + 16384 + 36864 + 9216);
    bf16_t* GA = (bf16_t*)(lds + 16384 + 65536);
    const bf16_t* WG = (const bf16_t*)(p.ws + WS_WG);
    __syncthreads();
    for (int idx = tid; idx < 67 * 8; idx += 512) {
        const int rr = idx >> 3, c8 = (idx & 7) * 8;
        const int pos = pos0 + rr - 2;
        u32x4 w = (u32x4){0u, 0u, 0u, 0u};
        if (pos >= PADR && pos < L) w = *(const u32x4*)(PROJ + (size_t)(row0 + rr - 2) * PLD + OFF_AX + n * 64 + c8);
        *(u32x4*)(XA + rr * 64 + c8) = w;
    }
    for (int idx = tid; idx < 256 * 8; idx += 512) { const int r = idx >> 3, c8 = (idx & 7) * 8; *(u32x4*)(WGs + r * 72 + c8) = *(const u32x4*)(WG + (size_t)(n * 256 + r) * 64 + c8); }
    if (fin) { const int t = tid >> 3, c8 = (tid & 7) * 8; *(u32x4*)(GA + t * 64 + c8) = *(const u32x4*)(PROJ + (size_t)(row0 + t) * PLD + OFF_AG + n * 64 + c8); }
    __syncthreads();
    { const int t = tid >> 3, c8 = (tid & 7) * 8;
      const float* cw = p.in[I_CONVW] + (size_t)l * 4 * 384 + n * 64 + c8; const float* cb = p.in[I_CONVB] + (size_t)l * 384 + n * 64 + c8;
      float xc[8];
#pragma unroll
      for (int i = 0; i < 8; ++i) { float s = cb[i];
#pragma unroll
          for (int jj = 0; jj < 4; ++jj) s += cw[jj * 384 + i] * bf2f(XA[(t + jj) * 64 + c8 + i]);
          xc[i] = s; XCF[t * 64 + c8 + i] = s; }
      *(u32x4*)(XCB + t * 72 + c8) = pack8(xc); }
    __syncthreads();
    const int rb = wave & 3, dir = wave >> 2;
    f32x4 acc[8];
#pragma unroll
    for (int c = 0; c < 8; ++c) acc[c] = mma_tile64(XCB + rb * 16 * 72, WGs + (dir * 8 + c) * 16 * 72, 72, lane, (f32x4){0.f, 0.f, 0.f, 0.f});
    __syncthreads();
    { const int cl = lane & 15, q = lane >> 4;
#pragma unroll
      for (int cc = 0; cc < 4; ++cc) {
          const int c = cc * 16 + cl, ch = n * 64 + c;
          const float brv = p.in[I_BR][(size_t)(l * 2 + dir) * 384 + ch], biv = p.in[I_BI][(size_t)(l * 2 + dir) * 384 + ch];
          const float lam = p.in[I_LAM][(size_t)(l * 2 + dir) * 384 + ch];
          const float sp = log1pf(__expf(-lam));
#pragma unroll
          for (int jj = 0; jj < 4; ++jj) {
              const int t = rb * 16 + q * 4 + jj;
              const float r = sigmoidf_(acc[cc][jj] + brv), ig = sigmoidf_(acc[cc + 4][jj] + biv);
              const float la = -8.0f * r * sp;
              float a = __expf(la), b = sqrtf(fmaxf(-expm1f(2.0f * la), 0.f)) * ig * XCF[t * 64 + c];
              if (pos0 + t < PADR) { a = 1.0f; b = 0.f; }
              AB[(dir * 2) * 4096 + t * 64 + c] = a; AB[(dir * 2 + 1) * 4096 + t * 64 + c] = b;
          } } }
    __syncthreads();
    float* RGC = (float*)((unsigned char*)p.out + DO_RGC);
    if (tid < 128) {
        const int c = tid & 63, d = tid >> 6, ch = n * 64 + c;
        float* cp = RGC + ((size_t)(j * 2 + d) * 384 + ch) * 2;
        const float* Aa = AB + (d * 2) * 4096 + c; float* Bb = AB + (d * 2 + 1) * 4096 + c;
        if (!fin) {
            float P = 1.f, E = 0.f;
            if (d == 0) {
_Pragma("unroll 8")
 for (int t = 0; t < 64; ++t) { const float a = Aa[t * 64]; E = a * E + Bb[t * 64]; P *= a; } }
            else {
_Pragma("unroll 8")
 for (int t = 63; t >= 0; --t) { const float a = Aa[t * 64]; E = a * E + Bb[t * 64]; P *= a; } }
            cp[0] = P; cp[1] = E;
        } else {
            float h = cp[1];
            if (d == 0) {
_Pragma("unroll 8")
 for (int t = 0; t < 64; ++t) { h = Aa[t * 64] * h + Bb[t * 64]; Bb[t * 64] = h; } }
            else {
_Pragma("unroll 8")
 for (int t = 63; t >= 0; --t) { h = Aa[t * 64] * h + Bb[t * 64]; Bb[t * 64] = h; } }
        }
    }
    if (!fin) return;
    __syncthreads();
    { const int t = tid >> 3, c8 = (tid & 7) * 8;
      bf16_t* YM = (bf16_t*)(p.ws + WS_ACT); float* SS = (float*)(p.ws + WS_SS);
      const bool valid = pos0 + t >= PADR;
      float y[8], ss = 0.f;
#pragma unroll
      for (int i = 0; i < 8; ++i) { const int c = c8 + i; const float hs = AB[1 * 4096 + t * 64 + c] + AB[3 * 4096 + t * 64 + c];
          const float o = valid ? hs * gelu_tanh(bf2f(GA[t * 64 + c])) : 0.f; y[i] = o; ss += o * o; }
      *(u32x4*)(YM + (size_t)(row0 + t) * D + n * 64 + c8) = pack8(y);
      ss += __shfl_xor(ss, 1); ss += __shfl_xor(ss, 2); ss += __shfl_xor(ss, 4);
      if ((tid & 7) == 0) SS[(size_t)(row0 + t) * 16 + n] = ss; }
}

DI void hg_item(const Params& p, int l, int item, bool fin, unsigned char* lds) {
    const int tid = ltid(), lane = tid & 63, wave = tid >> 6;
    const int j = item / 6, n = item % 6;
    const int row0 = j * 64, pos0 = chunk64_pos0(j);
    const bf16_t* PROJ = (const bf16_t*)(p.ws + WS_PROJ);
    const float* LB = (const float*)(p.ws + WS_LB);
    float* LF = (float*)lds;
    bf16_t* QT = (bf16_t*)(lds + 32768);
    bf16_t* KT = (bf16_t*)(lds + 51200);
    bf16_t* VT = (bf16_t*)(lds + 69632);
    bf16_t* SC = (bf16_t*)(lds + 78848);
    bf16_t* SP = (bf16_t*)(lds + 97280);
    bf16_t* XG = (bf16_t*)(lds + 115712);
    float* OX = (float*)lds;
    float* HGS = (float*)((unsigned char*)p.out + DO_HGS);
    float* HGD = (float*)(p.ws + WS_HGD);
    const int t = tid >> 3, k8 = (tid & 7) * 8;
    const bool masked = pos0 + t < PADR;
    __syncthreads();
    float kk[2][8], q[8];
    {
        const bf16_t* rowp = PROJ + (size_t)(row0 + t) * PLD + n * 64 + k8;
        float xf[8], xv[8];
        unpack8(*(const u32x4*)(rowp + OFF_BI), xv);
#pragma unroll
        for (int i = 0; i < 8; ++i) VT[(k8 + i) * 72 + t] = f2bf(masked ? 0.f : xv[i]);
#pragma unroll
        for (int d = 0; d < 2; ++d) {
            unpack8(*(const u32x4*)(rowp + (d == 0 ? OFF_BFF : OFF_BFB)), xf);
#pragma unroll
            for (int i = 0; i < 8; ++i) {
                const float lb = LB[(d * 4 + l) * 384 + n * 64 + k8 + i];
                const float sg = sigmoidf_(xf[i]);
                const float f = lb + (1.0f - lb) * sg;
                kk[d][i] = masked ? 0.f : (1.0f - lb) * (1.0f - sg);
                LF[d * 4096 + t * 64 + k8 + i] = masked ? 0.f : __logf(f);
            }
        }
#pragma unroll
        for (int i = 0; i < 8; ++i) q[i] = 0.f;
        if (fin) {
            unpack8(*(const u32x4*)(rowp + OFF_BQ), q);
#pragma unroll
            for (int i = 0; i < 8; ++i) q[i] = siluf_(q[i]);
            *(u32x4*)(XG + t * 64 + k8) = *(const u32x4*)(rowp + OFF_BG);
        }
    }
    __syncthreads();
    if (tid < 128) {
        const int k = tid & 63, d = tid >> 6; float run = 0.f; float* lf = LF + d * 4096 + k;
        if (d == 0) {
_Pragma("unroll 8")
 for (int s = 0; s < 64; ++s) { run += lf[s * 64]; lf[s * 64] = run; } }
        else {
_Pragma("unroll 8")
 for (int s = 63; s >= 0; --s) { run += lf[s * 64]; lf[s * 64] = run; } }
    }
    __syncthreads();
    const int rb = wave & 3, dir = wave >> 2, cl = lane & 15, qd = lane >> 4;
    if (!fin) {
#pragma unroll
        for (int d = 0; d < 2; ++d)
#pragma unroll
            for (int i = 0; i < 8; ++i) {
                const int k = k8 + i; const float tot = d == 0 ? LF[63 * 64 + k] : LF[4096 + k];
                KT[d * 4608 + k * 72 + t] = f2bf(kk[d][i] * __expf(tot - LF[d * 4096 + t * 64 + k]));
                if (t == 0) HGD[((size_t)(j * 6 + n) * 2 + d) * 64 + k] = __expf(tot);
            }
        __syncthreads();
#pragma unroll
        for (int kb = 0; kb < 4; ++kb) {
            const f32x4 a = mma_tile64(VT + rb * 16 * 72, KT + dir * 4608 + kb * 16 * 72, 72, lane, (f32x4){0.f, 0.f, 0.f, 0.f});
            float* dst = HGS + ((size_t)(j * 6 + n) * 2 + dir) * 4096;
#pragma unroll
            for (int jj = 0; jj < 4; ++jj) dst[(rb * 16 + qd * 4 + jj) * 64 + kb * 16 + cl] = a[jj];
        }
        return;
    }
#pragma unroll
    for (int d = 0; d < 2; ++d) {
        float qv[8], kv[8];
#pragma unroll
        for (int i = 0; i < 8; ++i) {
            const int k = k8 + i; const float m = LF[d * 4096 + 32 * 64 + k];
            const float e1 = fminf(fmaxf(LF[d * 4096 + t * 64 + k] - m, -80.f), 80.f);
            qv[i] = q[i] * __expf(e1); kv[i] = kk[d][i] * __expf(-e1);
        }
        *(u32x4*)(QT + d * 4608 + t * 72 + k8) = pack8(qv);
        *(u32x4*)(KT + d * 4608 + t * 72 + k8) = pack8(kv);
        const float* sin_ = HGS + ((size_t)(j * 6 + n) * 2 + d) * 4096 + t * 64 + k8;
        const f32x4 s0 = *(const f32x4*)sin_, s1 = *(const f32x4*)(sin_ + 4);
        float sv[8];
#pragma unroll
        for (int i = 0; i < 4; ++i) { sv[i] = s0[i] * __expf(LF[d * 4096 + 32 * 64 + k8 + i]); sv[4 + i] = s1[i] * __expf(LF[d * 4096 + 32 * 64 + k8 + 4 + i]); }
        *(u32x4*)(SP + d * 4608 + t * 72 + k8) = pack8(sv);
    }
    __syncthreads();
#pragma unroll
    for (int ct = 0; ct < 4; ++ct) {
        const f32x4 a = mma_tile64(QT + dir * 4608 + rb * 16 * 72, KT + dir * 4608 + ct * 16 * 72, 72, lane, (f32x4){0.f, 0.f, 0.f, 0.f});
#pragma unroll
        for (int jj = 0; jj < 4; ++jj) {
            const int tt = rb * 16 + qd * 4 + jj, s = ct * 16 + cl;
            const bool keep = dir == 0 ? (s <= tt) : (s >= tt);
            SC[dir * 4608 + tt * 72 + s] = f2bf(keep ? a[jj] : 0.f);
        }
    }
    __syncthreads();
    f32x4 o[4];
#pragma unroll
    for (int vt = 0; vt < 4; ++vt) {
        f32x4 a = mma_tile64(SC + dir * 4608 + rb * 16 * 72, VT + vt * 16 * 72, 72, lane, (f32x4){0.f, 0.f, 0.f, 0.f});
        o[vt] = mma_tile64(QT + dir * 4608 + rb * 16 * 72, SP + dir * 4608 + vt * 16 * 72, 72, lane, a);
    }
    if (dir == 1) {
#pragma unroll
        for (int vt = 0; vt < 4; ++vt)
#pragma unroll
            for (int jj = 0; jj < 4; ++jj) OX[(rb * 16 + qd * 4 + jj) * 64 + vt * 16 + cl] = o[vt][jj];
    }
    __syncthreads();
    if (dir == 0) {
        bf16_t* YM = (bf16_t*)(p.ws + WS_ACT); float* SS = (float*)(p.ws + WS_SS);
#pragma unroll
        for (int jj = 0; jj < 4; ++jj) {
            const int tt = rb * 16 + qd * 4 + jj;
            float ov[4], s = 0.f;
#pragma unroll
            for (int vt = 0; vt < 4; ++vt) { ov[vt] = o[vt][jj] + OX[tt * 64 + vt * 16 + cl]; s += ov[vt] * ov[vt]; }
            s += __shfl_xor(s, 1); s += __shfl_xor(s, 2); s += __shfl_xor(s, 4); s += __shfl_xor(s, 8);
            const float rn = rsqrtf(s * (1.0f / 64.0f) + EPS);
            const bool valid = pos0 + tt >= PADR;
            float s2 = 0.f;
#pragma unroll
            for (int vt = 0; vt < 4; ++vt) {
                const int v = vt * 16 + cl;
                const float y = valid ? ov[vt] * rn * siluf_(bf2f(XG[tt * 64 + v])) : 0.f;
                s2 += y * y;
                YM[(size_t)(row0 + tt) * D + 384 + n * 64 + v] = f2bf(y);
            }
            s2 += __shfl_xor(s2, 1); s2 += __shfl_xor(s2, 2); s2 += __shfl_xor(s2, 4); s2 += __shfl_xor(s2, 8);
            if (cl == 0) SS[(size_t)(row0 + tt) * 16 + 6 + n] = s2;
        }
    }
}

DI void phase_carries(const Params& p, int l) {
    float* HGS = (float*)((unsigned char*)p.out + DO_HGS);
    const float* HGD = (const float*)(p.ws + WS_HGD);
    float* RGC = (float*)((unsigned char*)p.out + DO_RGC);
    const float* S5E = (const float*)((const unsigned char*)p.out + DO_S5E);
    bf16_t* U2 = (bf16_t*)(p.ws + WS_U2);
    const float* PAR = (const float*)(p.ws + WS_PAR);
    const int N_HG = 12 * 6 * 2 * 4096, N_RG = 12 * 2 * 384, N_S5 = 12 * 16 * 2 * 64;
    for (int idx = lbid() * 512 + ltid(); idx < N_HG + N_RG + N_S5; idx += lgdim() * 512) {
        if (idx < N_HG) {
            const int seq = idx / 49152, rem = idx % 49152, n = rem / 8192, d = (rem >> 12) & 1, e = rem & 4095, k = e & 63;
            int c0, nc; seq_chunks64(seq, c0, nc);
            float S = 0.f;
_Pragma("unroll 4")
            for (int i = 0; i < nc; ++i) {
                const int jc = d == 0 ? c0 + i : c0 + nc - 1 - i;
                const size_t b = (size_t)(jc * 6 + n) * 2 + d;
                const float loc = HGS[b * 4096 + e], dec = HGD[b * 64 + k];
                HGS[b * 4096 + e] = S;
                S = dec * S + loc;
            }
        } else if (idx < N_HG + N_RG) {
            const int i2 = idx - N_HG; const int seq = i2 / 768, rem = i2 % 768, d = rem / 384, ch = rem % 384;
            int c0, nc; seq_chunks64(seq, c0, nc);
            float c = 0.f;
_Pragma("unroll 4")
            for (int i = 0; i < nc; ++i) {
                const int jc = d == 0 ? c0 + i : c0 + nc - 1 - i;
                float* cp = RGC + ((size_t)(jc * 2 + d) * 384 + ch) * 2;
                const float P = cp[0], E = cp[1];
                cp[1] = c; c = P * c + E;
            }
        } else {
            const int i2 = idx - N_HG - N_RG; const int seq = i2 / 2048, g = (i2 >> 7) & 15, d = (i2 >> 6) & 1, pp = i2 & 63;
            int c0, nc; seq_chunks32(seq, c0, nc);
            const int base = (l * 2 + d) * 16 + g;
            const float ar = PAR[(base * 64 + pp) * 2], ai = PAR[(base * 64 + pp) * 2 + 1];
            const float mg = expf(32.0f * ar); float sn, cs; sincosf(32.0f * ai, &sn, &cs);
            const float wr_ = mg * cs, wi_ = mg * sn;
            float hr = 0.f, hi = 0.f;
_Pragma("unroll 4")
            for (int i = 0; i < nc; ++i) {
                const int c = d == 0 ? c0 + i : c0 + nc - 1 - i;
                const size_t ro = (size_t)(g * U2ROWS + c);
                U2[ro * U2LD + 512 + d * 128 + pp] = f2bf(hr); U2[ro * U2LD + 512 + d * 128 + 64 + pp] = f2bf(hi);
                const float er = S5E[ro * 256 + d * 128 + pp], ei = S5E[ro * 256 + d * 128 + 64 + pp];
                const float nr = wr_ * hr - wi_ * hi + er, ni = wr_ * hi + wi_ * hr + ei;
                hr = nr; hi = ni;
            }
        }
    }
}

DI void phase_mixnorm(const Params& p, int l) {
    bf16_t* YM = (bf16_t*)(p.ws + WS_ACT); const float* SS = (const float*)(p.ws + WS_SS);
    const float* gain = p.in[I_MGAIN] + (size_t)l * D;
    for (size_t e = (size_t)lbid() * 512 + ltid(); e < (size_t)MP * 128; e += (size_t)lgdim() * 512) {
        const int R = (int)(e >> 7), c0 = (int)(e & 127) * 8;
        const int br = c0 < 384 ? 0 : (c0 < 768 ? 1 : 2);
        const float inv = br == 2 ? (1.0f / 256.0f) : (1.0f / 384.0f);
        const float* sp = SS + (size_t)R * 16; const f32x4 s0 = *(const f32x4*)sp, s1 = *(const f32x4*)(sp + 4), s2 = *(const f32x4*)(sp + 8), s3 = *(const f32x4*)(sp + 12);
        const float tot = br == 0 ? (((s0[0] + s0[1]) + (s0[2] + s0[3])) + (s1[0] + s1[1])) : (br == 1 ? (((s1[2] + s1[3]) + (s2[0] + s2[1])) + (s2[2] + s2[3])) : ((s3[0] + s3[1]) + (s3[2] + s3[3])));
        const float rn = rsqrtf(tot * inv + EPS);
        float f[8]; unpack8(*(const u32x4*)(YM + (size_t)R * D + c0), f);
#pragma unroll
        for (int i = 0; i < 8; ++i) f[i] = f[i] * rn * gain[c0 + i];
        *(u32x4*)(YM + (size_t)R * D + c0) = pack8(f);
    }
}

DI void phase_final(const Params& p) {
    const int tid = ltid(); const int lane = tid & 63, wave = tid >> 6;
    const float* H = (const float*)(p.ws + WS_H); const float* gain = p.in[I_NFIN];
    for (int R = lbid() * 8 + wave; R < MP; R += lgdim() * 8) {
        int seq, pos; row_info(R, seq, pos);
        const int t = pos - PADR - 16;
        if (t < 0) continue;
        float* dst = seq < 4 ? p.out + ((size_t)seq * 4096 + t) * D : p.out + (size_t)4 * 4096 * D + ((size_t)(seq - 4) * 2048 + t) * D;
        f32x4 v[4]; float ss = 0.f;
#pragma unroll
        for (int i = 0; i < 4; ++i) { v[i] = *(const f32x4*)(H + (size_t)R * D + (lane + 64 * i) * 4); ss += v[i][0] * v[i][0] + v[i][1] * v[i][1] + v[i][2] * v[i][2] + v[i][3] * v[i][3]; }
#pragma unroll
        for (int o = 1; o < 64; o <<= 1) ss += __shfl_xor(ss, o);
        const float rn = rsqrtf(ss * (1.0f / D) + EPS);
#pragma unroll
        for (int i = 0; i < 4; ++i) { const f32x4 gg = *(const f32x4*)(gain + (lane + 64 * i) * 4); *(f32x4*)(dst + (lane + 64 * i) * 4) = v[i] * rn * gg; }
    }
}

constexpr int NPHASE = 2 + 11 * DEPTH;
enum { GM_NONE = 0, GM_INPROJ, GM_RESADD, GM_RELU2, GM_S5E, GM_S5Y, GM_GLU };

struct EpiAny {
    const pg8::Gemm* g;
    DI void operator()(const f32x4 (&acc)[2][2][4][2], const Unit& u, int wr, int wc, int fr, int fq) const {
        asm volatile("" : "+v"(fr), "+v"(fq));
        asm volatile("" : "+s"(wr), "+s"(wc));
        switch (g->mode) {
        case GM_INPROJ: { EpiInProj E{(bf16_t*)g->o0, (bf16_t*)g->o1}; E(acc, u, wr, wc, fr, fq); } break;
        case GM_RESADD: { EpiResAdd E{(float*)g->o0}; E(acc, u, wr, wc, fr, fq); } break;
        case GM_RELU2:  { EpiRelu2 E{(bf16_t*)g->o0}; E(acc, u, wr, wc, fr, fq); } break;
        case GM_S5E:    { EpiS5E E{(float*)g->o0}; E(acc, u, wr, wc, fr, fq); } break;
        case GM_S5Y:    { EpiS5Y E{(const bf16_t*)g->i0, (bf16_t*)g->o0, (const float*)g->i1}; E(acc, u, wr, wc, fr, fq); } break;
        default:        { EpiGlu E{(const bf16_t*)g->i0, (bf16_t*)g->o0, (float*)g->o1, (const float*)g->i1}; E(acc, u, wr, wc, fr, fq); } break;
        }
    }
};

__global__ void __launch_bounds__(512, 2) mega(Params p) {
    extern __shared__ __attribute__((aligned(16))) unsigned char lds[];
    cg::grid_group grid = cg::this_grid();
    LAS unsigned char* ldsl = (LAS unsigned char*)lds;

    for (int ph = p.ph_lo; ph < p.ph_hi; ++ph) {
        const int l = (ph - 1) / 11, s = (ph == 0) ? 100 : (ph == NPHASE - 1 ? 101 : (ph - 1) % 11);
        unsigned char* ws = p.ws; unsigned char* ob = (unsigned char*)p.out; asm volatile("" : "+s"(ws), "+s"(ob));
        const int G = lgdim(), c = lbid();
        pg8::Gemm g; g.mode = GM_NONE; g.perm = 0; g.sched = 0; g.M = MP; g.N = 0; g.o0 = nullptr; g.o1 = nullptr; g.i0 = nullptr; g.i1 = nullptr; g.A = nullptr; g.Bt = nullptr; g.K = 0; g.lda = 0; g.ldb = 0;
        switch (s) {
        case 1:  g.mode = GM_INPROJ; g.perm = 1; g.A = (const bf16_t*)(ws + WS_ACT); g.Bt = (const bf16_t*)(ws + WS_WIN); g.K = 1024; g.lda = 1024; g.ldb = 1024; g.N = 3072; g.o0 = ws + WS_PROJ; g.o1 = ws + WS_U2; break;
        case 2:  g.mode = GM_S5E; g.sched = 1; g.A = (const bf16_t*)(ws + WS_U2); g.Bt = (const bf16_t*)(ws + WS_M1); g.K = 512; g.lda = U2LD; g.ldb = 512; g.o0 = ob + DO_S5E; break;
        case 4:  g.mode = GM_S5Y; g.perm = 1; g.sched = 2; g.A = (const bf16_t*)(ws + WS_U2); g.Bt = (const bf16_t*)(ws + WS_T2); g.K = 768; g.lda = U2LD; g.ldb = 768; g.i0 = ws + WS_U2; g.o0 = ws + WS_Z; g.i1 = p.in[I_S5D] + (size_t)l * 256; break;
        case 5:  g.mode = GM_GLU; g.perm = 1; g.A = (const bf16_t*)(ws + WS_Z); g.Bt = (const bf16_t*)(ws + WS_GLU); g.K = 256; g.lda = 256; g.ldb = 256; g.N = 256; g.i0 = ws + WS_Z; g.o0 = ws + WS_ACT; g.o1 = ws + WS_SS; g.i1 = p.in[I_GLUB] + (size_t)l * 256; break;
        case 7:  g.mode = GM_RESADD; g.A = (const bf16_t*)(ws + WS_ACT); g.Bt = (const bf16_t*)(ws + WS_WOUT); g.K = 1024; g.lda = 1024; g.ldb = 1024; g.N = 1024; g.o0 = ws + WS_H; break;
        case 9:  g.mode = GM_RELU2; g.perm = 1; g.A = (const bf16_t*)(ws + WS_ACT); g.Bt = (const bf16_t*)(ws + WS_WUP); g.K = 1024; g.lda = 1024; g.ldb = 1024; g.N = 4096; g.o0 = ws + WS_FF; break;
        case 10: g.mode = GM_RESADD; g.A = (const bf16_t*)(ws + WS_FF); g.Bt = (const bf16_t*)(ws + WS_WDN); g.K = 4096; g.lda = 4096; g.ldb = 4096; g.N = 1024; g.o0 = ws + WS_H; break;
        default: break;
        }
        if (g.mode != GM_NONE) {
            pg8::AnyOrder S; S.kind = g.sched; S.G = G; S.c = c; S.so.init(g.M, g.N, G, c);
            EpiAny E{&g};
            pg8::gemm_phase(ldsl, g, S, E);
        }
        if (s == 2 || s == 4) {
            const bool fin = (s == 4);
            const int skip = fin ? 160 : 80;
            const int rot = (c + G - skip % G) % G;
            for (int it = rot; it < NCH64 * 6; it += G) rg_item(p, l, it, fin, lds);
            for (int it = rot; it < NCH64 * 6; it += G) hg_item(p, l, it, fin, lds);
        } else if (s == 0) {
            norm_rows(p, true, l == 0, p.in[I_NMIX] + (size_t)l * D);
            convert_weights(p, l, lds);
            build_s5_mats(p, l);
        } else if (s == 8) norm_rows(p, false, false, p.in[I_NMLP] + (size_t)l * D);
        else if (s == 3) phase_carries(p, l);
        else if (s == 6) phase_mixnorm(p, l);
        else if (s == 100) phase_prep(p, lds);
        else if (s == 101) phase_final(p);
        if (ph + 1 < p.ph_hi) { __threadfence(); grid.sync(); }
    }
}

#ifndef MK_MULTI
#define MK_MULTI 0
#endif

extern "C" void kernel_launch(void* const* d_in, const int* in_sizes, int n_in, void* d_out, int out_size, void* d_ws, size_t ws_size, hipStream_t stream) {
    static int grid = 0;
    if (grid == 0) {
        if (n_in != 29 || ws_size < WS_END || out_size != 33554432) { fprintf(stderr, "kernel_launch: unexpected sizes n_in %d ws %zu need %zu out %d\n", n_in, ws_size, (size_t)WS_END, out_size); grid = -1; return; }
        int dev = 0, cus = 0, per_cu = 0;
        hipGetDevice(&dev);
        hipDeviceGetAttribute(&cus, hipDeviceAttributeMultiprocessorCount, dev);
        if (hipFuncSetAttribute((const void*)mega, hipFuncAttributeMaxDynamicSharedMemorySize, LDS_BYTES) != hipSuccess) { fprintf(stderr, "kernel_launch: hipFuncSetAttribute failed\n"); }
        hipOccupancyMaxActiveBlocksPerMultiprocessor(&per_cu, (const void*)mega, 512, LDS_BYTES);
        (void)hipGetLastError();
        if (per_cu < 1) per_cu = 1;
        grid = cus * 1;
        fprintf(stderr, "kernel_launch: cus %d per_cu %d grid %d ws %zu need %zu\n", cus, per_cu, grid, ws_size, (size_t)WS_END);
    }
    if (grid < 0) return;
    Params p{};
    for (int i = 0; i < 29; ++i) p.in[i] = (const float*)d_in[i];
    p.out = (float*)d_out; p.ws = (unsigned char*)d_ws;
#if MK_MULTI
    for (int ph = 0; ph < NPHASE; ++ph) {
        p.ph_lo = ph; p.ph_hi = ph + 1;
        hipLaunchKernelGGL(mega, dim3(grid), dim3(512), LDS_BYTES, stream, p);
    }
#else
    p.ph_lo = 0; p.ph_hi = NPHASE;
    void* args[] = {&p};
    hipError_t e = hipLaunchCooperativeKernel((const void*)mega, dim3(grid), dim3(512), args, LDS_BYTES, stream);
    if (e != hipSuccess) fprintf(stderr, "cooperative launch failed: %s (grid %d)\n", hipGetErrorString(e), grid);
#endif
}
```

```cpp
#include <hip/hip_runtime.h>
#include <hip/hip_cooperative_groups.h>
#include <cstdio>
namespace cg = cooperative_groups;

#define DI __device__ __forceinline__
#define LAS __attribute__((address_space(3)))
typedef unsigned short bf16_t;
typedef short bf16x8 __attribute__((ext_vector_type(8)));
typedef float f32x4 __attribute__((ext_vector_type(4)));
typedef unsigned u32x4 __attribute__((ext_vector_type(4)));
typedef unsigned u32x2 __attribute__((ext_vector_type(2)));

constexpr int D = 1024, DEPTH = 4, DFF = 4096;
constexpr int PADR = 48;
constexpr int LP = 4160, LS = 2112;
constexpr int ROWS_P = 4 * LP;
constexpr int MP = ROWS_P + 8 * LS;
constexpr int NCH64 = MP / 64;
constexpr int NCH32 = MP / 32;
constexpr int U2ROWS = 1280;
constexpr int U2LD = 768;
constexpr int PLD = 2816;
constexpr int OFF_AX = 0, OFF_AG = 384, OFF_BQ = 768, OFF_BI = 1152, OFF_BFF = 1536, OFF_BFB = 1920, OFF_BG = 2304;
constexpr float EPS = 1e-6f;
constexpr int LDS_BYTES = 147456;

constexpr size_t al256(size_t x) { return (x + 255) & ~(size_t)255; }
constexpr size_t WS_H     = 0;
constexpr size_t WS_ACT   = WS_H + (size_t)MP * D * 4;
constexpr size_t WS_BIG   = WS_ACT + (size_t)MP * D * 2;
constexpr size_t BIG_SIZE = (size_t)MP * DFF * 2;
constexpr size_t WS_PROJ  = WS_BIG;
constexpr size_t WS_U2    = WS_PROJ + (size_t)MP * PLD * 2;
constexpr size_t WS_Z     = WS_U2 + (size_t)16 * U2ROWS * U2LD * 2;
static_assert(WS_Z + (size_t)MP * 256 * 2 <= WS_BIG + BIG_SIZE, "BIG overflow");
constexpr size_t WS_FF    = WS_BIG;
constexpr size_t WS_WIN   = WS_BIG + BIG_SIZE;
constexpr size_t WS_WOUT  = WS_WIN + (size_t)3072 * 1024 * 2;
constexpr size_t WS_WUP   = WS_WOUT + (size_t)1024 * 1024 * 2;
constexpr size_t WS_WDN   = WS_WUP + (size_t)4096 * 1024 * 2;
constexpr size_t WS_WG    = WS_WDN + (size_t)1024 * 4096 * 2;
constexpr size_t WS_GLU   = WS_WG + (size_t)6 * 256 * 64 * 2;
constexpr size_t WS_T2    = WS_GLU + (size_t)256 * 256 * 2;
constexpr size_t WS_M1    = WS_T2 + (size_t)16 * 512 * 768 * 2;
constexpr size_t WS_SS    = WS_M1 + (size_t)16 * 256 * 512 * 2;
constexpr size_t WS_HGD   = WS_SS + (size_t)MP * 16 * 4;
constexpr size_t WS_LB    = WS_HGD + (size_t)NCH64 * 6 * 2 * 64 * 4;
constexpr size_t WS_PAR   = WS_LB + al256((size_t)2 * 4 * 384 * 4);
constexpr size_t WS_BAR   = WS_PAR + (size_t)4 * 2 * 16 * 64 * 2 * 4;
constexpr size_t WS_END   = WS_BAR + 16384;
constexpr size_t DO_HGS   = 0;
constexpr size_t DO_S5E   = DO_HGS + (size_t)NCH64 * 6 * 2 * 4096 * 4;
constexpr size_t DO_KTAB  = DO_S5E + (size_t)16 * U2ROWS * 256 * 4;
constexpr size_t DO_BBAR  = DO_KTAB + (size_t)4 * 16 * 2 * 32 * 256 * 4;
constexpr size_t DO_RGC   = DO_BBAR + (size_t)4 * 2 * 16 * 64 * 16 * 2 * 4;
constexpr size_t DO_END   = DO_RGC + (size_t)NCH64 * 2 * 384 * 2 * 4;
static_assert(DO_END <= (size_t)33554432 * 4, "d_out scratch overflow");

struct Params {
    const float* in[29];
    float* out;
    unsigned char* ws;
    int ph_lo, ph_hi;
};
enum { I_XP = 0, I_XS, I_META, I_NMIX, I_WIN, I_CONVW, I_CONVB, I_WR, I_BR, I_WI, I_BI, I_LAM, I_LBL, I_ARE, I_AIM, I_LDT, I_BRE, I_BIM, I_CRE, I_CIM,
       I_S5D, I_GLUW, I_GLUB, I_MGAIN, I_WOUT, I_NMLP, I_WUP, I_WDN, I_NFIN };

DI int ltid() { int t = threadIdx.x; asm volatile("" : "+v"(t)); return t; }
DI int lbid() { int t = blockIdx.x; asm volatile("" : "+s"(t)); return t; }
DI int lgdim() { int t = gridDim.x; asm volatile("" : "+s"(t)); return t; }
DI unsigned short f2bf(float f) { unsigned u = __float_as_uint(f); u += 0x7FFFu + ((u >> 16) & 1u); return (unsigned short)(u >> 16); }
DI float bf2f(unsigned short b) { return __uint_as_float(((unsigned)b) << 16); }
DI unsigned pack2(float lo, float hi) { return (unsigned)f2bf(lo) | ((unsigned)f2bf(hi) << 16); }
DI float bflo(unsigned w) { return __uint_as_float(w << 16); }
DI float bfhi(unsigned w) { return __uint_as_float(w & 0xFFFF0000u); }
DI float sigmoidf_(float x) { return 1.0f / (1.0f + __expf(-x)); }
DI float siluf_(float x) { return x * sigmoidf_(x); }
DI float gelu_tanh(float x) { const float u = 0.7978845608028654f * (x + 0.044715f * x * x * x); return x * sigmoidf_(2.0f * u); }
DI void unpack8(const u32x4& w, float* f) { f[0] = bflo(w.x); f[1] = bfhi(w.x); f[2] = bflo(w.y); f[3] = bfhi(w.y); f[4] = bflo(w.z); f[5] = bfhi(w.z); f[6] = bflo(w.w); f[7] = bfhi(w.w); }
DI u32x4 pack8(const float* f) { u32x4 w; w.x = pack2(f[0], f[1]); w.y = pack2(f[2], f[3]); w.z = pack2(f[4], f[5]); w.w = pack2(f[6], f[7]); return w; }

DI void row_info(int R, int& seq, int& pos) {
    if (R < ROWS_P) { seq = R / LP; pos = R - seq * LP; }
    else { const int r = R - ROWS_P; const int s = r / LS; seq = 4 + s; pos = r - s * LS; }
}
DI void seq_chunks64(int seq, int& c0, int& nc) { if (seq < 4) { c0 = seq * 65; nc = 65; } else { c0 = 260 + (seq - 4) * 33; nc = 33; } }
DI void seq_chunks32(int seq, int& c0, int& nc) { if (seq < 4) { c0 = seq * 130; nc = 130; } else { c0 = 520 + (seq - 4) * 66; nc = 66; } }
DI int chunk64_pos0(int j) { if (j < 260) return (j % 65) * 64; return ((j - 260) % 33) * 64; }
DI int chunk64_len(int j) { return j < 260 ? LP : LS; }

namespace pg8 {
constexpr int BM = 256, BK = 64, HALF = 128, HTB = HALF * BK * 2, STAGE_BYTES = 8 * HTB, NXCD = 8, WGM = 8;
__host__ __device__ __forceinline__ int lds_byte(int r, int c) { const int st = (r >> 4) * 2 + (c >> 5), rr = r & 15, cc = c & 31, ob = rr * 64 + cc * 2; return st * 1024 + (ob ^ (((ob >> 9) & 1) << 5)); }
__host__ __device__ __forceinline__ void stage_rc(int b, int& R, int& C) { const int st = b / 1024, sb = b % 1024, swz = sb ^ (((sb >> 9) & 1) << 5); R = (st >> 1) * 16 + swz / 64; C = (st & 1) * 32 + (swz % 64) / 2; }
__host__ __device__ __forceinline__ int perm32(int rho) { const int n = rho >> 4, i = rho & 15; return 8 * (i >> 2) + 4 * n + (i & 3); }
struct Unit { int pm, pn; };
struct Gemm { const bf16_t* A; const bf16_t* Bt; int K, lda, ldb;
              int mode, perm, sched, M, N;
              void* o0; void* o1; const void* i0; const void* i1; };

struct StaticOrder {
    int nM, nN, nwg, G, c;
    DI void init(int M, int N, int G_, int c_) { nM = M / BM; nN = N / BM; nwg = nM * nN; G = G_; c = c_; }
    DI bool next(int i, Unit& u) const {
        const long L = (long)i * G + c; if (L >= nwg) return false;
        int wgid = (int)L; { const int q = nwg / NXCD, r = nwg % NXCD, xcd = wgid % NXCD, off = wgid / NXCD; wgid = (xcd < r ? xcd * (q + 1) : r * (q + 1) + (xcd - r) * q) + off; }
        const int nig = WGM * nN, gid = wgid / nig, fm = gid * WGM, gsz = (nM - fm) < WGM ? (nM - fm) : WGM;
        u.pm = fm + ((wgid % nig) % gsz); u.pn = (wgid % nig) / gsz; return true;
    }
    DI void a_ready(const Unit&) const {}
    DI void done(const Unit&) const {}
};
template <int NPN> struct GroupOrder {
    int G, c;
    DI bool next(int i, Unit& u) const {
        const int L = i * G + c; if (L >= 16 * 5 * NPN) return false;
        const int g = L / (5 * NPN), r = L % (5 * NPN); u.pm = g * 5 + (r % 5); u.pn = g * NPN + (r / 5); return true;
    }
    DI void a_ready(const Unit&) const {}
    DI void done(const Unit&) const {}
};

DI unsigned cvt_pk_bf16(float lo, float hi) { unsigned r; asm volatile("v_cvt_pk_bf16_f32 %0, %1, %2" : "=v"(r) : "v"(lo), "v"(hi)); return r; }

struct AnyOrder {
    StaticOrder so; int kind, G, c;
    DI bool next(int i, Unit& u) const {
        if (kind == 0) return so.next(i, u);
        if (kind == 1) { GroupOrder<1> o{G, c}; return o.next(i, u); }
        GroupOrder<2> o{G, c}; return o.next(i, u);
    }
};
template <class EpiFn>
DI void gemm_phase(LAS unsigned char* lds, const Gemm& g, const AnyOrder& S, const EpiFn& E) {
    int tid_ = ltid();
    const int tid = tid_, wid = __builtin_amdgcn_readfirstlane(tid >> 6), lane = tid & 63, wr = wid >> 2, wc = wid & 3, fr = lane & 15, fq = lane >> 4;
    const int K = g.K, nt = K / BK;
    unsigned voffA[2], voffB[2];
#pragma unroll
    for (int i = 0; i < 2; ++i) { int R, C; stage_rc(tid * 16 + i * 8192, R, C); const int Rb = g.perm ? ((R & ~31) + perm32(R & 31)) : R;
        voffA[i] = (unsigned)(R * g.lda + C) * 2u; voffB[i] = (unsigned)(Rb * g.ldb + C) * 2u; }
    const size_t kstep = (size_t)(BK * 2);
    const size_t hstepA = (size_t)HALF * g.lda * 2, hstepB = (size_t)HALF * g.ldb * 2;
    const size_t tstepA = 2 * hstepA, tstepB = 2 * hstepB;
    const unsigned ldsw = (unsigned)wid * 1024u;
    const int aoff = lds_byte(wr * 64 + fr, fq * 8), boff = lds_byte(wc * 32 + fr, fq * 8);
#define PG8_SA(b, h) (((b) * 2 + (h)) * HTB)
#define PG8_SB(b, h) ((4 + (b) * 2 + (h)) * HTB)
#define PG8_STAGE(bufoff, gbase, voff) do { _Pragma("unroll") for (int _i = 0; _i < 2; ++_i) \
        __builtin_amdgcn_global_load_lds((const unsigned*)((const char*)(gbase) + (voff)[_i]), (LAS unsigned*)(lds + (bufoff) + ldsw + _i * 8192), 16, 0, 0); } while (0)
#define PG8_LDA(dst, b, h) do { _Pragma("unroll") for (int m = 0; m < 4; ++m) _Pragma("unroll") for (int k = 0; k < 2; ++k) dst[m][k] = *(const LAS bf16x8*)(lds + PG8_SA(b, h) + aoff + m * 2048 + k * 1024); } while (0)
#define PG8_LDB(dst, b, h) do { _Pragma("unroll") for (int n = 0; n < 2; ++n) _Pragma("unroll") for (int k = 0; k < 2; ++k) dst[n][k] = *(const LAS bf16x8*)(lds + PG8_SB(b, h) + boff + n * 2048 + k * 1024); } while (0)
#define PG8_MMA(ai, bj, At, Bt) do { __builtin_amdgcn_s_setprio(1); _Pragma("unroll") for (int m = 0; m < 4; ++m) _Pragma("unroll") for (int n = 0; n < 2; ++n) _Pragma("unroll") for (int k = 0; k < 2; ++k) \
        acc[ai][bj][m][n] = __builtin_amdgcn_mfma_f32_16x16x32_bf16(Bt[n][k], At[m][k], acc[ai][bj][m][n], 0, 0, 0); __builtin_amdgcn_s_setprio(0); } while (0)
#define PG8_WAIT_V(n) asm volatile("s_waitcnt vmcnt(" #n ")" ::: "memory")
#define PG8_WAIT_L(n) asm volatile("s_waitcnt lgkmcnt(" #n ")" ::: "memory")
#define PG8_BAR __builtin_amdgcn_s_barrier()
#define PG8_SCHED __builtin_amdgcn_sched_barrier(0)
    Unit cur, nxt; int ui = 0;
    if (!S.next(0, cur)) return;
    f32x4 acc[2][2][4][2];
#pragma unroll
    for (int a = 0; a < 2; ++a)
#pragma unroll
        for (int b = 0; b < 2; ++b)
#pragma unroll
            for (int m = 0; m < 4; ++m)
#pragma unroll
                for (int n = 0; n < 2; ++n) acc[a][b][m][n] = (f32x4){0.f, 0.f, 0.f, 0.f};
    bf16x8 At[4][2], B0[2][2], B1[2][2];
    const char* cA = (const char*)g.A + (size_t)cur.pm * tstepA; const char* cB = (const char*)g.Bt + (size_t)cur.pn * tstepB;
    PG8_STAGE(PG8_SB(0, 0), cB, voffB); PG8_STAGE(PG8_SA(0, 0), cA, voffA); PG8_STAGE(PG8_SB(0, 1), cB + hstepB, voffB); PG8_STAGE(PG8_SA(0, 1), cA + hstepA, voffA);
    if (wr == 1) PG8_BAR;
    PG8_WAIT_V(4); PG8_BAR;
    PG8_STAGE(PG8_SB(1, 0), cB + kstep, voffB); PG8_STAGE(PG8_SA(1, 0), cA + kstep, voffA); PG8_STAGE(PG8_SB(1, 1), cB + hstepB + kstep, voffB);
    PG8_WAIT_V(6); PG8_BAR;
    for (;;) {
        const bool has_next = S.next(ui + 1, nxt);
        const char* nA = has_next ? (const char*)g.A + (size_t)nxt.pm * tstepA : cA; const char* nB = has_next ? (const char*)g.Bt + (size_t)nxt.pn * tstepB : cB;
        for (int t = 0; t < nt; t += 2) {
            const bool last = (t == nt - 2);
            const char* a1 = cA + (size_t)(t + 1) * kstep;
            const char* a2 = last ? nA : cA + (size_t)(t + 2) * kstep; const char* b2 = last ? nB : cB + (size_t)(t + 2) * kstep;
            const char* a3 = a2 + kstep; const char* b3 = b2 + kstep;
            PG8_LDB(B0, 0, 0); PG8_SCHED; PG8_LDA(At, 0, 0); PG8_STAGE(PG8_SA(1, 1), a1 + hstepA, voffA);
            PG8_WAIT_L(8); PG8_BAR; PG8_WAIT_L(0); PG8_MMA(0, 0, At, B0); PG8_BAR; PG8_SCHED;
            PG8_LDB(B1, 0, 1); PG8_STAGE(PG8_SB(0, 0), b2, voffB);
            PG8_BAR; PG8_WAIT_L(0); PG8_MMA(0, 1, At, B1); PG8_BAR;
            PG8_LDA(At, 0, 1); PG8_STAGE(PG8_SA(0, 0), a2, voffA);
            PG8_BAR; PG8_WAIT_L(0); PG8_MMA(1, 0, At, B0); PG8_BAR; PG8_SCHED;
            PG8_STAGE(PG8_SB(0, 1), b2 + hstepB, voffB);
            PG8_WAIT_V(6); PG8_BAR; PG8_MMA(1, 1, At, B1); PG8_BAR;
            PG8_LDB(B0, 1, 0); PG8_SCHED; PG8_LDA(At, 1, 0); PG8_STAGE(PG8_SA(0, 1), a2 + hstepA, voffA);
            PG8_WAIT_L(8); PG8_BAR; PG8_WAIT_L(0); PG8_MMA(0, 0, At, B0); PG8_BAR; PG8_SCHED;
            PG8_LDB(B1, 1, 1); PG8_STAGE(PG8_SB(1, 0), b3, voffB);
            PG8_BAR; PG8_WAIT_L(0); PG8_MMA(0, 1, At, B1); PG8_BAR;
            PG8_LDA(At, 1, 1); PG8_STAGE(PG8_SA(1, 0), a3, voffA);
            PG8_BAR; PG8_WAIT_L(0); PG8_MMA(1, 0, At, B0); PG8_BAR; PG8_SCHED;
            PG8_STAGE(PG8_SB(1, 1), b3 + hstepB, voffB);
            PG8_WAIT_V(6); PG8_BAR; PG8_MMA(1, 1, At, B1); PG8_BAR;
        }
        E(acc, cur, wr, wc, fr, fq);
        if (!has_next) break;
#pragma unroll
        for (int a = 0; a < 2; ++a)
#pragma unroll
            for (int b = 0; b < 2; ++b)
#pragma unroll
                for (int m = 0; m < 4; ++m)
#pragma unroll
                    for (int n = 0; n < 2; ++n) acc[a][b][m][n] = (f32x4){0.f, 0.f, 0.f, 0.f};
        cur = nxt; cA = nA; cB = nB; ++ui;
    }
    PG8_WAIT_V(0);
    if (wr == 0) PG8_BAR;
    PG8_BAR;
#undef PG8_SA
#undef PG8_SB
#undef PG8_STAGE
#undef PG8_LDA
#undef PG8_LDB
#undef PG8_MMA
#undef PG8_WAIT_V
#undef PG8_WAIT_L
#undef PG8_BAR
#undef PG8_SCHED
}
}
using pg8::Unit;

struct EpiInProj {
    static constexpr bool PERM = true;
    bf16_t* PROJ; bf16_t* U2;
    DI void operator()(const f32x4 (&acc)[2][2][4][2], const Unit& u, int wr, int wc, int fr, int fq) const {
        const int row0 = u.pm * 256 + wr * 64 + fr;
#pragma unroll
        for (int ai = 0; ai < 2; ++ai)
#pragma unroll
            for (int m = 0; m < 4; ++m) {
                const int r = row0 + ai * 128 + m * 16;
#pragma unroll
                for (int bj = 0; bj < 2; ++bj) {
                    const f32x4 v0 = acc[ai][bj][m][0], v1 = acc[ai][bj][m][1];
                    u32x4 w; w.x = pg8::cvt_pk_bf16(v0[0], v0[1]); w.y = pg8::cvt_pk_bf16(v0[2], v0[3]); w.z = pg8::cvt_pk_bf16(v1[0], v1[1]); w.w = pg8::cvt_pk_bf16(v1[2], v1[3]);
                    const int cl = bj * 128 + wc * 32 + 8 * fq;
                    if (u.pn == 0) { const int g = cl >> 4, h = cl & 15; *(u32x4*)(U2 + ((size_t)(g * U2ROWS + (r >> 5)) * U2LD + (r & 31) * 16 + h)) = w; }
                    else *(u32x4*)(PROJ + (size_t)r * PLD + (u.pn - 1) * 256 + cl) = w;
                }
                __builtin_amdgcn_sched_barrier(0);
            }
    }
};
struct EpiResAdd {
    static constexpr bool PERM = false;
    float* H;
    DI void operator()(const f32x4 (&acc)[2][2][4][2], const Unit& u, int wr, int wc, int fr, int fq) const {
        const int row0 = u.pm * 256 + wr * 64 + fr, col0 = u.pn * 256 + wc * 32 + 4 * fq;
#pragma unroll
        for (int ai = 0; ai < 2; ++ai)
#pragma unroll
            for (int m = 0; m < 4; ++m) { float* rowp = H + (size_t)(row0 + ai * 128 + m * 16) * D + col0;
#pragma unroll
                for (int bj = 0; bj < 2; ++bj)
#pragma unroll
                    for (int n = 0; n < 2; ++n) { f32x4* q = (f32x4*)(rowp + bj * 128 + n * 16); *q = *q + acc[ai][bj][m][n]; } }
    }
};
struct EpiRelu2 {
    static constexpr bool PERM = true;
    bf16_t* FF;
    DI void operator()(const f32x4 (&acc)[2][2][4][2], const Unit& u, int wr, int wc, int fr, int fq) const {
        const int row0 = u.pm * 256 + wr * 64 + fr, col0 = u.pn * 256 + wc * 32 + 8 * fq;
#pragma unroll
        for (int ai = 0; ai < 2; ++ai)
#pragma unroll
            for (int m = 0; m < 4; ++m) { bf16_t* rowp = FF + (size_t)(row0 + ai * 128 + m * 16) * DFF + col0;
#pragma unroll
                for (int bj = 0; bj < 2; ++bj) { f32x4 v0 = acc[ai][bj][m][0], v1 = acc[ai][bj][m][1];
#pragma unroll
                    for (int j = 0; j < 4; ++j) { const float a = fmaxf(v0[j], 0.f), b = fmaxf(v1[j], 0.f); v0[j] = a * a; v1[j] = b * b; }
                    u32x4 w; w.x = pg8::cvt_pk_bf16(v0[0], v0[1]); w.y = pg8::cvt_pk_bf16(v0[2], v0[3]); w.z = pg8::cvt_pk_bf16(v1[0], v1[1]); w.w = pg8::cvt_pk_bf16(v1[2], v1[3]);
                    *(u32x4*)(rowp + bj * 128) = w; } }
    }
};
struct EpiS5E {
    static constexpr bool PERM = false;
    float* E;
    DI void operator()(const f32x4 (&acc)[2][2][4][2], const Unit& u, int wr, int wc, int fr, int fq) const {
        const int row0 = u.pm * 256 + wr * 64 + fr, col0 = wc * 32 + 4 * fq;
#pragma unroll
        for (int ai = 0; ai < 2; ++ai)
#pragma unroll
            for (int m = 0; m < 4; ++m) { float* rowp = E + (size_t)(row0 + ai * 128 + m * 16) * 256 + col0;
#pragma unroll
                for (int bj = 0; bj < 2; ++bj)
#pragma unroll
                    for (int n = 0; n < 2; ++n) *(f32x4*)(rowp + bj * 128 + n * 16) = acc[ai][bj][m][n]; }
    }
};
struct EpiS5Y {
    static constexpr bool PERM = true;
    const bf16_t* U2; bf16_t* Z; const float* dskip;
    DI void operator()(const f32x4 (&acc)[2][2][4][2], const Unit& u, int wr, int wc, int fr, int fq) const {
        const int g = u.pm / 5, pml = u.pm - g * 5, pnl = u.pn - g * 2;
#pragma unroll
        for (int ai = 0; ai < 2; ++ai)
#pragma unroll
            for (int m = 0; m < 4; ++m) {
                const int chunk = pml * 256 + ai * 128 + wr * 64 + m * 16 + fr;
                if (chunk < NCH32) {
#pragma unroll
                    for (int bj = 0; bj < 2; ++bj) {
                        const int n0 = pnl * 256 + bj * 128 + wc * 32 + 8 * fq;
                        const int t = n0 >> 4, h0 = n0 & 15;
                        const u32x4 uw = *(const u32x4*)(U2 + ((size_t)(g * U2ROWS + chunk) * U2LD + n0));
                        float uf[8]; unpack8(uw, uf);
                        const f32x4 v0 = acc[ai][bj][m][0], v1 = acc[ai][bj][m][1];
                        float y[8];
#pragma unroll
                        for (int j = 0; j < 4; ++j) { y[j] = v0[j]; y[4 + j] = v1[j]; }
#pragma unroll
                        for (int j = 0; j < 8; ++j) y[j] = gelu_tanh(y[j] + dskip[g * 16 + h0 + j] * uf[j]);
                        *(u32x4*)(Z + ((size_t)(chunk * 32 + t) * 256 + g * 16 + h0)) = pack8(y);
                        __builtin_amdgcn_sched_barrier(0);
                    }
                }
            }
    }
};
struct EpiGlu {
    static constexpr bool PERM = true;
    const bf16_t* Z; bf16_t* YM; float* SS; const float* glub;
    DI void operator()(const f32x4 (&acc)[2][2][4][2], const Unit& u, int wr, int wc, int fr, int fq) const {
        const int row0 = u.pm * 256 + wr * 64 + fr;
#pragma unroll
        for (int ai = 0; ai < 2; ++ai)
#pragma unroll
            for (int m = 0; m < 4; ++m) {
                const int r = row0 + ai * 128 + m * 16;
                int seq, pos; row_info(r, seq, pos);
                const bool valid = pos >= PADR;
                float ssum = 0.f;
#pragma unroll
                for (int bj = 0; bj < 2; ++bj) {
                    const int c0 = bj * 128 + wc * 32 + 8 * fq;
                    const u32x4 zw = *(const u32x4*)(Z + (size_t)r * 256 + c0);
                    float zf[8]; unpack8(zw, zf);
                    const f32x4 v0 = acc[ai][bj][m][0], v1 = acc[ai][bj][m][1];
                    float y[8];
#pragma unroll
                    for (int j = 0; j < 4; ++j) { y[j] = v0[j]; y[4 + j] = v1[j]; }
#pragma unroll
                    for (int j = 0; j < 8; ++j) { const float o = valid ? zf[j] * sigmoidf_(y[j] + glub[c0 + j]) : 0.f; y[j] = o; ssum += o * o; }
                    *(u32x4*)(YM + (size_t)r * D + 768 + c0) = pack8(y);
                    __builtin_amdgcn_sched_barrier(0);
                }
                ssum += __shfl_xor(ssum, 16); ssum += __shfl_xor(ssum, 32);
                if (fq == 0) SS[(size_t)r * 16 + 12 + wc] = ssum;
            }
    }
};

DI f32x4 mma_tile64(const bf16_t* A, const bf16_t* Bt, int ld, int lane, f32x4 acc) {
    const int r = lane & 15, q = lane >> 4;
#pragma unroll
    for (int ks = 0; ks < 2; ++ks) {
        const bf16x8 a = *(const bf16x8*)(A + r * ld + ks * 32 + q * 8);
        const bf16x8 b = *(const bf16x8*)(Bt + r * ld + ks * 32 + q * 8);
        acc = __builtin_amdgcn_mfma_f32_16x16x32_bf16(a, b, acc, 0, 0, 0);
    }
    return acc;
}

DI void phase_prep(const Params& p, unsigned char* lds) {
    const int tid = ltid();
    float* LB = (float*)(p.ws + WS_LB);
    for (int i = lbid() * 512 + tid; i < 2 * 384; i += lgdim() * 512) {
        const int d = i / 384, c = i % 384;
        float lg[4], mx = -1e30f;
#pragma unroll
        for (int l = 0; l < 4; ++l) { lg[l] = p.in[I_LBL][(d * 4 + l) * 384 + c]; mx = fmaxf(mx, lg[l]); }
        float s = 0.f;
#pragma unroll
        for (int l = 0; l < 4; ++l) { lg[l] = expf(lg[l] - mx); s += lg[l]; }
        float cum = 0.f;
#pragma unroll
        for (int l = 0; l < 4; ++l) { if (l > 0) cum += lg[l] / s; LB[(d * 4 + l) * 384 + c] = cum; }
    }
    float* PAR = (float*)(p.ws + WS_PAR);
    float* KTAB = (float*)((unsigned char*)p.out + DO_KTAB);
    float* BBAR = (float*)((unsigned char*)p.out + DO_BBAR);
    float* sAR = (float*)lds;
    float* sAI = sAR + 64;
    float* sBB = sAI + 64;
    float* sC  = sBB + 2048;
    float* sW  = sC + 2048;
    for (int item = lbid(); item < 4 * 16 * 2; item += lgdim()) {
        const int l = item / 32, g = (item / 2) % 16, d = item % 2;
        const int base = ((l * 2 + d) * 16 + g);
        const float dt = expf(p.in[I_LDT][base]);
        __syncthreads();
        if (tid < 64) {
            const float lr = p.in[I_ARE][base * 64 + tid], li = p.in[I_AIM][base * 64 + tid];
            const float ar = lr * dt, ai = li * dt;
            sAR[tid] = ar; sAI[tid] = ai;
            PAR[(base * 64 + tid) * 2 + 0] = ar; PAR[(base * 64 + tid) * 2 + 1] = ai;
        }
        __syncthreads();
        for (int e = tid; e < 1024; e += 512) {
            const int pp = e >> 4, h = e & 15;
            const float ar = sAR[pp], ai = sAI[pp];
            const float lr = p.in[I_ARE][base * 64 + pp], li = p.in[I_AIM][base * 64 + pp];
            float sn, cs; sincosf(ai, &sn, &cs);
            const float em1 = expm1f(ar), ex = em1 + 1.0f;
            const float sh = sinf(0.5f * ai);
            const float x = em1 * cs - 2.0f * sh * sh, y = ex * sn;
            const float den = lr * lr + li * li;
            const float cr = (x * lr + y * li) / den, ci = (y * lr - x * li) / den;
            const float br = p.in[I_BRE][(size_t)(base * 64 + pp) * 16 + h], bi = p.in[I_BIM][(size_t)(base * 64 + pp) * 16 + h];
            const float rr = cr * br - ci * bi, ri = cr * bi + ci * br;
            sBB[e * 2] = rr; sBB[e * 2 + 1] = ri;
            BBAR[((size_t)(base * 64 + pp) * 16 + h) * 2] = rr; BBAR[((size_t)(base * 64 + pp) * 16 + h) * 2 + 1] = ri;
        }
        for (int e = tid; e < 1024; e += 512) {
            sC[e * 2] = p.in[I_CRE][(size_t)base * 1024 + e]; sC[e * 2 + 1] = p.in[I_CIM][(size_t)base * 1024 + e];
        }
        __syncthreads();
_Pragma("nounroll")
        for (int tau = 0; tau < 32; ++tau) {
            if (tid < 64) { const float mg = expf(tau * sAR[tid]); float sn, cs; sincosf(tau * sAI[tid], &sn, &cs); sW[tid * 2] = mg * cs; sW[tid * 2 + 1] = mg * sn; }
            __syncthreads();
            if (tid < 256) {
                const int hp = tid >> 4, h = tid & 15;
                float s = 0.f;
_Pragma("unroll 4")
                for (int pp = 0; pp < 64; ++pp) {
                    const float wr_ = sW[pp * 2], wi_ = sW[pp * 2 + 1];
                    const float br = sBB[(pp * 16 + h) * 2], bi = sBB[(pp * 16 + h) * 2 + 1];
                    const float tr = wr_ * br - wi_ * bi, ti = wr_ * bi + wi_ * br;
                    const float cr = sC[(hp * 64 + pp) * 2], ci = sC[(hp * 64 + pp) * 2 + 1];
                    s += cr * tr - ci * ti;
                }
                KTAB[((size_t)((l * 16 + g) * 2 + d) * 32 + tau) * 256 + tid] = s;
            }
            __syncthreads();
        }
    }
}

DI void norm_rows(const Params& p, bool zero_ss, bool build, const float* gain) {
    const int tid = ltid(); const int lane = tid & 63, wave = tid >> 6;
    float* H = (float*)(p.ws + WS_H); bf16_t* ACT = (bf16_t*)(p.ws + WS_ACT); float* SS = (float*)(p.ws + WS_SS);
    for (int R = lbid() * 8 + wave; R < MP; R += lgdim() * 8) {
        f32x4 v[4];
        float* hr = H + (size_t)R * D;
        if (build) {
            int seq, pos; row_info(R, seq, pos);
            const int t = pos - PADR;
            const float* src = nullptr;
            if (t >= 0) { if (t < 16) src = p.in[I_META] + (size_t)t * D; else src = (seq < 4) ? p.in[I_XP] + ((size_t)seq * 4096 + (t - 16)) * D : p.in[I_XS] + ((size_t)(seq - 4) * 2048 + (t - 16)) * D; }
#pragma unroll
            for (int i = 0; i < 4; ++i) { v[i] = src ? *(const f32x4*)(src + (lane + 64 * i) * 4) : (f32x4){0.f, 0.f, 0.f, 0.f}; *(f32x4*)(hr + (lane + 64 * i) * 4) = v[i]; }
        } else {
#pragma unroll
            for (int i = 0; i < 4; ++i) v[i] = *(const f32x4*)(hr + (lane + 64 * i) * 4);
        }
        float ss = 0.f;
#pragma unroll
        for (int i = 0; i < 4; ++i) ss += v[i][0] * v[i][0] + v[i][1] * v[i][1] + v[i][2] * v[i][2] + v[i][3] * v[i][3];
#pragma unroll
        for (int o = 1; o < 64; o <<= 1) ss += __shfl_xor(ss, o);
        const float rn = rsqrtf(ss * (1.0f / D) + EPS);
#pragma unroll
        for (int i = 0; i < 4; ++i) {
            const f32x4 gg = *(const f32x4*)(gain + (lane + 64 * i) * 4);
            u32x2 w; w.x = pack2(v[i][0] * rn * gg[0], v[i][1] * rn * gg[1]); w.y = pack2(v[i][2] * rn * gg[2], v[i][3] * rn * gg[3]);
            *(u32x2*)(ACT + (size_t)R * D + (lane + 64 * i) * 4) = w;
        }
    }
}

DI void tr_tile(const float* src, int lds_, bf16_t* dst, int ldd, float* tile) {
    const int tid = ltid();
    __syncthreads();
    { const int r = tid >> 4, c4 = (tid & 15) * 4;
#pragma unroll
      for (int rr = 0; rr < 64; rr += 32) { const f32x4 v = *(const f32x4*)(src + (size_t)(r + rr) * lds_ + c4); float* tp = tile + (r + rr) * 65 + c4; tp[0] = v[0]; tp[1] = v[1]; tp[2] = v[2]; tp[3] = v[3]; } }
    __syncthreads();
    { const int n = tid >> 3, k8 = (tid & 7) * 8; float f[8];
#pragma unroll
      for (int i = 0; i < 8; ++i) f[i] = tile[(k8 + i) * 65 + n];
      *(u32x4*)(dst + (size_t)n * ldd + k8) = pack8(f); }
}

DI void convert_weights(const Params& p, int l, unsigned char* lds) {
    float* tile = (float*)lds;
    bf16_t* WIN = (bf16_t*)(p.ws + WS_WIN); bf16_t* WOUT = (bf16_t*)(p.ws + WS_WOUT); bf16_t* WUP = (bf16_t*)(p.ws + WS_WUP); bf16_t* WDN = (bf16_t*)(p.ws + WS_WDN);
    bf16_t* WG = (bf16_t*)(p.ws + WS_WG); bf16_t* GLU = (bf16_t*)(p.ws + WS_GLU);
    const int T_IN = 16 * 46, T_OUT = 16 * 16, T_UP = 16 * 64, T_DN = 64 * 16, T_WG = 24, T_GLU = 16;
    const int total = T_IN + T_OUT + T_UP + T_DN + T_WG + T_GLU;
    for (int it = lbid(); it < total; it += lgdim()) {
        int i = it;
        if (i < T_IN) { const int kt = i / 46, nt = i % 46;
            const int n0 = nt * 64; const int nd = (n0 >= 2688) ? n0 - 2688 : n0 + 256;
            tr_tile(p.in[I_WIN] + (size_t)l * 1024 * 2944 + (size_t)kt * 64 * 2944 + n0, 2944, WIN + (size_t)nd * 1024 + kt * 64, 1024, tile); continue; }
        i -= T_IN;
        if (i < T_OUT) { const int kt = i / 16, nt = i % 16;
            tr_tile(p.in[I_WOUT] + (size_t)l * 1024 * 1024 + (size_t)kt * 64 * 1024 + nt * 64, 1024, WOUT + (size_t)nt * 64 * 1024 + kt * 64, 1024, tile); continue; }
        i -= T_OUT;
        if (i < T_UP) { const int kt = i / 64, nt = i % 64;
            tr_tile(p.in[I_WUP] + (size_t)l * 1024 * 4096 + (size_t)kt * 64 * 4096 + nt * 64, 4096, WUP + (size_t)nt * 64 * 1024 + kt * 64, 1024, tile); continue; }
        i -= T_UP;
        if (i < T_DN) { const int kt = i / 16, nt = i % 16;
            tr_tile(p.in[I_WDN] + (size_t)l * 4096 * 1024 + (size_t)kt * 64 * 1024 + nt * 64, 1024, WDN + (size_t)nt * 64 * 4096 + kt * 64, 4096, tile); continue; }
        i -= T_DN;
        if (i < T_WG) { const int n = i / 4, gi = i % 4, d = gi >> 1;
            const float* src = ((gi & 1) ? p.in[I_WI] : p.in[I_WR]) + ((size_t)((l * 2 + d) * 6 + n)) * 4096;
            tr_tile(src, 64, WG + (size_t)(n * 256 + gi * 64) * 64, 64, tile); continue; }
        i -= T_WG;
        { const int kt = i / 4, nt = i % 4;
          tr_tile(p.in[I_GLUW] + (size_t)l * 65536 + (size_t)kt * 64 * 256 + nt * 64, 256, GLU + (size_t)nt * 64 * 256 + kt * 64, 256, tile); }
    }
    for (size_t e = (size_t)lbid() * 512 + ltid(); e < (size_t)128 * 1024 / 8; e += (size_t)lgdim() * 512) *(u32x4*)(WIN + (size_t)2944 * 1024 + e * 8) = (u32x4){0u, 0u, 0u, 0u};
}

DI void build_s5_mats(const Params& p, int l) {
    const float* KTAB = (const float*)((const unsigned char*)p.out + DO_KTAB);
    const float* BBAR = (const float*)((const unsigned char*)p.out + DO_BBAR);
    const float* PAR = (const float*)(p.ws + WS_PAR);
    bf16_t* T2 = (bf16_t*)(p.ws + WS_T2); bf16_t* M1 = (bf16_t*)(p.ws + WS_M1);
    const size_t nT2 = (size_t)16 * 512 * 96, nM1 = (size_t)16 * 256 * 64;
    for (size_t e = (size_t)lbid() * 512 + ltid(); e < nT2 + nM1; e += (size_t)lgdim() * 512) {
        float f[8];
        if (e < nT2) {
            const int g = (int)(e / (512 * 96)), rem = (int)(e % (512 * 96)), n = rem / 96, k0 = (rem % 96) * 8;
            const int t = n >> 4, hp = n & 15;
            if (k0 < 512) {
                const int s = k0 >> 4, h0 = k0 & 15;
#pragma unroll
                for (int j = 0; j < 8; ++j) {
                    float v = 0.f;
                    if (s <= t) v += KTAB[((size_t)((l * 16 + g) * 2 + 0) * 32 + (t - s)) * 256 + hp * 16 + h0 + j];
                    if (s >= t) v += KTAB[((size_t)((l * 16 + g) * 2 + 1) * 32 + (s - t)) * 256 + hp * 16 + h0 + j];
                    f[j] = v;
                }
            } else {
                const int kk = k0 - 512, d = kk >> 7, part = (kk >> 6) & 1, p0 = kk & 63;
                const int base = (l * 2 + d) * 16 + g;
                const float pw = d == 0 ? (float)(t + 1) : (float)(32 - t);
#pragma unroll
                for (int j = 0; j < 8; ++j) {
                    const int pp = p0 + j;
                    const float ar = PAR[(base * 64 + pp) * 2], ai = PAR[(base * 64 + pp) * 2 + 1];
                    const float mg = expf(pw * ar); float sn, cs; sincosf(pw * ai, &sn, &cs);
                    const float wr_ = mg * cs, wi_ = mg * sn;
                    const float cr = p.in[I_CRE][(size_t)base * 1024 + hp * 64 + pp], ci = p.in[I_CIM][(size_t)base * 1024 + hp * 64 + pp];
                    f[j] = part == 0 ? (cr * wr_ - ci * wi_) : -(cr * wi_ + ci * wr_);
                }
            }
            *(u32x4*)(T2 + ((size_t)(g * 512 + n) * 768 + k0)) = pack8(f);
        } else {
            const size_t e2 = e - nT2;
            const int g = (int)(e2 / (256 * 64)), rem = (int)(e2 % (256 * 64)), n = rem / 64, k0 = (rem % 64) * 8;
            const int d = n >> 7, part = (n >> 6) & 1, pp = n & 63;
            const int s = k0 >> 4, h0 = k0 & 15;
            const int base = (l * 2 + d) * 16 + g;
            const float pw = d == 0 ? (float)(31 - s) : (float)s;
            const float ar = PAR[(base * 64 + pp) * 2], ai = PAR[(base * 64 + pp) * 2 + 1];
            const float mg = expf(pw * ar); float sn, cs; sincosf(pw * ai, &sn, &cs);
            const float wr_ = mg * cs, wi_ = mg * sn;
#pragma unroll
            for (int j = 0; j < 8; ++j) {
                const float br = BBAR[((size_t)(base * 64 + pp) * 16 + h0 + j) * 2], bi = BBAR[((size_t)(base * 64 + pp) * 16 + h0 + j) * 2 + 1];
                f[j] = part == 0 ? (wr_ * br - wi_ * bi) : (wr_ * bi + wi_ * br);
            }
            *(u32x4*)(M1 + ((size_t)(g * 256 + n) * 512 + k0)) = pack8(f);
        }
    }
}

DI void rg_item(const Params& p, int l, int item, bool fin, unsigned char* lds) {
    const int tid = ltid(), lane = tid & 63, wave = tid >> 6;
    const int j = item / 6, n = item % 6;
    const int row0 = j * 64, pos0 = chunk64_pos0(j), L = chunk64_len(j);
    const bf16_t* PROJ = (const bf16_t*)(p.ws + WS_PROJ);
    float* XCF = (float*)lds;
    float* AB = (float*)(lds + 16384);
    bf16_t* WGs = (bf16_t*)(lds + 16384);
    bf16_t* XCB = (bf16_t*)(lds + 16384 + 36864);
    bf16_t* XA = (bf16_t*)(lds + 16384 + 36864 + 9216);
    bf16_t* GA = (bf16_t*)(lds + 16384 + 65536);
    const bf16_t* WG = (const bf16_t*)(p.ws + WS_WG);
    __syncthreads();
    for (int idx = tid; idx < 67 * 8; idx += 512) {
        const int rr = idx >> 3, c8 = (idx & 7) * 8;
        const int pos = pos0 + rr - 2;
        u32x4 w = (u32x4){0u, 0u, 0u, 0u};
        if (pos >= PADR && pos < L) w = *(const u32x4*)(PROJ + (size_t)(row0 + rr - 2) * PLD + OFF_AX + n * 64 + c8);
        *(u32x4*)(XA + rr * 64 + c8) = w;
    }
    for (int idx = tid; idx < 256 * 8; idx += 512) { const int r = idx >> 3, c8 = (idx & 7) * 8; *(u32x4*)(WGs + r * 72 + c8) = *(const u32x4*)(WG + (size_t)(n * 256 + r) * 64 + c8); }
    if (fin) { const int t = tid >> 3, c8 = (tid & 7) * 8; *(u32x4*)(GA + t * 64 + c8) = *(const u32x4*)(PROJ + (size_t)(row0 + t) * PLD + OFF_AG + n * 64 + c8); }
    __syncthreads();
    { const int t = tid >> 3, c8 = (tid & 7) * 8;
      const float* cw = p.in[I_CONVW] + (size_t)l * 4 * 384 + n * 64 + c8; const float* cb = p.in[I_CONVB] + (size_t)l * 384 + n * 64 + c8;
      float xc[8];
#pragma unroll
      for (int i = 0; i < 8; ++i) { float s = cb[i];
#pragma unroll
          for (int jj = 0; jj < 4; ++jj) s += cw[jj * 384 + i] * bf2f(XA[(t + jj) * 64 + c8 + i]);
          xc[i] = s; XCF[t * 64 + c8 + i] = s; }
      *(u32x4*)(XCB + t * 72 + c8) = pack8(xc); }
    __syncthreads();
    const int rb = wave & 3, dir = wave >> 2;
    f32x4 acc[8];
#pragma unroll
    for (int c = 0; c < 8; ++c) acc[c] = mma_tile64(XCB + rb * 16 * 72, WGs + (dir * 8 + c) * 16 * 72, 72, lane, (f32x4){0.f, 0.f, 0.f, 0.f});
    __syncthreads();
    { const int cl = lane & 15, q = lane >> 4;
#pragma unroll
      for (int cc = 0; cc < 4; ++cc) {
          const int c = cc * 16 + cl, ch = n * 64 + c;
          const float brv = p.in[I_BR][(size_t)(l * 2 + dir) * 384 + ch], biv = p.in[I_BI][(size_t)(l * 2 + dir) * 384 + ch];
          const float lam = p.in[I_LAM][(size_t)(l * 2 + dir) * 384 + ch];
          const float sp = log1pf(__expf(-lam));
#pragma unroll
          for (int jj = 0; jj < 4; ++jj) {
              const int t = rb * 16 + q * 4 + jj;
              const float r = sigmoidf_(acc[cc][jj] + brv), ig = sigmoidf_(acc[cc + 4][jj] + biv);
              const float la = -8.0f * r * sp;
              float a = __expf(la), b = sqrtf(fmaxf(-expm1f(2.0f * la), 0.f)) * ig * XCF[t * 64 + c];
              if (pos0 + t < PADR) { a = 1.0f; b = 0.f; }
              AB[(dir * 2) * 4096 + t * 64 + c] = a; AB[(dir * 2 + 1) * 4096 + t * 64 + c] = b;
          } } }
    __syncthreads();
    float* RGC = (float*)((unsigned char*)p.out + DO_RGC);
    if (tid < 128) {
        const int c = tid & 63, d = tid >> 6, ch = n * 64 + c;
        float* cp = RGC + ((size_t)(j * 2 + d) * 384 + ch) * 2;
        const float* Aa = AB + (d * 2) * 4096 + c; float* Bb = AB + (d * 2 + 1) * 4096 + c;
        if (!fin) {
            float P = 1.f, E = 0.f;
            if (d == 0) {
_Pragma("unroll 8")
 for (int t = 0; t < 64; ++t) { const float a = Aa[t * 64]; E = a * E + Bb[t * 64]; P *= a; } }
            else {
_Pragma("unroll 8")
 for (int t = 63; t >= 0; --t) { const float a = Aa[t * 64]; E = a * E + Bb[t * 64]; P *= a; } }
            cp[0] = P; cp[1] = E;
        } else {
            float h = cp[1];
            if (d == 0) {
_Pragma("unroll 8")
 for (int t = 0; t < 64; ++t) { h = Aa[t * 64] * h + Bb[t * 64]; Bb[t * 64] = h; } }
            else {
_Pragma("unroll 8")
 for (int t = 63; t >= 0; --t) { h = Aa[t * 64] * h + Bb[t * 64]; Bb[t * 64] = h; } }
        }
    }
    if (!fin) return;
    __syncthreads();
    { const int t = tid >> 3, c8 = (tid & 7) * 8;
      bf16_t* YM = (bf16_t*)(p.ws + WS_ACT); float* SS = (float*)(p.ws + WS_SS);
      const bool valid = pos0 + t >= PADR;
      float y[8], ss = 0.f;
#pragma unroll
      for (int i = 0; i < 8; ++i) { const int c = c8 + i; const float hs = AB[1 * 4096 + t * 64 + c] + AB[3 * 4096 + t * 64 + c];
          const float o = valid ? hs * gelu_tanh(bf2f(GA[t * 64 + c])) : 0.f; y[i] = o; ss += o * o; }
      *(u32x4*)(YM + (size_t)(row0 + t) * D + n * 64 + c8) = pack8(y);
      ss += __shfl_xor(ss, 1); ss += __shfl_xor(ss, 2); ss += __shfl_xor(ss, 4);
      if ((tid & 7) == 0) SS[(size_t)(row0 + t) * 16 + n] = ss; }
}

DI void hg_item(const Params& p, int l, int item, bool fin, unsigned char* lds) {
    const int tid = ltid(), lane = tid & 63, wave = tid >> 6;
    const int j = item / 6, n = item % 6;
    const int row0 = j * 64, pos0 = chunk64_pos0(j);
    const bf16_t* PROJ = (const bf16_t*)(p.ws + WS_PROJ);
    const float* LB = (const float*)(p.ws + WS_LB);
    float* LF = (float*)lds;
    bf16_t* QT = (bf16_t*)(lds + 32768);
    bf16_t* KT = (bf16_t*)(lds + 51200);
    bf16_t* VT = (bf16_t*)(lds + 69632);
    bf16_t* SC = (bf16_t*)(lds + 78848);
    bf16_t* SP = (bf16_t*)(lds + 97280);
    bf16_t* XG = (bf16_t*)(lds + 115712);
    float* OX = (float*)lds;
    float* HGS = (float*)((unsigned char*)p.out + DO_HGS);
    float* HGD = (float*)(p.ws + WS_HGD);
    const int t = tid >> 3, k8 = (tid & 7) * 8;
    const bool masked = pos0 + t < PADR;
    __syncthreads();
    float kk[2][8], q[8];
    {
        const bf16_t* rowp = PROJ + (size_t)(row0 + t) * PLD + n * 64 + k8;
        float xf[8], xv[8];
        unpack8(*(const u32x4*)(rowp + OFF_BI), xv);
#pragma unroll
        for (int i = 0; i < 8; ++i) VT[(k8 + i) * 72 + t] = f2bf(masked ? 0.f : xv[i]);
#pragma unroll
        for (int d = 0; d < 2; ++d) {
            unpack8(*(const u32x4*)(rowp + (d == 0 ? OFF_BFF : OFF_BFB)), xf);
#pragma unroll
            for (int i = 0; i < 8; ++i) {
                const float lb = LB[(d * 4 + l) * 384 + n * 64 + k8 + i];
                const float sg = sigmoidf_(xf[i]);
                const float f = lb + (1.0f - lb) * sg;
                kk[d][i] = masked ? 0.f : (1.0f - lb) * (1.0f - sg);
                LF[d * 4096 + t * 64 + k8 + i] = masked ? 0.f : __logf(f);
            }
        }
#pragma unroll
        for (int i = 0; i < 8; ++i) q[i] = 0.f;
        if (fin) {
            unpack8(*(const u32x4*)(rowp + OFF_BQ), q);
#pragma unroll
            for (int i = 0; i < 8; ++i) q[i] = siluf_(q[i]);
            *(u32x4*)(XG + t * 64 + k8) = *(const u32x4*)(rowp + OFF_BG);
        }
    }
    __syncthreads();
    if (tid < 128) {
        const int k = tid & 63, d = tid >> 6; float run = 0.f; float* lf = LF + d * 4096 + k;
        if (d == 0) {
_Pragma("unroll 8")
 for (int s = 0; s < 64; ++s) { run += lf[s * 64]; lf[s * 64] = run; } }
        else {
_Pragma("unroll 8")
 for (int s = 63; s >= 0; --s) { run += lf[s * 64]; lf[s * 64] = run; } }
    }
    __syncthreads();
    const int rb = wave & 3, dir = wave >> 2, cl = lane & 15, qd = lane >> 4;
    if (!fin) {
#pragma unroll
        for (int d = 0; d < 2; ++d)
#pragma unroll
            for (int i = 0; i < 8; ++i) {
                const int k = k8 + i; const float tot = d == 0 ? LF[63 * 64 + k] : LF[4096 + k];
                KT[d * 4608 + k * 72 + t] = f2bf(kk[d][i] * __expf(tot - LF[d * 4096 + t * 64 + k]));
                if (t == 0) HGD[((size_t)(j * 6 + n) * 2 + d) * 64 + k] = __expf(tot);
            }
        __syncthreads();
#pragma unroll
        for (int kb = 0; kb < 4; ++kb) {
            const f32x4 a = mma_tile64(VT + rb * 16 * 72, KT + dir * 4608 + kb * 16 * 72, 72, lane, (f32x4){0.f, 0.f, 0.f, 0.f});
            float* dst = HGS + ((size_t)(j * 6 + n) * 2 + dir) * 4096;
#pragma unroll
            for (int jj = 0; jj < 4; ++jj) dst[(rb * 16 + qd * 4 + jj) * 64 + kb * 16 + cl] = a[jj];
        }
        return;
    }
#pragma unroll
    for (int d = 0; d < 2; ++d) {
        float qv[8], kv[8];
#pragma unroll
        for (int i = 0; i < 8; ++i) {
            const int k = k8 + i; const float m = LF[d * 4096 + 32 * 64 + k];
            const float e1 = fminf(fmaxf(LF[d * 4096 + t * 64 + k] - m, -80.f), 80.f);
            qv[i] = q[i] * __expf(e1); kv[i] = kk[d][i] * __expf(-e1);
        }
        *(u32x4*)(QT + d * 4608 + t * 72 + k8) = pack8(qv);
        *(u32x4*)(KT + d * 4608 + t * 72 + k8) = pack8(kv);
        const float* sin_ = HGS + ((size_t)(j * 6 + n) * 2 + d) * 4096 + t * 64 + k8;
        const f32x4 s0 = *(const f32x4*)sin_, s1 = *(const f32x4*)(sin_ + 4);
        float sv[8];
#pragma unroll
        for (int i = 0; i < 4; ++i) { sv[i] = s0[i] * __expf(LF[d * 4096 + 32 * 64 + k8 + i]); sv[4 + i] = s1[i] * __expf(LF[d * 4096 + 32 * 64 + k8 + 4 + i]); }
        *(u32x4*)(SP + d * 4608 + t * 72 + k8) = pack8(sv);
    }
    __syncthreads();
#pragma unroll
    for (int ct = 0; ct < 4; ++ct) {
        const f32x4 a = mma_tile64(QT + dir * 4608 + rb * 16 * 72, KT + dir * 4608 + ct * 16 * 72, 72, lane, (f32x4){0.f, 0.f, 0.f, 0.f});
#pragma unroll
        for (int jj = 0; jj < 4; ++jj) {
            const int tt = rb * 16 + qd * 4 + jj, s = ct * 16 + cl;
            const bool keep = dir == 0 ? (s <= tt) : (s >= tt);
            SC[dir * 4608 + tt * 72 + s] = f2bf(keep ? a[jj] : 0.f);
        }
    }
    __syncthreads();
    f32x4 o[4];
#pragma unroll
    for (int vt = 0; vt < 4; ++vt) {
        f32x4 a = mma_tile64(SC + dir * 4608 + rb * 16 * 72, VT + vt * 16 * 72, 72, lane, (f32x4){0.f, 0.f, 0.f, 0.f});
        o[vt] = mma_tile64(QT + dir * 4608 + rb * 16 * 72, SP + dir * 4608 + vt * 16 * 72, 72, lane, a);
    }
    if (dir == 1) {
#pragma unroll
        for (int vt = 0; vt < 4; ++vt)
#pragma unroll
            for (int jj = 0; jj < 4; ++jj) OX[(rb * 16 + qd * 4 + jj) * 64 + vt * 16 + cl] = o[vt][jj];
    }
    __syncthreads();
    if (dir == 0) {
        bf16_t* YM = (bf16_t*)(p.ws + WS_ACT); float* SS = (float*)(p.ws + WS_SS);
#pragma unroll
        for (int jj = 0; jj < 4; ++jj) {
            const int tt = rb * 16 + qd * 4 + jj;
            float ov[4], s = 0.f;
#pragma unroll
            for (int vt = 0; vt < 4; ++vt) { ov[vt] = o[vt][jj] + OX[tt * 64 + vt * 16 + cl]; s += ov[vt] * ov[vt]; }
            s += __shfl_xor(s, 1); s += __shfl_xor(s, 2); s += __shfl_xor(s, 4); s += __shfl_xor(s, 8);
            const float rn = rsqrtf(s * (1.0f / 64.0f) + EPS);
            const bool valid = pos0 + tt >= PADR;
            float s2 = 0.f;
#pragma unroll
            for (int vt = 0; vt < 4; ++vt) {
                const int v = vt * 16 + cl;
                const float y = valid ? ov[vt] * rn * siluf_(bf2f(XG[tt * 64 + v])) : 0.f;
                s2 += y * y;
                YM[(size_t)(row0 + tt) * D + 384 + n * 64 + v] = f2bf(y);
            }
            s2 += __shfl_xor(s2, 1); s2 += __shfl_xor(s2, 2); s2 += __shfl_xor(s2, 4); s2 += __shfl_xor(s2, 8);
            if (cl == 0) SS[(size_t)(row0 + tt) * 16 + 6 + n] = s2;
        }
    }
}

constexpr int CG = 16;
DI void phase_carries(const Params& p, int l) {
    float* HGS = (float*)((unsigned char*)p.out + DO_HGS);
    const float* HGD = (const float*)(p.ws + WS_HGD);
    float* RGC = (float*)((unsigned char*)p.out + DO_RGC);
    const float* S5E = (const float*)((const unsigned char*)p.out + DO_S5E);
    bf16_t* U2 = (bf16_t*)(p.ws + WS_U2);
    const float* PAR = (const float*)(p.ws + WS_PAR);
    const int N_HG = 12 * 6 * 2 * 4096, N_RG = 12 * 2 * 384, N_S5 = 12 * 16 * 2 * 64;
    for (int idx = lbid() * 512 + ltid(); idx < N_HG + N_RG + N_S5; idx += lgdim() * 512) {
        if (idx < N_HG) {
            const int seq = idx / 49152, rem = idx % 49152, n = rem / 8192, d = (rem >> 12) & 1, e = rem & 4095, k = e & 63;
            int c0, nc; seq_chunks64(seq, c0, nc);
            float S = 0.f;
            for (int i0 = 0; i0 < nc; i0 += CG) {
                float loc[CG], dec[CG];
#pragma unroll
                for (int u = 0; u < CG; ++u) { const int i = i0 + u; if (i < nc) { const int jc = d == 0 ? c0 + i : c0 + nc - 1 - i; const size_t b = (size_t)(jc * 6 + n) * 2 + d; loc[u] = HGS[b * 4096 + e]; dec[u] = HGD[b * 64 + k]; } else { loc[u] = 0.f; dec[u] = 0.f; } }
#pragma unroll
                for (int u = 0; u < CG; ++u) { const int i = i0 + u; if (i < nc) { const int jc = d == 0 ? c0 + i : c0 + nc - 1 - i; const size_t b = (size_t)(jc * 6 + n) * 2 + d; HGS[b * 4096 + e] = S; S = dec[u] * S + loc[u]; } }
            }
        } else if (idx < N_HG + N_RG) {
            const int i2 = idx - N_HG; const int seq = i2 / 768, rem = i2 % 768, d = rem / 384, ch = rem % 384;
            int c0, nc; seq_chunks64(seq, c0, nc);
            float c = 0.f;
            for (int i0 = 0; i0 < nc; i0 += CG) {
                float P[CG], E[CG];
#pragma unroll
                for (int u = 0; u < CG; ++u) { const int i = i0 + u; if (i < nc) { const int jc = d == 0 ? c0 + i : c0 + nc - 1 - i; const float* cp = RGC + ((size_t)(jc * 2 + d) * 384 + ch) * 2; P[u] = cp[0]; E[u] = cp[1]; } else { P[u] = 0.f; E[u] = 0.f; } }
#pragma unroll
                for (int u = 0; u < CG; ++u) { const int i = i0 + u; if (i < nc) { const int jc = d == 0 ? c0 + i : c0 + nc - 1 - i; float* cp = RGC + ((size_t)(jc * 2 + d) * 384 + ch) * 2; cp[1] = c; c = P[u] * c + E[u]; } }
            }
        } else {
            const int i2 = idx - N_HG - N_RG; const int seq = i2 / 2048, g = (i2 >> 7) & 15, d = (i2 >> 6) & 1, pp = i2 & 63;
            int c0, nc; seq_chunks32(seq, c0, nc);
            const int base = (l * 2 + d) * 16 + g;
            const float ar = PAR[(base * 64 + pp) * 2], ai = PAR[(base * 64 + pp) * 2 + 1];
            const float mg = expf(32.0f * ar); float sn, cs; sincosf(32.0f * ai, &sn, &cs);
            const float wr_ = mg * cs, wi_ = mg * sn;
            float hr = 0.f, hi = 0.f;
            for (int i0 = 0; i0 < nc; i0 += CG) {
                float er[CG], ei[CG];
#pragma unroll
                for (int u = 0; u < CG; ++u) { const int i = i0 + u; if (i < nc) { const int c = d == 0 ? c0 + i : c0 + nc - 1 - i; const size_t ro = (size_t)(g * U2ROWS + c); er[u] = S5E[ro * 256 + d * 128 + pp]; ei[u] = S5E[ro * 256 + d * 128 + 64 + pp]; } else { er[u] = 0.f; ei[u] = 0.f; } }
#pragma unroll
                for (int u = 0; u < CG; ++u) { const int i = i0 + u; if (i < nc) { const int c = d == 0 ? c0 + i : c0 + nc - 1 - i; const size_t ro = (size_t)(g * U2ROWS + c);
                    U2[ro * U2LD + 512 + d * 128 + pp] = f2bf(hr); U2[ro * U2LD + 512 + d * 128 + 64 + pp] = f2bf(hi);
                    const float nr = wr_ * hr - wi_ * hi + er[u], ni = wr_ * hi + wi_ * hr + ei[u]; hr = nr; hi = ni; } }
            }
        }
    }
}

DI void phase_mixnorm(const Params& p, int l) {
    bf16_t* YM = (bf16_t*)(p.ws + WS_ACT); const float* SS = (const float*)(p.ws + WS_SS);
    const float* gain = p.in[I_MGAIN] + (size_t)l * D;
    for (size_t e = (size_t)lbid() * 512 + ltid(); e < (size_t)MP * 128; e += (size_t)lgdim() * 512) {
        const int R = (int)(e >> 7), c0 = (int)(e & 127) * 8;
        const int br = c0 < 384 ? 0 : (c0 < 768 ? 1 : 2);
        const float inv = br == 2 ? (1.0f / 256.0f) : (1.0f / 384.0f);
        const float* sp = SS + (size_t)R * 16; const f32x4 s0 = *(const f32x4*)sp, s1 = *(const f32x4*)(sp + 4), s2 = *(const f32x4*)(sp + 8), s3 = *(const f32x4*)(sp + 12);
        const float tot = br == 0 ? (((s0[0] + s0[1]) + (s0[2] + s0[3])) + (s1[0] + s1[1])) : (br == 1 ? (((s1[2] + s1[3]) + (s2[0] + s2[1])) + (s2[2] + s2[3])) : ((s3[0] + s3[1]) + (s3[2] + s3[3])));
        const float rn = rsqrtf(tot * inv + EPS);
        float f[8]; unpack8(*(const u32x4*)(YM + (size_t)R * D + c0), f);
#pragma unroll
        for (int i = 0; i < 8; ++i) f[i] = f[i] * rn * gain[c0 + i];
        *(u32x4*)(YM + (size_t)R * D + c0) = pack8(f);
    }
}

DI void phase_final(const Params& p) {
    const int tid = ltid(); const int lane = tid & 63, wave = tid >> 6;
    const float* H = (const float*)(p.ws + WS_H); const float* gain = p.in[I_NFIN];
    for (int R = lbid() * 8 + wave; R < MP; R += lgdim() * 8) {
        int seq, pos; row_info(R, seq, pos);
        const int t = pos - PADR - 16;
        if (t < 0) continue;
        float* dst = seq < 4 ? p.out + ((size_t)seq * 4096 + t) * D : p.out + (size_t)4 * 4096 * D + ((size_t)(seq - 4) * 2048 + t) * D;
        f32x4 v[4]; float ss = 0.f;
#pragma unroll
        for (int i = 0; i < 4; ++i) { v[i] = *(const f32x4*)(H + (size_t)R * D + (lane + 64 * i) * 4); ss += v[i][0] * v[i][0] + v[i][1] * v[i][1] + v[i][2] * v[i][2] + v[i][3] * v[i][3]; }
#pragma unroll
        for (int o = 1; o < 64; o <<= 1) ss += __shfl_xor(ss, o);
        const float rn = rsqrtf(ss * (1.0f / D) + EPS);
#pragma unroll
        for (int i = 0; i < 4; ++i) { const f32x4 gg = *(const f32x4*)(gain + (lane + 64 * i) * 4); *(f32x4*)(dst + (lane + 64 * i) * 4) = v[i] * rn * gg; }
    }
}

#define XB_TMO      128
#define XB_XCNT(j)  (256  + 64 * (j))
#define XB_XSUB(j)  (1280 + 64 * (j))
#define XB_XGEN(j)  (2304 + 64 * (j))
#define XB_TOP      3328
#define XB_TOPGEN   3392
#define XCD_BAR_WORDS 3456
#define XB_SPIN_CAP (1u << 18)
DI unsigned xb_ld(unsigned* p)              { return __hip_atomic_load(p, __ATOMIC_RELAXED, __HIP_MEMORY_SCOPE_AGENT); }
DI unsigned xb_add(unsigned* p, unsigned v) { return __hip_atomic_fetch_add(p, v, __ATOMIC_RELAXED, __HIP_MEMORY_SCOPE_AGENT); }
DI unsigned xb_xcc_id() { return (unsigned)__builtin_amdgcn_s_getreg((3 << 11) | 20) & 0xFu; }
#define XB_SPIN(cond, bar) do { unsigned _sp = 0; while (cond) { __builtin_amdgcn_s_sleep(1); \
    if ((++_sp & 255u) == 0u) { if (xb_ld(&(bar)[XB_TMO])) break; if (_sp > XB_SPIN_CAP) { atomicAdd(&(bar)[XB_TMO], 1u); break; } } } } while (0)
struct XcdBarrier { unsigned* bar; unsigned x; volatile LAS unsigned* st; };
DI XcdBarrier xcd_barrier_post(unsigned* bar, volatile LAS unsigned* st) {
    XcdBarrier b; b.bar = bar; b.x = xb_xcc_id(); b.st = st;
    if (threadIdx.x == 0) (void)xb_add(&bar[XB_XCNT(b.x)], 1u);
    return b;
}
DI void xcd_barrier_complete(unsigned* bar, unsigned x, unsigned& nloc, unsigned& nx) {
    const unsigned G = gridDim.x * gridDim.y * gridDim.z;
    unsigned sum, cnt, mine, sp = 0u;
    for (;;) {
        sum = 0u; cnt = 0u; mine = 0u;
#pragma unroll
        for (unsigned j = 0; j < 16; ++j) { const unsigned c = xb_ld(&bar[XB_XCNT(j)]); sum += c; cnt += (c > 0u) ? 1u : 0u; mine = (j == x) ? c : mine; }
        if (sum == G) break;
        __builtin_amdgcn_s_sleep(1);
        if ((++sp & 255u) == 0u) { if (xb_ld(&bar[XB_TMO])) break; if (sp > XB_SPIN_CAP) { atomicAdd(&bar[XB_TMO], 1u); break; } }
    }
    nloc = mine > 0u ? mine : 1u; nx = cnt > 0u ? cnt : 1u;
}
DI void xcd_barrier(const XcdBarrier& b) {
    asm volatile("s_waitcnt vmcnt(0)" ::: "memory");
    __syncthreads();
    if (threadIdx.x == 0) {
        unsigned* bar = b.bar;
        __builtin_amdgcn_s_waitcnt(0);
        unsigned nloc = b.st[0], nx = b.st[1];
        if (nloc == 0u) { xcd_barrier_complete(bar, b.x, nloc, nx); b.st[0] = nloc; b.st[1] = nx; }
        const unsigned old = xb_add(&bar[XB_XSUB(b.x)], 1u);
        const unsigned gen = old / nloc;
        if (old + 1u == (gen + 1u) * nloc) {
            __builtin_amdgcn_fence(__ATOMIC_RELEASE, "agent");
            asm volatile("s_waitcnt vmcnt(0)" ::: "memory");
            const unsigned og = xb_add(&bar[XB_TOP], 1u);
            const unsigned tg = og / nx;
            if (og + 1u == (tg + 1u) * nx) xb_add(&bar[XB_TOPGEN], 1u);
            else XB_SPIN(xb_ld(&bar[XB_TOPGEN]) == tg, bar);
            __builtin_amdgcn_fence(__ATOMIC_ACQUIRE, "agent");
            xb_add(&bar[XB_XGEN(b.x)], 1u);
            asm volatile("s_waitcnt vmcnt(0)" ::: "memory");
        } else {
            XB_SPIN(xb_ld(&bar[XB_XGEN(b.x)]) == gen, bar);
            __builtin_amdgcn_fence(__ATOMIC_ACQUIRE, "agent");
            asm volatile("s_waitcnt vmcnt(0)" ::: "memory");
        }
    }
    __syncthreads();
}

constexpr int NPHASE = 2 + 11 * DEPTH;
enum { GM_NONE = 0, GM_INPROJ, GM_RESADD, GM_RELU2, GM_S5E, GM_S5Y, GM_GLU };

struct EpiAny {
    const pg8::Gemm* g;
    DI void operator()(const f32x4 (&acc)[2][2][4][2], const Unit& u, int wr, int wc, int fr, int fq) const {
        asm volatile("" : "+v"(fr), "+v"(fq));
        asm volatile("" : "+s"(wr), "+s"(wc));
        switch (g->mode) {
        case GM_INPROJ: { EpiInProj E{(bf16_t*)g->o0, (bf16_t*)g->o1}; E(acc, u, wr, wc, fr, fq); } break;
        case GM_RESADD: { EpiResAdd E{(float*)g->o0}; E(acc, u, wr, wc, fr, fq); } break;
        case GM_RELU2:  { EpiRelu2 E{(bf16_t*)g->o0}; E(acc, u, wr, wc, fr, fq); } break;
        case GM_S5E:    { EpiS5E E{(float*)g->o0}; E(acc, u, wr, wc, fr, fq); } break;
        case GM_S5Y:    { EpiS5Y E{(const bf16_t*)g->i0, (bf16_t*)g->o0, (const float*)g->i1}; E(acc, u, wr, wc, fr, fq); } break;
        default:        { EpiGlu E{(const bf16_t*)g->i0, (bf16_t*)g->o0, (float*)g->o1, (const float*)g->i1}; E(acc, u, wr, wc, fr, fq); } break;
        }
    }
};

__global__ void __launch_bounds__(512, 2) mega(Params p) {
    extern __shared__ __attribute__((aligned(16))) unsigned char lds[];
    cg::grid_group grid = cg::this_grid();
    LAS unsigned char* ldsl = (LAS unsigned char*)lds;
    volatile LAS unsigned* xbst = (volatile LAS unsigned*)(ldsl + LDS_BYTES - 16);
    if (threadIdx.x < 4) xbst[threadIdx.x] = 0u;
    __syncthreads();
    const XcdBarrier xbar = xcd_barrier_post((unsigned*)(p.ws + WS_BAR), xbst);

#ifdef PROBE_DOUBLE_MASK
    bool rep = false;
#endif
    for (int ph = p.ph_lo; ph < p.ph_hi; ++ph) {
        const int l = (ph - 1) / 11, s = (ph == 0) ? 100 : (ph == NPHASE - 1 ? 101 : (ph - 1) % 11);
        unsigned char* ws = p.ws; unsigned char* ob = (unsigned char*)p.out; asm volatile("" : "+s"(ws), "+s"(ob));
        const int G = lgdim(), c = lbid();
        pg8::Gemm g; g.mode = GM_NONE; g.perm = 0; g.sched = 0; g.M = MP; g.N = 0; g.o0 = nullptr; g.o1 = nullptr; g.i0 = nullptr; g.i1 = nullptr; g.A = nullptr; g.Bt = nullptr; g.K = 0; g.lda = 0; g.ldb = 0;
        switch (s) {
        case 1:  g.mode = GM_INPROJ; g.perm = 1; g.A = (const bf16_t*)(ws + WS_ACT); g.Bt = (const bf16_t*)(ws + WS_WIN); g.K = 1024; g.lda = 1024; g.ldb = 1024; g.N = 3072; g.o0 = ws + WS_PROJ; g.o1 = ws + WS_U2; break;
        case 2:  g.mode = GM_S5E; g.sched = 1; g.A = (const bf16_t*)(ws + WS_U2); g.Bt = (const bf16_t*)(ws + WS_M1); g.K = 512; g.lda = U2LD; g.ldb = 512; g.o0 = ob + DO_S5E; break;
        case 4:  g.mode = GM_S5Y; g.perm = 1; g.sched = 2; g.A = (const bf16_t*)(ws + WS_U2); g.Bt = (const bf16_t*)(ws + WS_T2); g.K = 768; g.lda = U2LD; g.ldb = 768; g.i0 = ws + WS_U2; g.o0 = ws + WS_Z; g.i1 = p.in[I_S5D] + (size_t)l * 256; break;
        case 5:  g.mode = GM_GLU; g.perm = 1; g.A = (const bf16_t*)(ws + WS_Z); g.Bt = (const bf16_t*)(ws + WS_GLU); g.K = 256; g.lda = 256; g.ldb = 256; g.N = 256; g.i0 = ws + WS_Z; g.o0 = ws + WS_ACT; g.o1 = ws + WS_SS; g.i1 = p.in[I_GLUB] + (size_t)l * 256; break;
        case 7:  g.mode = GM_RESADD; g.A = (const bf16_t*)(ws + WS_ACT); g.Bt = (const bf16_t*)(ws + WS_WOUT); g.K = 1024; g.lda = 1024; g.ldb = 1024; g.N = 1024; g.o0 = ws + WS_H; break;
        case 9:  g.mode = GM_RELU2; g.perm = 1; g.A = (const bf16_t*)(ws + WS_ACT); g.Bt = (const bf16_t*)(ws + WS_WUP); g.K = 1024; g.lda = 1024; g.ldb = 1024; g.N = 4096; g.o0 = ws + WS_FF; break;
        case 10: g.mode = GM_RESADD; g.A = (const bf16_t*)(ws + WS_FF); g.Bt = (const bf16_t*)(ws + WS_WDN); g.K = 4096; g.lda = 4096; g.ldb = 4096; g.N = 1024; g.o0 = ws + WS_H; break;
        default: break;
        }
        if (g.mode != GM_NONE) {
            pg8::AnyOrder S; S.kind = g.sched; S.G = G; S.c = c; S.so.init(g.M, g.N, G, c);
            EpiAny E{&g};
            pg8::gemm_phase(ldsl, g, S, E);
        }
        if (s == 2 || s == 4) {
            const bool fin = (s == 4);
            const int skip = fin ? 160 : 80;
            const int rot = (c + G - skip % G) % G;
            for (int it = rot; it < NCH64 * 6; it += G) rg_item(p, l, it, fin, lds);
            for (int it = rot; it < NCH64 * 6; it += G) hg_item(p, l, it, fin, lds);
        } else if (s == 0) {
            norm_rows(p, true, l == 0, p.in[I_NMIX] + (size_t)l * D);
            convert_weights(p, l, lds);
            build_s5_mats(p, l);
        } else if (s == 8) norm_rows(p, false, false, p.in[I_NMLP] + (size_t)l * D);
        else if (s == 3) phase_carries(p, l);
        else if (s == 6) phase_mixnorm(p, l);
        else if (s == 100) phase_prep(p, lds);
        else if (s == 101) phase_final(p);
        if (ph + 1 < p.ph_hi) { if (ph == p.ph_lo) { __threadfence(); grid.sync(); } else xcd_barrier(xbar); }
#ifdef PROBE_DOUBLE_MASK
        if (s < 11 && ((PROBE_DOUBLE_MASK >> s) & 1) && !rep) { rep = true; --ph; } else rep = false;
#endif
    }
}

#ifndef MK_MULTI
#define MK_MULTI 0
#endif

extern "C" void kernel_launch(void* const* d_in, const int* in_sizes, int n_in, void* d_out, int out_size, void* d_ws, size_t ws_size, hipStream_t stream) {
    static int grid = 0;
    if (grid == 0) {
        if (n_in != 29 || ws_size < WS_END || out_size != 33554432) { fprintf(stderr, "kernel_launch: unexpected sizes n_in %d ws %zu need %zu out %d\n", n_in, ws_size, (size_t)WS_END, out_size); grid = -1; return; }
        int dev = 0, cus = 0, per_cu = 0;
        hipGetDevice(&dev);
        hipDeviceGetAttribute(&cus, hipDeviceAttributeMultiprocessorCount, dev);
        if (hipFuncSetAttribute((const void*)mega, hipFuncAttributeMaxDynamicSharedMemorySize, LDS_BYTES) != hipSuccess) { fprintf(stderr, "kernel_launch: hipFuncSetAttribute failed\n"); }
        hipOccupancyMaxActiveBlocksPerMultiprocessor(&per_cu, (const void*)mega, 512, LDS_BYTES);
        (void)hipGetLastError();
        if (per_cu < 1) per_cu = 1;
        grid = cus * 1;
        fprintf(stderr, "kernel_launch: cus %d per_cu %d grid %d ws %zu need %zu\n", cus, per_cu, grid, ws_size, (size_t)WS_END);
    }
    if (grid < 0) return;
    Params p{};
    for (int i = 0; i < 29; ++i) p.in[i] = (const float*)d_in[i];
    p.out = (float*)d_out; p.ws = (unsigned char*)d_ws;
#if MK_MULTI
    for (int ph = 0; ph < NPHASE; ++ph) {
        p.ph_lo = ph; p.ph_hi = ph + 1;
        hipLaunchKernelGGL(mega, dim3(grid), dim3(512), LDS_BYTES, stream, p);
    }
#else
    p.ph_lo = 0; p.ph_hi = NPHASE;
    if (hipMemsetAsync((unsigned char*)d_ws + WS_BAR, 0, 16384, stream) != hipSuccess) { fprintf(stderr, "kernel_launch: memset of the barrier words failed\n"); return; }
    void* args[] = {&p};
    hipError_t e = hipLaunchCooperativeKernel((const void*)mega, dim3(grid), dim3(512), args, LDS_BYTES, stream);
    if (e != hipSuccess) fprintf(stderr, "cooperative launch failed: %s (grid %d)\n", hipGetErrorString(e), grid);
#endif
}
```

```cpp
#include <hip/hip_runtime.h>
#include <hip/hip_cooperative_groups.h>
#include <cstdio>
namespace cg = cooperative_groups;

#define DI __device__ __forceinline__
#define LAS __attribute__((address_space(3)))
typedef unsigned short bf16_t;
typedef short bf16x8 __attribute__((ext_vector_type(8)));
typedef float f32x4 __attribute__((ext_vector_type(4)));
typedef unsigned u32x4 __attribute__((ext_vector_type(4)));
typedef unsigned u32x2 __attribute__((ext_vector_type(2)));

constexpr int D = 1024, DEPTH = 4, DFF = 4096;
constexpr int PADR = 48;
constexpr int LP = 4160, LS = 2112;
constexpr int ROWS_P = 4 * LP;
constexpr int MP = ROWS_P + 8 * LS;
constexpr int NCH64 = MP / 64;
constexpr int NCH32 = MP / 32;
constexpr int U2ROWS = 1280;
constexpr int U2LD = 768;
constexpr int PLD = 2816;
constexpr int OFF_AX = 0, OFF_AG = 384, OFF_BQ = 768, OFF_BI = 1152, OFF_BFF = 1536, OFF_BFB = 1920, OFF_BG = 2304;
constexpr float EPS = 1e-6f;
constexpr int LDS_BYTES = 147456;

constexpr size_t al256(size_t x) { return (x + 255) & ~(size_t)255; }
constexpr size_t WS_H     = 0;
constexpr size_t WS_ACT   = WS_H + (size_t)MP * D * 4;
constexpr size_t WS_BIG   = WS_ACT + (size_t)MP * D * 2;
constexpr size_t BIG_SIZE = (size_t)MP * DFF * 2;
constexpr size_t WS_PROJ  = WS_BIG;
constexpr size_t WS_U2    = WS_PROJ + (size_t)MP * PLD * 2;
constexpr size_t WS_Z     = WS_U2 + (size_t)16 * U2ROWS * U2LD * 2;
static_assert(WS_Z + (size_t)MP * 256 * 2 <= WS_BIG + BIG_SIZE, "BIG overflow");
constexpr size_t WS_FF    = WS_BIG;
constexpr size_t WS_WIN   = WS_BIG + BIG_SIZE;
constexpr size_t WS_WOUT  = WS_WIN + (size_t)3072 * 1024 * 2;
constexpr size_t WS_WUP   = WS_WOUT + (size_t)1024 * 1024 * 2;
constexpr size_t WS_WDN   = WS_WUP + (size_t)4096 * 1024 * 2;
constexpr size_t WS_WG    = WS_WDN + (size_t)1024 * 4096 * 2;
constexpr size_t WS_GLU   = WS_WG + (size_t)6 * 256 * 64 * 2;
constexpr size_t WS_T2    = WS_GLU + (size_t)256 * 256 * 2;
constexpr size_t WS_M1    = WS_T2 + (size_t)16 * 512 * 768 * 2;
constexpr size_t WS_SS    = WS_M1 + (size_t)16 * 256 * 512 * 2;
constexpr size_t WS_HGD   = WS_SS + (size_t)MP * 16 * 4;
constexpr size_t WS_LB    = WS_HGD + (size_t)NCH64 * 6 * 2 * 64 * 4;
constexpr size_t WS_PAR   = WS_LB + al256((size_t)2 * 4 * 384 * 4);
constexpr size_t WS_BAR   = WS_PAR + (size_t)4 * 2 * 16 * 64 * 2 * 4;
constexpr size_t WS_END   = WS_BAR + 16384;
constexpr size_t DO_HGS   = 0;
constexpr size_t DO_S5E   = DO_HGS + (size_t)NCH64 * 6 * 2 * 4096 * 4;
constexpr size_t DO_KTAB  = DO_S5E + (size_t)16 * U2ROWS * 256 * 4;
constexpr size_t DO_BBAR  = DO_KTAB + (size_t)4 * 16 * 2 * 32 * 256 * 4;
constexpr size_t DO_RGC   = DO_BBAR + (size_t)4 * 2 * 16 * 64 * 16 * 2 * 4;
constexpr size_t DO_END   = DO_RGC + (size_t)NCH64 * 2 * 384 * 2 * 4;
static_assert(DO_END <= (size_t)33554432 * 4, "d_out scratch overflow");

struct Params {
    const float* in[29];
    float* out;
    unsigned char* ws;
    int ph_lo, ph_hi;
};
enum { I_XP = 0, I_XS, I_META, I_NMIX, I_WIN, I_CONVW, I_CONVB, I_WR, I_BR, I_WI, I_BI, I_LAM, I_LBL, I_ARE, I_AIM, I_LDT, I_BRE, I_BIM, I_CRE, I_CIM,
       I_S5D, I_GLUW, I_GLUB, I_MGAIN, I_WOUT, I_NMLP, I_WUP, I_WDN, I_NFIN };

DI int ltid() { int t = threadIdx.x; asm volatile("" : "+v"(t)); return t; }
DI int lbid() { int t = blockIdx.x; asm volatile("" : "+s"(t)); return t; }
DI int lgdim() { int t = gridDim.x; asm volatile("" : "+s"(t)); return t; }
DI unsigned pack2(float lo, float hi) { unsigned r; asm("v_cvt_pk_bf16_f32 %0, %1, %2" : "=v"(r) : "v"(lo), "v"(hi)); return r; }
DI unsigned short f2bf(float f) { return (unsigned short)(pack2(f, 0.f) & 0xFFFFu); }
DI float bf2f(unsigned short b) { return __uint_as_float(((unsigned)b) << 16); }
DI float bflo(unsigned w) { return __uint_as_float(w << 16); }
DI float bfhi(unsigned w) { return __uint_as_float(w & 0xFFFF0000u); }
DI float sigmoidf_(float x) { return __builtin_amdgcn_rcpf(1.0f + __expf(-x)); }
DI float siluf_(float x) { return x * sigmoidf_(x); }
DI float gelu_tanh(float x) { const float u = 0.7978845608028654f * (x + 0.044715f * x * x * x); return x * sigmoidf_(2.0f * u); }
DI void unpack8(const u32x4& w, float* f) { f[0] = bflo(w.x); f[1] = bfhi(w.x); f[2] = bflo(w.y); f[3] = bfhi(w.y); f[4] = bflo(w.z); f[5] = bfhi(w.z); f[6] = bflo(w.w); f[7] = bfhi(w.w); }
DI u32x4 pack8(const float* f) { u32x4 w; w.x = pack2(f[0], f[1]); w.y = pack2(f[2], f[3]); w.z = pack2(f[4], f[5]); w.w = pack2(f[6], f[7]); return w; }

DI void row_info(int R, int& seq, int& pos) {
    if (R < ROWS_P) { seq = R / LP; pos = R - seq * LP; }
    else { const int r = R - ROWS_P; const int s = r / LS; seq = 4 + s; pos = r - s * LS; }
}
DI void seq_chunks64(int seq, int& c0, int& nc) { if (seq < 4) { c0 = seq * 65; nc = 65; } else { c0 = 260 + (seq - 4) * 33; nc = 33; } }
DI void seq_chunks32(int seq, int& c0, int& nc) { if (seq < 4) { c0 = seq * 130; nc = 130; } else { c0 = 520 + (seq - 4) * 66; nc = 66; } }
DI int chunk64_pos0(int j) { if (j < 260) return (j % 65) * 64; return ((j - 260) % 33) * 64; }
DI int chunk64_len(int j) { return j < 260 ? LP : LS; }

namespace pg8 {
constexpr int BM = 256, BK = 64, HALF = 128, HTB = HALF * BK * 2, STAGE_BYTES = 8 * HTB, NXCD = 8, WGM = 8;
__host__ __device__ __forceinline__ int lds_byte(int r, int c) { const int st = (r >> 4) * 2 + (c >> 5), rr = r & 15, cc = c & 31, ob = rr * 64 + cc * 2; return st * 1024 + (ob ^ (((ob >> 9) & 1) << 5)); }
__host__ __device__ __forceinline__ void stage_rc(int b, int& R, int& C) { const int st = b / 1024, sb = b % 1024, swz = sb ^ (((sb >> 9) & 1) << 5); R = (st >> 1) * 16 + swz / 64; C = (st & 1) * 32 + (swz % 64) / 2; }
__host__ __device__ __forceinline__ int perm32(int rho) { const int n = rho >> 4, i = rho & 15; return 8 * (i >> 2) + 4 * n + (i & 3); }
struct Unit { int pm, pn; };
struct Gemm { const bf16_t* A; const bf16_t* Bt; int K, lda, ldb;
              int mode, perm, sched, M, N;
              void* o0; void* o1; const void* i0; const void* i1; };

struct StaticOrder {
    int nM, nN, nwg, G, c;
    DI void init(int M, int N, int G_, int c_) { nM = M / BM; nN = N / BM; nwg = nM * nN; G = G_; c = c_; }
    DI bool next(int i, Unit& u) const {
        const long L = (long)i * G + c; if (L >= nwg) return false;
        int wgid = (int)L; { const int q = nwg / NXCD, r = nwg % NXCD, xcd = wgid % NXCD, off = wgid / NXCD; wgid = (xcd < r ? xcd * (q + 1) : r * (q + 1) + (xcd - r) * q) + off; }
        const int nig = WGM * nN, gid = wgid / nig, fm = gid * WGM, gsz = (nM - fm) < WGM ? (nM - fm) : WGM;
        u.pm = fm + ((wgid % nig) % gsz); u.pn = (wgid % nig) / gsz; return true;
    }
    DI void a_ready(const Unit&) const {}
    DI void done(const Unit&) const {}
};
template <int NPN> struct GroupOrder {
    int G, c;
    DI bool next(int i, Unit& u) const {
        const int L = i * G + c; if (L >= 16 * 5 * NPN) return false;
        const int g = L / (5 * NPN), r = L % (5 * NPN); u.pm = g * 5 + (r % 5); u.pn = g * NPN + (r / 5); return true;
    }
    DI void a_ready(const Unit&) const {}
    DI void done(const Unit&) const {}
};

DI unsigned cvt_pk_bf16(float lo, float hi) { unsigned r; asm volatile("v_cvt_pk_bf16_f32 %0, %1, %2" : "=v"(r) : "v"(lo), "v"(hi)); return r; }

struct AnyOrder {
    StaticOrder so; int kind, G, c;
    DI bool next(int i, Unit& u) const {
        if (kind == 0) return so.next(i, u);
        if (kind == 1) { GroupOrder<1> o{G, c}; return o.next(i, u); }
        GroupOrder<2> o{G, c}; return o.next(i, u);
    }
};
template <class EpiFn>
DI void gemm_phase(LAS unsigned char* lds, const Gemm& g, const AnyOrder& S, const EpiFn& E) {
    int tid_ = ltid();
    const int tid = tid_, wid = __builtin_amdgcn_readfirstlane(tid >> 6), lane = tid & 63, wr = wid >> 2, wc = wid & 3, fr = lane & 15, fq = lane >> 4;
    const int K = g.K, nt = K / BK;
    unsigned voffA[2], voffB[2];
#pragma unroll
    for (int i = 0; i < 2; ++i) { int R, C; stage_rc(tid * 16 + i * 8192, R, C); const int Rb = g.perm ? ((R & ~31) + perm32(R & 31)) : R;
        voffA[i] = (unsigned)(R * g.lda + C) * 2u; voffB[i] = (unsigned)(Rb * g.ldb + C) * 2u; }
    const size_t kstep = (size_t)(BK * 2);
    const size_t hstepA = (size_t)HALF * g.lda * 2, hstepB = (size_t)HALF * g.ldb * 2;
    const size_t tstepA = 2 * hstepA, tstepB = 2 * hstepB;
    const unsigned ldsw = (unsigned)wid * 1024u;
    const int aoff = lds_byte(wr * 64 + fr, fq * 8), boff = lds_byte(wc * 32 + fr, fq * 8);
#define PG8_SA(b, h) (((b) * 2 + (h)) * HTB)
#define PG8_SB(b, h) ((4 + (b) * 2 + (h)) * HTB)
#define PG8_STAGE(bufoff, gbase, voff) do { _Pragma("unroll") for (int _i = 0; _i < 2; ++_i) \
        __builtin_amdgcn_global_load_lds((const unsigned*)((const char*)(gbase) + (voff)[_i]), (LAS unsigned*)(lds + (bufoff) + ldsw + _i * 8192), 16, 0, 0); } while (0)
#define PG8_LDA(dst, b, h) do { _Pragma("unroll") for (int m = 0; m < 4; ++m) _Pragma("unroll") for (int k = 0; k < 2; ++k) dst[m][k] = *(const LAS bf16x8*)(lds + PG8_SA(b, h) + aoff + m * 2048 + k * 1024); } while (0)
#define PG8_LDB(dst, b, h) do { _Pragma("unroll") for (int n = 0; n < 2; ++n) _Pragma("unroll") for (int k = 0; k < 2; ++k) dst[n][k] = *(const LAS bf16x8*)(lds + PG8_SB(b, h) + boff + n * 2048 + k * 1024); } while (0)
#define PG8_MMA(ai, bj, At, Bt) do { __builtin_amdgcn_s_setprio(1); _Pragma("unroll") for (int m = 0; m < 4; ++m) _Pragma("unroll") for (int n = 0; n < 2; ++n) _Pragma("unroll") for (int k = 0; k < 2; ++k) \
        acc[ai][bj][m][n] = __builtin_amdgcn_mfma_f32_16x16x32_bf16(Bt[n][k], At[m][k], acc[ai][bj][m][n], 0, 0, 0); __builtin_amdgcn_s_setprio(0); } while (0)
#define PG8_WAIT_V(n) asm volatile("s_waitcnt vmcnt(" #n ")" ::: "memory")
#define PG8_WAIT_L(n) asm volatile("s_waitcnt lgkmcnt(" #n ")" ::: "memory")
#define PG8_BAR __builtin_amdgcn_s_barrier()
#define PG8_SCHED __builtin_amdgcn_sched_barrier(0)
    Unit cur, nxt; int ui = 0;
    if (!S.next(0, cur)) return;
    f32x4 acc[2][2][4][2];
#pragma unroll
    for (int a = 0; a < 2; ++a)
#pragma unroll
        for (int b = 0; b < 2; ++b)
#pragma unroll
            for (int m = 0; m < 4; ++m)
#pragma unroll
                for (int n = 0; n < 2; ++n) acc[a][b][m][n] = (f32x4){0.f, 0.f, 0.f, 0.f};
    bf16x8 At[4][2], B0[2][2], B1[2][2];
    const char* cA = (const char*)g.A + (size_t)cur.pm * tstepA; const char* cB = (const char*)g.Bt + (size_t)cur.pn * tstepB;
    PG8_STAGE(PG8_SB(0, 0), cB, voffB); PG8_STAGE(PG8_SA(0, 0), cA, voffA); PG8_STAGE(PG8_SB(0, 1), cB + hstepB, voffB); PG8_STAGE(PG8_SA(0, 1), cA + hstepA, voffA);
    if (wr == 1) PG8_BAR;
    PG8_WAIT_V(4); PG8_BAR;
    PG8_STAGE(PG8_SB(1, 0), cB + kstep, voffB); PG8_STAGE(PG8_SA(1, 0), cA + kstep, voffA); PG8_STAGE(PG8_SB(1, 1), cB + hstepB + kstep, voffB);
    PG8_WAIT_V(6); PG8_BAR;
    for (;;) {
        const bool has_next = S.next(ui + 1, nxt);
        const char* nA = has_next ? (const char*)g.A + (size_t)nxt.pm * tstepA : cA; const char* nB = has_next ? (const char*)g.Bt + (size_t)nxt.pn * tstepB : cB;
        for (int t = 0; t < nt; t += 2) {
            const bool last = (t == nt - 2);
            const char* a1 = cA + (size_t)(t + 1) * kstep;
            const char* a2 = last ? nA : cA + (size_t)(t + 2) * kstep; const char* b2 = last ? nB : cB + (size_t)(t + 2) * kstep;
            const char* a3 = a2 + kstep; const char* b3 = b2 + kstep;
            PG8_LDB(B0, 0, 0); PG8_SCHED; PG8_LDA(At, 0, 0); PG8_STAGE(PG8_SA(1, 1), a1 + hstepA, voffA);
            PG8_WAIT_L(8); PG8_BAR; PG8_WAIT_L(0); PG8_MMA(0, 0, At, B0); PG8_BAR; PG8_SCHED;
            PG8_LDB(B1, 0, 1); PG8_STAGE(PG8_SB(0, 0), b2, voffB);
            PG8_BAR; PG8_WAIT_L(0); PG8_MMA(0, 1, At, B1); PG8_BAR;
            PG8_LDA(At, 0, 1); PG8_STAGE(PG8_SA(0, 0), a2, voffA);
            PG8_BAR; PG8_WAIT_L(0); PG8_MMA(1, 0, At, B0); PG8_BAR; PG8_SCHED;
            PG8_STAGE(PG8_SB(0, 1), b2 + hstepB, voffB);
            PG8_WAIT_V(6); PG8_BAR; PG8_MMA(1, 1, At, B1); PG8_BAR;
            PG8_LDB(B0, 1, 0); PG8_SCHED; PG8_LDA(At, 1, 0); PG8_STAGE(PG8_SA(0, 1), a2 + hstepA, voffA);
            PG8_WAIT_L(8); PG8_BAR; PG8_WAIT_L(0); PG8_MMA(0, 0, At, B0); PG8_BAR; PG8_SCHED;
            PG8_LDB(B1, 1, 1); PG8_STAGE(PG8_SB(1, 0), b3, voffB);
            PG8_BAR; PG8_WAIT_L(0); PG8_MMA(0, 1, At, B1); PG8_BAR;
            PG8_LDA(At, 1, 1); PG8_STAGE(PG8_SA(1, 0), a3, voffA);
            PG8_BAR; PG8_WAIT_L(0); PG8_MMA(1, 0, At, B0); PG8_BAR; PG8_SCHED;
            PG8_STAGE(PG8_SB(1, 1), b3 + hstepB, voffB);
            PG8_WAIT_V(6); PG8_BAR; PG8_MMA(1, 1, At, B1); PG8_BAR;
        }
        E(acc, cur, wr, wc, fr, fq);
        if (!has_next) break;
#pragma unroll
        for (int a = 0; a < 2; ++a)
#pragma unroll
            for (int b = 0; b < 2; ++b)
#pragma unroll
                for (int m = 0; m < 4; ++m)
#pragma unroll
                    for (int n = 0; n < 2; ++n) acc[a][b][m][n] = (f32x4){0.f, 0.f, 0.f, 0.f};
        cur = nxt; cA = nA; cB = nB; ++ui;
    }
    PG8_WAIT_V(0);
    if (wr == 0) PG8_BAR;
    PG8_BAR;
#undef PG8_SA
#undef PG8_SB
#undef PG8_STAGE
#undef PG8_LDA
#undef PG8_LDB
#undef PG8_MMA
#undef PG8_WAIT_V
#undef PG8_WAIT_L
#undef PG8_BAR
#undef PG8_SCHED
}
}
using pg8::Unit;

struct EpiInProj {
    static constexpr bool PERM = true;
    bf16_t* PROJ; bf16_t* U2;
    DI void operator()(const f32x4 (&acc)[2][2][4][2], const Unit& u, int wr, int wc, int fr, int fq) const {
        const int row0 = u.pm * 256 + wr * 64 + fr;
#pragma unroll
        for (int ai = 0; ai < 2; ++ai)
#pragma unroll
            for (int m = 0; m < 4; ++m) {
                const int r = row0 + ai * 128 + m * 16;
#pragma unroll
                for (int bj = 0; bj < 2; ++bj) {
                    const f32x4 v0 = acc[ai][bj][m][0], v1 = acc[ai][bj][m][1];
                    u32x4 w; w.x = pg8::cvt_pk_bf16(v0[0], v0[1]); w.y = pg8::cvt_pk_bf16(v0[2], v0[3]); w.z = pg8::cvt_pk_bf16(v1[0], v1[1]); w.w = pg8::cvt_pk_bf16(v1[2], v1[3]);
                    const int cl = bj * 128 + wc * 32 + 8 * fq;
                    if (u.pn == 0) { const int g = cl >> 4, h = cl & 15; *(u32x4*)(U2 + ((size_t)(g * U2ROWS + (r >> 5)) * U2LD + (r & 31) * 16 + h)) = w; }
                    else *(u32x4*)(PROJ + (size_t)r * PLD + (u.pn - 1) * 256 + cl) = w;
                }
                __builtin_amdgcn_sched_barrier(0);
            }
    }
};
struct EpiResAdd {
    static constexpr bool PERM = false;
    float* H;
    DI void operator()(const f32x4 (&acc)[2][2][4][2], const Unit& u, int wr, int wc, int fr, int fq) const {
        const int row0 = u.pm * 256 + wr * 64 + fr, col0 = u.pn * 256 + wc * 32 + 4 * fq;
#pragma unroll
        for (int ai = 0; ai < 2; ++ai)
#pragma unroll
            for (int m = 0; m < 4; ++m) { float* rowp = H + (size_t)(row0 + ai * 128 + m * 16) * D + col0;
#pragma unroll
                for (int bj = 0; bj < 2; ++bj)
#pragma unroll
                    for (int n = 0; n < 2; ++n) { f32x4* q = (f32x4*)(rowp + bj * 128 + n * 16); *q = *q + acc[ai][bj][m][n]; } }
    }
};
struct EpiRelu2 {
    static constexpr bool PERM = true;
    bf16_t* FF;
    DI void operator()(const f32x4 (&acc)[2][2][4][2], const Unit& u, int wr, int wc, int fr, int fq) const {
        const int row0 = u.pm * 256 + wr * 64 + fr, col0 = u.pn * 256 + wc * 32 + 8 * fq;
#pragma unroll
        for (int ai = 0; ai < 2; ++ai)
#pragma unroll
            for (int m = 0; m < 4; ++m) { bf16_t* rowp = FF + (size_t)(row0 + ai * 128 + m * 16) * DFF + col0;
#pragma unroll
                for (int bj = 0; bj < 2; ++bj) { f32x4 v0 = acc[ai][bj][m][0], v1 = acc[ai][bj][m][1];
#pragma unroll
                    for (int j = 0; j < 4; ++j) { const float a = fmaxf(v0[j], 0.f), b = fmaxf(v1[j], 0.f); v0[j] = a * a; v1[j] = b * b; }
                    u32x4 w; w.x = pg8::cvt_pk_bf16(v0[0], v0[1]); w.y = pg8::cvt_pk_bf16(v0[2], v0[3]); w.z = pg8::cvt_pk_bf16(v1[0], v1[1]); w.w = pg8::cvt_pk_bf16(v1[2], v1[3]);
                    *(u32x4*)(rowp + bj * 128) = w; } }
    }
};
struct EpiS5E {
    static constexpr bool PERM = false;
    float* E;
    DI void operator()(const f32x4 (&acc)[2][2][4][2], const Unit& u, int wr, int wc, int fr, int fq) const {
        const int row0 = u.pm * 256 + wr * 64 + fr, col0 = wc * 32 + 4 * fq;
#pragma unroll
        for (int ai = 0; ai < 2; ++ai)
#pragma unroll
            for (int m = 0; m < 4; ++m) { float* rowp = E + (size_t)(row0 + ai * 128 + m * 16) * 256 + col0;
#pragma unroll
                for (int bj = 0; bj < 2; ++bj)
#pragma unroll
                    for (int n = 0; n < 2; ++n) *(f32x4*)(rowp + bj * 128 + n * 16) = acc[ai][bj][m][n]; }
    }
};
struct EpiS5Y {
    static constexpr bool PERM = true;
    const bf16_t* U2; bf16_t* Z; const float* dskip;
    DI void operator()(const f32x4 (&acc)[2][2][4][2], const Unit& u, int wr, int wc, int fr, int fq) const {
        const int g = u.pm / 5, pml = u.pm - g * 5, pnl = u.pn - g * 2;
#pragma unroll
        for (int ai = 0; ai < 2; ++ai)
#pragma unroll
            for (int m = 0; m < 4; ++m) {
                const int chunk = pml * 256 + ai * 128 + wr * 64 + m * 16 + fr;
                if (chunk < NCH32) {
#pragma unroll
                    for (int bj = 0; bj < 2; ++bj) {
                        const int n0 = pnl * 256 + bj * 128 + wc * 32 + 8 * fq;
                        const int t = n0 >> 4, h0 = n0 & 15;
                        const u32x4 uw = *(const u32x4*)(U2 + ((size_t)(g * U2ROWS + chunk) * U2LD + n0));
                        float uf[8]; unpack8(uw, uf);
                        const f32x4 v0 = acc[ai][bj][m][0], v1 = acc[ai][bj][m][1];
                        float y[8];
#pragma unroll
                        for (int j = 0; j < 4; ++j) { y[j] = v0[j]; y[4 + j] = v1[j]; }
#pragma unroll
                        for (int j = 0; j < 8; ++j) y[j] = gelu_tanh(y[j] + dskip[g * 16 + h0 + j] * uf[j]);
                        *(u32x4*)(Z + ((size_t)(chunk * 32 + t) * 256 + g * 16 + h0)) = pack8(y);
                        __builtin_amdgcn_sched_barrier(0);
                    }
                }
            }
    }
};
struct EpiGlu {
    static constexpr bool PERM = true;
    const bf16_t* Z; bf16_t* YM; float* SS; const float* glub;
    DI void operator()(const f32x4 (&acc)[2][2][4][2], const Unit& u, int wr, int wc, int fr, int fq) const {
        const int row0 = u.pm * 256 + wr * 64 + fr;
#pragma unroll
        for (int ai = 0; ai < 2; ++ai)
#pragma unroll
            for (int m = 0; m < 4; ++m) {
                const int r = row0 + ai * 128 + m * 16;
                int seq, pos; row_info(r, seq, pos);
                const bool valid = pos >= PADR;
                float ssum = 0.f;
#pragma unroll
                for (int bj = 0; bj < 2; ++bj) {
                    const int c0 = bj * 128 + wc * 32 + 8 * fq;
                    const u32x4 zw = *(const u32x4*)(Z + (size_t)r * 256 + c0);
                    float zf[8]; unpack8(zw, zf);
                    const f32x4 v0 = acc[ai][bj][m][0], v1 = acc[ai][bj][m][1];
                    float y[8];
#pragma unroll
                    for (int j = 0; j < 4; ++j) { y[j] = v0[j]; y[4 + j] = v1[j]; }
#pragma unroll
                    for (int j = 0; j < 8; ++j) { const float o = valid ? zf[j] * sigmoidf_(y[j] + glub[c0 + j]) : 0.f; y[j] = o; ssum += o * o; }
                    *(u32x4*)(YM + (size_t)r * D + 768 + c0) = pack8(y);
                    __builtin_amdgcn_sched_barrier(0);
                }
                ssum += __shfl_xor(ssum, 16); ssum += __shfl_xor(ssum, 32);
                if (fq == 0) SS[(size_t)r * 16 + 12 + wc] = ssum;
            }
    }
};

DI f32x4 mma_tile64(const bf16_t* A, const bf16_t* Bt, int ld, int lane, f32x4 acc) {
    const int r = lane & 15, q = lane >> 4;
#pragma unroll
    for (int ks = 0; ks < 2; ++ks) {
        const bf16x8 a = *(const bf16x8*)(A + r * ld + ks * 32 + q * 8);
        const bf16x8 b = *(const bf16x8*)(Bt + r * ld + ks * 32 + q * 8);
        acc = __builtin_amdgcn_mfma_f32_16x16x32_bf16(a, b, acc, 0, 0, 0);
    }
    return acc;
}

DI void phase_prep(const Params& p, unsigned char* lds) {
    const int tid = ltid();
    float* LB = (float*)(p.ws + WS_LB);
    for (int i = lbid() * 512 + tid; i < 2 * 384; i += lgdim() * 512) {
        const int d = i / 384, c = i % 384;
        float lg[4], mx = -1e30f;
#pragma unroll
        for (int l = 0; l < 4; ++l) { lg[l] = p.in[I_LBL][(d * 4 + l) * 384 + c]; mx = fmaxf(mx, lg[l]); }
        float s = 0.f;
#pragma unroll
        for (int l = 0; l < 4; ++l) { lg[l] = expf(lg[l] - mx); s += lg[l]; }
        float cum = 0.f;
#pragma unroll
        for (int l = 0; l < 4; ++l) { if (l > 0) cum += lg[l] / s; LB[(d * 4 + l) * 384 + c] = cum; }
    }
    float* PAR = (float*)(p.ws + WS_PAR);
    float* KTAB = (float*)((unsigned char*)p.out + DO_KTAB);
    float* BBAR = (float*)((unsigned char*)p.out + DO_BBAR);
    float* sAR = (float*)lds;
    float* sAI = sAR + 64;
    float* sBB = sAI + 64;
    float* sC  = sBB + 2048;
    float* sW  = sC + 2048;
    for (int item = lbid(); item < 4 * 16 * 2; item += lgdim()) {
        const int l = item / 32, g = (item / 2) % 16, d = item % 2;
        const int base = ((l * 2 + d) * 16 + g);
        const float dt = expf(p.in[I_LDT][base]);
        __syncthreads();
        if (tid < 64) {
            const float lr = p.in[I_ARE][base * 64 + tid], li = p.in[I_AIM][base * 64 + tid];
            const float ar = lr * dt, ai = li * dt;
            sAR[tid] = ar; sAI[tid] = ai;
            PAR[(base * 64 + tid) * 2 + 0] = ar; PAR[(base * 64 + tid) * 2 + 1] = ai;
        }
        __syncthreads();
        for (int e = tid; e < 1024; e += 512) {
            const int pp = e >> 4, h = e & 15;
            const float ar = sAR[pp], ai = sAI[pp];
            const float lr = p.in[I_ARE][base * 64 + pp], li = p.in[I_AIM][base * 64 + pp];
            float sn, cs; sincosf(ai, &sn, &cs);
            const float em1 = expm1f(ar), ex = em1 + 1.0f;
            const float sh = sinf(0.5f * ai);
            const float x = em1 * cs - 2.0f * sh * sh, y = ex * sn;
            const float den = lr * lr + li * li;
            const float cr = (x * lr + y * li) / den, ci = (y * lr - x * li) / den;
            const float br = p.in[I_BRE][(size_t)(base * 64 + pp) * 16 + h], bi = p.in[I_BIM][(size_t)(base * 64 + pp) * 16 + h];
            const float rr = cr * br - ci * bi, ri = cr * bi + ci * br;
            sBB[e * 2] = rr; sBB[e * 2 + 1] = ri;
            BBAR[((size_t)(base * 64 + pp) * 16 + h) * 2] = rr; BBAR[((size_t)(base * 64 + pp) * 16 + h) * 2 + 1] = ri;
        }
        for (int e = tid; e < 1024; e += 512) {
            sC[e * 2] = p.in[I_CRE][(size_t)base * 1024 + e]; sC[e * 2 + 1] = p.in[I_CIM][(size_t)base * 1024 + e];
        }
        __syncthreads();
_Pragma("nounroll")
        for (int tau = 0; tau < 32; ++tau) {
            if (tid < 64) { const float mg = expf(tau * sAR[tid]); float sn, cs; sincosf(tau * sAI[tid], &sn, &cs); sW[tid * 2] = mg * cs; sW[tid * 2 + 1] = mg * sn; }
            __syncthreads();
            if (tid < 256) {
                const int hp = tid >> 4, h = tid & 15;
                float s = 0.f;
_Pragma("unroll 4")
                for (int pp = 0; pp < 64; ++pp) {
                    const float wr_ = sW[pp * 2], wi_ = sW[pp * 2 + 1];
                    const float br = sBB[(pp * 16 + h) * 2], bi = sBB[(pp * 16 + h) * 2 + 1];
                    const float tr = wr_ * br - wi_ * bi, ti = wr_ * bi + wi_ * br;
                    const float cr = sC[(hp * 64 + pp) * 2], ci = sC[(hp * 64 + pp) * 2 + 1];
                    s += cr * tr - ci * ti;
                }
                KTAB[((size_t)((l * 16 + g) * 2 + d) * 32 + tau) * 256 + tid] = s;
            }
            __syncthreads();
        }
    }
}

DI void norm_rows(const Params& p, bool zero_ss, bool build, const float* gain) {
    const int tid = ltid(); const int lane = tid & 63, wave = tid >> 6;
    float* H = (float*)(p.ws + WS_H); bf16_t* ACT = (bf16_t*)(p.ws + WS_ACT); float* SS = (float*)(p.ws + WS_SS);
    for (int R = lbid() * 8 + wave; R < MP; R += lgdim() * 8) {
        f32x4 v[4];
        float* hr = H + (size_t)R * D;
        if (build) {
            int seq, pos; row_info(R, seq, pos);
            const int t = pos - PADR;
            const float* src = nullptr;
            if (t >= 0) { if (t < 16) src = p.in[I_META] + (size_t)t * D; else src = (seq < 4) ? p.in[I_XP] + ((size_t)seq * 4096 + (t - 16)) * D : p.in[I_XS] + ((size_t)(seq - 4) * 2048 + (t - 16)) * D; }
#pragma unroll
            for (int i = 0; i < 4; ++i) { v[i] = src ? *(const f32x4*)(src + (lane + 64 * i) * 4) : (f32x4){0.f, 0.f, 0.f, 0.f}; *(f32x4*)(hr + (lane + 64 * i) * 4) = v[i]; }
        } else {
#pragma unroll
            for (int i = 0; i < 4; ++i) v[i] = *(const f32x4*)(hr + (lane + 64 * i) * 4);
        }
        float ss = 0.f;
#pragma unroll
        for (int i = 0; i < 4; ++i) ss += v[i][0] * v[i][0] + v[i][1] * v[i][1] + v[i][2] * v[i][2] + v[i][3] * v[i][3];
#pragma unroll
        for (int o = 1; o < 64; o <<= 1) ss += __shfl_xor(ss, o);
        const float rn = rsqrtf(ss * (1.0f / D) + EPS);
#pragma unroll
        for (int i = 0; i < 4; ++i) {
            const f32x4 gg = *(const f32x4*)(gain + (lane + 64 * i) * 4);
            u32x2 w; w.x = pack2(v[i][0] * rn * gg[0], v[i][1] * rn * gg[1]); w.y = pack2(v[i][2] * rn * gg[2], v[i][3] * rn * gg[3]);
            *(u32x2*)(ACT + (size_t)R * D + (lane + 64 * i) * 4) = w;
        }
    }
}

DI void tr_tile(const float* src, int lds_, bf16_t* dst, int ldd, float* tile) {
    const int tid = ltid();
    __syncthreads();
    { const int r = tid >> 4, c4 = (tid & 15) * 4;
#pragma unroll
      for (int rr = 0; rr < 64; rr += 32) { const f32x4 v = *(const f32x4*)(src + (size_t)(r + rr) * lds_ + c4); float* tp = tile + (r + rr) * 65 + c4; tp[0] = v[0]; tp[1] = v[1]; tp[2] = v[2]; tp[3] = v[3]; } }
    __syncthreads();
    { const int n = tid >> 3, k8 = (tid & 7) * 8; float f[8];
#pragma unroll
      for (int i = 0; i < 8; ++i) f[i] = tile[(k8 + i) * 65 + n];
      *(u32x4*)(dst + (size_t)n * ldd + k8) = pack8(f); }
}

DI void convert_weights(const Params& p, int l, unsigned char* lds) {
    float* tile = (float*)lds;
    bf16_t* WIN = (bf16_t*)(p.ws + WS_WIN); bf16_t* WOUT = (bf16_t*)(p.ws + WS_WOUT); bf16_t* WUP = (bf16_t*)(p.ws + WS_WUP); bf16_t* WDN = (bf16_t*)(p.ws + WS_WDN);
    bf16_t* WG = (bf16_t*)(p.ws + WS_WG); bf16_t* GLU = (bf16_t*)(p.ws + WS_GLU);
    const int T_IN = 16 * 46, T_OUT = 16 * 16, T_UP = 16 * 64, T_DN = 64 * 16, T_WG = 24, T_GLU = 16;
    const int total = T_IN + T_OUT + T_UP + T_DN + T_WG + T_GLU;
    for (int it = lbid(); it < total; it += lgdim()) {
        int i = it;
        if (i < T_IN) { const int kt = i / 46, nt = i % 46;
            const int n0 = nt * 64; const int nd = (n0 >= 2688) ? n0 - 2688 : n0 + 256;
            tr_tile(p.in[I_WIN] + (size_t)l * 1024 * 2944 + (size_t)kt * 64 * 2944 + n0, 2944, WIN + (size_t)nd * 1024 + kt * 64, 1024, tile); continue; }
        i -= T_IN;
        if (i < T_OUT) { const int kt = i / 16, nt = i % 16;
            tr_tile(p.in[I_WOUT] + (size_t)l * 1024 * 1024 + (size_t)kt * 64 * 1024 + nt * 64, 1024, WOUT + (size_t)nt * 64 * 1024 + kt * 64, 1024, tile); continue; }
        i -= T_OUT;
        if (i < T_UP) { const int kt = i / 64, nt = i % 64;
            tr_tile(p.in[I_WUP] + (size_t)l * 1024 * 4096 + (size_t)kt * 64 * 4096 + nt * 64, 4096, WUP + (size_t)nt * 64 * 1024 + kt * 64, 1024, tile); continue; }
        i -= T_UP;
        if (i < T_DN) { const int kt = i / 16, nt = i % 16;
            tr_tile(p.in[I_WDN] + (size_t)l * 4096 * 1024 + (size_t)kt * 64 * 1024 + nt * 64, 1024, WDN + (size_t)nt * 64 * 4096 + kt * 64, 4096, tile); continue; }
        i -= T_DN;
        if (i < T_WG) { const int n = i / 4, gi = i % 4, d = gi >> 1;
            const float* src = ((gi & 1) ? p.in[I_WI] : p.in[I_WR]) + ((size_t)((l * 2 + d) * 6 + n)) * 4096;
            tr_tile(src, 64, WG + (size_t)(n * 256 + gi * 64) * 64, 64, tile); continue; }
        i -= T_WG;
        { const int kt = i / 4, nt = i % 4;
          tr_tile(p.in[I_GLUW] + (size_t)l * 65536 + (size_t)kt * 64 * 256 + nt * 64, 256, GLU + (size_t)nt * 64 * 256 + kt * 64, 256, tile); }
    }
    for (size_t e = (size_t)lbid() * 512 + ltid(); e < (size_t)128 * 1024 / 8; e += (size_t)lgdim() * 512) *(u32x4*)(WIN + (size_t)2944 * 1024 + e * 8) = (u32x4){0u, 0u, 0u, 0u};
}

DI void build_s5_mats(const Params& p, int l) {
    const float* KTAB = (const float*)((const unsigned char*)p.out + DO_KTAB);
    const float* BBAR = (const float*)((const unsigned char*)p.out + DO_BBAR);
    const float* PAR = (const float*)(p.ws + WS_PAR);
    bf16_t* T2 = (bf16_t*)(p.ws + WS_T2); bf16_t* M1 = (bf16_t*)(p.ws + WS_M1);
    const size_t nT2 = (size_t)16 * 512 * 96, nM1 = (size_t)16 * 256 * 64;
    for (size_t e = (size_t)lbid() * 512 + ltid(); e < nT2 + nM1; e += (size_t)lgdim() * 512) {
        float f[8];
        if (e < nT2) {
            const int g = (int)(e / (512 * 96)), rem = (int)(e % (512 * 96)), n = rem / 96, k0 = (rem % 96) * 8;
            const int t = n >> 4, hp = n & 15;
            if (k0 < 512) {
                const int s = k0 >> 4, h0 = k0 & 15;
#pragma unroll
                for (int j = 0; j < 8; ++j) {
                    float v = 0.f;
                    if (s <= t) v += KTAB[((size_t)((l * 16 + g) * 2 + 0) * 32 + (t - s)) * 256 + hp * 16 + h0 + j];
                    if (s >= t) v += KTAB[((size_t)((l * 16 + g) * 2 + 1) * 32 + (s - t)) * 256 + hp * 16 + h0 + j];
                    f[j] = v;
                }
            } else {
                const int kk = k0 - 512, d = kk >> 7, part = (kk >> 6) & 1, p0 = kk & 63;
                const int base = (l * 2 + d) * 16 + g;
                const float pw = d == 0 ? (float)(t + 1) : (float)(32 - t);
#pragma unroll
                for (int j = 0; j < 8; ++j) {
                    const int pp = p0 + j;
                    const float ar = PAR[(base * 64 + pp) * 2], ai = PAR[(base * 64 + pp) * 2 + 1];
                    const float mg = expf(pw * ar); float sn, cs; sincosf(pw * ai, &sn, &cs);
                    const float wr_ = mg * cs, wi_ = mg * sn;
                    const float cr = p.in[I_CRE][(size_t)base * 1024 + hp * 64 + pp], ci = p.in[I_CIM][(size_t)base * 1024 + hp * 64 + pp];
                    f[j] = part == 0 ? (cr * wr_ - ci * wi_) : -(cr * wi_ + ci * wr_);
                }
            }
            *(u32x4*)(T2 + ((size_t)(g * 512 + n) * 768 + k0)) = pack8(f);
        } else {
            const size_t e2 = e - nT2;
            const int g = (int)(e2 / (256 * 64)), rem = (int)(e2 % (256 * 64)), n = rem / 64, k0 = (rem % 64) * 8;
            const int d = n >> 7, part = (n >> 6) & 1, pp = n & 63;
            const int s = k0 >> 4, h0 = k0 & 15;
            const int base = (l * 2 + d) * 16 + g;
            const float pw = d == 0 ? (float)(31 - s) : (float)s;
            const float ar = PAR[(base * 64 + pp) * 2], ai = PAR[(base * 64 + pp) * 2 + 1];
            const float mg = expf(pw * ar); float sn, cs; sincosf(pw * ai, &sn, &cs);
            const float wr_ = mg * cs, wi_ = mg * sn;
#pragma unroll
            for (int j = 0; j < 8; ++j) {
                const float br = BBAR[((size_t)(base * 64 + pp) * 16 + h0 + j) * 2], bi = BBAR[((size_t)(base * 64 + pp) * 16 + h0 + j) * 2 + 1];
                f[j] = part == 0 ? (wr_ * br - wi_ * bi) : (wr_ * bi + wi_ * br);
            }
            *(u32x4*)(M1 + ((size_t)(g * 256 + n) * 512 + k0)) = pack8(f);
        }
    }
}

constexpr int PB_OFF = 126976;
constexpr int PB_CW = 0, PB_CB = 1536, PB_BR = 1920, PB_BI = 2688, PB_SP = 3456, PB_LB = 4224;
DI void stage_params(const Params& p, int l, unsigned char* lds) {
    float* PB = (float*)(lds + PB_OFF); const int tid = ltid();
    const float* LB = (const float*)(p.ws + WS_LB);
    for (int i = tid; i < 1536; i += 512) PB[PB_CW + i] = p.in[I_CONVW][(size_t)l * 1536 + i];
    if (tid < 384) PB[PB_CB + tid] = p.in[I_CONVB][(size_t)l * 384 + tid];
    for (int i = tid; i < 768; i += 512) {
        PB[PB_BR + i] = p.in[I_BR][(size_t)l * 768 + i]; PB[PB_BI + i] = p.in[I_BI][(size_t)l * 768 + i];
        PB[PB_SP + i] = log1pf(__expf(-p.in[I_LAM][(size_t)l * 768 + i]));
        const int d = i / 384, c = i % 384; PB[PB_LB + i] = LB[(d * 4 + l) * 384 + c];
    }
}

struct RgPre { u32x4 xa0, xa1, ga, wg[4]; float cin; };
DI RgPre rg_load(const Params& p, int item, bool fin) {
    const int tid = ltid();
    const int j = item / 6, n = item % 6;
    const int row0 = j * 64, pos0 = chunk64_pos0(j), L = chunk64_len(j);
    const bf16_t* PROJ = (const bf16_t*)(p.ws + WS_PROJ); const bf16_t* WG = (const bf16_t*)(p.ws + WS_WG);
    const float* RGC = (const float*)((const unsigned char*)p.out + DO_RGC);
    RgPre r; const u32x4 z = (u32x4){0u, 0u, 0u, 0u};
    const int c8 = (tid & 7) * 8;
    { const int rr = tid >> 3, pos = pos0 + rr - 2; r.xa0 = (pos >= PADR && pos < L) ? *(const u32x4*)(PROJ + (size_t)(row0 + rr - 2) * PLD + OFF_AX + n * 64 + c8) : z; }
    r.xa1 = z;
    if (tid < 24) { const int rr = 64 + (tid >> 3), pos = pos0 + rr - 2; if (pos >= PADR && pos < L) r.xa1 = *(const u32x4*)(PROJ + (size_t)(row0 + rr - 2) * PLD + OFF_AX + n * 64 + c8); }
    r.ga = fin ? *(const u32x4*)(PROJ + (size_t)(row0 + (tid >> 3)) * PLD + OFF_AG + n * 64 + c8) : z;
#pragma unroll
    for (int q = 0; q < 4; ++q) { const int idx = tid + 512 * q; r.wg[q] = *(const u32x4*)(WG + (size_t)(n * 256 + (idx >> 3)) * 64 + (idx & 7) * 8); }
    r.cin = 0.f;
    if (fin) { const int sc = tid & 127, c = sc & 63, d = sc >> 6; r.cin = RGC[((size_t)(j * 2 + d) * 384 + n * 64 + c) * 2 + 1]; }
    return r;
}
DI void rg_compute(const Params& p, int item, bool fin, const RgPre& pre, unsigned char* lds) {
    const int tid = ltid(), lane = tid & 63, wave = tid >> 6;
    const int j = item / 6, n = item % 6;
    const int row0 = j * 64, pos0 = chunk64_pos0(j);
    float* XCF = (float*)lds;
    float* AB = (float*)(lds + 16384);
    bf16_t* WGs = (bf16_t*)(lds + 16384);
    bf16_t* XCB = (bf16_t*)(lds + 16384 + 36864);
    bf16_t* XA = (bf16_t*)(lds + 16384 + 36864 + 9216);
    bf16_t* GA = (bf16_t*)(lds + 16384 + 65536);
    float* SEG = (float*)(lds + 16384 + 65536 + 8192);
    const float* PB = (const float*)(lds + PB_OFF);
    __syncthreads();
    { const int c8 = (tid & 7) * 8;
      *(u32x4*)(XA + (tid >> 3) * 64 + c8) = pre.xa0;
      if (tid < 24) *(u32x4*)(XA + (64 + (tid >> 3)) * 64 + c8) = pre.xa1;
#pragma unroll
      for (int q = 0; q < 4; ++q) { const int idx = tid + 512 * q; *(u32x4*)(WGs + (idx >> 3) * 72 + (idx & 7) * 8) = pre.wg[q]; }
      if (fin) *(u32x4*)(GA + (tid >> 3) * 64 + c8) = pre.ga; }
    __syncthreads();
    { const int t = tid >> 3, c8 = (tid & 7) * 8;
      const float* cw = PB + PB_CW + n * 64 + c8; const float* cb = PB + PB_CB + n * 64 + c8;
      float xc[8];
#pragma unroll
      for (int i = 0; i < 8; ++i) xc[i] = cb[i];
#pragma unroll
      for (int jj = 0; jj < 4; ++jj) { float xr[8]; unpack8(*(const u32x4*)(XA + (t + jj) * 64 + c8), xr);
#pragma unroll
          for (int i = 0; i < 8; ++i) xc[i] += cw[jj * 384 + i] * xr[i]; }
      *(f32x4*)(XCF + t * 64 + c8) = (f32x4){xc[0], xc[1], xc[2], xc[3]}; *(f32x4*)(XCF + t * 64 + c8 + 4) = (f32x4){xc[4], xc[5], xc[6], xc[7]};
      *(u32x4*)(XCB + t * 72 + c8) = pack8(xc); }
    __syncthreads();
    const int rb = wave & 3, dir = wave >> 2;
    f32x4 acc[8];
#pragma unroll
    for (int c = 0; c < 8; ++c) acc[c] = mma_tile64(XCB + rb * 16 * 72, WGs + (dir * 8 + c) * 16 * 72, 72, lane, (f32x4){0.f, 0.f, 0.f, 0.f});
    __syncthreads();
    { const int cl = lane & 15, q = lane >> 4;
#pragma unroll
      for (int cc = 0; cc < 4; ++cc) {
          const int c = cc * 16 + cl, ch = n * 64 + c;
          const float brv = PB[PB_BR + dir * 384 + ch], biv = PB[PB_BI + dir * 384 + ch], sp = PB[PB_SP + dir * 384 + ch];
#pragma unroll
          for (int jj = 0; jj < 4; ++jj) {
              const int t = rb * 16 + q * 4 + jj;
              const float r = sigmoidf_(acc[cc][jj] + brv), ig = sigmoidf_(acc[cc + 4][jj] + biv);
              const float la = -8.0f * r * sp;
              const float xx = -2.0f * la;
              float a = __expf(la);
              const float om = xx < 0.125f ? xx * (1.0f - xx * (0.5f - xx * (0.16666667f - xx * 0.041666668f))) : 1.0f - a * a;
              float b = __builtin_amdgcn_sqrtf(fmaxf(om, 0.f)) * ig * XCF[t * 64 + c];
              if (pos0 + t < PADR) { a = 1.0f; b = 0.f; }
              AB[(dir * 2) * 4096 + t * 64 + c] = a; AB[(dir * 2 + 1) * 4096 + t * 64 + c] = b;
          } } }
    __syncthreads();
    float* RGC = (float*)((unsigned char*)p.out + DO_RGC);
    const int sc = tid & 127, seg = tid >> 7, sch = sc & 63, sd = sc >> 6;
    const float* Aa = AB + (sd * 2) * 4096 + sch; float* Bb = AB + (sd * 2 + 1) * 4096 + sch;
    { float P = 1.f, E = 0.f;
#pragma unroll
      for (int u = 0; u < 16; ++u) { const int uu = seg * 16 + u, t = sd == 0 ? uu : 63 - uu; const float a = Aa[t * 64]; E = a * E + Bb[t * 64]; P *= a; }
      SEG[(sc * 4 + seg) * 2] = P; SEG[(sc * 4 + seg) * 2 + 1] = E; }
    __syncthreads();
    if (!fin) {
        if (tid < 128) { float Pt = 1.f, Et = 0.f;
#pragma unroll
            for (int q = 0; q < 4; ++q) { const float Ps = SEG[(tid * 4 + q) * 2], Es = SEG[(tid * 4 + q) * 2 + 1]; Et = Ps * Et + Es; Pt *= Ps; }
            float* cp = RGC + ((size_t)(j * 2 + sd) * 384 + n * 64 + sch) * 2; cp[0] = Pt; cp[1] = Et; }
        return;
    }
    { float h = pre.cin;
      for (int q = 0; q < seg; ++q) h = SEG[(sc * 4 + q) * 2] * h + SEG[(sc * 4 + q) * 2 + 1];
#pragma unroll
      for (int u = 0; u < 16; ++u) { const int uu = seg * 16 + u, t = sd == 0 ? uu : 63 - uu; h = Aa[t * 64] * h + Bb[t * 64]; Bb[t * 64] = h; } }
    __syncthreads();
    { const int t = tid >> 3, c8 = (tid & 7) * 8;
      bf16_t* YM = (bf16_t*)(p.ws + WS_ACT); float* SS = (float*)(p.ws + WS_SS);
      const bool valid = pos0 + t >= PADR;
      float y[8], ss = 0.f;
      float gg[8]; unpack8(*(const u32x4*)(GA + t * 64 + c8), gg);
      const f32x4 h0a = *(const f32x4*)(AB + 1 * 4096 + t * 64 + c8), h0b = *(const f32x4*)(AB + 1 * 4096 + t * 64 + c8 + 4), h1a = *(const f32x4*)(AB + 3 * 4096 + t * 64 + c8), h1b = *(const f32x4*)(AB + 3 * 4096 + t * 64 + c8 + 4);
#pragma unroll
      for (int i = 0; i < 8; ++i) { const float hs = i < 4 ? h0a[i & 3] + h1a[i & 3] : h0b[i & 3] + h1b[i & 3];
          const float o = valid ? hs * gelu_tanh(gg[i]) : 0.f; y[i] = o; ss += o * o; }
      *(u32x4*)(YM + (size_t)(row0 + t) * D + n * 64 + c8) = pack8(y);
      ss += __shfl_xor(ss, 1); ss += __shfl_xor(ss, 2); ss += __shfl_xor(ss, 4);
      if ((tid & 7) == 0) SS[(size_t)(row0 + t) * 16 + n] = ss; }
}

struct HgPre { u32x4 xi, xff, xfb, xq, xg; f32x4 s00, s01, s10, s11; };
DI HgPre hg_load(const Params& p, int item, bool fin) {
    const int tid = ltid();
    const int j = item / 6, n = item % 6, row0 = j * 64;
    const int t = tid >> 3, k8 = (tid & 7) * 8;
    const bf16_t* rowp = (const bf16_t*)(p.ws + WS_PROJ) + (size_t)(row0 + t) * PLD + n * 64 + k8;
    const float* HGS = (const float*)((const unsigned char*)p.out + DO_HGS);
    HgPre r; const u32x4 z = (u32x4){0u, 0u, 0u, 0u}; const f32x4 zf = (f32x4){0.f, 0.f, 0.f, 0.f};
    r.xi = *(const u32x4*)(rowp + OFF_BI); r.xff = *(const u32x4*)(rowp + OFF_BFF); r.xfb = *(const u32x4*)(rowp + OFF_BFB);
    r.xq = z; r.xg = z; r.s00 = zf; r.s01 = zf; r.s10 = zf; r.s11 = zf;
    if (fin) {
        r.xq = *(const u32x4*)(rowp + OFF_BQ); r.xg = *(const u32x4*)(rowp + OFF_BG);
        const float* s0 = HGS + ((size_t)(j * 6 + n) * 2 + 0) * 4096 + t * 64 + k8; const float* s1 = s0 + 4096;
        r.s00 = *(const f32x4*)s0; r.s01 = *(const f32x4*)(s0 + 4); r.s10 = *(const f32x4*)s1; r.s11 = *(const f32x4*)(s1 + 4);
    }
    return r;
}
DI void hg_compute(const Params& p, int item, bool fin, const HgPre& pre, unsigned char* lds) {
    const int tid = ltid(), lane = tid & 63, wave = tid >> 6;
    const int j = item / 6, n = item % 6;
    const int row0 = j * 64, pos0 = chunk64_pos0(j);
    float* LF = (float*)lds;
    bf16_t* QT = (bf16_t*)(lds + 32768);
    bf16_t* KT = (bf16_t*)(lds + 51200);
    bf16_t* VT = (bf16_t*)(lds + 69632);
    bf16_t* SC = (bf16_t*)(lds + 78848);
    bf16_t* SP = (bf16_t*)(lds + 97280);
    bf16_t* XG = (bf16_t*)(lds + 115712);
    float* SEGT = (float*)(lds + 123904);
    float* OX = (float*)lds;
    const float* PB = (const float*)(lds + PB_OFF);
    float* HGS = (float*)((unsigned char*)p.out + DO_HGS);
    float* HGD = (float*)(p.ws + WS_HGD);
    const int t = tid >> 3, k8 = (tid & 7) * 8;
    const bool masked = pos0 + t < PADR;
    __syncthreads();
    float kk[2][8], q[8];
    {
        float xf[8], xv[8];
        unpack8(pre.xi, xv);
#pragma unroll
        for (int i = 0; i < 8; ++i) VT[(k8 + i) * 72 + t] = f2bf(masked ? 0.f : xv[i]);
#pragma unroll
        for (int d = 0; d < 2; ++d) {
            unpack8(d == 0 ? pre.xff : pre.xfb, xf);
#pragma unroll
            for (int i = 0; i < 8; ++i) {
                const float lb = PB[PB_LB + d * 384 + n * 64 + k8 + i];
                const float sg = sigmoidf_(xf[i]);
                const float f = lb + (1.0f - lb) * sg;
                kk[d][i] = masked ? 0.f : (1.0f - lb) * (1.0f - sg);
                LF[d * 4096 + t * 64 + k8 + i] = masked ? 0.f : __logf(f);
            }
        }
        unpack8(pre.xq, q);
#pragma unroll
        for (int i = 0; i < 8; ++i) q[i] = siluf_(q[i]);
        if (fin) *(u32x4*)(XG + t * 64 + k8) = pre.xg;
    }
    __syncthreads();
    { const int sc = tid & 127, seg = tid >> 7, k = sc & 63, d = sc >> 6; float run = 0.f; float* lf = LF + d * 4096 + k;
#pragma unroll
      for (int u = 0; u < 16; ++u) { const int uu = seg * 16 + u, s_ = d == 0 ? uu : 63 - uu; run += lf[s_ * 64]; lf[s_ * 64] = run; }
      SEGT[sc * 4 + seg] = run;
      __syncthreads();
      float off = 0.f;
      for (int q2 = 0; q2 < seg; ++q2) off += SEGT[sc * 4 + q2];
      if (seg > 0) {
#pragma unroll
          for (int u = 0; u < 16; ++u) { const int uu = seg * 16 + u, s_ = d == 0 ? uu : 63 - uu; lf[s_ * 64] += off; } } }
    __syncthreads();
    const int rb = wave & 3, dir = wave >> 2, cl = lane & 15, qd = lane >> 4;
    if (!fin) {
#pragma unroll
        for (int d = 0; d < 2; ++d)
#pragma unroll
            for (int i = 0; i < 8; ++i) {
                const int k = k8 + i; const float tot = d == 0 ? LF[63 * 64 + k] : LF[4096 + k];
                KT[d * 4608 + k * 72 + t] = f2bf(kk[d][i] * __expf(tot - LF[d * 4096 + t * 64 + k]));
                if (t == 0) HGD[((size_t)(j * 6 + n) * 2 + d) * 64 + k] = __expf(tot);
            }
        __syncthreads();
#pragma unroll
        for (int kb = 0; kb < 4; ++kb) {
            const f32x4 a = mma_tile64(VT + rb * 16 * 72, KT + dir * 4608 + kb * 16 * 72, 72, lane, (f32x4){0.f, 0.f, 0.f, 0.f});
            float* dst = HGS + ((size_t)(j * 6 + n) * 2 + dir) * 4096;
#pragma unroll
            for (int jj = 0; jj < 4; ++jj) dst[(rb * 16 + qd * 4 + jj) * 64 + kb * 16 + cl] = a[jj];
        }
        return;
    }
#pragma unroll
    for (int d = 0; d < 2; ++d) {
        float qv[8], kv[8];
#pragma unroll
        for (int i = 0; i < 8; ++i) {
            const int k = k8 + i; const float m = LF[d * 4096 + 32 * 64 + k];
            const float e1 = fminf(fmaxf(LF[d * 4096 + t * 64 + k] - m, -80.f), 80.f);
            qv[i] = q[i] * __expf(e1); kv[i] = kk[d][i] * __expf(-e1);
        }
        *(u32x4*)(QT + d * 4608 + t * 72 + k8) = pack8(qv);
        *(u32x4*)(KT + d * 4608 + t * 72 + k8) = pack8(kv);
        const f32x4 s0 = d == 0 ? pre.s00 : pre.s10, s1 = d == 0 ? pre.s01 : pre.s11;
        float sv[8];
#pragma unroll
        for (int i = 0; i < 4; ++i) { sv[i] = s0[i] * __expf(LF[d * 4096 + 32 * 64 + k8 + i]); sv[4 + i] = s1[i] * __expf(LF[d * 4096 + 32 * 64 + k8 + 4 + i]); }
        *(u32x4*)(SP + d * 4608 + t * 72 + k8) = pack8(sv);
    }
    __syncthreads();
#pragma unroll
    for (int ct = 0; ct < 4; ++ct) {
        const f32x4 a = mma_tile64(QT + dir * 4608 + rb * 16 * 72, KT + dir * 4608 + ct * 16 * 72, 72, lane, (f32x4){0.f, 0.f, 0.f, 0.f});
#pragma unroll
        for (int jj = 0; jj < 4; ++jj) {
            const int tt = rb * 16 + qd * 4 + jj, s_ = ct * 16 + cl;
            const bool keep = dir == 0 ? (s_ <= tt) : (s_ >= tt);
            SC[dir * 4608 + tt * 72 + s_] = f2bf(keep ? a[jj] : 0.f);
        }
    }
    __syncthreads();
    f32x4 o[4];
#pragma unroll
    for (int vt = 0; vt < 4; ++vt) {
        f32x4 a = mma_tile64(SC + dir * 4608 + rb * 16 * 72, VT + vt * 16 * 72, 72, lane, (f32x4){0.f, 0.f, 0.f, 0.f});
        o[vt] = mma_tile64(QT + dir * 4608 + rb * 16 * 72, SP + dir * 4608 + vt * 16 * 72, 72, lane, a);
    }
    if (dir == 1) {
#pragma unroll
        for (int vt = 0; vt < 4; ++vt)
#pragma unroll
            for (int jj = 0; jj < 4; ++jj) OX[(rb * 16 + qd * 4 + jj) * 64 + vt * 16 + cl] = o[vt][jj];
    }
    __syncthreads();
    if (dir == 0) {
        bf16_t* YM = (bf16_t*)(p.ws + WS_ACT); float* SS = (float*)(p.ws + WS_SS);
#pragma unroll
        for (int jj = 0; jj < 4; ++jj) {
            const int tt = rb * 16 + qd * 4 + jj;
            float ov[4], sq = 0.f;
#pragma unroll
            for (int vt = 0; vt < 4; ++vt) { ov[vt] = o[vt][jj] + OX[tt * 64 + vt * 16 + cl]; sq += ov[vt] * ov[vt]; }
            sq += __shfl_xor(sq, 1); sq += __shfl_xor(sq, 2); sq += __shfl_xor(sq, 4); sq += __shfl_xor(sq, 8);
            const float rn = rsqrtf(sq * (1.0f / 64.0f) + EPS);
            const bool valid = pos0 + tt >= PADR;
            float s2 = 0.f;
#pragma unroll
            for (int vt = 0; vt < 4; ++vt) {
                const int v = vt * 16 + cl;
                const float y = valid ? ov[vt] * rn * siluf_(bf2f(XG[tt * 64 + v])) : 0.f;
                s2 += y * y;
                YM[(size_t)(row0 + tt) * D + 384 + n * 64 + v] = f2bf(y);
            }
            s2 += __shfl_xor(s2, 1); s2 += __shfl_xor(s2, 2); s2 += __shfl_xor(s2, 4); s2 += __shfl_xor(s2, 8);
            if (cl == 0) SS[(size_t)(row0 + tt) * 16 + 6 + n] = s2;
        }
    }
}

constexpr int CG = 16;
DI void phase_carries(const Params& p, int l) {
    float* HGS = (float*)((unsigned char*)p.out + DO_HGS);
    const float* HGD = (const float*)(p.ws + WS_HGD);
    float* RGC = (float*)((unsigned char*)p.out + DO_RGC);
    const float* S5E = (const float*)((const unsigned char*)p.out + DO_S5E);
    bf16_t* U2 = (bf16_t*)(p.ws + WS_U2);
    const float* PAR = (const float*)(p.ws + WS_PAR);
    const int N_HG = 12 * 6 * 2 * 4096, N_RG = 12 * 2 * 384, N_S5 = 12 * 16 * 2 * 64;
    for (int idx = lbid() * 512 + ltid(); idx < N_HG + N_RG + N_S5; idx += lgdim() * 512) {
        if (idx < N_HG) {
            const int seq = idx / 49152, rem = idx % 49152, n = rem / 8192, d = (rem >> 12) & 1, e = rem & 4095, k = e & 63;
            int c0, nc; seq_chunks64(seq, c0, nc);
            float S = 0.f;
            for (int i0 = 0; i0 < nc; i0 += CG) {
                float loc[CG], dec[CG];
#pragma unroll
                for (int u = 0; u < CG; ++u) { const int i = i0 + u; if (i < nc) { const int jc = d == 0 ? c0 + i : c0 + nc - 1 - i; const size_t b = (size_t)(jc * 6 + n) * 2 + d; loc[u] = HGS[b * 4096 + e]; dec[u] = HGD[b * 64 + k]; } else { loc[u] = 0.f; dec[u] = 0.f; } }
#pragma unroll
                for (int u = 0; u < CG; ++u) { const int i = i0 + u; if (i < nc) { const int jc = d == 0 ? c0 + i : c0 + nc - 1 - i; const size_t b = (size_t)(jc * 6 + n) * 2 + d; HGS[b * 4096 + e] = S; S = dec[u] * S + loc[u]; } }
            }
        } else if (idx < N_HG + N_RG) {
            const int i2 = idx - N_HG; const int seq = i2 / 768, rem = i2 % 768, d = rem / 384, ch = rem % 384;
            int c0, nc; seq_chunks64(seq, c0, nc);
            float c = 0.f;
            for (int i0 = 0; i0 < nc; i0 += CG) {
                float P[CG], E[CG];
#pragma unroll
                for (int u = 0; u < CG; ++u) { const int i = i0 + u; if (i < nc) { const int jc = d == 0 ? c0 + i : c0 + nc - 1 - i; const float* cp = RGC + ((size_t)(jc * 2 + d) * 384 + ch) * 2; P[u] = cp[0]; E[u] = cp[1]; } else { P[u] = 0.f; E[u] = 0.f; } }
#pragma unroll
                for (int u = 0; u < CG; ++u) { const int i = i0 + u; if (i < nc) { const int jc = d == 0 ? c0 + i : c0 + nc - 1 - i; float* cp = RGC + ((size_t)(jc * 2 + d) * 384 + ch) * 2; cp[1] = c; c = P[u] * c + E[u]; } }
            }
        } else {
            const int i2 = idx - N_HG - N_RG; const int seq = i2 / 2048, g = (i2 >> 7) & 15, d = (i2 >> 6) & 1, pp = i2 & 63;
            int c0, nc; seq_chunks32(seq, c0, nc);
            const int base = (l * 2 + d) * 16 + g;
            const float ar = PAR[(base * 64 + pp) * 2], ai = PAR[(base * 64 + pp) * 2 + 1];
            const float mg = expf(32.0f * ar); float sn, cs; sincosf(32.0f * ai, &sn, &cs);
            const float wr_ = mg * cs, wi_ = mg * sn;
            float hr = 0.f, hi = 0.f;
            for (int i0 = 0; i0 < nc; i0 += CG) {
                float er[CG], ei[CG];
#pragma unroll
                for (int u = 0; u < CG; ++u) { const int i = i0 + u; if (i < nc) { const int c = d == 0 ? c0 + i : c0 + nc - 1 - i; const size_t ro = (size_t)(g * U2ROWS + c); er[u] = S5E[ro * 256 + d * 128 + pp]; ei[u] = S5E[ro * 256 + d * 128 + 64 + pp]; } else { er[u] = 0.f; ei[u] = 0.f; } }
#pragma unroll
                for (int u = 0; u < CG; ++u) { const int i = i0 + u; if (i < nc) { const int c = d == 0 ? c0 + i : c0 + nc - 1 - i; const size_t ro = (size_t)(g * U2ROWS + c);
                    U2[ro * U2LD + 512 + d * 128 + pp] = f2bf(hr); U2[ro * U2LD + 512 + d * 128 + 64 + pp] = f2bf(hi);
                    const float nr = wr_ * hr - wi_ * hi + er[u], ni = wr_ * hi + wi_ * hr + ei[u]; hr = nr; hi = ni; } }
            }
        }
    }
}

DI void phase_mixnorm(const Params& p, int l) {
    bf16_t* YM = (bf16_t*)(p.ws + WS_ACT); const float* SS = (const float*)(p.ws + WS_SS);
    const float* gain = p.in[I_MGAIN] + (size_t)l * D;
    for (size_t e = (size_t)lbid() * 512 + ltid(); e < (size_t)MP * 128; e += (size_t)lgdim() * 512) {
        const int R = (int)(e >> 7), c0 = (int)(e & 127) * 8;
        const int br = c0 < 384 ? 0 : (c0 < 768 ? 1 : 2);
        const float inv = br == 2 ? (1.0f / 256.0f) : (1.0f / 384.0f);
        const float* sp = SS + (size_t)R * 16; const f32x4 s0 = *(const f32x4*)sp, s1 = *(const f32x4*)(sp + 4), s2 = *(const f32x4*)(sp + 8), s3 = *(const f32x4*)(sp + 12);
        const float tot = br == 0 ? (((s0[0] + s0[1]) + (s0[2] + s0[3])) + (s1[0] + s1[1])) : (br == 1 ? (((s1[2] + s1[3]) + (s2[0] + s2[1])) + (s2[2] + s2[3])) : ((s3[0] + s3[1]) + (s3[2] + s3[3])));
        const float rn = rsqrtf(tot * inv + EPS);
        float f[8]; unpack8(*(const u32x4*)(YM + (size_t)R * D + c0), f);
#pragma unroll
        for (int i = 0; i < 8; ++i) f[i] = f[i] * rn * gain[c0 + i];
        *(u32x4*)(YM + (size_t)R * D + c0) = pack8(f);
    }
}

DI void phase_final(const Params& p) {
    const int tid = ltid(); const int lane = tid & 63, wave = tid >> 6;
    const float* H = (const float*)(p.ws + WS_H); const float* gain = p.in[I_NFIN];
    for (int R = lbid() * 8 + wave; R < MP; R += lgdim() * 8) {
        int seq, pos; row_info(R, seq, pos);
        const int t = pos - PADR - 16;
        if (t < 0) continue;
        float* dst = seq < 4 ? p.out + ((size_t)seq * 4096 + t) * D : p.out + (size_t)4 * 4096 * D + ((size_t)(seq - 4) * 2048 + t) * D;
        f32x4 v[4]; float ss = 0.f;
#pragma unroll
        for (int i = 0; i < 4; ++i) { v[i] = *(const f32x4*)(H + (size_t)R * D + (lane + 64 * i) * 4); ss += v[i][0] * v[i][0] + v[i][1] * v[i][1] + v[i][2] * v[i][2] + v[i][3] * v[i][3]; }
#pragma unroll
        for (int o = 1; o < 64; o <<= 1) ss += __shfl_xor(ss, o);
        const float rn = rsqrtf(ss * (1.0f / D) + EPS);
#pragma unroll
        for (int i = 0; i < 4; ++i) { const f32x4 gg = *(const f32x4*)(gain + (lane + 64 * i) * 4); *(f32x4*)(dst + (lane + 64 * i) * 4) = v[i] * rn * gg; }
    }
}

#define XB_TMO      128
#define XB_XCNT(j)  (256  + 64 * (j))
#define XB_XSUB(j)  (1280 + 64 * (j))
#define XB_XGEN(j)  (2304 + 64 * (j))
#define XB_TOP      3328
#define XB_TOPGEN   3392
#define XCD_BAR_WORDS 3456
#define XB_SPIN_CAP (1u << 18)
DI unsigned xb_ld(unsigned* p)              { return __hip_atomic_load(p, __ATOMIC_RELAXED, __HIP_MEMORY_SCOPE_AGENT); }
DI unsigned xb_add(unsigned* p, unsigned v) { return __hip_atomic_fetch_add(p, v, __ATOMIC_RELAXED, __HIP_MEMORY_SCOPE_AGENT); }
DI unsigned xb_xcc_id() { return (unsigned)__builtin_amdgcn_s_getreg((3 << 11) | 20) & 0xFu; }
#define XB_SPIN(cond, bar) do { unsigned _sp = 0; while (cond) { __builtin_amdgcn_s_sleep(1); \
    if ((++_sp & 255u) == 0u) { if (xb_ld(&(bar)[XB_TMO])) break; if (_sp > XB_SPIN_CAP) { atomicAdd(&(bar)[XB_TMO], 1u); break; } } } } while (0)
struct XcdBarrier { unsigned* bar; unsigned x; volatile LAS unsigned* st; };
DI XcdBarrier xcd_barrier_post(unsigned* bar, volatile LAS unsigned* st) {
    XcdBarrier b; b.bar = bar; b.x = xb_xcc_id(); b.st = st;
    if (threadIdx.x == 0) (void)xb_add(&bar[XB_XCNT(b.x)], 1u);
    return b;
}
DI void xcd_barrier_complete(unsigned* bar, unsigned x, unsigned& nloc, unsigned& nx) {
    const unsigned G = gridDim.x * gridDim.y * gridDim.z;
    unsigned sum, cnt, mine, sp = 0u;
    for (;;) {
        sum = 0u; cnt = 0u; mine = 0u;
#pragma unroll
        for (unsigned j = 0; j < 16; ++j) { const unsigned c = xb_ld(&bar[XB_XCNT(j)]); sum += c; cnt += (c > 0u) ? 1u : 0u; mine = (j == x) ? c : mine; }
        if (sum == G) break;
        __builtin_amdgcn_s_sleep(1);
        if ((++sp & 255u) == 0u) { if (xb_ld(&bar[XB_TMO])) break; if (sp > XB_SPIN_CAP) { atomicAdd(&bar[XB_TMO], 1u); break; } }
    }
    nloc = mine > 0u ? mine : 1u; nx = cnt > 0u ? cnt : 1u;
}
DI void xcd_barrier(const XcdBarrier& b) {
    asm volatile("s_waitcnt vmcnt(0)" ::: "memory");
    __syncthreads();
    if (threadIdx.x == 0) {
        unsigned* bar = b.bar;
        __builtin_amdgcn_s_waitcnt(0);
        unsigned nloc = b.st[0], nx = b.st[1];
        if (nloc == 0u) { xcd_barrier_complete(bar, b.x, nloc, nx); b.st[0] = nloc; b.st[1] = nx; }
        const unsigned old = xb_add(&bar[XB_XSUB(b.x)], 1u);
        const unsigned gen = old / nloc;
        if (old + 1u == (gen + 1u) * nloc) {
            __builtin_amdgcn_fence(__ATOMIC_RELEASE, "agent");
            asm volatile("s_waitcnt vmcnt(0)" ::: "memory");
            const unsigned og = xb_add(&bar[XB_TOP], 1u);
            const unsigned tg = og / nx;
            if (og + 1u == (tg + 1u) * nx) xb_add(&bar[XB_TOPGEN], 1u);
            else XB_SPIN(xb_ld(&bar[XB_TOPGEN]) == tg, bar);
            __builtin_amdgcn_fence(__ATOMIC_ACQUIRE, "agent");
            xb_add(&bar[XB_XGEN(b.x)], 1u);
            asm volatile("s_waitcnt vmcnt(0)" ::: "memory");
        } else {
            XB_SPIN(xb_ld(&bar[XB_XGEN(b.x)]) == gen, bar);
            __builtin_amdgcn_fence(__ATOMIC_ACQUIRE, "agent");
            asm volatile("s_waitcnt vmcnt(0)" ::: "memory");
        }
    }
    __syncthreads();
}

constexpr int NPHASE = 2 + 11 * DEPTH;
enum { GM_NONE = 0, GM_INPROJ, GM_RESADD, GM_RELU2, GM_S5E, GM_S5Y, GM_GLU };

struct EpiAny {
    const pg8::Gemm* g;
    DI void operator()(const f32x4 (&acc)[2][2][4][2], const Unit& u, int wr, int wc, int fr, int fq) const {
        asm volatile("" : "+v"(fr), "+v"(fq));
        asm volatile("" : "+s"(wr), "+s"(wc));
        switch (g->mode) {
        case GM_INPROJ: { EpiInProj E{(bf16_t*)g->o0, (bf16_t*)g->o1}; E(acc, u, wr, wc, fr, fq); } break;
        case GM_RESADD: { EpiResAdd E{(float*)g->o0}; E(acc, u, wr, wc, fr, fq); } break;
        case GM_RELU2:  { EpiRelu2 E{(bf16_t*)g->o0}; E(acc, u, wr, wc, fr, fq); } break;
        case GM_S5E:    { EpiS5E E{(float*)g->o0}; E(acc, u, wr, wc, fr, fq); } break;
        case GM_S5Y:    { EpiS5Y E{(const bf16_t*)g->i0, (bf16_t*)g->o0, (const float*)g->i1}; E(acc, u, wr, wc, fr, fq); } break;
        default:        { EpiGlu E{(const bf16_t*)g->i0, (bf16_t*)g->o0, (float*)g->o1, (const float*)g->i1}; E(acc, u, wr, wc, fr, fq); } break;
        }
    }
};

__global__ void __launch_bounds__(512, 2) mega(Params p) {
    extern __shared__ __attribute__((aligned(16))) unsigned char lds[];
    cg::grid_group grid = cg::this_grid();
    LAS unsigned char* ldsl = (LAS unsigned char*)lds;
    volatile LAS unsigned* xbst = (volatile LAS unsigned*)(ldsl + LDS_BYTES - 16);
    if (threadIdx.x < 4) xbst[threadIdx.x] = 0u;
    __syncthreads();
    const XcdBarrier xbar = xcd_barrier_post((unsigned*)(p.ws + WS_BAR), xbst);

#ifdef PROBE_DOUBLE_MASK
    bool rep = false;
#endif
    for (int ph = p.ph_lo; ph < p.ph_hi; ++ph) {
        const int l = (ph - 1) / 11, s = (ph == 0) ? 100 : (ph == NPHASE - 1 ? 101 : (ph - 1) % 11);
        unsigned char* ws = p.ws; unsigned char* ob = (unsigned char*)p.out; asm volatile("" : "+s"(ws), "+s"(ob));
        const int G = lgdim(), c = lbid();
        pg8::Gemm g; g.mode = GM_NONE; g.perm = 0; g.sched = 0; g.M = MP; g.N = 0; g.o0 = nullptr; g.o1 = nullptr; g.i0 = nullptr; g.i1 = nullptr; g.A = nullptr; g.Bt = nullptr; g.K = 0; g.lda = 0; g.ldb = 0;
        switch (s) {
        case 1:  g.mode = GM_INPROJ; g.perm = 1; g.A = (const bf16_t*)(ws + WS_ACT); g.Bt = (const bf16_t*)(ws + WS_WIN); g.K = 1024; g.lda = 1024; g.ldb = 1024; g.N = 3072; g.o0 = ws + WS_PROJ; g.o1 = ws + WS_U2; break;
        case 2:  g.mode = GM_S5E; g.sched = 1; g.A = (const bf16_t*)(ws + WS_U2); g.Bt = (const bf16_t*)(ws + WS_M1); g.K = 512; g.lda = U2LD; g.ldb = 512; g.o0 = ob + DO_S5E; break;
        case 4:  g.mode = GM_S5Y; g.perm = 1; g.sched = 2; g.A = (const bf16_t*)(ws + WS_U2); g.Bt = (const bf16_t*)(ws + WS_T2); g.K = 768; g.lda = U2LD; g.ldb = 768; g.i0 = ws + WS_U2; g.o0 = ws + WS_Z; g.i1 = p.in[I_S5D] + (size_t)l * 256; break;
        case 5:  g.mode = GM_GLU; g.perm = 1; g.A = (const bf16_t*)(ws + WS_Z); g.Bt = (const bf16_t*)(ws + WS_GLU); g.K = 256; g.lda = 256; g.ldb = 256; g.N = 256; g.i0 = ws + WS_Z; g.o0 = ws + WS_ACT; g.o1 = ws + WS_SS; g.i1 = p.in[I_GLUB] + (size_t)l * 256; break;
        case 7:  g.mode = GM_RESADD; g.A = (const bf16_t*)(ws + WS_ACT); g.Bt = (const bf16_t*)(ws + WS_WOUT); g.K = 1024; g.lda = 1024; g.ldb = 1024; g.N = 1024; g.o0 = ws + WS_H; break;
        case 9:  g.mode = GM_RELU2; g.perm = 1; g.A = (const bf16_t*)(ws + WS_ACT); g.Bt = (const bf16_t*)(ws + WS_WUP); g.K = 1024; g.lda = 1024; g.ldb = 1024; g.N = 4096; g.o0 = ws + WS_FF; break;
        case 10: g.mode = GM_RESADD; g.A = (const bf16_t*)(ws + WS_FF); g.Bt = (const bf16_t*)(ws + WS_WDN); g.K = 4096; g.lda = 4096; g.ldb = 4096; g.N = 1024; g.o0 = ws + WS_H; break;
        default: break;
        }
        if (g.mode != GM_NONE) {
            pg8::AnyOrder S; S.kind = g.sched; S.G = G; S.c = c; S.so.init(g.M, g.N, G, c);
            EpiAny E{&g};
            pg8::gemm_phase(ldsl, g, S, E);
        }
        if (s == 2 || s == 4) {
            const bool fin = (s == 4);
            const int skip = fin ? 160 : 80;
            const int rot = (c + G - skip % G) % G;
            stage_params(p, l, lds);
            if (rot < NCH64 * 6) {
                RgPre nx = rg_load(p, rot, fin);
                for (int it = rot; it < NCH64 * 6; it += G) { const RgPre cur = nx; if (it + G < NCH64 * 6) nx = rg_load(p, it + G, fin); rg_compute(p, it, fin, cur, lds); }
            }
            if (rot < NCH64 * 6) {
                HgPre nx = hg_load(p, rot, fin);
                for (int it = rot; it < NCH64 * 6; it += G) { const HgPre cur = nx; if (it + G < NCH64 * 6) nx = hg_load(p, it + G, fin); hg_compute(p, it, fin, cur, lds); }
            }
        } else if (s == 0) {
            norm_rows(p, true, l == 0, p.in[I_NMIX] + (size_t)l * D);
            convert_weights(p, l, lds);
            build_s5_mats(p, l);
        } else if (s == 8) norm_rows(p, false, false, p.in[I_NMLP] + (size_t)l * D);
        else if (s == 3) phase_carries(p, l);
        else if (s == 6) phase_mixnorm(p, l);
        else if (s == 100) phase_prep(p, lds);
        else if (s == 101) phase_final(p);
        if (ph + 1 < p.ph_hi) { if (ph == p.ph_lo) { __threadfence(); grid.sync(); } else xcd_barrier(xbar); }
#ifdef PROBE_DOUBLE_MASK
        if (s < 11 && ((PROBE_DOUBLE_MASK >> s) & 1) && !rep) { rep = true; --ph; } else rep = false;
#endif
    }
}

#ifndef MK_MULTI
#define MK_MULTI 0
#endif

extern "C" void kernel_launch(void* const* d_in, const int* in_sizes, int n_in, void* d_out, int out_size, void* d_ws, size_t ws_size, hipStream_t stream) {
    static int grid = 0;
    if (grid == 0) {
        if (n_in != 29 || ws_size < WS_END || out_size != 33554432) { fprintf(stderr, "kernel_launch: unexpected sizes n_in %d ws %zu need %zu out %d\n", n_in, ws_size, (size_t)WS_END, out_size); grid = -1; return; }
        int dev = 0, cus = 0, per_cu = 0;
        hipGetDevice(&dev);
        hipDeviceGetAttribute(&cus, hipDeviceAttributeMultiprocessorCount, dev);
        if (hipFuncSetAttribute((const void*)mega, hipFuncAttributeMaxDynamicSharedMemorySize, LDS_BYTES) != hipSuccess) { fprintf(stderr, "kernel_launch: hipFuncSetAttribute failed\n"); }
        hipOccupancyMaxActiveBlocksPerMultiprocessor(&per_cu, (const void*)mega, 512, LDS_BYTES);
        (void)hipGetLastError();
        if (per_cu < 1) per_cu = 1;
        grid = cus * 1;
        fprintf(stderr, "kernel_launch: cus %d per_cu %d grid %d ws %zu need %zu\n", cus, per_cu, grid, ws_size, (size_t)WS_END);
    }
    if (grid < 0) return;
    Params p{};
    for (int i = 0; i < 29; ++i) p.in[i] = (const float*)d_in[i];
    p.out = (float*)d_out; p.ws = (unsigned char*)d_ws;
#if MK_MULTI
    for (int ph = 0; ph < NPHASE; ++ph) {
        p.ph_lo = ph; p.ph_hi = ph + 1;
        hipLaunchKernelGGL(mega, dim3(grid), dim3(512), LDS_BYTES, stream, p);
    }
#else
    p.ph_lo = 0; p.ph_hi = NPHASE;
    if (hipMemsetAsync((unsigned char*)d_ws + WS_BAR, 0, 16384, stream) != hipSuccess) { fprintf(stderr, "kernel_launch: memset of the barrier words failed\n"); return; }
    void* args[] = {&p};
    hipError_t e = hipLaunchCooperativeKernel((const void*)mega, dim3(grid), dim3(512), args, LDS_BYTES, stream);
    if (e != hipSuccess) fprintf(stderr, "cooperative launch failed: %s (grid %d)\n", hipGetErrorString(e), grid);
#endif
}
```

```cpp
#include <hip/hip_runtime.h>
#include <hip/hip_cooperative_groups.h>
#include <cstdio>
namespace cg = cooperative_groups;

#define DI __device__ __forceinline__
#define LAS __attribute__((address_space(3)))
typedef unsigned short bf16_t;
typedef short bf16x8 __attribute__((ext_vector_type(8)));
typedef float f32x4 __attribute__((ext_vector_type(4)));
typedef unsigned u32x4 __attribute__((ext_vector_type(4)));
typedef unsigned u32x2 __attribute__((ext_vector_type(2)));

constexpr int D = 1024, DEPTH = 4, DFF = 4096;
constexpr int PADR = 48;
constexpr int LP = 4160, LS = 2112;
constexpr int ROWS_P = 4 * LP;
constexpr int MP = ROWS_P + 8 * LS;
constexpr int NCH64 = MP / 64;
constexpr int NCH32 = MP / 32;
constexpr int U2ROWS = 1280;
constexpr int U2LD = 768;
constexpr int PLD = 2816;
constexpr int OFF_AX = 0, OFF_AG = 384, OFF_BQ = 768, OFF_BI = 1152, OFF_BFF = 1536, OFF_BFB = 1920, OFF_BG = 2304;
constexpr float EPS = 1e-6f;
constexpr int LDS_BYTES = 147456;

constexpr size_t al256(size_t x) { return (x + 255) & ~(size_t)255; }
constexpr size_t WS_H     = 0;
constexpr size_t WS_ACT   = WS_H + (size_t)MP * D * 4;
constexpr size_t WS_BIG   = WS_ACT + (size_t)MP * D * 2;
constexpr size_t BIG_SIZE = (size_t)MP * DFF * 2;
constexpr size_t WS_PROJ  = WS_BIG;
constexpr size_t WS_U2    = WS_PROJ + (size_t)MP * PLD * 2;
constexpr size_t WS_Z     = WS_U2 + (size_t)16 * U2ROWS * U2LD * 2;
static_assert(WS_Z + (size_t)MP * 256 * 2 <= WS_BIG + BIG_SIZE, "BIG overflow");
constexpr size_t WS_FF    = WS_BIG;
constexpr size_t WS_WIN   = WS_BIG + BIG_SIZE;
constexpr size_t WS_WOUT  = WS_WIN + (size_t)3072 * 1024 * 2;
constexpr size_t WS_WUP   = WS_WOUT + (size_t)1024 * 1024 * 2;
constexpr size_t WS_WDN   = WS_WUP + (size_t)4096 * 1024 * 2;
constexpr size_t WS_WG    = WS_WDN + (size_t)1024 * 4096 * 2;
constexpr size_t WS_GLU   = WS_WG + (size_t)6 * 256 * 64 * 2;
constexpr size_t WS_T2    = WS_GLU + (size_t)256 * 256 * 2;
constexpr size_t WS_M1    = WS_T2 + (size_t)16 * 512 * 768 * 2;
constexpr size_t WS_SS    = WS_M1 + (size_t)16 * 256 * 512 * 2;
constexpr size_t WS_HGD   = WS_SS + (size_t)MP * 16 * 4;
constexpr size_t WS_LB    = WS_HGD + (size_t)NCH64 * 6 * 2 * 64 * 4;
constexpr size_t WS_PAR   = WS_LB + al256((size_t)2 * 4 * 384 * 4);
constexpr size_t WS_BAR   = WS_PAR + (size_t)4 * 2 * 16 * 64 * 2 * 4;
constexpr size_t WS_RSS   = WS_BAR + 16384;
constexpr size_t WS_TS    = WS_RSS + (size_t)MP * 16 * 4;
constexpr size_t WS_END   = WS_TS + 1024;
constexpr size_t DO_HB2   = 0;
constexpr size_t DO_PART  = 0;
constexpr size_t DO_HGS   = 0;
constexpr size_t DO_S5E   = DO_HGS + (size_t)NCH64 * 6 * 2 * 4096 * 4;
constexpr size_t DO_KTAB  = DO_S5E + (size_t)16 * U2ROWS * 256 * 4;
constexpr size_t DO_BBAR  = DO_KTAB + (size_t)4 * 16 * 2 * 32 * 256 * 4;
constexpr size_t DO_RGC   = DO_BBAR + (size_t)4 * 2 * 16 * 64 * 16 * 2 * 4;
constexpr size_t DO_END   = DO_RGC + (size_t)NCH64 * 2 * 384 * 2 * 4;
static_assert(DO_END <= (size_t)33554432 * 4, "d_out scratch overflow");

struct Params {
    const float* in[29];
    float* out;
    unsigned char* ws;
    int ph_lo, ph_hi;
};
enum { I_XP = 0, I_XS, I_META, I_NMIX, I_WIN, I_CONVW, I_CONVB, I_WR, I_BR, I_WI, I_BI, I_LAM, I_LBL, I_ARE, I_AIM, I_LDT, I_BRE, I_BIM, I_CRE, I_CIM,
       I_S5D, I_GLUW, I_GLUB, I_MGAIN, I_WOUT, I_NMLP, I_WUP, I_WDN, I_NFIN };

DI int ltid() { int t = threadIdx.x; asm volatile("" : "+v"(t)); return t; }
DI int lbid() { int t = blockIdx.x; asm volatile("" : "+s"(t)); return t; }
DI int lgdim() { int t = gridDim.x; asm volatile("" : "+s"(t)); return t; }
typedef __bf16 bf16x2_t __attribute__((ext_vector_type(2)));
typedef float f32x2_t __attribute__((ext_vector_type(2)));
DI unsigned pack2(float lo, float hi) { const f32x2_t v = {lo, hi}; const bf16x2_t b = __builtin_convertvector(v, bf16x2_t); return __builtin_bit_cast(unsigned, b); }
DI unsigned short f2bf(float f) { return (unsigned short)(pack2(f, 0.f) & 0xFFFFu); }
DI float bf2f(unsigned short b) { return __uint_as_float(((unsigned)b) << 16); }
DI float bflo(unsigned w) { return __uint_as_float(w << 16); }
DI float bfhi(unsigned w) { return __uint_as_float(w & 0xFFFF0000u); }
DI float sigmoidf_(float x) { return __builtin_amdgcn_rcpf(1.0f + __expf(-x)); }
DI float siluf_(float x) { return x * sigmoidf_(x); }
DI float gelu_tanh(float x) { const float u = 0.7978845608028654f * (x + 0.044715f * x * x * x); return x * sigmoidf_(2.0f * u); }
DI void unpack8(const u32x4& w, float* f) { f[0] = bflo(w.x); f[1] = bfhi(w.x); f[2] = bflo(w.y); f[3] = bfhi(w.y); f[4] = bflo(w.z); f[5] = bfhi(w.z); f[6] = bflo(w.w); f[7] = bfhi(w.w); }
DI u32x4 pack8(const float* f) { u32x4 w; w.x = pack2(f[0], f[1]); w.y = pack2(f[2], f[3]); w.z = pack2(f[4], f[5]); w.w = pack2(f[6], f[7]); return w; }

DI void row_info(int R, int& seq, int& pos) {
    if (R < ROWS_P) { seq = R / LP; pos = R - seq * LP; }
    else { const int r = R - ROWS_P; const int s = r / LS; seq = 4 + s; pos = r - s * LS; }
}
DI void seq_chunks64(int seq, int& c0, int& nc) { if (seq < 4) { c0 = seq * 65; nc = 65; } else { c0 = 260 + (seq - 4) * 33; nc = 33; } }
DI void seq_chunks32(int seq, int& c0, int& nc) { if (seq < 4) { c0 = seq * 130; nc = 130; } else { c0 = 520 + (seq - 4) * 66; nc = 66; } }
DI int chunk64_pos0(int j) { if (j < 260) return (j % 65) * 64; return ((j - 260) % 33) * 64; }
DI int chunk64_len(int j) { return j < 260 ? LP : LS; }

namespace pg8 {
constexpr int BM = 256, BK = 64, HALF = 128, HTB = HALF * BK * 2, STAGE_BYTES = 8 * HTB, NXCD = 8, WGM = 8;
__host__ __device__ __forceinline__ int lds_byte(int r, int c) { const int st = (r >> 4) * 2 + (c >> 5), rr = r & 15, cc = c & 31, ob = rr * 64 + cc * 2; return st * 1024 + (ob ^ (((ob >> 9) & 1) << 5)); }
__host__ __device__ __forceinline__ void stage_rc(int b, int& R, int& C) { const int st = b / 1024, sb = b % 1024, swz = sb ^ (((sb >> 9) & 1) << 5); R = (st >> 1) * 16 + swz / 64; C = (st & 1) * 32 + (swz % 64) / 2; }
__host__ __device__ __forceinline__ int perm32(int rho) { const int n = rho >> 4, i = rho & 15; return 8 * (i >> 2) + 4 * n + (i & 3); }
struct Unit { int pm, pn, koff, nt; };
struct Gemm { const bf16_t* A; const bf16_t* Bt; int K, lda, ldb;
              int mode, perm, sched, M, N;
              void* o0; void* o1; const void* i0; const void* i1; };

struct StaticOrder {
    int nM, nN, nwg, G, c;
    DI void init(int M, int N, int G_, int c_) { nM = M / BM; nN = N / BM; nwg = nM * nN; G = G_; c = c_; }
    DI bool next(int i, Unit& u) const {
        const long L = (long)i * G + c; if (L >= nwg) return false;
        int wgid = (int)L; { const int q = nwg / NXCD, r = nwg % NXCD, xcd = wgid % NXCD, off = wgid / NXCD; wgid = (xcd < r ? xcd * (q + 1) : r * (q + 1) + (xcd - r) * q) + off; }
        const int nig = WGM * nN, gid = wgid / nig, fm = gid * WGM, gsz = (nM - fm) < WGM ? (nM - fm) : WGM;
        u.pm = fm + ((wgid % nig) % gsz); u.pn = (wgid % nig) / gsz; u.koff = 0; u.nt = 0; return true;
    }
    DI void a_ready(const Unit&) const {}
    DI void done(const Unit&) const {}
};
template <int NPN> struct GroupOrder {
    int G, c;
    DI bool next(int i, Unit& u) const {
        const int L = i * G + c; if (L >= 16 * 5 * NPN) return false;
        const int g = L / (5 * NPN), r = L % (5 * NPN); u.pm = g * 5 + (r % 5); u.pn = g * NPN + (r / 5); u.koff = 0; u.nt = 0; return true;
    }
    DI void a_ready(const Unit&) const {}
    DI void done(const Unit&) const {}
};

DI unsigned cvt_pk_bf16(float lo, float hi) { unsigned r; asm volatile("v_cvt_pk_bf16_f32 %0, %1, %2" : "=v"(r) : "v"(lo), "v"(hi)); return r; }

struct AnyOrder {
    StaticOrder so; int kind, G, c, ntfull;
    DI bool next(int i, Unit& u) const {
        bool ok;
        if (kind == 0) ok = so.next(i, u);
        else if (kind == 1) { GroupOrder<1> o{G, c}; ok = o.next(i, u); }
        else if (kind == 2) { GroupOrder<2> o{G, c}; ok = o.next(i, u); }
        else {
            const int L = i * G + c;
            if (L < 512) ok = so.next(i, u);
            else { const int q = L - 512; if (q >= 48) return false; u.pm = 128 + q / 16; u.pn = (q >> 2) & 3; u.koff = (q & 3) * 1024; u.nt = 16; return true; }
        }
        u.nt = ntfull; return ok;
    }
};
template <class EpiFn>
DI void gemm_phase(LAS unsigned char* lds, const Gemm& g, const AnyOrder& S, const EpiFn& E) {
    int tid_ = ltid();
    const int tid = tid_, wid = __builtin_amdgcn_readfirstlane(tid >> 6), lane = tid & 63, wr = wid >> 2, wc = wid & 3, fr = lane & 15, fq = lane >> 4;
    int nt = g.K / BK;
    unsigned voffA[2], voffB[2];
#pragma unroll
    for (int i = 0; i < 2; ++i) { int R, C; stage_rc(tid * 16 + i * 8192, R, C); const int Rb = g.perm ? ((R & ~31) + perm32(R & 31)) : R;
        voffA[i] = (unsigned)(R * g.lda + C) * 2u; voffB[i] = (unsigned)(Rb * g.ldb + C) * 2u; }
    const size_t kstep = (size_t)(BK * 2);
    const size_t hstepA = (size_t)HALF * g.lda * 2, hstepB = (size_t)HALF * g.ldb * 2;
    const size_t tstepA = 2 * hstepA, tstepB = 2 * hstepB;
    const unsigned ldsw = (unsigned)wid * 1024u;
    const int aoff = lds_byte(wr * 64 + fr, fq * 8), boff = lds_byte(wc * 32 + fr, fq * 8);
#define PG8_SA(b, h) (((b) * 2 + (h)) * HTB)
#define PG8_SB(b, h) ((4 + (b) * 2 + (h)) * HTB)
#define PG8_STAGE(bufoff, gbase, voff) do { _Pragma("unroll") for (int _i = 0; _i < 2; ++_i) \
        __builtin_amdgcn_global_load_lds((const unsigned*)((const char*)(gbase) + (voff)[_i]), (LAS unsigned*)(lds + (bufoff) + ldsw + _i * 8192), 16, 0, 0); } while (0)
#define PG8_LDA(dst, b, h) do { _Pragma("unroll") for (int m = 0; m < 4; ++m) _Pragma("unroll") for (int k = 0; k < 2; ++k) dst[m][k] = *(const LAS bf16x8*)(lds + PG8_SA(b, h) + aoff + m * 2048 + k * 1024); } while (0)
#define PG8_LDB(dst, b, h) do { _Pragma("unroll") for (int n = 0; n < 2; ++n) _Pragma("unroll") for (int k = 0; k < 2; ++k) dst[n][k] = *(const LAS bf16x8*)(lds + PG8_SB(b, h) + boff + n * 2048 + k * 1024); } while (0)
#define PG8_MMA(ai, bj, At, Bt) do { __builtin_amdgcn_s_setprio(1); _Pragma("unroll") for (int m = 0; m < 4; ++m) _Pragma("unroll") for (int n = 0; n < 2; ++n) _Pragma("unroll") for (int k = 0; k < 2; ++k) \
        acc[ai][bj][m][n] = __builtin_amdgcn_mfma_f32_16x16x32_bf16(Bt[n][k], At[m][k], acc[ai][bj][m][n], 0, 0, 0); __builtin_amdgcn_s_setprio(0); } while (0)
#define PG8_WAIT_V(n) asm volatile("s_waitcnt vmcnt(" #n ")" ::: "memory")
#define PG8_WAIT_L(n) asm volatile("s_waitcnt lgkmcnt(" #n ")" ::: "memory")
#define PG8_BAR __builtin_amdgcn_s_barrier()
#define PG8_SCHED __builtin_amdgcn_sched_barrier(0)
    Unit cur, nxt; int ui = 0;
    if (!S.next(0, cur)) return;
    f32x4 acc[2][2][4][2];
#pragma unroll
    for (int a = 0; a < 2; ++a)
#pragma unroll
        for (int b = 0; b < 2; ++b)
#pragma unroll
            for (int m = 0; m < 4; ++m)
#pragma unroll
                for (int n = 0; n < 2; ++n) acc[a][b][m][n] = (f32x4){0.f, 0.f, 0.f, 0.f};
    bf16x8 At[4][2], B0[2][2], B1[2][2];
    const char* cA = (const char*)g.A + (size_t)cur.pm * tstepA + (size_t)cur.koff * 2; const char* cB = (const char*)g.Bt + (size_t)cur.pn * tstepB + (size_t)cur.koff * 2;
    nt = cur.nt;
    f32x4 pra = (f32x4){0.f, 0.f, 0.f, 0.f}, prb = pra; const bool rsm = E.prime_issue(cur, tid, pra, prb);
    PG8_STAGE(PG8_SB(0, 0), cB, voffB); PG8_STAGE(PG8_SA(0, 0), cA, voffA); PG8_STAGE(PG8_SB(0, 1), cB + hstepB, voffB); PG8_STAGE(PG8_SA(0, 1), cA + hstepA, voffA);
    if (wr == 1) PG8_BAR;
    PG8_WAIT_V(4); PG8_BAR;
    if (rsm) E.prime_commit(lds, tid, pra, prb);
    PG8_STAGE(PG8_SB(1, 0), cB + kstep, voffB); PG8_STAGE(PG8_SA(1, 0), cA + kstep, voffA); PG8_STAGE(PG8_SB(1, 1), cB + hstepB + kstep, voffB);
    PG8_WAIT_V(6); PG8_BAR;
    for (;;) {
        const bool has_next = S.next(ui + 1, nxt);
        const char* nA = has_next ? (const char*)g.A + (size_t)nxt.pm * tstepA + (size_t)nxt.koff * 2 : cA; const char* nB = has_next ? (const char*)g.Bt + (size_t)nxt.pn * tstepB + (size_t)nxt.koff * 2 : cB;
        for (int t = 0; t < nt; t += 2) {
            const bool last = (t == nt - 2);
            const char* a1 = cA + (size_t)(t + 1) * kstep;
            const char* a2 = last ? nA : cA + (size_t)(t + 2) * kstep; const char* b2 = last ? nB : cB + (size_t)(t + 2) * kstep;
            const char* a3 = a2 + kstep; const char* b3 = b2 + kstep;
            PG8_LDB(B0, 0, 0); PG8_SCHED; PG8_LDA(At, 0, 0); PG8_STAGE(PG8_SA(1, 1), a1 + hstepA, voffA);
            PG8_WAIT_L(8); PG8_BAR; PG8_WAIT_L(0); PG8_MMA(0, 0, At, B0); PG8_BAR; PG8_SCHED;
            PG8_LDB(B1, 0, 1); PG8_STAGE(PG8_SB(0, 0), b2, voffB);
            PG8_BAR; PG8_WAIT_L(0); PG8_MMA(0, 1, At, B1); PG8_BAR;
            PG8_LDA(At, 0, 1); PG8_STAGE(PG8_SA(0, 0), a2, voffA);
            PG8_BAR; PG8_WAIT_L(0); PG8_MMA(1, 0, At, B0); PG8_BAR; PG8_SCHED;
            PG8_STAGE(PG8_SB(0, 1), b2 + hstepB, voffB);
            PG8_WAIT_V(6); PG8_BAR; PG8_MMA(1, 1, At, B1); PG8_BAR;
            PG8_LDB(B0, 1, 0); PG8_SCHED; PG8_LDA(At, 1, 0); PG8_STAGE(PG8_SA(0, 1), a2 + hstepA, voffA);
            PG8_WAIT_L(8); PG8_BAR; PG8_WAIT_L(0); PG8_MMA(0, 0, At, B0); PG8_BAR; PG8_SCHED;
            PG8_LDB(B1, 1, 1); PG8_STAGE(PG8_SB(1, 0), b3, voffB);
            PG8_BAR; PG8_WAIT_L(0); PG8_MMA(0, 1, At, B1); PG8_BAR;
            PG8_LDA(At, 1, 1); PG8_STAGE(PG8_SA(1, 0), a3, voffA);
            PG8_BAR; PG8_WAIT_L(0); PG8_MMA(1, 0, At, B0); PG8_BAR; PG8_SCHED;
            PG8_STAGE(PG8_SB(1, 1), b3 + hstepB, voffB);
            PG8_WAIT_V(6); PG8_BAR; PG8_MMA(1, 1, At, B1); PG8_BAR;
        }
        E(acc, cur, wr, wc, fr, fq, lds, has_next, nxt, ui & 1);
        if (!has_next) break;
#pragma unroll
        for (int a = 0; a < 2; ++a)
#pragma unroll
            for (int b = 0; b < 2; ++b)
#pragma unroll
                for (int m = 0; m < 4; ++m)
#pragma unroll
                    for (int n = 0; n < 2; ++n) acc[a][b][m][n] = (f32x4){0.f, 0.f, 0.f, 0.f};
        cur = nxt; cA = nA; cB = nB; nt = cur.nt; ++ui;
    }
    PG8_WAIT_V(0);
    if (wr == 0) PG8_BAR;
    PG8_BAR;
#undef PG8_SA
#undef PG8_SB
#undef PG8_STAGE
#undef PG8_LDA
#undef PG8_LDB
#undef PG8_MMA
#undef PG8_WAIT_V
#undef PG8_WAIT_L
#undef PG8_BAR
#undef PG8_SCHED
}
}
using pg8::Unit;

DI float row_rn(const float* RSS, int r) {
    const float* sp = RSS + (size_t)r * 16; const f32x4 a = *(const f32x4*)sp, b = *(const f32x4*)(sp + 4), c = *(const f32x4*)(sp + 8), d = *(const f32x4*)(sp + 12);
    const float tot = (((a[0] + a[1]) + (a[2] + a[3])) + ((b[0] + b[1]) + (b[2] + b[3]))) + (((c[0] + c[1]) + (c[2] + c[3])) + ((d[0] + d[1]) + (d[2] + d[3])));
    return rsqrtf(tot * (1.0f / D) + EPS);
}
DI float row_rn4(const float* RSS, int r, int fq) {
    const f32x4 a = *(const f32x4*)(RSS + (size_t)r * 16 + fq * 4);
    float t = (a[0] + a[1]) + (a[2] + a[3]);
    t += __shfl_xor(t, 16); t += __shfl_xor(t, 32);
    return rsqrtf(t * (1.0f / D) + EPS);
}
constexpr int PS_OFF = 131072;
DI void rs_issue(const float* RSS, int pm, int tid, f32x4& a, f32x4& b) { const float* sp = RSS + (size_t)(pm * 256 + (tid & 255)) * 16 + (tid >> 8) * 8; a = *(const f32x4*)sp; b = *(const f32x4*)(sp + 4); }
DI void rs_commit(LAS unsigned char* lds, int par, int tid, const f32x4& a, const f32x4& b) { ((LAS float*)(lds + PS_OFF))[(par * 2 + (tid >> 8)) * 256 + (tid & 255)] = ((a[0] + a[1]) + (a[2] + a[3])) + ((b[0] + b[1]) + (b[2] + b[3])); }
DI float rs_get(LAS unsigned char* lds, int par, int rl) { const LAS float* PS = (const LAS float*)(lds + PS_OFF); return rsqrtf((PS[(par * 2) * 256 + rl] + PS[(par * 2 + 1) * 256 + rl]) * (1.0f / D) + EPS); }
struct EpiInProj {
    static constexpr bool PERM = true;
    bf16_t* PROJ; bf16_t* U2; const float* RSS;
    DI void operator()(const f32x4 (&acc)[2][2][4][2], const Unit& u, int wr, int wc, int fr, int fq, LAS unsigned char* lds, bool has_next, const Unit& nx, int par) const {
        const int row0 = u.pm * 256 + wr * 64 + fr;
        const int tid = ltid(); f32x4 na = (f32x4){0.f, 0.f, 0.f, 0.f}, nb = na;
        if (has_next) rs_issue(RSS, nx.pm, tid, na, nb);
        float rn[2][4];
#pragma unroll
        for (int ai = 0; ai < 2; ++ai)
#pragma unroll
            for (int m = 0; m < 4; ++m) rn[ai][m] = rs_get(lds, par, wr * 64 + fr + ai * 128 + m * 16);
#pragma unroll
        for (int ai = 0; ai < 2; ++ai)
#pragma unroll
            for (int m = 0; m < 4; ++m) {
                const int r = row0 + ai * 128 + m * 16;
#pragma unroll
                for (int bj = 0; bj < 2; ++bj) {
                    const f32x4 v0 = acc[ai][bj][m][0] * rn[ai][m], v1 = acc[ai][bj][m][1] * rn[ai][m];
                    u32x4 w; w.x = pack2(v0[0], v0[1]); w.y = pack2(v0[2], v0[3]); w.z = pack2(v1[0], v1[1]); w.w = pack2(v1[2], v1[3]);
                    const int cl = bj * 128 + wc * 32 + 8 * fq;
                    if (u.pn == 0) { const int g = cl >> 4, h = cl & 15; *(u32x4*)(U2 + ((size_t)(g * U2ROWS + (r >> 5)) * U2LD + (r & 31) * 16 + h)) = w; }
                    else __builtin_nontemporal_store(w, (u32x4*)(PROJ + (size_t)r * PLD + (u.pn - 1) * 256 + cl));
                }
            }
        if (has_next) rs_commit(lds, par ^ 1, tid, na, nb);
    }
};
struct EpiResAdd {
    static constexpr bool PERM = false;
    bf16_t* H; float* RSS;
    DI void ld(u32x2 (&hv)[2][2][2], int row0, int col0, int ai, int mp) const {
#pragma unroll
        for (int mm = 0; mm < 2; ++mm)
#pragma unroll
            for (int bj = 0; bj < 2; ++bj)
#pragma unroll
                for (int n = 0; n < 2; ++n) hv[mm][bj][n] = *(const u32x2*)(H + (size_t)(row0 + ai * 128 + (mp * 2 + mm) * 16) * D + col0 + bj * 128 + n * 16);
    }
    template <int AI, int MP_>
    DI void proc(const u32x2 (&hv)[2][2][2], const f32x4 (&acc)[2][2][4][2], int row0, int col0, int pn, int wc, int fq) const {
#pragma unroll
        for (int mm = 0; mm < 2; ++mm) { const int m = MP_ * 2 + mm; const int r = row0 + AI * 128 + m * 16; bf16_t* rowp = H + (size_t)r * D + col0;
            float ss = 0.f;
#pragma unroll
            for (int bj = 0; bj < 2; ++bj)
#pragma unroll
                for (int n = 0; n < 2; ++n) { const u32x2 o = hv[mm][bj][n]; const f32x4 a = acc[AI][bj][m][n];
                    const float h0 = bflo(o.x) + a[0], h1 = bfhi(o.x) + a[1], h2 = bflo(o.y) + a[2], h3 = bfhi(o.y) + a[3];
                    u32x2 w; w.x = pack2(h0, h1); w.y = pack2(h2, h3); *(u32x2*)(rowp + bj * 128 + n * 16) = w;
                    ss += (h0 * h0 + h1 * h1) + (h2 * h2 + h3 * h3); }
            ss += __shfl_xor(ss, 16); ss += __shfl_xor(ss, 32);
            if (fq == 0) RSS[(size_t)r * 16 + pn * 4 + wc] = ss; }
    }
    DI void operator()(const f32x4 (&acc)[2][2][4][2], const Unit& u, int wr, int wc, int fr, int fq) const {
        const int row0 = u.pm * 256 + wr * 64 + fr, col0 = u.pn * 256 + wc * 32 + 4 * fq;
        u32x2 ha[2][2][2], hb[2][2][2];
        ld(ha, row0, col0, 0, 0);
        ld(hb, row0, col0, 0, 1); proc<0, 0>(ha, acc, row0, col0, u.pn, wc, fq);
        ld(ha, row0, col0, 1, 0); proc<0, 1>(hb, acc, row0, col0, u.pn, wc, fq);
        ld(hb, row0, col0, 1, 1); proc<1, 0>(ha, acc, row0, col0, u.pn, wc, fq);
        proc<1, 1>(hb, acc, row0, col0, u.pn, wc, fq);
    }
};
struct EpiPart {
    static constexpr bool PERM = false;
    float* P;
    DI void operator()(const f32x4 (&acc)[2][2][4][2], const Unit& u, int wr, int wc, int fr, int fq) const {
        const int row0 = (u.pm - 128) * 256 + wr * 64 + fr, col0 = u.pn * 256 + wc * 32 + 4 * fq; const int ks = u.koff >> 10;
#pragma unroll
        for (int ai = 0; ai < 2; ++ai)
#pragma unroll
            for (int m = 0; m < 4; ++m) { float* rowp = P + ((size_t)ks * 768 + row0 + ai * 128 + m * 16) * D + col0;
#pragma unroll
                for (int bj = 0; bj < 2; ++bj)
#pragma unroll
                    for (int n = 0; n < 2; ++n) *(f32x4*)(rowp + bj * 128 + n * 16) = acc[ai][bj][m][n]; }
    }
};
struct EpiRelu2 {
    static constexpr bool PERM = true;
    bf16_t* FF; const float* RSS;
    DI void operator()(const f32x4 (&acc)[2][2][4][2], const Unit& u, int wr, int wc, int fr, int fq, LAS unsigned char* lds, bool has_next, const Unit& nx, int par) const {
        const int row0 = u.pm * 256 + wr * 64 + fr, col0 = u.pn * 256 + wc * 32 + 8 * fq;
        const int tid = ltid(); f32x4 na = (f32x4){0.f, 0.f, 0.f, 0.f}, nb = na;
        if (has_next) rs_issue(RSS, nx.pm, tid, na, nb);
        float rn[2][4];
#pragma unroll
        for (int ai = 0; ai < 2; ++ai)
#pragma unroll
            for (int m = 0; m < 4; ++m) rn[ai][m] = rs_get(lds, par, wr * 64 + fr + ai * 128 + m * 16);
#pragma unroll
        for (int ai = 0; ai < 2; ++ai)
#pragma unroll
            for (int m = 0; m < 4; ++m) { bf16_t* rowp = FF + (size_t)(row0 + ai * 128 + m * 16) * DFF + col0;
#pragma unroll
                for (int bj = 0; bj < 2; ++bj) { f32x4 v0 = acc[ai][bj][m][0] * rn[ai][m], v1 = acc[ai][bj][m][1] * rn[ai][m];
#pragma unroll
                    for (int j = 0; j < 4; ++j) { const float a = fmaxf(v0[j], 0.f), b = fmaxf(v1[j], 0.f); v0[j] = a * a; v1[j] = b * b; }
                    u32x4 w; w.x = pack2(v0[0], v0[1]); w.y = pack2(v0[2], v0[3]); w.z = pack2(v1[0], v1[1]); w.w = pack2(v1[2], v1[3]);
                    __builtin_nontemporal_store(w, (u32x4*)(rowp + bj * 128)); } }
        if (has_next) rs_commit(lds, par ^ 1, tid, na, nb);
    }
};
struct EpiS5E {
    static constexpr bool PERM = false;
    float* E;
    DI void operator()(const f32x4 (&acc)[2][2][4][2], const Unit& u, int wr, int wc, int fr, int fq) const {
        const int row0 = u.pm * 256 + wr * 64 + fr, col0 = wc * 32 + 4 * fq;
#pragma unroll
        for (int ai = 0; ai < 2; ++ai)
#pragma unroll
            for (int m = 0; m < 4; ++m) { float* rowp = E + (size_t)(row0 + ai * 128 + m * 16) * 256 + col0;
#pragma unroll
                for (int bj = 0; bj < 2; ++bj)
#pragma unroll
                    for (int n = 0; n < 2; ++n) *(f32x4*)(rowp + bj * 128 + n * 16) = acc[ai][bj][m][n]; }
    }
};
struct EpiS5Y {
    static constexpr bool PERM = true;
    const bf16_t* U2; bf16_t* Z; const float* dskip;
    DI void operator()(const f32x4 (&acc)[2][2][4][2], const Unit& u, int wr, int wc, int fr, int fq) const {
        const int g = u.pm / 5, pml = u.pm - g * 5, pnl = u.pn - g * 2;
        float dsk[2][8];
#pragma unroll
        for (int bj = 0; bj < 2; ++bj) { const int h0 = (bj * 128 + wc * 32 + 8 * fq) & 15; const f32x4 d0 = *(const f32x4*)(dskip + g * 16 + h0), d1 = *(const f32x4*)(dskip + g * 16 + h0 + 4);
#pragma unroll
            for (int j = 0; j < 4; ++j) { dsk[bj][j] = d0[j]; dsk[bj][4 + j] = d1[j]; } }
#pragma unroll
        for (int ai = 0; ai < 2; ++ai) {
            u32x4 uw[4][2];
#pragma unroll
            for (int m = 0; m < 4; ++m) { const int chunk = pml * 256 + ai * 128 + wr * 64 + m * 16 + fr;
#pragma unroll
                for (int bj = 0; bj < 2; ++bj) { const int n0 = pnl * 256 + bj * 128 + wc * 32 + 8 * fq;
                    uw[m][bj] = chunk < NCH32 ? *(const u32x4*)(U2 + ((size_t)(g * U2ROWS + chunk) * U2LD + n0)) : (u32x4){0u, 0u, 0u, 0u}; } }
#pragma unroll
            for (int m = 0; m < 4; ++m) {
                const int chunk = pml * 256 + ai * 128 + wr * 64 + m * 16 + fr;
                if (chunk < NCH32) {
#pragma unroll
                    for (int bj = 0; bj < 2; ++bj) {
                        const int n0 = pnl * 256 + bj * 128 + wc * 32 + 8 * fq;
                        const int t = n0 >> 4, h0 = n0 & 15;
                        float uf[8]; unpack8(uw[m][bj], uf);
                        const f32x4 v0 = acc[ai][bj][m][0], v1 = acc[ai][bj][m][1];
                        float y[8];
#pragma unroll
                        for (int j = 0; j < 4; ++j) { y[j] = v0[j]; y[4 + j] = v1[j]; }
#pragma unroll
                        for (int j = 0; j < 8; ++j) y[j] = gelu_tanh(y[j] + dsk[bj][j] * uf[j]);
                        *(u32x4*)(Z + ((size_t)(chunk * 32 + t) * 256 + g * 16 + h0)) = pack8(y);
                    }
                }
            }
        }
    }
};
struct EpiGlu {
    static constexpr bool PERM = true;
    const bf16_t* Z; bf16_t* YM; float* SS; const float* glub;
    DI void operator()(const f32x4 (&acc)[2][2][4][2], const Unit& u, int wr, int wc, int fr, int fq) const {
        const int row0 = u.pm * 256 + wr * 64 + fr;
        float gb[2][8];
#pragma unroll
        for (int bj = 0; bj < 2; ++bj) { const int c0 = bj * 128 + wc * 32 + 8 * fq; const f32x4 d0 = *(const f32x4*)(glub + c0), d1 = *(const f32x4*)(glub + c0 + 4);
#pragma unroll
            for (int j = 0; j < 4; ++j) { gb[bj][j] = d0[j]; gb[bj][4 + j] = d1[j]; } }
#pragma unroll
        for (int ai = 0; ai < 2; ++ai) {
            u32x4 zw[4][2];
#pragma unroll
            for (int m = 0; m < 4; ++m)
#pragma unroll
                for (int bj = 0; bj < 2; ++bj) zw[m][bj] = *(const u32x4*)(Z + (size_t)(row0 + ai * 128 + m * 16) * 256 + bj * 128 + wc * 32 + 8 * fq);
#pragma unroll
            for (int m = 0; m < 4; ++m) {
                const int r = row0 + ai * 128 + m * 16;
                int seq, pos; row_info(r, seq, pos);
                const bool valid = pos >= PADR;
                float ssum = 0.f;
#pragma unroll
                for (int bj = 0; bj < 2; ++bj) {
                    const int c0 = bj * 128 + wc * 32 + 8 * fq;
                    float zf[8]; unpack8(zw[m][bj], zf);
                    const f32x4 v0 = acc[ai][bj][m][0], v1 = acc[ai][bj][m][1];
                    float y[8];
#pragma unroll
                    for (int j = 0; j < 4; ++j) { y[j] = v0[j]; y[4 + j] = v1[j]; }
#pragma unroll
                    for (int j = 0; j < 8; ++j) { const float o = valid ? zf[j] * sigmoidf_(y[j] + gb[bj][j]) : 0.f; y[j] = o; ssum += o * o; }
                    *(u32x4*)(YM + (size_t)r * D + 768 + c0) = pack8(y);
                }
                ssum += __shfl_xor(ssum, 16); ssum += __shfl_xor(ssum, 32);
                if (fq == 0) SS[(size_t)r * 16 + 12 + wc] = ssum;
            }
        }
    }
};

DI f32x4 mma_tile64(const bf16_t* A, const bf16_t* Bt, int ld, int lane, f32x4 acc) {
    const int r = lane & 15, q = lane >> 4;
#pragma unroll
    for (int ks = 0; ks < 2; ++ks) {
        const bf16x8 a = *(const bf16x8*)(A + r * ld + ks * 32 + q * 8);
        const bf16x8 b = *(const bf16x8*)(Bt + r * ld + ks * 32 + q * 8);
        acc = __builtin_amdgcn_mfma_f32_16x16x32_bf16(a, b, acc, 0, 0, 0);
    }
    return acc;
}

DI void phase_prep(const Params& p, unsigned char* lds) {
    const int tid = ltid();
    float* LB = (float*)(p.ws + WS_LB);
    for (int i = lbid() * 512 + tid; i < 2 * 384; i += lgdim() * 512) {
        const int d = i / 384, c = i % 384;
        float lg[4], mx = -1e30f;
#pragma unroll
        for (int l = 0; l < 4; ++l) { lg[l] = p.in[I_LBL][(d * 4 + l) * 384 + c]; mx = fmaxf(mx, lg[l]); }
        float s = 0.f;
#pragma unroll
        for (int l = 0; l < 4; ++l) { lg[l] = expf(lg[l] - mx); s += lg[l]; }
        float cum = 0.f;
#pragma unroll
        for (int l = 0; l < 4; ++l) { if (l > 0) cum += lg[l] / s; LB[(d * 4 + l) * 384 + c] = cum; }
    }
    float* PAR = (float*)(p.ws + WS_PAR);
    float* KTAB = (float*)((unsigned char*)p.out + DO_KTAB);
    float* BBAR = (float*)((unsigned char*)p.out + DO_BBAR);
    float* sAR = (float*)lds;
    float* sAI = sAR + 64;
    float* sBB = sAI + 64;
    float* sC  = sBB + 2048;
    float* sW  = sC + 2048;
    float* sW2 = sW;
    for (int item2 = lbid(); item2 < 4 * 16 * 2 * 2; item2 += lgdim()) {
        const int item = item2 >> 1, half = item2 & 1;
        const int l = item / 32, g = (item / 2) % 16, d = item % 2;
        const int base = ((l * 2 + d) * 16 + g);
        const float dt = expf(p.in[I_LDT][base]);
        __syncthreads();
        if (tid < 64) {
            const float lr = p.in[I_ARE][base * 64 + tid], li = p.in[I_AIM][base * 64 + tid];
            const float ar = lr * dt, ai = li * dt;
            sAR[tid] = ar; sAI[tid] = ai;
            if (half == 0) { PAR[(base * 64 + tid) * 2 + 0] = ar; PAR[(base * 64 + tid) * 2 + 1] = ai; }
        }
        __syncthreads();
        for (int e = tid; e < 1024; e += 512) {
            const int pp = e >> 4, h = e & 15;
            const float ar = sAR[pp], ai = sAI[pp];
            const float lr = p.in[I_ARE][base * 64 + pp], li = p.in[I_AIM][base * 64 + pp];
            float sn, cs; sincosf(ai, &sn, &cs);
            const float em1 = expm1f(ar), ex = em1 + 1.0f;
            const float sh = sinf(0.5f * ai);
            const float x = em1 * cs - 2.0f * sh * sh, y = ex * sn;
            const float den = lr * lr + li * li;
            const float cr = (x * lr + y * li) / den, ci = (y * lr - x * li) / den;
            const float br = p.in[I_BRE][(size_t)(base * 64 + pp) * 16 + h], bi = p.in[I_BIM][(size_t)(base * 64 + pp) * 16 + h];
            const float rr = cr * br - ci * bi, ri = cr * bi + ci * br;
            sBB[e * 2] = rr; sBB[e * 2 + 1] = ri;
            if (half == 0) { BBAR[((size_t)(base * 64 + pp) * 16 + h) * 2] = rr; BBAR[((size_t)(base * 64 + pp) * 16 + h) * 2 + 1] = ri; }
        }
        for (int e = tid; e < 1024; e += 512) {
            sC[e * 2] = p.in[I_CRE][(size_t)base * 1024 + e]; sC[e * 2 + 1] = p.in[I_CIM][(size_t)base * 1024 + e];
        }
        __syncthreads();
_Pragma("nounroll")
        for (int tp = 0; tp < 8; ++tp) {
            if (tid < 128) { const int w = tid >> 6, pp = tid & 63; const float tau = (float)(half * 16 + tp * 2 + w);
                const float mg = expf(tau * sAR[pp]); float sn, cs; sincosf(tau * sAI[pp], &sn, &cs); sW2[(w * 64 + pp) * 2] = mg * cs; sW2[(w * 64 + pp) * 2 + 1] = mg * sn; }
            __syncthreads();
            {
                const int w = tid >> 8, o = tid & 255, hp = o >> 4, h = o & 15;
                float sacc = 0.f;
_Pragma("unroll 4")
                for (int pp = 0; pp < 64; ++pp) {
                    const float wr_ = sW2[(w * 64 + pp) * 2], wi_ = sW2[(w * 64 + pp) * 2 + 1];
                    const float br = sBB[(pp * 16 + h) * 2], bi = sBB[(pp * 16 + h) * 2 + 1];
                    const float tr = wr_ * br - wi_ * bi, ti = wr_ * bi + wi_ * br;
                    const float cr = sC[(hp * 64 + pp) * 2], ci = sC[(hp * 64 + pp) * 2 + 1];
                    sacc += cr * tr - ci * ti;
                }
                KTAB[((size_t)((l * 16 + g) * 2 + d) * 32 + (half * 16 + tp * 2 + w)) * 256 + o] = sacc;
            }
            __syncthreads();
        }
    }
}

DI const float* build_src(const Params& p, int R) {
    int seq, pos; row_info(R, seq, pos);
    const int t = pos - PADR;
    if (t < 0) return nullptr;
    if (t < 16) return p.in[I_META] + (size_t)t * D;
    return (seq < 4) ? p.in[I_XP] + ((size_t)seq * 4096 + (t - 16)) * D : p.in[I_XS] + ((size_t)(seq - 4) * 2048 + (t - 16)) * D;
}
DI void build_rows(const Params& p) {
    const int tid = ltid(); const int lane = tid & 63, wave = tid >> 6;
    bf16_t* H = (bf16_t*)(p.ws + WS_H); float* RSS = (float*)(p.ws + WS_RSS);
    const int stride = lgdim() * 8;
    int R = lbid() * 8 + wave;
    if (R >= MP) return;
    const f32x4 zf = (f32x4){0.f, 0.f, 0.f, 0.f};
    f32x4 nx[4];
    { const float* src = build_src(p, R);
#pragma unroll
      for (int i = 0; i < 4; ++i) nx[i] = src ? __builtin_nontemporal_load((const f32x4*)(src + (lane + 64 * i) * 4)) : zf; }
    while (R < MP) {
        f32x4 v[4];
#pragma unroll
        for (int i = 0; i < 4; ++i) v[i] = nx[i];
        const int Rn = R + stride;
        if (Rn < MP) { const float* src = build_src(p, Rn);
#pragma unroll
            for (int i = 0; i < 4; ++i) nx[i] = src ? __builtin_nontemporal_load((const f32x4*)(src + (lane + 64 * i) * 4)) : zf; }
        float ss = 0.f;
#pragma unroll
        for (int i = 0; i < 4; ++i) {
            u32x2 w; w.x = pack2(v[i][0], v[i][1]); w.y = pack2(v[i][2], v[i][3]); *(u32x2*)(H + (size_t)R * D + (lane + 64 * i) * 4) = w;
            ss += (v[i][0] * v[i][0] + v[i][1] * v[i][1]) + (v[i][2] * v[i][2] + v[i][3] * v[i][3]); }
#pragma unroll
        for (int o = 1; o < 64; o <<= 1) ss += __shfl_xor(ss, o);
        if (lane < 16) RSS[(size_t)R * 16 + lane] = lane == 0 ? ss : 0.f;
        R = Rn;
    }
}

DI void tr_tile(const float* src, int lds_, bf16_t* dst, int ldd, float* tile, const float* kgain = nullptr) {
    const int tid = ltid();
    __syncthreads();
    { const int r = tid >> 4, c4 = (tid & 15) * 4;
#pragma unroll
      for (int rr = 0; rr < 64; rr += 32) { f32x4 v = __builtin_nontemporal_load((const f32x4*)(src + (size_t)(r + rr) * lds_ + c4)); if (kgain) v = v * kgain[r + rr]; float* tp = tile + (r + rr) * 65 + c4; tp[0] = v[0]; tp[1] = v[1]; tp[2] = v[2]; tp[3] = v[3]; } }
    __syncthreads();
    { const int n = tid >> 3, k8 = (tid & 7) * 8; float f[8];
#pragma unroll
      for (int i = 0; i < 8; ++i) f[i] = tile[(k8 + i) * 65 + n];
      *(u32x4*)(dst + (size_t)n * ldd + k8) = pack8(f); }
}

enum { CV_UP = 1, CV_DN = 2, CV_IN = 4, CV_OUT = 8, CV_SMALL = 16 };
DI void convert_weights(const Params& p, int l, int what, int widx, int nw, unsigned char* lds) {
    float* tile = (float*)lds;
    bf16_t* WIN = (bf16_t*)(p.ws + WS_WIN); bf16_t* WOUT = (bf16_t*)(p.ws + WS_WOUT); bf16_t* WUP = (bf16_t*)(p.ws + WS_WUP); bf16_t* WDN = (bf16_t*)(p.ws + WS_WDN);
    bf16_t* WG = (bf16_t*)(p.ws + WS_WG); bf16_t* GLU = (bf16_t*)(p.ws + WS_GLU);
    const int T_UP = (what & CV_UP) ? 16 * 64 : 0, T_DN = (what & CV_DN) ? 64 * 16 : 0, T_IN = (what & CV_IN) ? 16 * 46 : 0, T_OUT = (what & CV_OUT) ? 16 * 16 : 0, T_WG = (what & CV_SMALL) ? 24 : 0, T_GLU = (what & CV_SMALL) ? 16 : 0;
    for (int it = widx; it < T_UP + T_DN + T_IN + T_OUT + T_WG + T_GLU; it += nw) {
        int i = it;
        if (i < T_UP) { const int kt = i / 64, nt = i % 64;
            tr_tile(p.in[I_WUP] + (size_t)l * 1024 * 4096 + (size_t)kt * 64 * 4096 + nt * 64, 4096, WUP + (size_t)nt * 64 * 1024 + kt * 64, 1024, tile, p.in[I_NMLP] + (size_t)l * D + kt * 64); continue; }
        i -= T_UP;
        if (i < T_DN) { const int kt = i / 16, nt = i % 16;
            tr_tile(p.in[I_WDN] + (size_t)l * 4096 * 1024 + (size_t)kt * 64 * 1024 + nt * 64, 1024, WDN + (size_t)nt * 64 * 4096 + kt * 64, 4096, tile); continue; }
        i -= T_DN;
        if (i < T_IN) { const int kt = i / 46, nt = i % 46;
            const int n0 = nt * 64; const int nd = (n0 >= 2688) ? n0 - 2688 : n0 + 256;
            tr_tile(p.in[I_WIN] + (size_t)l * 1024 * 2944 + (size_t)kt * 64 * 2944 + n0, 2944, WIN + (size_t)nd * 1024 + kt * 64, 1024, tile, p.in[I_NMIX] + (size_t)l * D + kt * 64); continue; }
        i -= T_IN;
        if (i < T_OUT) { const int kt = i / 16, nt = i % 16;
            tr_tile(p.in[I_WOUT] + (size_t)l * 1024 * 1024 + (size_t)kt * 64 * 1024 + nt * 64, 1024, WOUT + (size_t)nt * 64 * 1024 + kt * 64, 1024, tile); continue; }
        i -= T_OUT;
        if (i < T_WG) { const int n = i / 4, gi = i % 4, d = gi >> 1;
            const float* src = ((gi & 1) ? p.in[I_WI] : p.in[I_WR]) + ((size_t)((l * 2 + d) * 6 + n)) * 4096;
            tr_tile(src, 64, WG + (size_t)(n * 256 + gi * 64) * 64, 64, tile); continue; }
        i -= T_WG;
        { const int kt = i / 4, nt = i % 4;
          tr_tile(p.in[I_GLUW] + (size_t)l * 65536 + (size_t)kt * 64 * 256 + nt * 64, 256, GLU + (size_t)nt * 64 * 256 + kt * 64, 256, tile); }
    }
    if (what & CV_IN)
        for (size_t e = (size_t)widx * 512 + ltid(); e < (size_t)128 * 1024 / 8; e += (size_t)nw * 512) *(u32x4*)(WIN + (size_t)2944 * 1024 + e * 8) = (u32x4){0u, 0u, 0u, 0u};
}

DI void build_s5_mats(const Params& p, int l, int widx, int nw) {
    const float* KTAB = (const float*)((const unsigned char*)p.out + DO_KTAB);
    const float* BBAR = (const float*)((const unsigned char*)p.out + DO_BBAR);
    const float* PAR = (const float*)(p.ws + WS_PAR);
    bf16_t* T2 = (bf16_t*)(p.ws + WS_T2); bf16_t* M1 = (bf16_t*)(p.ws + WS_M1);
    const size_t nT2 = (size_t)16 * 512 * 96, nM1 = (size_t)16 * 256 * 64;
    for (size_t e = (size_t)widx * 512 + ltid(); e < nT2 + nM1; e += (size_t)nw * 512) {
        float f[8];
        if (e < nT2) {
            const int g = (int)(e / (512 * 96)), rem = (int)(e % (512 * 96)), n = rem / 96, k0 = (rem % 96) * 8;
            const int t = n >> 4, hp = n & 15;
            if (k0 < 512) {
                const int s = k0 >> 4, h0 = k0 & 15;
#pragma unroll
                for (int j = 0; j < 8; ++j) {
                    float v = 0.f;
                    if (s <= t) v += KTAB[((size_t)((l * 16 + g) * 2 + 0) * 32 + (t - s)) * 256 + hp * 16 + h0 + j];
                    if (s >= t) v += KTAB[((size_t)((l * 16 + g) * 2 + 1) * 32 + (s - t)) * 256 + hp * 16 + h0 + j];
                    f[j] = v;
                }
            } else {
                const int kk = k0 - 512, d = kk >> 7, part = (kk >> 6) & 1, p0 = kk & 63;
                const int base = (l * 2 + d) * 16 + g;
                const float pw = d == 0 ? (float)(t + 1) : (float)(32 - t);
#pragma unroll
                for (int j = 0; j < 8; ++j) {
                    const int pp = p0 + j;
                    const float ar = PAR[(base * 64 + pp) * 2], ai = PAR[(base * 64 + pp) * 2 + 1];
                    const float mg = expf(pw * ar); float sn, cs; sincosf(pw * ai, &sn, &cs);
                    const float wr_ = mg * cs, wi_ = mg * sn;
                    const float cr = p.in[I_CRE][(size_t)base * 1024 + hp * 64 + pp], ci = p.in[I_CIM][(size_t)base * 1024 + hp * 64 + pp];
                    f[j] = part == 0 ? (cr * wr_ - ci * wi_) : -(cr * wi_ + ci * wr_);
                }
            }
            *(u32x4*)(T2 + ((size_t)(g * 512 + n) * 768 + k0)) = pack8(f);
        } else {
            const size_t e2 = e - nT2;
            const int g = (int)(e2 / (256 * 64)), rem = (int)(e2 % (256 * 64)), n = rem / 64, k0 = (rem % 64) * 8;
            const int d = n >> 7, part = (n >> 6) & 1, pp = n & 63;
            const int s = k0 >> 4, h0 = k0 & 15;
            const int base = (l * 2 + d) * 16 + g;
            const float pw = d == 0 ? (float)(31 - s) : (float)s;
            const float ar = PAR[(base * 64 + pp) * 2], ai = PAR[(base * 64 + pp) * 2 + 1];
            const float mg = expf(pw * ar); float sn, cs; sincosf(pw * ai, &sn, &cs);
            const float wr_ = mg * cs, wi_ = mg * sn;
#pragma unroll
            for (int j = 0; j < 8; ++j) {
                const float br = BBAR[((size_t)(base * 64 + pp) * 16 + h0 + j) * 2], bi = BBAR[((size_t)(base * 64 + pp) * 16 + h0 + j) * 2 + 1];
                f[j] = part == 0 ? (wr_ * br - wi_ * bi) : (wr_ * bi + wi_ * br);
            }
            *(u32x4*)(M1 + ((size_t)(g * 256 + n) * 512 + k0)) = pack8(f);
        }
    }
}

constexpr int PB_OFF = 126976;
constexpr int PB_CW = 0, PB_CB = 1536, PB_BR = 1920, PB_BI = 2688, PB_SP = 3456, PB_LB = 4224;
DI void stage_params(const Params& p, int l, unsigned char* lds) {
    float* PB = (float*)(lds + PB_OFF); const int tid = ltid();
    const float* LB = (const float*)(p.ws + WS_LB);
    for (int i = tid; i < 1536; i += 512) PB[PB_CW + i] = p.in[I_CONVW][(size_t)l * 1536 + i];
    if (tid < 384) PB[PB_CB + tid] = p.in[I_CONVB][(size_t)l * 384 + tid];
    for (int i = tid; i < 768; i += 512) {
        PB[PB_BR + i] = p.in[I_BR][(size_t)l * 768 + i]; PB[PB_BI + i] = p.in[I_BI][(size_t)l * 768 + i];
        PB[PB_SP + i] = log1pf(__expf(-p.in[I_LAM][(size_t)l * 768 + i]));
        const int d = i / 384, c = i % 384; PB[PB_LB + i] = LB[(d * 4 + l) * 384 + c];
    }
}

struct RgPre { u32x4 xa0, xa1, ga, wg[4]; float cin; };
DI RgPre rg_load(const Params& p, int item, bool fin) {
    const int tid = ltid();
    const int j = item / 6, n = item % 6;
    const int row0 = j * 64, pos0 = chunk64_pos0(j), L = chunk64_len(j);
    const bf16_t* PROJ = (const bf16_t*)(p.ws + WS_PROJ); const bf16_t* WG = (const bf16_t*)(p.ws + WS_WG);
    const float* RGC = (const float*)((const unsigned char*)p.out + DO_RGC);
    RgPre r; const u32x4 z = (u32x4){0u, 0u, 0u, 0u};
    const int c8 = (tid & 7) * 8;
    { const int rr = tid >> 3, pos = pos0 + rr - 2; r.xa0 = (pos >= PADR && pos < L) ? __builtin_nontemporal_load((const u32x4*)(PROJ + (size_t)(row0 + rr - 2) * PLD + OFF_AX + n * 64 + c8)) : z; }
    r.xa1 = z;
    if (tid < 24) { const int rr = 64 + (tid >> 3), pos = pos0 + rr - 2; if (pos >= PADR && pos < L) r.xa1 = __builtin_nontemporal_load((const u32x4*)(PROJ + (size_t)(row0 + rr - 2) * PLD + OFF_AX + n * 64 + c8)); }
    r.ga = fin ? __builtin_nontemporal_load((const u32x4*)(PROJ + (size_t)(row0 + (tid >> 3)) * PLD + OFF_AG + n * 64 + c8)) : z;
#pragma unroll
    for (int q = 0; q < 4; ++q) { const int idx = tid + 512 * q; r.wg[q] = *(const u32x4*)(WG + (size_t)(n * 256 + (idx >> 3)) * 64 + (idx & 7) * 8); }
    r.cin = 0.f;
    if (fin) { const int sc = tid & 127, c = sc & 63, d = sc >> 6; r.cin = RGC[((size_t)(j * 2 + d) * 384 + n * 64 + c) * 2 + 1]; }
    return r;
}
DI void rg_compute(const Params& p, int item, bool fin, const RgPre& pre, unsigned char* lds) {
    const int tid = ltid(), lane = tid & 63, wave = tid >> 6;
    const int j = item / 6, n = item % 6;
    const int row0 = j * 64, pos0 = chunk64_pos0(j);
    float* XCF = (float*)lds;
    float* AB = (float*)(lds + 16384);
    bf16_t* WGs = (bf16_t*)(lds + 16384);
    bf16_t* XCB = (bf16_t*)(lds + 16384 + 36864);
    bf16_t* XA = (bf16_t*)(lds + 16384 + 36864 + 9216);
    bf16_t* GA = (bf16_t*)(lds + 16384 + 65536);
    float* SEG = (float*)(lds + 16384 + 65536 + 8192);
    const float* PB = (const float*)(lds + PB_OFF);
    __syncthreads();
    { const int c8 = (tid & 7) * 8;
      *(u32x4*)(XA + (tid >> 3) * 64 + c8) = pre.xa0;
      if (tid < 24) *(u32x4*)(XA + (64 + (tid >> 3)) * 64 + c8) = pre.xa1;
#pragma unroll
      for (int q = 0; q < 4; ++q) { const int idx = tid + 512 * q; *(u32x4*)(WGs + (idx >> 3) * 72 + (idx & 7) * 8) = pre.wg[q]; }
    }
    __syncthreads();
    { const int t = tid >> 3, c8 = (tid & 7) * 8;
      const float* cw = PB + PB_CW + n * 64 + c8; const float* cb = PB + PB_CB + n * 64 + c8;
      float xc[8];
#pragma unroll
      for (int i = 0; i < 8; ++i) xc[i] = cb[i];
#pragma unroll
      for (int jj = 0; jj < 4; ++jj) { float xr[8]; unpack8(*(const u32x4*)(XA + (t + jj) * 64 + c8), xr);
#pragma unroll
          for (int i = 0; i < 8; ++i) xc[i] += cw[jj * 384 + i] * xr[i]; }
      *(f32x4*)(XCF + t * 64 + c8) = (f32x4){xc[0], xc[1], xc[2], xc[3]}; *(f32x4*)(XCF + t * 64 + c8 + 4) = (f32x4){xc[4], xc[5], xc[6], xc[7]};
      *(u32x4*)(XCB + t * 72 + c8) = pack8(xc); }
    __syncthreads();
    const int rb = wave & 3, dir = wave >> 2;
    f32x4 acc[8];
#pragma unroll
    for (int c = 0; c < 8; ++c) acc[c] = mma_tile64(XCB + rb * 16 * 72, WGs + (dir * 8 + c) * 16 * 72, 72, lane, (f32x4){0.f, 0.f, 0.f, 0.f});
    __syncthreads();
    { const int cl = lane & 15, q = lane >> 4;
#pragma unroll
      for (int cc = 0; cc < 4; ++cc) {
          const int c = cc * 16 + cl, ch = n * 64 + c;
          const float brv = PB[PB_BR + dir * 384 + ch], biv = PB[PB_BI + dir * 384 + ch], sp = PB[PB_SP + dir * 384 + ch];
#pragma unroll
          for (int jj = 0; jj < 4; ++jj) {
              const int t = rb * 16 + q * 4 + jj;
              const float r = sigmoidf_(acc[cc][jj] + brv), ig = sigmoidf_(acc[cc + 4][jj] + biv);
              const float la = -8.0f * r * sp;
              float a = __expf(la);
              const float om = __builtin_fmaf(-a, a, 1.0f);
              float b = __builtin_amdgcn_sqrtf(fmaxf(om, 0.f)) * ig * XCF[t * 64 + c];
              if (pos0 + t < PADR) { a = 1.0f; b = 0.f; }
              AB[(dir * 2) * 4096 + t * 64 + c] = a; AB[(dir * 2 + 1) * 4096 + t * 64 + c] = b;
          } } }
    __syncthreads();
    float* RGC = (float*)((unsigned char*)p.out + DO_RGC);
    const int sc = tid & 127, seg = tid >> 7, sch = sc & 63, sd = sc >> 6;
    const float* Aa = AB + (sd * 2) * 4096 + sch; float* Bb = AB + (sd * 2 + 1) * 4096 + sch;
    { float P = 1.f, E = 0.f;
#pragma unroll
      for (int u = 0; u < 16; ++u) { const int uu = seg * 16 + u, t = sd == 0 ? uu : 63 - uu; const float a = Aa[t * 64]; E = a * E + Bb[t * 64]; P *= a; }
      SEG[(sc * 4 + seg) * 2] = P; SEG[(sc * 4 + seg) * 2 + 1] = E; }
    __syncthreads();
    if (!fin) {
        if (tid < 128) { float Pt = 1.f, Et = 0.f;
#pragma unroll
            for (int q = 0; q < 4; ++q) { const float Ps = SEG[(tid * 4 + q) * 2], Es = SEG[(tid * 4 + q) * 2 + 1]; Et = Ps * Et + Es; Pt *= Ps; }
            float* cp = RGC + ((size_t)(j * 2 + sd) * 384 + n * 64 + sch) * 2; cp[0] = Pt; cp[1] = Et; }
        return;
    }
    { float h = pre.cin;
      for (int q = 0; q < seg; ++q) h = SEG[(sc * 4 + q) * 2] * h + SEG[(sc * 4 + q) * 2 + 1];
#pragma unroll
      for (int u = 0; u < 16; ++u) { const int uu = seg * 16 + u, t = sd == 0 ? uu : 63 - uu; h = Aa[t * 64] * h + Bb[t * 64]; Bb[t * 64] = h; } }
    __syncthreads();
    { const int t = tid >> 3, c8 = (tid & 7) * 8;
      bf16_t* YM = (bf16_t*)(p.ws + WS_ACT); float* SS = (float*)(p.ws + WS_SS);
      const bool valid = pos0 + t >= PADR;
      float y[8], ss = 0.f;
      float gg[8]; unpack8(pre.ga, gg);
      const f32x4 h0a = *(const f32x4*)(AB + 1 * 4096 + t * 64 + c8), h0b = *(const f32x4*)(AB + 1 * 4096 + t * 64 + c8 + 4), h1a = *(const f32x4*)(AB + 3 * 4096 + t * 64 + c8), h1b = *(const f32x4*)(AB + 3 * 4096 + t * 64 + c8 + 4);
#pragma unroll
      for (int i = 0; i < 8; ++i) { const float hs = i < 4 ? h0a[i & 3] + h1a[i & 3] : h0b[i & 3] + h1b[i & 3];
          const float o = valid ? hs * gelu_tanh(gg[i]) : 0.f; y[i] = o; ss += o * o; }
      *(u32x4*)(YM + (size_t)(row0 + t) * D + n * 64 + c8) = pack8(y);
      ss += __shfl_xor(ss, 1); ss += __shfl_xor(ss, 2); ss += __shfl_xor(ss, 4);
      if ((tid & 7) == 0) SS[(size_t)(row0 + t) * 16 + n] = ss; }
}

struct HgPre { u32x4 xi, xff, xfb, xq, xg, s0, s1; };
DI HgPre hg_load(const Params& p, int item, bool fin) {
    const int tid = ltid();
    const int j = item / 6, n = item % 6, row0 = j * 64;
    const int t = tid >> 3, k8 = (tid & 7) * 8;
    const bf16_t* rowp = (const bf16_t*)(p.ws + WS_PROJ) + (size_t)(row0 + t) * PLD + n * 64 + k8;
    const bf16_t* HGS = (const bf16_t*)((const unsigned char*)p.out + DO_HGS);
    HgPre r; const u32x4 z = (u32x4){0u, 0u, 0u, 0u};
    r.xi = __builtin_nontemporal_load((const u32x4*)(rowp + OFF_BI)); r.xff = __builtin_nontemporal_load((const u32x4*)(rowp + OFF_BFF)); r.xfb = __builtin_nontemporal_load((const u32x4*)(rowp + OFF_BFB));
    r.xq = z; r.xg = z; r.s0 = z; r.s1 = z;
    if (fin) {
        r.xq = __builtin_nontemporal_load((const u32x4*)(rowp + OFF_BQ)); r.xg = __builtin_nontemporal_load((const u32x4*)(rowp + OFF_BG));
        const bf16_t* s0 = HGS + ((size_t)(j * 6 + n) * 2 + 0) * 4096 + t * 64 + k8;
        r.s0 = __builtin_nontemporal_load((const u32x4*)s0); r.s1 = __builtin_nontemporal_load((const u32x4*)(s0 + 4096));
    }
    return r;
}
DI void hg_compute(const Params& p, int item, bool fin, const HgPre& pre, unsigned char* lds) {
    const int tid = ltid(), lane = tid & 63, wave = tid >> 6;
    const int j = item / 6, n = item % 6;
    const int row0 = j * 64, pos0 = chunk64_pos0(j);
    float* LF = (float*)lds;
    bf16_t* QT = (bf16_t*)(lds + 32768);
    bf16_t* KT = (bf16_t*)(lds + 51200);
    bf16_t* VT = (bf16_t*)(lds + 69632);
    bf16_t* SC = (bf16_t*)(lds + 78848);
    bf16_t* SP = (bf16_t*)(lds + 97280);
    bf16_t* XG = (bf16_t*)(lds + 115712);
    float* SEGT = (float*)(lds + 123904);
    float* OX = (float*)lds;
    const float* PB = (const float*)(lds + PB_OFF);
    bf16_t* HGS = (bf16_t*)((unsigned char*)p.out + DO_HGS);
    float* HGD = (float*)(p.ws + WS_HGD);
    const int t = tid >> 3, k8 = (tid & 7) * 8;
    const bool masked = pos0 + t < PADR;
    __syncthreads();
    float kk[2][8], q[8];
    {
        float xf[8], xv[8];
        unpack8(pre.xi, xv);
#pragma unroll
        for (int i = 0; i < 8; ++i) VT[(k8 + i) * 72 + t] = f2bf(masked ? 0.f : xv[i]);
#pragma unroll
        for (int d = 0; d < 2; ++d) {
            unpack8(d == 0 ? pre.xff : pre.xfb, xf);
#pragma unroll
            for (int i = 0; i < 8; ++i) {
                const float lb = PB[PB_LB + d * 384 + n * 64 + k8 + i];
                const float sg = sigmoidf_(xf[i]);
                const float f = lb + (1.0f - lb) * sg;
                kk[d][i] = masked ? 0.f : (1.0f - lb) * (1.0f - sg);
                LF[d * 4096 + t * 64 + k8 + i] = masked ? 0.f : __logf(f);
            }
        }
#pragma unroll
        for (int i = 0; i < 8; ++i) q[i] = 0.f;
        if (fin) { unpack8(pre.xq, q);
#pragma unroll
            for (int i = 0; i < 8; ++i) q[i] = siluf_(q[i]);
            *(u32x4*)(XG + t * 64 + k8) = pre.xg; }
    }
    __syncthreads();
    { const int sc = tid & 127, seg = tid >> 7, k = sc & 63, d = sc >> 6; float run = 0.f; float* lf = LF + d * 4096 + k;
#pragma unroll
      for (int u = 0; u < 16; ++u) { const int uu = seg * 16 + u, s_ = d == 0 ? uu : 63 - uu; run += lf[s_ * 64]; lf[s_ * 64] = run; }
      SEGT[sc * 4 + seg] = run;
      __syncthreads();
      float off = 0.f;
      for (int q2 = 0; q2 < seg; ++q2) off += SEGT[sc * 4 + q2];
      if (seg > 0) {
#pragma unroll
          for (int u = 0; u < 16; ++u) { const int uu = seg * 16 + u, s_ = d == 0 ? uu : 63 - uu; lf[s_ * 64] += off; } } }
    __syncthreads();
    const int rb = wave & 3, dir = wave >> 2, cl = lane & 15, qd = lane >> 4;
    if (!fin) {
#pragma unroll
        for (int d = 0; d < 2; ++d)
#pragma unroll
            for (int i = 0; i < 8; ++i) {
                const int k = k8 + i; const float tot = d == 0 ? LF[63 * 64 + k] : LF[4096 + k];
                KT[d * 4608 + k * 72 + t] = f2bf(kk[d][i] * __expf(tot - LF[d * 4096 + t * 64 + k]));
                if (t == 0) HGD[((size_t)(j * 6 + n) * 2 + d) * 64 + k] = __expf(tot);
            }
        __syncthreads();
#pragma unroll
        for (int kb = 0; kb < 4; ++kb) {
            const f32x4 a = mma_tile64(VT + rb * 16 * 72, KT + dir * 4608 + kb * 16 * 72, 72, lane, (f32x4){0.f, 0.f, 0.f, 0.f});
            bf16_t* dst = HGS + ((size_t)(j * 6 + n) * 2 + dir) * 4096;
#pragma unroll
            for (int jj = 0; jj < 4; ++jj) dst[(rb * 16 + qd * 4 + jj) * 64 + kb * 16 + cl] = f2bf(a[jj]);
        }
        return;
    }
#pragma unroll
    for (int d = 0; d < 2; ++d) {
        float qv[8], kv[8];
#pragma unroll
        for (int i = 0; i < 8; ++i) {
            const int k = k8 + i; const float m = LF[d * 4096 + 32 * 64 + k];
            const float e1 = fminf(fmaxf(LF[d * 4096 + t * 64 + k] - m, -80.f), 80.f);
            const float ex = __expf(e1); qv[i] = q[i] * ex; kv[i] = kk[d][i] * __builtin_amdgcn_rcpf(ex);
        }
        *(u32x4*)(QT + d * 4608 + t * 72 + k8) = pack8(qv);
        *(u32x4*)(KT + d * 4608 + t * 72 + k8) = pack8(kv);
        float sv[8]; unpack8(d == 0 ? pre.s0 : pre.s1, sv);
#pragma unroll
        for (int i = 0; i < 8; ++i) sv[i] *= __expf(LF[d * 4096 + 32 * 64 + k8 + i]);
        *(u32x4*)(SP + d * 4608 + t * 72 + k8) = pack8(sv);
    }
    __syncthreads();
#pragma unroll
    for (int ct = 0; ct < 4; ++ct) {
        const f32x4 a = mma_tile64(QT + dir * 4608 + rb * 16 * 72, KT + dir * 4608 + ct * 16 * 72, 72, lane, (f32x4){0.f, 0.f, 0.f, 0.f});
#pragma unroll
        for (int jj = 0; jj < 4; ++jj) {
            const int tt = rb * 16 + qd * 4 + jj, s_ = ct * 16 + cl;
            const bool keep = dir == 0 ? (s_ <= tt) : (s_ >= tt);
            SC[dir * 4608 + tt * 72 + s_] = f2bf(keep ? a[jj] : 0.f);
        }
    }
    __syncthreads();
    f32x4 o[4];
#pragma unroll
    for (int vt = 0; vt < 4; ++vt) {
        f32x4 a = mma_tile64(SC + dir * 4608 + rb * 16 * 72, VT + vt * 16 * 72, 72, lane, (f32x4){0.f, 0.f, 0.f, 0.f});
        o[vt] = mma_tile64(QT + dir * 4608 + rb * 16 * 72, SP + dir * 4608 + vt * 16 * 72, 72, lane, a);
    }
#pragma unroll
    for (int vt = 0; vt < 4; ++vt)
#pragma unroll
        for (int jh = 0; jh < 2; ++jh) { const int jj = dir == 0 ? 2 + jh : jh; const float val = dir == 0 ? o[vt][2 + jh] : o[vt][jh];
            OX[(rb * 16 + qd * 4 + jj) * 64 + vt * 16 + cl] = val; }
    __syncthreads();
    {
        bf16_t* YM = (bf16_t*)(p.ws + WS_ACT); float* SS = (float*)(p.ws + WS_SS);
#pragma unroll
        for (int jh = 0; jh < 2; ++jh) {
            const int jj = dir * 2 + jh;
            const int tt = rb * 16 + qd * 4 + jj;
            float ov[4], sq = 0.f;
#pragma unroll
            for (int vt = 0; vt < 4; ++vt) { const float own = dir == 0 ? o[vt][jh] : o[vt][2 + jh]; ov[vt] = own + OX[tt * 64 + vt * 16 + cl]; sq += ov[vt] * ov[vt]; }
            sq += __shfl_xor(sq, 1); sq += __shfl_xor(sq, 2); sq += __shfl_xor(sq, 4); sq += __shfl_xor(sq, 8);
            const float rn = rsqrtf(sq * (1.0f / 64.0f) + EPS);
            const bool valid = pos0 + tt >= PADR;
            float s2 = 0.f;
#pragma unroll
            for (int vt = 0; vt < 4; ++vt) {
                const int v = vt * 16 + cl;
                const float y = valid ? ov[vt] * rn * siluf_(bf2f(XG[tt * 64 + v])) : 0.f;
                s2 += y * y;
                YM[(size_t)(row0 + tt) * D + 384 + n * 64 + v] = f2bf(y);
            }
            s2 += __shfl_xor(s2, 1); s2 += __shfl_xor(s2, 2); s2 += __shfl_xor(s2, 4); s2 += __shfl_xor(s2, 8);
            if (cl == 0) SS[(size_t)(row0 + tt) * 16 + 6 + n] = s2;
        }
    }
}

constexpr int CG = 33;
DI void phase_carries(const Params& p, int l) {
    bf16_t* HGS = (bf16_t*)((unsigned char*)p.out + DO_HGS);
    const float* HGD = (const float*)(p.ws + WS_HGD);
    float* RGC = (float*)((unsigned char*)p.out + DO_RGC);
    const float* S5E = (const float*)((const unsigned char*)p.out + DO_S5E);
    bf16_t* U2 = (bf16_t*)(p.ws + WS_U2);
    const float* PAR = (const float*)(p.ws + WS_PAR);
    const int N_HG = 12 * 6 * 2 * 2048, N_RG = 12 * 2 * 384, N_S5 = 12 * 16 * 2 * 64;
    for (int idx = lbid() * 512 + ltid(); idx < N_HG + N_RG + N_S5; idx += lgdim() * 512) {
        if (idx < N_HG) {
            const int seq = idx / 24576, rem = idx % 24576, n = rem / 4096, d = (rem >> 11) & 1, e2 = rem & 2047, k = (e2 * 2) & 63;
            int c0, nc; seq_chunks64(seq, c0, nc);
            unsigned* HG32 = (unsigned*)HGS;
            float S0 = 0.f, S1 = 0.f;
            for (int i0 = 0; i0 < nc; i0 += CG) {
                unsigned loc[CG]; float dec0[CG], dec1[CG];
#pragma unroll
                for (int u = 0; u < CG; ++u) { const int i = i0 + u; if (i < nc) { const int jc = d == 0 ? c0 + i : c0 + nc - 1 - i; const size_t b = (size_t)(jc * 6 + n) * 2 + d; loc[u] = __builtin_nontemporal_load(HG32 + b * 2048 + e2); dec0[u] = HGD[b * 64 + k]; dec1[u] = HGD[b * 64 + k + 1]; } else { loc[u] = 0u; dec0[u] = 0.f; dec1[u] = 0.f; } }
#pragma unroll
                for (int u = 0; u < CG; ++u) { const int i = i0 + u; if (i < nc) { const int jc = d == 0 ? c0 + i : c0 + nc - 1 - i; const size_t b = (size_t)(jc * 6 + n) * 2 + d; HG32[b * 2048 + e2] = pack2(S0, S1); S0 = dec0[u] * S0 + bflo(loc[u]); S1 = dec1[u] * S1 + bfhi(loc[u]); } }
            }
        } else if (idx < N_HG + N_RG) {
            const int i2 = idx - N_HG; const int seq = i2 / 768, rem = i2 % 768, d = rem / 384, ch = rem % 384;
            int c0, nc; seq_chunks64(seq, c0, nc);
            float c = 0.f;
            for (int i0 = 0; i0 < nc; i0 += CG) {
                float P[CG], E[CG];
#pragma unroll
                for (int u = 0; u < CG; ++u) { const int i = i0 + u; if (i < nc) { const int jc = d == 0 ? c0 + i : c0 + nc - 1 - i; const float* cp = RGC + ((size_t)(jc * 2 + d) * 384 + ch) * 2; P[u] = cp[0]; E[u] = cp[1]; } else { P[u] = 0.f; E[u] = 0.f; } }
#pragma unroll
                for (int u = 0; u < CG; ++u) { const int i = i0 + u; if (i < nc) { const int jc = d == 0 ? c0 + i : c0 + nc - 1 - i; float* cp = RGC + ((size_t)(jc * 2 + d) * 384 + ch) * 2; cp[1] = c; c = P[u] * c + E[u]; } }
            }
        } else {
            const int i2 = idx - N_HG - N_RG; const int seq = i2 / 2048, g = (i2 >> 7) & 15, d = (i2 >> 6) & 1, pp = i2 & 63;
            int c0, nc; seq_chunks32(seq, c0, nc);
            const int base = (l * 2 + d) * 16 + g;
            const float ar = PAR[(base * 64 + pp) * 2], ai = PAR[(base * 64 + pp) * 2 + 1];
            const float mg = expf(32.0f * ar); float sn, cs; sincosf(32.0f * ai, &sn, &cs);
            const float wr_ = mg * cs, wi_ = mg * sn;
            float hr = 0.f, hi = 0.f;
            for (int i0 = 0; i0 < nc; i0 += CG) {
                float er[CG], ei[CG];
#pragma unroll
                for (int u = 0; u < CG; ++u) { const int i = i0 + u; if (i < nc) { const int c = d == 0 ? c0 + i : c0 + nc - 1 - i; const size_t ro = (size_t)(g * U2ROWS + c); er[u] = __builtin_nontemporal_load(S5E + ro * 256 + d * 128 + pp); ei[u] = __builtin_nontemporal_load(S5E + ro * 256 + d * 128 + 64 + pp); } else { er[u] = 0.f; ei[u] = 0.f; } }
#pragma unroll
                for (int u = 0; u < CG; ++u) { const int i = i0 + u; if (i < nc) { const int c = d == 0 ? c0 + i : c0 + nc - 1 - i; const size_t ro = (size_t)(g * U2ROWS + c);
                    U2[ro * U2LD + 512 + d * 128 + pp] = f2bf(hr); U2[ro * U2LD + 512 + d * 128 + 64 + pp] = f2bf(hi);
                    const float nr = wr_ * hr - wi_ * hi + er[u], ni = wr_ * hi + wi_ * hr + ei[u]; hr = nr; hi = ni; } }
            }
        }
    }
}

struct MnPre { u32x4 y; f32x4 s0, s1, s2, s3, g0, g1; };
DI MnPre mn_load(const bf16_t* YM, const float* SS, const float* gain, size_t e) {
    const int R = (int)(e >> 7), c0 = (int)(e & 127) * 8; const float* sp = SS + (size_t)R * 16;
    MnPre r; r.y = __builtin_nontemporal_load((const u32x4*)(YM + (size_t)R * D + c0));
    r.s0 = *(const f32x4*)sp; r.s1 = *(const f32x4*)(sp + 4); r.s2 = *(const f32x4*)(sp + 8); r.s3 = *(const f32x4*)(sp + 12);
    r.g0 = *(const f32x4*)(gain + c0); r.g1 = *(const f32x4*)(gain + c0 + 4);
    return r;
}
DI void phase_mixnorm(const Params& p, int l) {
    bf16_t* YM = (bf16_t*)(p.ws + WS_ACT); const float* SS = (const float*)(p.ws + WS_SS);
    const float* gain = p.in[I_MGAIN] + (size_t)l * D;
    const size_t N = (size_t)MP * 128, stride = (size_t)lgdim() * 512;
    size_t e = (size_t)lbid() * 512 + ltid();
    if (e >= N) return;
    MnPre nx = mn_load(YM, SS, gain, e);
    while (e < N) {
        const MnPre cur = nx; const size_t en = e + stride;
        if (en < N) nx = mn_load(YM, SS, gain, en);
        const int R = (int)(e >> 7), c0 = (int)(e & 127) * 8;
        const int br = c0 < 384 ? 0 : (c0 < 768 ? 1 : 2);
        const float inv = br == 2 ? (1.0f / 256.0f) : (1.0f / 384.0f);
        const f32x4 s0 = cur.s0, s1 = cur.s1, s2 = cur.s2, s3 = cur.s3;
        const float tot = br == 0 ? (((s0[0] + s0[1]) + (s0[2] + s0[3])) + (s1[0] + s1[1])) : (br == 1 ? (((s1[2] + s1[3]) + (s2[0] + s2[1])) + (s2[2] + s2[3])) : ((s3[0] + s3[1]) + (s3[2] + s3[3])));
        const float rn = rsqrtf(tot * inv + EPS);
        float f[8]; unpack8(cur.y, f);
#pragma unroll
        for (int i = 0; i < 4; ++i) { f[i] = f[i] * rn * cur.g0[i]; f[4 + i] = f[4 + i] * rn * cur.g1[i]; }
        *(u32x4*)(YM + (size_t)R * D + c0) = pack8(f);
        e = en;
    }
}

DI void phase_combine(const Params& p) {
    const int tid = ltid(); const int lane = tid & 63, wave = tid >> 6;
    bf16_t* H = (bf16_t*)(p.ws + WS_H); float* RSS = (float*)(p.ws + WS_RSS);
    const float* P = (const float*)((const unsigned char*)p.out + DO_PART);
    for (int rr = lbid() * 8 + wave; rr < 768; rr += lgdim() * 8) {
        const int R = 32768 + rr;
        float ss = 0.f;
        u32x2 ho[4]; f32x4 pp[4][4];
#pragma unroll
        for (int q = 0; q < 4; ++q) { const int col = lane * 16 + q * 4; ho[q] = *(const u32x2*)(H + (size_t)R * D + col);
#pragma unroll
            for (int ks = 0; ks < 4; ++ks) pp[q][ks] = *(const f32x4*)(P + ((size_t)ks * 768 + rr) * D + col); }
#pragma unroll
        for (int q = 0; q < 4; ++q) {
            const int col = lane * 16 + q * 4;
            f32x4 h = (f32x4){bflo(ho[q].x), bfhi(ho[q].x), bflo(ho[q].y), bfhi(ho[q].y)};
#pragma unroll
            for (int ks = 0; ks < 4; ++ks) h = h + pp[q][ks];
            u32x2 w; w.x = pack2(h[0], h[1]); w.y = pack2(h[2], h[3]); *(u32x2*)(H + (size_t)R * D + col) = w;
            ss += (h[0] * h[0] + h[1] * h[1]) + (h[2] * h[2] + h[3] * h[3]);
        }
        ss += __shfl_xor(ss, 1); ss += __shfl_xor(ss, 2);
        if ((lane & 3) == 0) RSS[(size_t)R * 16 + (lane >> 2)] = ss;
    }
}

DI int out_row_to_R(int O) { if (O < 16384) return (O >> 12) * LP + 64 + (O & 4095); const int o2 = O - 16384; return ROWS_P + (o2 >> 11) * LS + 64 + (o2 & 2047); }
DI void phase_final(const Params& p) {
    const int tid = ltid(); const int lane = tid & 63, wave = tid >> 6;
    const bf16_t* H = (const bf16_t*)(p.ws + WS_H); const float* gain = p.in[I_NFIN];
    f32x4 gg[4];
#pragma unroll
    for (int i = 0; i < 4; ++i) gg[i] = *(const f32x4*)(gain + (lane + 64 * i) * 4);
    const int stride = lgdim() * 8;
    int O = lbid() * 8 + wave;
    if (O >= 32768) return;
    u32x2 nx[4];
#pragma unroll
    for (int i = 0; i < 4; ++i) nx[i] = __builtin_nontemporal_load((const u32x2*)(H + (size_t)out_row_to_R(O) * D + (lane + 64 * i) * 4));
    while (O < 32768) {
        u32x2 cur[4];
#pragma unroll
        for (int i = 0; i < 4; ++i) cur[i] = nx[i];
        const int On = O + stride;
        if (On < 32768) {
#pragma unroll
            for (int i = 0; i < 4; ++i) nx[i] = __builtin_nontemporal_load((const u32x2*)(H + (size_t)out_row_to_R(On) * D + (lane + 64 * i) * 4));
        }
        f32x4 v[4]; float ss = 0.f;
#pragma unroll
        for (int i = 0; i < 4; ++i) { v[i] = (f32x4){bflo(cur[i].x), bfhi(cur[i].x), bflo(cur[i].y), bfhi(cur[i].y)}; ss += (v[i][0] * v[i][0] + v[i][1] * v[i][1]) + (v[i][2] * v[i][2] + v[i][3] * v[i][3]); }
#pragma unroll
        for (int o = 1; o < 64; o <<= 1) ss += __shfl_xor(ss, o);
        const float rn = rsqrtf(ss * (1.0f / D) + EPS);
        float* dst = p.out + (size_t)O * D;
#pragma unroll
        for (int i = 0; i < 4; ++i) __builtin_nontemporal_store(v[i] * rn * gg[i], (f32x4*)(dst + (lane + 64 * i) * 4));
        O = On;
    }
}

#define XB_TMO      128
#define XB_XCNT(j)  (256  + 64 * (j))
#define XB_XSUB(j)  (1280 + 64 * (j))
#define XB_XGEN(j)  (2304 + 64 * (j))
#define XB_TOP      3328
#define XB_TOPGEN   3392
#define XCD_BAR_WORDS 3456
#define XB_SPIN_CAP (1u << 18)
DI unsigned xb_ld(unsigned* p)              { return __hip_atomic_load(p, __ATOMIC_RELAXED, __HIP_MEMORY_SCOPE_AGENT); }
DI unsigned xb_add(unsigned* p, unsigned v) { return __hip_atomic_fetch_add(p, v, __ATOMIC_RELAXED, __HIP_MEMORY_SCOPE_AGENT); }
DI unsigned xb_xcc_id() { return (unsigned)__builtin_amdgcn_s_getreg((3 << 11) | 20) & 0xFu; }
#define XB_SPIN(cond, bar) do { unsigned _sp = 0; while (cond) { __builtin_amdgcn_s_sleep(1); \
    if ((++_sp & 255u) == 0u) { if (xb_ld(&(bar)[XB_TMO])) break; if (_sp > XB_SPIN_CAP) { atomicAdd(&(bar)[XB_TMO], 1u); break; } } } } while (0)
struct XcdBarrier { unsigned* bar; unsigned x; volatile LAS unsigned* st; };
DI XcdBarrier xcd_barrier_post(unsigned* bar, volatile LAS unsigned* st) {
    XcdBarrier b; b.bar = bar; b.x = xb_xcc_id(); b.st = st;
    if (threadIdx.x == 0) (void)xb_add(&bar[XB_XCNT(b.x)], 1u);
    return b;
}
DI void xcd_barrier_complete(unsigned* bar, unsigned x, unsigned& nloc, unsigned& nx) {
    const unsigned G = gridDim.x * gridDim.y * gridDim.z;
    unsigned sum, cnt, mine, sp = 0u;
    for (;;) {
        sum = 0u; cnt = 0u; mine = 0u;
#pragma unroll
        for (unsigned j = 0; j < 16; ++j) { const unsigned c = xb_ld(&bar[XB_XCNT(j)]); sum += c; cnt += (c > 0u) ? 1u : 0u; mine = (j == x) ? c : mine; }
        if (sum == G) break;
        __builtin_amdgcn_s_sleep(1);
        if ((++sp & 255u) == 0u) { if (xb_ld(&bar[XB_TMO])) break; if (sp > XB_SPIN_CAP) { atomicAdd(&bar[XB_TMO], 1u); break; } }
    }
    nloc = mine > 0u ? mine : 1u; nx = cnt > 0u ? cnt : 1u;
}
DI void xcd_barrier(const XcdBarrier& b) {
    asm volatile("s_waitcnt vmcnt(0)" ::: "memory");
    __syncthreads();
    if (threadIdx.x == 0) {
        unsigned* bar = b.bar;
        __builtin_amdgcn_s_waitcnt(0);
        unsigned nloc = b.st[0], nx = b.st[1];
        if (nloc == 0u) { xcd_barrier_complete(bar, b.x, nloc, nx); b.st[0] = nloc; b.st[1] = nx; }
        const unsigned old = xb_add(&bar[XB_XSUB(b.x)], 1u);
        const unsigned gen = old / nloc;
        if (old + 1u == (gen + 1u) * nloc) {
            __builtin_amdgcn_fence(__ATOMIC_RELEASE, "agent");
            asm volatile("s_waitcnt vmcnt(0)" ::: "memory");
            const unsigned og = xb_add(&bar[XB_TOP], 1u);
            const unsigned tg = og / nx;
            if (og + 1u == (tg + 1u) * nx) xb_add(&bar[XB_TOPGEN], 1u);
            else XB_SPIN(xb_ld(&bar[XB_TOPGEN]) == tg, bar);
            __builtin_amdgcn_fence(__ATOMIC_ACQUIRE, "agent");
            xb_add(&bar[XB_XGEN(b.x)], 1u);
            asm volatile("s_waitcnt vmcnt(0)" ::: "memory");
        } else {
            XB_SPIN(xb_ld(&bar[XB_XGEN(b.x)]) == gen, bar);
            __builtin_amdgcn_fence(__ATOMIC_ACQUIRE, "agent");
            asm volatile("s_waitcnt vmcnt(0)" ::: "memory");
        }
    }
    __syncthreads();
}

DI int item_start(int c, int ng, int G, int NI, float pa, float per) {
    if (c >= G) return NI;
    const float f = c <= ng ? __fmul_rn(pa, (float)c) : __fadd_rn(__fmul_rn(pa, (float)ng), __fmul_rn(per, (float)(c - ng)));
    const int i = (int)__fadd_rn(f, 0.5f);
    return i > NI ? NI : i;
}

constexpr int NPHASE = 2 + 10 * DEPTH;
enum { GM_NONE = 0, GM_INPROJ, GM_RESADD, GM_RELU2, GM_S5E, GM_S5Y, GM_GLU };

struct EpiAny {
    const pg8::Gemm* g;
    DI void prime_commit(LAS unsigned char* lds, int tid, const f32x4& a, const f32x4& b) const { rs_commit(lds, 0, tid, a, b); }
    DI bool prime_issue(const Unit& u, int tid, f32x4& a, f32x4& b) const {
        const bool m = (g->mode == GM_INPROJ || g->mode == GM_RELU2);
        if (m) rs_issue((const float*)g->i0, u.pm, tid, a, b);
        return m;
    }
    DI void operator()(const f32x4 (&acc)[2][2][4][2], const Unit& u, int wr, int wc, int fr, int fq, LAS unsigned char* lds, bool has_next, const Unit& nx, int par) const {
        asm volatile("" : "+v"(fr), "+v"(fq));
        asm volatile("" : "+s"(wr), "+s"(wc));
        switch (g->mode) {
        case GM_INPROJ: { EpiInProj E{(bf16_t*)g->o0, (bf16_t*)g->o1, (const float*)g->i0}; E(acc, u, wr, wc, fr, fq, lds, has_next, nx, par); } break;
        case GM_RESADD: if (g->sched == 3 && u.pm >= 128) { EpiPart E{(float*)const_cast<void*>(g->i1)}; E(acc, u, wr, wc, fr, fq); }
                        else { EpiResAdd E{(bf16_t*)g->o0, (float*)const_cast<void*>(g->i0)}; E(acc, u, wr, wc, fr, fq); } break;
        case GM_RELU2:  { EpiRelu2 E{(bf16_t*)g->o0, (const float*)g->i0}; E(acc, u, wr, wc, fr, fq, lds, has_next, nx, par); } break;
        case GM_S5E:    { EpiS5E E{(float*)g->o0}; E(acc, u, wr, wc, fr, fq); } break;
        case GM_S5Y:    { EpiS5Y E{(const bf16_t*)g->i0, (bf16_t*)g->o0, (const float*)g->i1}; E(acc, u, wr, wc, fr, fq); } break;
        default:        { EpiGlu E{(const bf16_t*)g->i0, (bf16_t*)g->o0, (float*)g->o1, (const float*)g->i1}; E(acc, u, wr, wc, fr, fq); } break;
        }
    }
};

__global__ void __launch_bounds__(512, 2) mega(Params p) {
    extern __shared__ __attribute__((aligned(16))) unsigned char lds[];
    cg::grid_group grid = cg::this_grid();
    LAS unsigned char* ldsl = (LAS unsigned char*)lds;
    volatile LAS unsigned* xbst = (volatile LAS unsigned*)(ldsl + LDS_BYTES - 16);
    if (threadIdx.x < 4) xbst[threadIdx.x] = 0u;
    __syncthreads();
    const XcdBarrier xbar = xcd_barrier_post((unsigned*)(p.ws + WS_BAR), xbst);

#ifdef PROBE_DOUBLE_MASK
    bool rep = false;
#endif
    for (int ph = p.ph_lo; ph < p.ph_hi; ++ph) {
        const int l = ph >= 1 ? (ph - 1) / 10 : 0, si = ph >= 1 ? (ph - 1) % 10 : 0;
        const int s = (ph == 0) ? 100 : (ph == NPHASE - 1 ? 101 : (si < 7 ? si + 1 : si + 2));
        unsigned char* ws = p.ws; unsigned char* ob = (unsigned char*)p.out; asm volatile("" : "+s"(ws), "+s"(ob));
        const int G = lgdim(), c = lbid();
#ifdef PROBE_TS_MASK
        if (blockIdx.x == 0 && threadIdx.x == 0) ((unsigned long long*)(p.ws + WS_TS))[ph] = __builtin_amdgcn_s_memrealtime();
#endif
        pg8::Gemm g; g.mode = GM_NONE; g.perm = 0; g.sched = 0; g.M = MP; g.N = 0; g.o0 = nullptr; g.o1 = nullptr; g.i0 = nullptr; g.i1 = nullptr; g.A = nullptr; g.Bt = nullptr; g.K = 0; g.lda = 0; g.ldb = 0;
        switch (s) {
        case 1:  g.mode = GM_INPROJ; g.perm = 1; g.A = (const bf16_t*)(ws + WS_H); g.Bt = (const bf16_t*)(ws + WS_WIN); g.K = 1024; g.lda = 1024; g.ldb = 1024; g.N = 3072; g.o0 = ws + WS_PROJ; g.o1 = ws + WS_U2; g.i0 = ws + WS_RSS; break;
        case 2:  g.mode = GM_S5E; g.sched = 1; g.A = (const bf16_t*)(ws + WS_U2); g.Bt = (const bf16_t*)(ws + WS_M1); g.K = 512; g.lda = U2LD; g.ldb = 512; g.o0 = ob + DO_S5E; break;
        case 4:  g.mode = GM_S5Y; g.perm = 1; g.sched = 2; g.A = (const bf16_t*)(ws + WS_U2); g.Bt = (const bf16_t*)(ws + WS_T2); g.K = 768; g.lda = U2LD; g.ldb = 768; g.i0 = ws + WS_U2; g.o0 = ws + WS_Z; g.i1 = p.in[I_S5D] + (size_t)l * 256; break;
        case 5:  g.mode = GM_GLU; g.perm = 1; g.A = (const bf16_t*)(ws + WS_Z); g.Bt = (const bf16_t*)(ws + WS_GLU); g.K = 256; g.lda = 256; g.ldb = 256; g.N = 256; g.i0 = ws + WS_Z; g.o0 = ws + WS_ACT; g.o1 = ws + WS_SS; g.i1 = p.in[I_GLUB] + (size_t)l * 256; break;
        case 7:  g.mode = GM_RESADD; g.A = (const bf16_t*)(ws + WS_ACT); g.Bt = (const bf16_t*)(ws + WS_WOUT); g.K = 1024; g.lda = 1024; g.ldb = 1024; g.N = 1024; g.o0 = ws + WS_H; g.i0 = ws + WS_RSS; break;
        case 9:  g.mode = GM_RELU2; g.perm = 1; g.i0 = ws + WS_RSS; g.A = (const bf16_t*)(ws + WS_H); g.Bt = (const bf16_t*)(ws + WS_WUP); g.K = 1024; g.lda = 1024; g.ldb = 1024; g.N = 4096; g.o0 = ws + WS_FF; break;
        case 10: g.mode = GM_RESADD; g.A = (const bf16_t*)(ws + WS_FF); g.Bt = (const bf16_t*)(ws + WS_WDN); g.K = 4096; g.lda = 4096; g.ldb = 4096; g.N = 1024; g.o0 = ws + WS_H; g.i0 = ws + WS_RSS; g.i1 = ob + DO_PART; g.sched = 3; g.M = 32768; break;
        default: break;
        }
        if (g.mode != GM_NONE) {
            pg8::AnyOrder S; S.kind = g.sched; S.G = G; S.c = c; S.ntfull = g.K / 64; S.so.init(g.M, g.N, G, c);
            EpiAny E{&g};
            pg8::gemm_phase(ldsl, g, S, E);
        }
        if (s == 2 || s == 4) {
            const bool fin = (s == 4);
            const int ngemm = fin ? 160 : 80; const float wg = fin ? 2.1f : 1.4f;
            const int NI = NCH64 * 6;
            const int ng = ngemm < G ? ngemm : G;
            const float per = ((float)NI + wg * (float)ng) / (float)G;
            const float pa = per - wg;
            const int i0 = item_start(c, ng, G, NI, pa, per), i1 = item_start(c + 1, ng, G, NI, pa, per);
            stage_params(p, l, lds);
            if (i0 < i1) {
                RgPre nx = rg_load(p, i0, fin);
                for (int it = i0; it < i1; ++it) { const RgPre cur = nx; if (it + 1 < i1) nx = rg_load(p, it + 1, fin); rg_compute(p, it, fin, cur, lds); }
            }
            if (i0 < i1) {
                HgPre nx = hg_load(p, i0, fin);
                for (int it = i0; it < i1; ++it) { const HgPre cur = nx; if (it + 1 < i1) nx = hg_load(p, it + 1, fin); hg_compute(p, it, fin, cur, lds); }
            }
        } else if (s == 1 || s == 7 || s == 9 || s == 10) {
            const int extra = s == 1 ? 1572 % G : (s == 7 ? 524 % G : (s == 9 ? 2096 % G : 48)), widx = c - extra, nw = G - extra;
            if (widx >= 0) {
                if (s == 1) { if (l == 0) build_s5_mats(p, 0, widx, nw); else convert_weights(p, l, CV_UP, widx, nw, lds); }
                else if (s == 7) convert_weights(p, l, CV_DN, widx, nw, lds);
                else if (l + 1 < DEPTH) {
                    if (s == 9) { build_s5_mats(p, l + 1, widx, nw); convert_weights(p, l + 1, CV_SMALL, widx, nw, lds); }
                    else convert_weights(p, l + 1, CV_IN | CV_OUT, widx, nw, lds);
                }
            }
        }
        else if (s == 11) phase_combine(p);
        else if (s == 3) phase_carries(p, l);
        else if (s == 6) phase_mixnorm(p, l);
        else if (s == 100) { phase_prep(p, lds); build_rows(p); convert_weights(p, 0, CV_UP | CV_IN | CV_OUT | CV_SMALL, c, G, lds); }
        else if (s == 101) phase_final(p);
        if (ph + 1 < p.ph_hi) { if (p.ph_lo < 0) { __threadfence(); grid.sync(); } else xcd_barrier(xbar); }
#ifdef PROBE_DOUBLE_MASK
        if (s < 11 && ((PROBE_DOUBLE_MASK >> s) & 1) && !rep) { rep = true; --ph; } else rep = false;
#endif
    }
#ifdef PROBE_TS_MASK
    xcd_barrier(xbar);
    if (blockIdx.x == 0 && threadIdx.x == 0) {
        unsigned long long* TS = (unsigned long long*)(p.ws + WS_TS);
        TS[NPHASE] = __builtin_amdgcn_s_memrealtime();
        unsigned long long sel = 0;
        for (int ph = 0; ph < NPHASE; ++ph) {
            const int si = ph >= 1 ? (ph - 1) % 10 : 0;
            const int s = (ph == 0) ? 12 : (ph == NPHASE - 1 ? 13 : (si < 7 ? si + 1 : si + 2));
            if ((PROBE_TS_MASK >> s) & 1) sel += TS[ph + 1] - TS[ph];
        }
        const float v = (float)sel / (float)(TS[NPHASE] - TS[0]);
        const float dl = sqrtf(5000.0f * v);
        p.out[0] += dl; p.out[16777216] += dl;
    }
#endif
}

#ifndef MK_MULTI
#define MK_MULTI 0
#endif

extern "C" void kernel_launch(void* const* d_in, const int* in_sizes, int n_in, void* d_out, int out_size, void* d_ws, size_t ws_size, hipStream_t stream) {
    static int grid = 0;
    if (grid == 0) {
        if (n_in != 29 || ws_size < WS_END || out_size != 33554432) { fprintf(stderr, "kernel_launch: unexpected sizes n_in %d ws %zu need %zu out %d\n", n_in, ws_size, (size_t)WS_END, out_size); grid = -1; return; }
        int dev = 0, cus = 0, per_cu = 0;
        hipGetDevice(&dev);
        hipDeviceGetAttribute(&cus, hipDeviceAttributeMultiprocessorCount, dev);
        if (hipFuncSetAttribute((const void*)mega, hipFuncAttributeMaxDynamicSharedMemorySize, LDS_BYTES) != hipSuccess) { fprintf(stderr, "kernel_launch: hipFuncSetAttribute failed\n"); }
        hipOccupancyMaxActiveBlocksPerMultiprocessor(&per_cu, (const void*)mega, 512, LDS_BYTES);
        (void)hipGetLastError();
        if (per_cu < 1) per_cu = 1;
        grid = cus * 1;
        fprintf(stderr, "kernel_launch: cus %d per_cu %d grid %d ws %zu need %zu\n", cus, per_cu, grid, ws_size, (size_t)WS_END);
    }
    if (grid < 0) return;
    Params p{};
    for (int i = 0; i < 29; ++i) p.in[i] = (const float*)d_in[i];
    p.out = (float*)d_out; p.ws = (unsigned char*)d_ws;
#if MK_MULTI
    for (int ph = 0; ph < NPHASE; ++ph) {
        p.ph_lo = ph; p.ph_hi = ph + 1;
        hipLaunchKernelGGL(mega, dim3(grid), dim3(512), LDS_BYTES, stream, p);
    }
#else
    p.ph_lo = 0; p.ph_hi = NPHASE;
    if (hipMemsetAsync((unsigned char*)d_ws + WS_BAR, 0, 16384, stream) != hipSuccess) { fprintf(stderr, "kernel_launch: memset of the barrier words failed\n"); return; }
    void* args[] = {&p};
    hipError_t e = hipLaunchCooperativeKernel((const void*)mega, dim3(grid), dim3(512), args, LDS_BYTES, stream);
    if (e != hipSuccess) fprintf(stderr, "cooperative launch failed: %s (grid %d)\n", hipGetErrorString(e), grid);
#endif
}
```

```cpp
#include <hip/hip_runtime.h>
#include <hip/hip_cooperative_groups.h>
#include <cstdio>
namespace cg = cooperative_groups;

#define DI __device__ __forceinline__
#define LAS __attribute__((address_space(3)))
typedef unsigned short bf16_t;
typedef short bf16x8 __attribute__((ext_vector_type(8)));
typedef float f32x4 __attribute__((ext_vector_type(4)));
typedef unsigned u32x4 __attribute__((ext_vector_type(4)));
typedef unsigned u32x2 __attribute__((ext_vector_type(2)));

constexpr int D = 1024, DEPTH = 4, DFF = 4096;
constexpr int PADR = 48;
constexpr int LP = 4160, LS = 2112;
constexpr int ROWS_P = 4 * LP;
constexpr int MP = ROWS_P + 8 * LS;
constexpr int NCH64 = MP / 64;
constexpr int NCH32 = MP / 32;
constexpr int U2ROWS = 1280;
constexpr int U2LD = 768;
constexpr int PLD = 2816;
constexpr int OFF_AX = 0, OFF_AG = 384, OFF_BQ = 768, OFF_BI = 1152, OFF_BFF = 1536, OFF_BFB = 1920, OFF_BG = 2304;
constexpr float EPS = 1e-6f;
constexpr int LDS_BYTES = 147456;

constexpr size_t al256(size_t x) { return (x + 255) & ~(size_t)255; }
constexpr size_t WS_H     = 0;
constexpr size_t WS_ACT   = WS_H + (size_t)MP * D * 4;
constexpr size_t WS_BIG   = WS_ACT + (size_t)MP * D * 2;
constexpr size_t BIG_SIZE = (size_t)MP * DFF * 2;
constexpr size_t WS_PROJ  = WS_BIG;
constexpr size_t WS_U2    = WS_PROJ + (size_t)MP * PLD * 2;
constexpr size_t WS_Z     = WS_U2 + (size_t)16 * U2ROWS * U2LD * 2;
static_assert(WS_Z + (size_t)MP * 256 * 2 <= WS_BIG + BIG_SIZE, "BIG overflow");
constexpr size_t WS_FF    = WS_BIG;
constexpr size_t WS_WIN   = WS_BIG + BIG_SIZE;
constexpr size_t WS_WOUT  = WS_WIN + (size_t)3072 * 1024 * 2;
constexpr size_t WS_WUP   = WS_WOUT + (size_t)1024 * 1024 * 2;
constexpr size_t WS_WDN   = WS_WUP + (size_t)4096 * 1024 * 2;
constexpr size_t WS_WG    = WS_WDN + (size_t)1024 * 4096 * 2;
constexpr size_t WS_GLU   = WS_WG + (size_t)6 * 256 * 64 * 2;
constexpr size_t WS_T2    = WS_GLU + (size_t)256 * 256 * 2;
constexpr size_t WS_M1    = WS_T2 + (size_t)16 * 512 * 768 * 2;
constexpr size_t WS_SS    = WS_M1 + (size_t)16 * 256 * 512 * 2;
constexpr size_t WS_HGD   = WS_SS + (size_t)MP * 16 * 4;
constexpr size_t WS_LB    = WS_HGD + (size_t)NCH64 * 6 * 2 * 64 * 4;
constexpr size_t WS_PAR   = WS_LB + al256((size_t)2 * 4 * 384 * 4);
constexpr size_t WS_BAR   = WS_PAR + (size_t)4 * 2 * 16 * 64 * 2 * 4;
constexpr size_t WS_RSS   = WS_BAR + 16384;
constexpr size_t WS_TS    = WS_RSS + (size_t)MP * 16 * 4;
constexpr size_t WS_END   = WS_TS + 1024;
constexpr size_t DO_HB2   = 0;
constexpr size_t DO_PART  = 0;
constexpr size_t DO_HGS   = 0;
constexpr size_t DO_S5E   = DO_HGS + (size_t)NCH64 * 6 * 2 * 4096 * 4;
constexpr size_t DO_KTAB  = DO_S5E + (size_t)16 * U2ROWS * 256 * 4;
constexpr size_t DO_BBAR  = DO_KTAB + (size_t)4 * 16 * 2 * 32 * 256 * 4;
constexpr size_t DO_RGC   = DO_BBAR + (size_t)4 * 2 * 16 * 64 * 16 * 2 * 4;
constexpr size_t DO_END   = DO_RGC + (size_t)NCH64 * 2 * 384 * 2 * 4;
static_assert(DO_END <= (size_t)33554432 * 4, "d_out scratch overflow");

struct Params {
    const float* in[29];
    float* out;
    unsigned char* ws;
    int ph_lo, ph_hi;
};
enum { I_XP = 0, I_XS, I_META, I_NMIX, I_WIN, I_CONVW, I_CONVB, I_WR, I_BR, I_WI, I_BI, I_LAM, I_LBL, I_ARE, I_AIM, I_LDT, I_BRE, I_BIM, I_CRE, I_CIM,
       I_S5D, I_GLUW, I_GLUB, I_MGAIN, I_WOUT, I_NMLP, I_WUP, I_WDN, I_NFIN };

DI int ltid() { int t = threadIdx.x; asm volatile("" : "+v"(t)); return t; }
DI int lbid() { int t = blockIdx.x; asm volatile("" : "+s"(t)); return t; }
DI int lgdim() { int t = gridDim.x; asm volatile("" : "+s"(t)); return t; }
typedef __bf16 bf16x2_t __attribute__((ext_vector_type(2)));
typedef float f32x2_t __attribute__((ext_vector_type(2)));
DI unsigned pack2(float lo, float hi) { const f32x2_t v = {lo, hi}; const bf16x2_t b = __builtin_convertvector(v, bf16x2_t); return __builtin_bit_cast(unsigned, b); }
DI unsigned short f2bf(float f) { return (unsigned short)(pack2(f, 0.f) & 0xFFFFu); }
DI float bf2f(unsigned short b) { return __uint_as_float(((unsigned)b) << 16); }
DI float bflo(unsigned w) { return __uint_as_float(w << 16); }
DI float bfhi(unsigned w) { return __uint_as_float(w & 0xFFFF0000u); }
DI float sigmoidf_(float x) { return __builtin_amdgcn_rcpf(1.0f + __expf(-x)); }
DI float siluf_(float x) { return x * sigmoidf_(x); }
DI float gelu_tanh(float x) { const float u = 0.7978845608028654f * (x + 0.044715f * x * x * x); return x * sigmoidf_(2.0f * u); }
DI void unpack8(const u32x4& w, float* f) { f[0] = bflo(w.x); f[1] = bfhi(w.x); f[2] = bflo(w.y); f[3] = bfhi(w.y); f[4] = bflo(w.z); f[5] = bfhi(w.z); f[6] = bflo(w.w); f[7] = bfhi(w.w); }
DI u32x4 pack8(const float* f) { u32x4 w; w.x = pack2(f[0], f[1]); w.y = pack2(f[2], f[3]); w.z = pack2(f[4], f[5]); w.w = pack2(f[6], f[7]); return w; }

DI void row_info(int R, int& seq, int& pos) {
    if (R < ROWS_P) { seq = R / LP; pos = R - seq * LP; }
    else { const int r = R - ROWS_P; const int s = r / LS; seq = 4 + s; pos = r - s * LS; }
}
DI void seq_chunks64(int seq, int& c0, int& nc) { if (seq < 4) { c0 = seq * 65; nc = 65; } else { c0 = 260 + (seq - 4) * 33; nc = 33; } }
DI void seq_chunks32(int seq, int& c0, int& nc) { if (seq < 4) { c0 = seq * 130; nc = 130; } else { c0 = 520 + (seq - 4) * 66; nc = 66; } }
DI int chunk64_pos0(int j) { if (j < 260) return (j % 65) * 64; return ((j - 260) % 33) * 64; }
DI int chunk64_len(int j) { return j < 260 ? LP : LS; }

namespace pg8 {
constexpr int BM = 256, BK = 64, HALF = 128, HTB = HALF * BK * 2, STAGE_BYTES = 8 * HTB, NXCD = 8, WGM = 8;
__host__ __device__ __forceinline__ int lds_byte(int r, int c) { const int st = (r >> 4) * 2 + (c >> 5), rr = r & 15, cc = c & 31, ob = rr * 64 + cc * 2; return st * 1024 + (ob ^ (((ob >> 9) & 1) << 5)); }
__host__ __device__ __forceinline__ void stage_rc(int b, int& R, int& C) { const int st = b / 1024, sb = b % 1024, swz = sb ^ (((sb >> 9) & 1) << 5); R = (st >> 1) * 16 + swz / 64; C = (st & 1) * 32 + (swz % 64) / 2; }
__host__ __device__ __forceinline__ int perm32(int rho) { const int n = rho >> 4, i = rho & 15; return 8 * (i >> 2) + 4 * n + (i & 3); }
struct Unit { int pm, pn, koff, nt; };
struct Gemm { const bf16_t* A; const bf16_t* Bt; int K, lda, ldb;
              int mixn;
              int mode, perm, sched, M, N;
              void* o0; void* o1; const void* i0; const void* i1; };

struct StaticOrder {
    int nM, nN, nwg, G, c;
    DI void init(int M, int N, int G_, int c_) { nM = M / BM; nN = N / BM; nwg = nM * nN; G = G_; c = c_; }
    DI bool next(int i, Unit& u) const {
        const long L = (long)i * G + c; if (L >= nwg) return false;
        int wgid = (int)L; { const int q = nwg / NXCD, r = nwg % NXCD, xcd = wgid % NXCD, off = wgid / NXCD; wgid = (xcd < r ? xcd * (q + 1) : r * (q + 1) + (xcd - r) * q) + off; }
        const int nig = WGM * nN, gid = wgid / nig, fm = gid * WGM, gsz = (nM - fm) < WGM ? (nM - fm) : WGM;
        u.pm = fm + ((wgid % nig) % gsz); u.pn = (wgid % nig) / gsz; u.koff = 0; u.nt = 0; return true;
    }
    DI void a_ready(const Unit&) const {}
    DI void done(const Unit&) const {}
};
template <int NPN> struct GroupOrder {
    int G, c;
    DI bool next(int i, Unit& u) const {
        const int L = i * G + c; if (L >= 16 * 5 * NPN) return false;
        const int g = L / (5 * NPN), r = L % (5 * NPN); u.pm = g * 5 + (r % 5); u.pn = g * NPN + (r / 5); u.koff = 0; u.nt = 0; return true;
    }
    DI void a_ready(const Unit&) const {}
    DI void done(const Unit&) const {}
};

DI unsigned cvt_pk_bf16(float lo, float hi) { unsigned r; asm volatile("v_cvt_pk_bf16_f32 %0, %1, %2" : "=v"(r) : "v"(lo), "v"(hi)); return r; }

struct AnyOrder {
    StaticOrder so; int kind, G, c, ntfull;
    DI bool next(int i, Unit& u) const {
        bool ok;
        if (kind == 0) ok = so.next(i, u);
        else if (kind == 1) { GroupOrder<1> o{G, c}; ok = o.next(i, u); }
        else if (kind == 2) { GroupOrder<2> o{G, c}; ok = o.next(i, u); }
        else {
            const int L = i * G + c;
            if (L < 512) ok = so.next(i, u);
            else { const int q = L - 512; if (q >= 48) return false; u.pm = 128 + q / 16; u.pn = (q >> 2) & 3; u.koff = (q & 3) * 1024; u.nt = 16; return true; }
        }
        u.nt = ntfull; return ok;
    }
};
template <class EpiFn>
DI void gemm_phase(LAS unsigned char* lds, const Gemm& g, const AnyOrder& S, const EpiFn& E) {
    int tid_ = ltid();
    const int tid = tid_, wid = __builtin_amdgcn_readfirstlane(tid >> 6), lane = tid & 63, wr = wid >> 2, wc = wid & 3, fr = lane & 15, fq = lane >> 4;
    int nt = g.K / BK;
    unsigned voffA[2], voffB[2];
#pragma unroll
    for (int i = 0; i < 2; ++i) { int R, C; stage_rc(tid * 16 + i * 8192, R, C); const int Rb = g.perm ? ((R & ~31) + perm32(R & 31)) : R;
        voffA[i] = (unsigned)(R * g.lda + C) * 2u; voffB[i] = (unsigned)(Rb * g.ldb + C) * 2u; }
    const size_t kstep = (size_t)(BK * 2);
    const size_t hstepA = (size_t)HALF * g.lda * 2, hstepB = (size_t)HALF * g.ldb * 2;
    const size_t tstepA = 2 * hstepA, tstepB = 2 * hstepB;
    const unsigned ldsw = (unsigned)wid * 1024u;
    const int aoff = lds_byte(wr * 64 + fr, fq * 8), boff = lds_byte(wc * 32 + fr, fq * 8);
#define PG8_SA(b, h) (((b) * 2 + (h)) * HTB)
#define PG8_SB(b, h) ((4 + (b) * 2 + (h)) * HTB)
#define PG8_STAGE(bufoff, gbase, voff) do { _Pragma("unroll") for (int _i = 0; _i < 2; ++_i) \
        __builtin_amdgcn_global_load_lds((const unsigned*)((const char*)(gbase) + (voff)[_i]), (LAS unsigned*)(lds + (bufoff) + ldsw + _i * 8192), 16, 0, 0); } while (0)
#define PG8_LDA(dst, b, h) do { _Pragma("unroll") for (int m = 0; m < 4; ++m) _Pragma("unroll") for (int k = 0; k < 2; ++k) dst[m][k] = *(const LAS bf16x8*)(lds + PG8_SA(b, h) + aoff + m * 2048 + k * 1024); } while (0)
#define PG8_LDB(dst, b, h) do { _Pragma("unroll") for (int n = 0; n < 2; ++n) _Pragma("unroll") for (int k = 0; k < 2; ++k) dst[n][k] = *(const LAS bf16x8*)(lds + PG8_SB(b, h) + boff + n * 2048 + k * 1024); } while (0)
#define PG8_MMA(ai, bj, At, Bt) do { __builtin_amdgcn_s_setprio(1); _Pragma("unroll") for (int m = 0; m < 4; ++m) _Pragma("unroll") for (int n = 0; n < 2; ++n) _Pragma("unroll") for (int k = 0; k < 2; ++k) \
        acc[ai][bj][m][n] = __builtin_amdgcn_mfma_f32_16x16x32_bf16(Bt[n][k], At[m][k], acc[ai][bj][m][n], 0, 0, 0); __builtin_amdgcn_s_setprio(0); } while (0)
#define PG8_WAIT_V(n) asm volatile("s_waitcnt vmcnt(" #n ")" ::: "memory")
#define PG8_WAIT_L(n) asm volatile("s_waitcnt lgkmcnt(" #n ")" ::: "memory")
#define PG8_BAR __builtin_amdgcn_s_barrier()
#define PG8_SCHED __builtin_amdgcn_sched_barrier(0)
    Unit cur, nxt; int ui = 0;
    if (!S.next(0, cur)) return;
    f32x4 acc[2][2][4][2];
#pragma unroll
    for (int a = 0; a < 2; ++a)
#pragma unroll
        for (int b = 0; b < 2; ++b)
#pragma unroll
            for (int m = 0; m < 4; ++m)
#pragma unroll
                for (int n = 0; n < 2; ++n) acc[a][b][m][n] = (f32x4){0.f, 0.f, 0.f, 0.f};
    bf16x8 At[4][2], B0[2][2], B1[2][2];
    const char* cA = (const char*)g.A + (size_t)cur.pm * tstepA + (size_t)cur.koff * 2; const char* cB = (const char*)g.Bt + (size_t)cur.pn * tstepB + (size_t)cur.koff * 2;
    nt = cur.nt;
    f32x4 pra = (f32x4){0.f, 0.f, 0.f, 0.f}, prb = pra; const bool rsm = E.prime_issue(cur, tid, pra, prb);
    PG8_STAGE(PG8_SB(0, 0), cB, voffB); PG8_STAGE(PG8_SA(0, 0), cA, voffA); PG8_STAGE(PG8_SB(0, 1), cB + hstepB, voffB); PG8_STAGE(PG8_SA(0, 1), cA + hstepA, voffA);
    if (wr == 1) PG8_BAR;
    PG8_WAIT_V(4); PG8_BAR;
    if (rsm) E.prime_commit(lds, tid, pra, prb);
    PG8_STAGE(PG8_SB(1, 0), cB + kstep, voffB); PG8_STAGE(PG8_SA(1, 0), cA + kstep, voffA); PG8_STAGE(PG8_SB(1, 1), cB + hstepB + kstep, voffB);
    PG8_WAIT_V(6); PG8_BAR;
    for (;;) {
        const bool has_next = S.next(ui + 1, nxt);
        const char* nA = has_next ? (const char*)g.A + (size_t)nxt.pm * tstepA + (size_t)nxt.koff * 2 : cA; const char* nB = has_next ? (const char*)g.Bt + (size_t)nxt.pn * tstepB + (size_t)nxt.koff * 2 : cB;
        for (int t = 0; t < nt; t += 2) {
            const bool last = (t == nt - 2);
            const char* a1 = cA + (size_t)(t + 1) * kstep;
            const char* a2 = last ? nA : cA + (size_t)(t + 2) * kstep; const char* b2 = last ? nB : cB + (size_t)(t + 2) * kstep;
            const char* a3 = a2 + kstep; const char* b3 = b2 + kstep;
            if (E.mixn() && (t == 6 || t == 12)) { E.mix_rescale(acc, lds, ui & 1, t, wr, fr); PG8_SCHED; }
            PG8_LDB(B0, 0, 0); PG8_SCHED; PG8_LDA(At, 0, 0); PG8_STAGE(PG8_SA(1, 1), a1 + hstepA, voffA);
            PG8_WAIT_L(8); PG8_BAR; PG8_WAIT_L(0); PG8_MMA(0, 0, At, B0); PG8_BAR; PG8_SCHED;
            PG8_LDB(B1, 0, 1); PG8_STAGE(PG8_SB(0, 0), b2, voffB);
            PG8_BAR; PG8_WAIT_L(0); PG8_MMA(0, 1, At, B1); PG8_BAR;
            PG8_LDA(At, 0, 1); PG8_STAGE(PG8_SA(0, 0), a2, voffA);
            PG8_BAR; PG8_WAIT_L(0); PG8_MMA(1, 0, At, B0); PG8_BAR; PG8_SCHED;
            PG8_STAGE(PG8_SB(0, 1), b2 + hstepB, voffB);
            PG8_WAIT_V(6); PG8_BAR; PG8_MMA(1, 1, At, B1); PG8_BAR;
            PG8_LDB(B0, 1, 0); PG8_SCHED; PG8_LDA(At, 1, 0); PG8_STAGE(PG8_SA(0, 1), a2 + hstepA, voffA);
            PG8_WAIT_L(8); PG8_BAR; PG8_WAIT_L(0); PG8_MMA(0, 0, At, B0); PG8_BAR; PG8_SCHED;
            PG8_LDB(B1, 1, 1); PG8_STAGE(PG8_SB(1, 0), b3, voffB);
            PG8_BAR; PG8_WAIT_L(0); PG8_MMA(0, 1, At, B1); PG8_BAR;
            PG8_LDA(At, 1, 1); PG8_STAGE(PG8_SA(1, 0), a3, voffA);
            PG8_BAR; PG8_WAIT_L(0); PG8_MMA(1, 0, At, B0); PG8_BAR; PG8_SCHED;
            PG8_STAGE(PG8_SB(1, 1), b3 + hstepB, voffB);
            PG8_WAIT_V(6); PG8_BAR; PG8_MMA(1, 1, At, B1); PG8_BAR;
        }
        E(acc, cur, wr, wc, fr, fq, lds, has_next, nxt, ui & 1);
        if (!has_next) break;
#pragma unroll
        for (int a = 0; a < 2; ++a)
#pragma unroll
            for (int b = 0; b < 2; ++b)
#pragma unroll
                for (int m = 0; m < 4; ++m)
#pragma unroll
                    for (int n = 0; n < 2; ++n) acc[a][b][m][n] = (f32x4){0.f, 0.f, 0.f, 0.f};
        cur = nxt; cA = nA; cB = nB; nt = cur.nt; ++ui;
    }
    PG8_WAIT_V(0);
    if (wr == 0) PG8_BAR;
    PG8_BAR;
#undef PG8_SA
#undef PG8_SB
#undef PG8_STAGE
#undef PG8_LDA
#undef PG8_LDB
#undef PG8_MMA
#undef PG8_WAIT_V
#undef PG8_WAIT_L
#undef PG8_BAR
#undef PG8_SCHED
}
}
using pg8::Unit;

DI float row_rn(const float* RSS, int r) {
    const float* sp = RSS + (size_t)r * 16; const f32x4 a = *(const f32x4*)sp, b = *(const f32x4*)(sp + 4), c = *(const f32x4*)(sp + 8), d = *(const f32x4*)(sp + 12);
    const float tot = (((a[0] + a[1]) + (a[2] + a[3])) + ((b[0] + b[1]) + (b[2] + b[3]))) + (((c[0] + c[1]) + (c[2] + c[3])) + ((d[0] + d[1]) + (d[2] + d[3])));
    return rsqrtf(tot * (1.0f / D) + EPS);
}
DI float row_rn4(const float* RSS, int r, int fq) {
    const f32x4 a = *(const f32x4*)(RSS + (size_t)r * 16 + fq * 4);
    float t = (a[0] + a[1]) + (a[2] + a[3]);
    t += __shfl_xor(t, 16); t += __shfl_xor(t, 32);
    return rsqrtf(t * (1.0f / D) + EPS);
}
constexpr int PS_OFF = 131072;
DI void rs_issue(const float* RSS, int pm, int tid, f32x4& a, f32x4& b) { const float* sp = RSS + (size_t)(pm * 256 + (tid & 255)) * 16 + (tid >> 8) * 8; a = *(const f32x4*)sp; b = *(const f32x4*)(sp + 4); }
DI void rs_commit(LAS unsigned char* lds, int par, int tid, const f32x4& a, const f32x4& b) { ((LAS float*)(lds + PS_OFF))[(par * 2 + (tid >> 8)) * 256 + (tid & 255)] = ((a[0] + a[1]) + (a[2] + a[3])) + ((b[0] + b[1]) + (b[2] + b[3])); }
DI float rs_get(LAS unsigned char* lds, int par, int rl) { const LAS float* PS = (const LAS float*)(lds + PS_OFF); return rsqrtf((PS[(par * 2) * 256 + rl] + PS[(par * 2 + 1) * 256 + rl]) * (1.0f / D) + EPS); }
constexpr int MN_OFF = 131072 + 4096;
DI void mn_commit(LAS unsigned char* lds, int par, int tid, const f32x4& a, const f32x4& b) {
    LAS float* M = (LAS float*)(lds + MN_OFF) + par * 1024; const int h = tid >> 8, row = tid & 255;
    const float v0 = h == 0 ? (((a[0] + a[1]) + (a[2] + a[3])) + (b[0] + b[1])) : ((a[0] + a[1]) + (a[2] + a[3]));
    const float v1 = h == 0 ? (b[2] + b[3]) : ((b[0] + b[1]) + (b[2] + b[3]));
    M[(h * 2) * 256 + row] = v0; M[(h * 2 + 1) * 256 + row] = v1;
}
DI void mn_get(LAS unsigned char* lds, int par, int rl, float& rA, float& rB, float& rC) {
    const LAS float* M = (const LAS float*)(lds + MN_OFF) + par * 1024;
    rA = rsqrtf(M[rl] * (1.0f / 384.0f) + EPS); rB = rsqrtf((M[256 + rl] + M[512 + rl]) * (1.0f / 384.0f) + EPS); rC = rsqrtf(M[768 + rl] * (1.0f / 256.0f) + EPS);
}
struct EpiInProj {
    static constexpr bool PERM = true;
    bf16_t* PROJ; bf16_t* U2; const float* RSS;
    DI void operator()(const f32x4 (&acc)[2][2][4][2], const Unit& u, int wr, int wc, int fr, int fq, LAS unsigned char* lds, bool has_next, const Unit& nx, int par) const {
        const int row0 = u.pm * 256 + wr * 64 + fr;
        const int tid = ltid(); f32x4 na = (f32x4){0.f, 0.f, 0.f, 0.f}, nb = na;
        if (has_next) rs_issue(RSS, nx.pm, tid, na, nb);
        float rn[2][4];
#pragma unroll
        for (int ai = 0; ai < 2; ++ai)
#pragma unroll
            for (int m = 0; m < 4; ++m) rn[ai][m] = rs_get(lds, par, wr * 64 + fr + ai * 128 + m * 16);
#pragma unroll
        for (int ai = 0; ai < 2; ++ai)
#pragma unroll
            for (int m = 0; m < 4; ++m) {
                const int r = row0 + ai * 128 + m * 16;
#pragma unroll
                for (int bj = 0; bj < 2; ++bj) {
                    const f32x4 v0 = acc[ai][bj][m][0] * rn[ai][m], v1 = acc[ai][bj][m][1] * rn[ai][m];
                    u32x4 w; w.x = pack2(v0[0], v0[1]); w.y = pack2(v0[2], v0[3]); w.z = pack2(v1[0], v1[1]); w.w = pack2(v1[2], v1[3]);
                    const int cl = bj * 128 + wc * 32 + 8 * fq;
                    if (u.pn == 0) { const int g = cl >> 4, h = cl & 15; *(u32x4*)(U2 + ((size_t)(g * U2ROWS + (r >> 5)) * U2LD + (r & 31) * 16 + h)) = w; }
                    else __builtin_nontemporal_store(w, (u32x4*)(PROJ + (size_t)r * PLD + (u.pn - 1) * 256 + cl));
                }
            }
        if (has_next) rs_commit(lds, par ^ 1, tid, na, nb);
    }
};
struct EpiResAdd {
    static constexpr bool PERM = false;
    bf16_t* H; float* RSS;
    DI void ld(u32x2 (&hv)[2][2][2], int row0, int col0, int ai, int mp) const {
#pragma unroll
        for (int mm = 0; mm < 2; ++mm)
#pragma unroll
            for (int bj = 0; bj < 2; ++bj)
#pragma unroll
                for (int n = 0; n < 2; ++n) hv[mm][bj][n] = *(const u32x2*)(H + (size_t)(row0 + ai * 128 + (mp * 2 + mm) * 16) * D + col0 + bj * 128 + n * 16);
    }
    template <int AI, int MP_>
    DI void proc(const u32x2 (&hv)[2][2][2], const f32x4 (&acc)[2][2][4][2], int row0, int col0, int pn, int wc, int fq, const float (&rc)[2][4]) const {
#pragma unroll
        for (int mm = 0; mm < 2; ++mm) { const int m = MP_ * 2 + mm; const int r = row0 + AI * 128 + m * 16; bf16_t* rowp = H + (size_t)r * D + col0;
            float ss = 0.f;
#pragma unroll
            for (int bj = 0; bj < 2; ++bj)
#pragma unroll
                for (int n = 0; n < 2; ++n) { const u32x2 o = hv[mm][bj][n]; const f32x4 a = acc[AI][bj][m][n] * rc[AI][m];
                    const float h0 = bflo(o.x) + a[0], h1 = bfhi(o.x) + a[1], h2 = bflo(o.y) + a[2], h3 = bfhi(o.y) + a[3];
                    u32x2 w; w.x = pack2(h0, h1); w.y = pack2(h2, h3); *(u32x2*)(rowp + bj * 128 + n * 16) = w;
                    ss += (h0 * h0 + h1 * h1) + (h2 * h2 + h3 * h3); }
            ss += __shfl_xor(ss, 16); ss += __shfl_xor(ss, 32);
            if (fq == 0) RSS[(size_t)r * 16 + pn * 4 + wc] = ss; }
    }
    DI void operator()(const f32x4 (&acc)[2][2][4][2], const Unit& u, int wr, int wc, int fr, int fq, const float* SSn, LAS unsigned char* lds, bool has_next, const Unit& nx, int par) const {
        const int row0 = u.pm * 256 + wr * 64 + fr, col0 = u.pn * 256 + wc * 32 + 4 * fq;
        const int tid = ltid(); f32x4 na = (f32x4){0.f, 0.f, 0.f, 0.f}, nb = na;
        if (SSn && has_next) rs_issue(SSn, nx.pm, tid, na, nb);
        float rc[2][4];
#pragma unroll
        for (int ai = 0; ai < 2; ++ai)
#pragma unroll
            for (int m = 0; m < 4; ++m) { float rA, rB, rC = 1.0f; if (SSn) mn_get(lds, par, wr * 64 + fr + ai * 128 + m * 16, rA, rB, rC); rc[ai][m] = rC; }
        u32x2 ha[2][2][2], hb[2][2][2];
        ld(ha, row0, col0, 0, 0);
        ld(hb, row0, col0, 0, 1); proc<0, 0>(ha, acc, row0, col0, u.pn, wc, fq, rc);
        ld(ha, row0, col0, 1, 0); proc<0, 1>(hb, acc, row0, col0, u.pn, wc, fq, rc);
        ld(hb, row0, col0, 1, 1); proc<1, 0>(ha, acc, row0, col0, u.pn, wc, fq, rc);
        proc<1, 1>(hb, acc, row0, col0, u.pn, wc, fq, rc);
        if (SSn && has_next) mn_commit(lds, par ^ 1, tid, na, nb);
    }
};
struct EpiPart {
    static constexpr bool PERM = false;
    float* P;
    DI void operator()(const f32x4 (&acc)[2][2][4][2], const Unit& u, int wr, int wc, int fr, int fq) const {
        const int row0 = (u.pm - 128) * 256 + wr * 64 + fr, col0 = u.pn * 256 + wc * 32 + 4 * fq; const int ks = u.koff >> 10;
#pragma unroll
        for (int ai = 0; ai < 2; ++ai)
#pragma unroll
            for (int m = 0; m < 4; ++m) { float* rowp = P + ((size_t)ks * 768 + row0 + ai * 128 + m * 16) * D + col0;
#pragma unroll
                for (int bj = 0; bj < 2; ++bj)
#pragma unroll
                    for (int n = 0; n < 2; ++n) *(f32x4*)(rowp + bj * 128 + n * 16) = acc[ai][bj][m][n]; }
    }
};
struct EpiRelu2 {
    static constexpr bool PERM = true;
    bf16_t* FF; const float* RSS;
    DI void operator()(const f32x4 (&acc)[2][2][4][2], const Unit& u, int wr, int wc, int fr, int fq, LAS unsigned char* lds, bool has_next, const Unit& nx, int par) const {
        const int row0 = u.pm * 256 + wr * 64 + fr, col0 = u.pn * 256 + wc * 32 + 8 * fq;
        const int tid = ltid(); f32x4 na = (f32x4){0.f, 0.f, 0.f, 0.f}, nb = na;
        if (has_next) rs_issue(RSS, nx.pm, tid, na, nb);
        float rn[2][4];
#pragma unroll
        for (int ai = 0; ai < 2; ++ai)
#pragma unroll
            for (int m = 0; m < 4; ++m) rn[ai][m] = rs_get(lds, par, wr * 64 + fr + ai * 128 + m * 16);
#pragma unroll
        for (int ai = 0; ai < 2; ++ai)
#pragma unroll
            for (int m = 0; m < 4; ++m) { bf16_t* rowp = FF + (size_t)(row0 + ai * 128 + m * 16) * DFF + col0;
#pragma unroll
                for (int bj = 0; bj < 2; ++bj) { f32x4 v0 = acc[ai][bj][m][0] * rn[ai][m], v1 = acc[ai][bj][m][1] * rn[ai][m];
#pragma unroll
                    for (int j = 0; j < 4; ++j) { const float a = fmaxf(v0[j], 0.f), b = fmaxf(v1[j], 0.f); v0[j] = a * a; v1[j] = b * b; }
                    u32x4 w; w.x = pack2(v0[0], v0[1]); w.y = pack2(v0[2], v0[3]); w.z = pack2(v1[0], v1[1]); w.w = pack2(v1[2], v1[3]);
                    __builtin_nontemporal_store(w, (u32x4*)(rowp + bj * 128)); } }
        if (has_next) rs_commit(lds, par ^ 1, tid, na, nb);
    }
};
struct EpiS5E {
    static constexpr bool PERM = false;
    float* E;
    DI void operator()(const f32x4 (&acc)[2][2][4][2], const Unit& u, int wr, int wc, int fr, int fq) const {
        const int row0 = u.pm * 256 + wr * 64 + fr, col0 = wc * 32 + 4 * fq;
#pragma unroll
        for (int ai = 0; ai < 2; ++ai)
#pragma unroll
            for (int m = 0; m < 4; ++m) { float* rowp = E + (size_t)(row0 + ai * 128 + m * 16) * 256 + col0;
#pragma unroll
                for (int bj = 0; bj < 2; ++bj)
#pragma unroll
                    for (int n = 0; n < 2; ++n) *(f32x4*)(rowp + bj * 128 + n * 16) = acc[ai][bj][m][n]; }
    }
};
struct EpiS5Y {
    static constexpr bool PERM = true;
    const bf16_t* U2; bf16_t* Z; const float* dskip;
    DI void operator()(const f32x4 (&acc)[2][2][4][2], const Unit& u, int wr, int wc, int fr, int fq) const {
        const int g = u.pm / 5, pml = u.pm - g * 5, pnl = u.pn - g * 2;
        float dsk[2][8];
#pragma unroll
        for (int bj = 0; bj < 2; ++bj) { const int h0 = (bj * 128 + wc * 32 + 8 * fq) & 15; const f32x4 d0 = *(const f32x4*)(dskip + g * 16 + h0), d1 = *(const f32x4*)(dskip + g * 16 + h0 + 4);
#pragma unroll
            for (int j = 0; j < 4; ++j) { dsk[bj][j] = d0[j]; dsk[bj][4 + j] = d1[j]; } }
#pragma unroll
        for (int ai = 0; ai < 2; ++ai) {
            u32x4 uw[4][2];
#pragma unroll
            for (int m = 0; m < 4; ++m) { const int chunk = pml * 256 + ai * 128 + wr * 64 + m * 16 + fr;
#pragma unroll
                for (int bj = 0; bj < 2; ++bj) { const int n0 = pnl * 256 + bj * 128 + wc * 32 + 8 * fq;
                    uw[m][bj] = chunk < NCH32 ? *(const u32x4*)(U2 + ((size_t)(g * U2ROWS + chunk) * U2LD + n0)) : (u32x4){0u, 0u, 0u, 0u}; } }
#pragma unroll
            for (int m = 0; m < 4; ++m) {
                const int chunk = pml * 256 + ai * 128 + wr * 64 + m * 16 + fr;
                if (chunk < NCH32) {
#pragma unroll
                    for (int bj = 0; bj < 2; ++bj) {
                        const int n0 = pnl * 256 + bj * 128 + wc * 32 + 8 * fq;
                        const int t = n0 >> 4, h0 = n0 & 15;
                        float uf[8]; unpack8(uw[m][bj], uf);
                        const f32x4 v0 = acc[ai][bj][m][0], v1 = acc[ai][bj][m][1];
                        float y[8];
#pragma unroll
                        for (int j = 0; j < 4; ++j) { y[j] = v0[j]; y[4 + j] = v1[j]; }
#pragma unroll
                        for (int j = 0; j < 8; ++j) y[j] = gelu_tanh(y[j] + dsk[bj][j] * uf[j]);
                        *(u32x4*)(Z + ((size_t)(chunk * 32 + t) * 256 + g * 16 + h0)) = pack8(y);
                    }
                }
            }
        }
    }
};
struct EpiGlu {
    static constexpr bool PERM = true;
    const bf16_t* Z; bf16_t* YM; float* SS; const float* glub;
    DI void operator()(const f32x4 (&acc)[2][2][4][2], const Unit& u, int wr, int wc, int fr, int fq) const {
        const int row0 = u.pm * 256 + wr * 64 + fr;
        float gb[2][8];
#pragma unroll
        for (int bj = 0; bj < 2; ++bj) { const int c0 = bj * 128 + wc * 32 + 8 * fq; const f32x4 d0 = *(const f32x4*)(glub + c0), d1 = *(const f32x4*)(glub + c0 + 4);
#pragma unroll
            for (int j = 0; j < 4; ++j) { gb[bj][j] = d0[j]; gb[bj][4 + j] = d1[j]; } }
#pragma unroll
        for (int ai = 0; ai < 2; ++ai) {
            u32x4 zw[4][2];
#pragma unroll
            for (int m = 0; m < 4; ++m)
#pragma unroll
                for (int bj = 0; bj < 2; ++bj) zw[m][bj] = *(const u32x4*)(Z + (size_t)(row0 + ai * 128 + m * 16) * 256 + bj * 128 + wc * 32 + 8 * fq);
#pragma unroll
            for (int m = 0; m < 4; ++m) {
                const int r = row0 + ai * 128 + m * 16;
                int seq, pos; row_info(r, seq, pos);
                const bool valid = pos >= PADR;
                float ssum = 0.f;
#pragma unroll
                for (int bj = 0; bj < 2; ++bj) {
                    const int c0 = bj * 128 + wc * 32 + 8 * fq;
                    float zf[8]; unpack8(zw[m][bj], zf);
                    const f32x4 v0 = acc[ai][bj][m][0], v1 = acc[ai][bj][m][1];
                    float y[8];
#pragma unroll
                    for (int j = 0; j < 4; ++j) { y[j] = v0[j]; y[4 + j] = v1[j]; }
#pragma unroll
                    for (int j = 0; j < 8; ++j) { const float o = valid ? zf[j] * sigmoidf_(y[j] + gb[bj][j]) : 0.f; y[j] = o; ssum += o * o; }
                    *(u32x4*)(YM + (size_t)r * D + 768 + c0) = pack8(y);
                }
                ssum += __shfl_xor(ssum, 16); ssum += __shfl_xor(ssum, 32);
                if (fq == 0) SS[(size_t)r * 16 + 12 + wc] = ssum;
            }
        }
    }
};

DI f32x4 mma_tile64(const bf16_t* A, const bf16_t* Bt, int ld, int lane, f32x4 acc) {
    const int r = lane & 15, q = lane >> 4;
#pragma unroll
    for (int ks = 0; ks < 2; ++ks) {
        const bf16x8 a = *(const bf16x8*)(A + r * ld + ks * 32 + q * 8);
        const bf16x8 b = *(const bf16x8*)(Bt + r * ld + ks * 32 + q * 8);
        acc = __builtin_amdgcn_mfma_f32_16x16x32_bf16(a, b, acc, 0, 0, 0);
    }
    return acc;
}

DI void phase_prep(const Params& p, unsigned char* lds) {
    const int tid = ltid();
    float* LB = (float*)(p.ws + WS_LB);
    for (int i = lbid() * 512 + tid; i < 2 * 384; i += lgdim() * 512) {
        const int d = i / 384, c = i % 384;
        float lg[4], mx = -1e30f;
#pragma unroll
        for (int l = 0; l < 4; ++l) { lg[l] = p.in[I_LBL][(d * 4 + l) * 384 + c]; mx = fmaxf(mx, lg[l]); }
        float s = 0.f;
#pragma unroll
        for (int l = 0; l < 4; ++l) { lg[l] = expf(lg[l] - mx); s += lg[l]; }
        float cum = 0.f;
#pragma unroll
        for (int l = 0; l < 4; ++l) { if (l > 0) cum += lg[l] / s; LB[(d * 4 + l) * 384 + c] = cum; }
    }
    float* PAR = (float*)(p.ws + WS_PAR);
    float* KTAB = (float*)((unsigned char*)p.out + DO_KTAB);
    float* BBAR = (float*)((unsigned char*)p.out + DO_BBAR);
    float* sAR = (float*)lds;
    float* sAI = sAR + 64;
    float* sBB = sAI + 64;
    float* sC  = sBB + 2048;
    float* sW  = sC + 2048;
    float* sW2 = sW;
    for (int item2 = lbid(); item2 < 4 * 16 * 2 * 2; item2 += lgdim()) {
        const int item = item2 >> 1, half = item2 & 1;
        const int l = item / 32, g = (item / 2) % 16, d = item % 2;
        const int base = ((l * 2 + d) * 16 + g);
        const float dt = expf(p.in[I_LDT][base]);
        __syncthreads();
        if (tid < 64) {
            const float lr = p.in[I_ARE][base * 64 + tid], li = p.in[I_AIM][base * 64 + tid];
            const float ar = lr * dt, ai = li * dt;
            sAR[tid] = ar; sAI[tid] = ai;
            if (half == 0) { PAR[(base * 64 + tid) * 2 + 0] = ar; PAR[(base * 64 + tid) * 2 + 1] = ai; }
        }
        __syncthreads();
        for (int e = tid; e < 1024; e += 512) {
            const int pp = e >> 4, h = e & 15;
            const float ar = sAR[pp], ai = sAI[pp];
            const float lr = p.in[I_ARE][base * 64 + pp], li = p.in[I_AIM][base * 64 + pp];
            float sn, cs; sincosf(ai, &sn, &cs);
            const float em1 = expm1f(ar), ex = em1 + 1.0f;
            const float sh = sinf(0.5f * ai);
            const float x = em1 * cs - 2.0f * sh * sh, y = ex * sn;
            const float den = lr * lr + li * li;
            const float cr = (x * lr + y * li) / den, ci = (y * lr - x * li) / den;
            const float br = p.in[I_BRE][(size_t)(base * 64 + pp) * 16 + h], bi = p.in[I_BIM][(size_t)(base * 64 + pp) * 16 + h];
            const float rr = cr * br - ci * bi, ri = cr * bi + ci * br;
            sBB[e * 2] = rr; sBB[e * 2 + 1] = ri;
            if (half == 0) { BBAR[((size_t)(base * 64 + pp) * 16 + h) * 2] = rr; BBAR[((size_t)(base * 64 + pp) * 16 + h) * 2 + 1] = ri; }
        }
        for (int e = tid; e < 1024; e += 512) {
            sC[e * 2] = p.in[I_CRE][(size_t)base * 1024 + e]; sC[e * 2 + 1] = p.in[I_CIM][(size_t)base * 1024 + e];
        }
        __syncthreads();
_Pragma("nounroll")
        for (int tp = 0; tp < 8; ++tp) {
            if (tid < 128) { const int w = tid >> 6, pp = tid & 63; const float tau = (float)(half * 16 + tp * 2 + w);
                const float mg = expf(tau * sAR[pp]); float sn, cs; sincosf(tau * sAI[pp], &sn, &cs); sW2[(w * 64 + pp) * 2] = mg * cs; sW2[(w * 64 + pp) * 2 + 1] = mg * sn; }
            __syncthreads();
            {
                const int w = tid >> 8, o = tid & 255, hp = o >> 4, h = o & 15;
                float sacc = 0.f;
_Pragma("unroll 4")
                for (int pp = 0; pp < 64; ++pp) {
                    const float wr_ = sW2[(w * 64 + pp) * 2], wi_ = sW2[(w * 64 + pp) * 2 + 1];
                    const float br = sBB[(pp * 16 + h) * 2], bi = sBB[(pp * 16 + h) * 2 + 1];
                    const float tr = wr_ * br - wi_ * bi, ti = wr_ * bi + wi_ * br;
                    const float cr = sC[(hp * 64 + pp) * 2], ci = sC[(hp * 64 + pp) * 2 + 1];
                    sacc += cr * tr - ci * ti;
                }
                KTAB[((size_t)((l * 16 + g) * 2 + d) * 32 + (half * 16 + tp * 2 + w)) * 256 + o] = sacc;
            }
            __syncthreads();
        }
    }
}

DI const float* build_src(const Params& p, int R) {
    int seq, pos; row_info(R, seq, pos);
    const int t = pos - PADR;
    if (t < 0) return nullptr;
    if (t < 16) return p.in[I_META] + (size_t)t * D;
    return (seq < 4) ? p.in[I_XP] + ((size_t)seq * 4096 + (t - 16)) * D : p.in[I_XS] + ((size_t)(seq - 4) * 2048 + (t - 16)) * D;
}
DI void build_rows(const Params& p) {
    const int tid = ltid(); const int lane = tid & 63, wave = tid >> 6;
    bf16_t* H = (bf16_t*)(p.ws + WS_H); float* RSS = (float*)(p.ws + WS_RSS);
    const int stride = lgdim() * 8;
    int R = lbid() * 8 + wave;
    if (R >= MP) return;
    const f32x4 zf = (f32x4){0.f, 0.f, 0.f, 0.f};
    f32x4 nx[4];
    { const float* src = build_src(p, R);
#pragma unroll
      for (int i = 0; i < 4; ++i) nx[i] = src ? __builtin_nontemporal_load((const f32x4*)(src + (lane + 64 * i) * 4)) : zf; }
    while (R < MP) {
        f32x4 v[4];
#pragma unroll
        for (int i = 0; i < 4; ++i) v[i] = nx[i];
        const int Rn = R + stride;
        if (Rn < MP) { const float* src = build_src(p, Rn);
#pragma unroll
            for (int i = 0; i < 4; ++i) nx[i] = src ? __builtin_nontemporal_load((const f32x4*)(src + (lane + 64 * i) * 4)) : zf; }
        float ss = 0.f;
#pragma unroll
        for (int i = 0; i < 4; ++i) {
            u32x2 w; w.x = pack2(v[i][0], v[i][1]); w.y = pack2(v[i][2], v[i][3]); *(u32x2*)(H + (size_t)R * D + (lane + 64 * i) * 4) = w;
            ss += (v[i][0] * v[i][0] + v[i][1] * v[i][1]) + (v[i][2] * v[i][2] + v[i][3] * v[i][3]); }
#pragma unroll
        for (int o = 1; o < 64; o <<= 1) ss += __shfl_xor(ss, o);
        if (lane < 16) RSS[(size_t)R * 16 + lane] = lane == 0 ? ss : 0.f;
        R = Rn;
    }
}

DI void tr_tile(const float* src, int lds_, bf16_t* dst, int ldd, float* tile, const float* kgain = nullptr) {
    const int tid = ltid();
    __syncthreads();
    { const int r = tid >> 4, c4 = (tid & 15) * 4;
#pragma unroll
      for (int rr = 0; rr < 64; rr += 32) { f32x4 v = __builtin_nontemporal_load((const f32x4*)(src + (size_t)(r + rr) * lds_ + c4)); if (kgain) v = v * kgain[r + rr]; float* tp = tile + (r + rr) * 65 + c4; tp[0] = v[0]; tp[1] = v[1]; tp[2] = v[2]; tp[3] = v[3]; } }
    __syncthreads();
    { const int n = tid >> 3, k8 = (tid & 7) * 8; float f[8];
#pragma unroll
      for (int i = 0; i < 8; ++i) f[i] = tile[(k8 + i) * 65 + n];
      *(u32x4*)(dst + (size_t)n * ldd + k8) = pack8(f); }
}

enum { CV_UP = 1, CV_DN = 2, CV_IN = 4, CV_OUT = 8, CV_SMALL = 16 };
DI void convert_weights(const Params& p, int l, int what, int widx, int nw, unsigned char* lds) {
    float* tile = (float*)lds;
    bf16_t* WIN = (bf16_t*)(p.ws + WS_WIN); bf16_t* WOUT = (bf16_t*)(p.ws + WS_WOUT); bf16_t* WUP = (bf16_t*)(p.ws + WS_WUP); bf16_t* WDN = (bf16_t*)(p.ws + WS_WDN);
    bf16_t* WG = (bf16_t*)(p.ws + WS_WG); bf16_t* GLU = (bf16_t*)(p.ws + WS_GLU);
    const int T_UP = (what & CV_UP) ? 16 * 64 : 0, T_DN = (what & CV_DN) ? 64 * 16 : 0, T_IN = (what & CV_IN) ? 16 * 46 : 0, T_OUT = (what & CV_OUT) ? 16 * 16 : 0, T_WG = (what & CV_SMALL) ? 24 : 0, T_GLU = (what & CV_SMALL) ? 16 : 0;
    for (int it = widx; it < T_UP + T_DN + T_IN + T_OUT + T_WG + T_GLU; it += nw) {
        int i = it;
        if (i < T_UP) { const int kt = i / 64, nt = i % 64;
            tr_tile(p.in[I_WUP] + (size_t)l * 1024 * 4096 + (size_t)kt * 64 * 4096 + nt * 64, 4096, WUP + (size_t)nt * 64 * 1024 + kt * 64, 1024, tile, p.in[I_NMLP] + (size_t)l * D + kt * 64); continue; }
        i -= T_UP;
        if (i < T_DN) { const int kt = i / 16, nt = i % 16;
            tr_tile(p.in[I_WDN] + (size_t)l * 4096 * 1024 + (size_t)kt * 64 * 1024 + nt * 64, 1024, WDN + (size_t)nt * 64 * 4096 + kt * 64, 4096, tile); continue; }
        i -= T_DN;
        if (i < T_IN) { const int kt = i / 46, nt = i % 46;
            const int n0 = nt * 64; const int nd = (n0 >= 2688) ? n0 - 2688 : n0 + 256;
            tr_tile(p.in[I_WIN] + (size_t)l * 1024 * 2944 + (size_t)kt * 64 * 2944 + n0, 2944, WIN + (size_t)nd * 1024 + kt * 64, 1024, tile, p.in[I_NMIX] + (size_t)l * D + kt * 64); continue; }
        i -= T_IN;
        if (i < T_OUT) { const int kt = i / 16, nt = i % 16;
            tr_tile(p.in[I_WOUT] + (size_t)l * 1024 * 1024 + (size_t)kt * 64 * 1024 + nt * 64, 1024, WOUT + (size_t)nt * 64 * 1024 + kt * 64, 1024, tile, p.in[I_MGAIN] + (size_t)l * D + kt * 64); continue; }
        i -= T_OUT;
        if (i < T_WG) { const int n = i / 4, gi = i % 4, d = gi >> 1;
            const float* src = ((gi & 1) ? p.in[I_WI] : p.in[I_WR]) + ((size_t)((l * 2 + d) * 6 + n)) * 4096;
            tr_tile(src, 64, WG + (size_t)(n * 256 + gi * 64) * 64, 64, tile); continue; }
        i -= T_WG;
        { const int kt = i / 4, nt = i % 4;
          tr_tile(p.in[I_GLUW] + (size_t)l * 65536 + (size_t)kt * 64 * 256 + nt * 64, 256, GLU + (size_t)nt * 64 * 256 + kt * 64, 256, tile); }
    }
    if (what & CV_IN)
        for (size_t e = (size_t)widx * 512 + ltid(); e < (size_t)128 * 1024 / 8; e += (size_t)nw * 512) *(u32x4*)(WIN + (size_t)2944 * 1024 + e * 8) = (u32x4){0u, 0u, 0u, 0u};
}

DI void build_s5_mats(const Params& p, int l, int widx, int nw) {
    const float* KTAB = (const float*)((const unsigned char*)p.out + DO_KTAB);
    const float* BBAR = (const float*)((const unsigned char*)p.out + DO_BBAR);
    const float* PAR = (const float*)(p.ws + WS_PAR);
    bf16_t* T2 = (bf16_t*)(p.ws + WS_T2); bf16_t* M1 = (bf16_t*)(p.ws + WS_M1);
    const size_t nT2 = (size_t)16 * 512 * 96, nM1 = (size_t)16 * 256 * 64;
    for (size_t e = (size_t)widx * 512 + ltid(); e < nT2 + nM1; e += (size_t)nw * 512) {
        float f[8];
        if (e < nT2) {
            const int g = (int)(e / (512 * 96)), rem = (int)(e % (512 * 96)), n = rem / 96, k0 = (rem % 96) * 8;
            const int t = n >> 4, hp = n & 15;
            if (k0 < 512) {
                const int s = k0 >> 4, h0 = k0 & 15;
#pragma unroll
                for (int j = 0; j < 8; ++j) {
                    float v = 0.f;
                    if (s <= t) v += KTAB[((size_t)((l * 16 + g) * 2 + 0) * 32 + (t - s)) * 256 + hp * 16 + h0 + j];
                    if (s >= t) v += KTAB[((size_t)((l * 16 + g) * 2 + 1) * 32 + (s - t)) * 256 + hp * 16 + h0 + j];
                    f[j] = v;
                }
            } else {
                const int kk = k0 - 512, d = kk >> 7, part = (kk >> 6) & 1, p0 = kk & 63;
                const int base = (l * 2 + d) * 16 + g;
                const float pw = d == 0 ? (float)(t + 1) : (float)(32 - t);
#pragma unroll
                for (int j = 0; j < 8; ++j) {
                    const int pp = p0 + j;
                    const float ar = PAR[(base * 64 + pp) * 2], ai = PAR[(base * 64 + pp) * 2 + 1];
                    const float mg = expf(pw * ar); float sn, cs; sincosf(pw * ai, &sn, &cs);
                    const float wr_ = mg * cs, wi_ = mg * sn;
                    const float cr = p.in[I_CRE][(size_t)base * 1024 + hp * 64 + pp], ci = p.in[I_CIM][(size_t)base * 1024 + hp * 64 + pp];
                    f[j] = part == 0 ? (cr * wr_ - ci * wi_) : -(cr * wi_ + ci * wr_);
                }
            }
            *(u32x4*)(T2 + ((size_t)(g * 512 + n) * 768 + k0)) = pack8(f);
        } else {
            const size_t e2 = e - nT2;
            const int g = (int)(e2 / (256 * 64)), rem = (int)(e2 % (256 * 64)), n = rem / 64, k0 = (rem % 64) * 8;
            const int d = n >> 7, part = (n >> 6) & 1, pp = n & 63;
            const int s = k0 >> 4, h0 = k0 & 15;
            const int base = (l * 2 + d) * 16 + g;
            const float pw = d == 0 ? (float)(31 - s) : (float)s;
            const float ar = PAR[(base * 64 + pp) * 2], ai = PAR[(base * 64 + pp) * 2 + 1];
            const float mg = expf(pw * ar); float sn, cs; sincosf(pw * ai, &sn, &cs);
            const float wr_ = mg * cs, wi_ = mg * sn;
#pragma unroll
            for (int j = 0; j < 8; ++j) {
                const float br = BBAR[((size_t)(base * 64 + pp) * 16 + h0 + j) * 2], bi = BBAR[((size_t)(base * 64 + pp) * 16 + h0 + j) * 2 + 1];
                f[j] = part == 0 ? (wr_ * br - wi_ * bi) : (wr_ * bi + wi_ * br);
            }
            *(u32x4*)(M1 + ((size_t)(g * 256 + n) * 512 + k0)) = pack8(f);
        }
    }
}

constexpr int PB_OFF = 126976;
constexpr int PB_CW = 0, PB_CB = 1536, PB_BR = 1920, PB_BI = 2688, PB_SP = 3456, PB_LB = 4224;
DI void stage_params(const Params& p, int l, unsigned char* lds) {
    float* PB = (float*)(lds + PB_OFF); const int tid = ltid();
    const float* LB = (const float*)(p.ws + WS_LB);
    for (int i = tid; i < 1536; i += 512) PB[PB_CW + i] = p.in[I_CONVW][(size_t)l * 1536 + i];
    if (tid < 384) PB[PB_CB + tid] = p.in[I_CONVB][(size_t)l * 384 + tid];
    for (int i = tid; i < 768; i += 512) {
        PB[PB_BR + i] = p.in[I_BR][(size_t)l * 768 + i]; PB[PB_BI + i] = p.in[I_BI][(size_t)l * 768 + i];
        PB[PB_SP + i] = log1pf(__expf(-p.in[I_LAM][(size_t)l * 768 + i]));
        const int d = i / 384, c = i % 384; PB[PB_LB + i] = LB[(d * 4 + l) * 384 + c];
    }
}

struct RgPre { u32x4 xa0, xa1, ga, wg[4]; float cin; };
DI RgPre rg_load(const Params& p, int item, bool fin) {
    const int tid = ltid();
    const int j = item / 6, n = item % 6;
    const int row0 = j * 64, pos0 = chunk64_pos0(j), L = chunk64_len(j);
    const bf16_t* PROJ = (const bf16_t*)(p.ws + WS_PROJ); const bf16_t* WG = (const bf16_t*)(p.ws + WS_WG);
    const float* RGC = (const float*)((const unsigned char*)p.out + DO_RGC);
    RgPre r; const u32x4 z = (u32x4){0u, 0u, 0u, 0u};
    const int c8 = (tid & 7) * 8;
    { const int rr = tid >> 3, pos = pos0 + rr - 2; r.xa0 = (pos >= PADR && pos < L) ? __builtin_nontemporal_load((const u32x4*)(PROJ + (size_t)(row0 + rr - 2) * PLD + OFF_AX + n * 64 + c8)) : z; }
    r.xa1 = z;
    if (tid < 24) { const int rr = 64 + (tid >> 3), pos = pos0 + rr - 2; if (pos >= PADR && pos < L) r.xa1 = __builtin_nontemporal_load((const u32x4*)(PROJ + (size_t)(row0 + rr - 2) * PLD + OFF_AX + n * 64 + c8)); }
    r.ga = fin ? __builtin_nontemporal_load((const u32x4*)(PROJ + (size_t)(row0 + (tid >> 3)) * PLD + OFF_AG + n * 64 + c8)) : z;
#pragma unroll
    for (int q = 0; q < 4; ++q) { const int idx = tid + 512 * q; r.wg[q] = *(const u32x4*)(WG + (size_t)(n * 256 + (idx >> 3)) * 64 + (idx & 7) * 8); }
    r.cin = 0.f;
    if (fin) { const int sc = tid & 127, c = sc & 63, d = sc >> 6; r.cin = RGC[((size_t)(j * 2 + d) * 384 + n * 64 + c) * 2 + 1]; }
    return r;
}
DI void rg_compute(const Params& p, int item, bool fin, const RgPre& pre, unsigned char* lds) {
    const int tid = ltid(), lane = tid & 63, wave = tid >> 6;
    const int j = item / 6, n = item % 6;
    const int row0 = j * 64, pos0 = chunk64_pos0(j);
    float* XCF = (float*)lds;
    float* AB = (float*)(lds + 16384);
    bf16_t* WGs = (bf16_t*)(lds + 16384);
    bf16_t* XCB = (bf16_t*)(lds + 16384 + 36864);
    bf16_t* XA = (bf16_t*)(lds + 16384 + 36864 + 9216);
    bf16_t* GA = (bf16_t*)(lds + 16384 + 65536);
    float* SEG = (float*)(lds + 16384 + 65536 + 8192);
    const float* PB = (const float*)(lds + PB_OFF);
    __syncthreads();
    { const int c8 = (tid & 7) * 8;
      *(u32x4*)(XA + (tid >> 3) * 64 + c8) = pre.xa0;
      if (tid < 24) *(u32x4*)(XA + (64 + (tid >> 3)) * 64 + c8) = pre.xa1;
#pragma unroll
      for (int q = 0; q < 4; ++q) { const int idx = tid + 512 * q; *(u32x4*)(WGs + (idx >> 3) * 72 + (idx & 7) * 8) = pre.wg[q]; }
    }
    __syncthreads();
    { const int t = tid >> 3, c8 = (tid & 7) * 8;
      const float* cw = PB + PB_CW + n * 64 + c8; const float* cb = PB + PB_CB + n * 64 + c8;
      float xc[8];
#pragma unroll
      for (int i = 0; i < 8; ++i) xc[i] = cb[i];
#pragma unroll
      for (int jj = 0; jj < 4; ++jj) { float xr[8]; unpack8(*(const u32x4*)(XA + (t + jj) * 64 + c8), xr);
#pragma unroll
          for (int i = 0; i < 8; ++i) xc[i] += cw[jj * 384 + i] * xr[i]; }
      *(f32x4*)(XCF + t * 64 + c8) = (f32x4){xc[0], xc[1], xc[2], xc[3]}; *(f32x4*)(XCF + t * 64 + c8 + 4) = (f32x4){xc[4], xc[5], xc[6], xc[7]};
      *(u32x4*)(XCB + t * 72 + c8) = pack8(xc); }
    __syncthreads();
    const int rb = wave & 3, dir = wave >> 2;
    f32x4 acc[8];
#pragma unroll
    for (int c = 0; c < 8; ++c) acc[c] = mma_tile64(XCB + rb * 16 * 72, WGs + (dir * 8 + c) * 16 * 72, 72, lane, (f32x4){0.f, 0.f, 0.f, 0.f});
    __syncthreads();
    { const int cl = lane & 15, q = lane >> 4;
#pragma unroll
      for (int cc = 0; cc < 4; ++cc) {
          const int c = cc * 16 + cl, ch = n * 64 + c;
          const float brv = PB[PB_BR + dir * 384 + ch], biv = PB[PB_BI + dir * 384 + ch], sp = PB[PB_SP + dir * 384 + ch];
#pragma unroll
          for (int jj = 0; jj < 4; ++jj) {
              const int t = rb * 16 + q * 4 + jj;
              const float r = sigmoidf_(acc[cc][jj] + brv), ig = sigmoidf_(acc[cc + 4][jj] + biv);
              const float la = -8.0f * r * sp;
              const float xx = -2.0f * la;
              float a = __expf(la);
              const float om = xx < 0.125f ? xx * (1.0f - xx * (0.5f - xx * (0.16666667f - xx * 0.041666668f))) : 1.0f - a * a;
              float b = __builtin_amdgcn_sqrtf(fmaxf(om, 0.f)) * ig * XCF[t * 64 + c];
              if (pos0 + t < PADR) { a = 1.0f; b = 0.f; }
              AB[(dir * 2) * 4096 + t * 64 + c] = a; AB[(dir * 2 + 1) * 4096 + t * 64 + c] = b;
          } } }
    __syncthreads();
    float* RGC = (float*)((unsigned char*)p.out + DO_RGC);
    const int sc = tid & 127, seg = tid >> 7, sch = sc & 63, sd = sc >> 6;
    const float* Aa = AB + (sd * 2) * 4096 + sch; float* Bb = AB + (sd * 2 + 1) * 4096 + sch;
    { float P = 1.f, E = 0.f;
#pragma unroll
      for (int u = 0; u < 16; ++u) { const int uu = seg * 16 + u, t = sd == 0 ? uu : 63 - uu; const float a = Aa[t * 64]; E = a * E + Bb[t * 64]; P *= a; }
      SEG[(sc * 4 + seg) * 2] = P; SEG[(sc * 4 + seg) * 2 + 1] = E; }
    __syncthreads();
    if (!fin) {
        if (tid < 128) { float Pt = 1.f, Et = 0.f;
#pragma unroll
            for (int q = 0; q < 4; ++q) { const float Ps = SEG[(tid * 4 + q) * 2], Es = SEG[(tid * 4 + q) * 2 + 1]; Et = Ps * Et + Es; Pt *= Ps; }
            float* cp = RGC + ((size_t)(j * 2 + sd) * 384 + n * 64 + sch) * 2; cp[0] = Pt; cp[1] = Et; }
        return;
    }
    { float h = pre.cin;
      for (int q = 0; q < seg; ++q) h = SEG[(sc * 4 + q) * 2] * h + SEG[(sc * 4 + q) * 2 + 1];
#pragma unroll
      for (int u = 0; u < 16; ++u) { const int uu = seg * 16 + u, t = sd == 0 ? uu : 63 - uu; h = Aa[t * 64] * h + Bb[t * 64]; Bb[t * 64] = h; } }
    __syncthreads();
    { const int t = tid >> 3, c8 = (tid & 7) * 8;
      bf16_t* YM = (bf16_t*)(p.ws + WS_ACT); float* SS = (float*)(p.ws + WS_SS);
      const bool valid = pos0 + t >= PADR;
      float y[8], ss = 0.f;
      float gg[8]; unpack8(pre.ga, gg);
      const f32x4 h0a = *(const f32x4*)(AB + 1 * 4096 + t * 64 + c8), h0b = *(const f32x4*)(AB + 1 * 4096 + t * 64 + c8 + 4), h1a = *(const f32x4*)(AB + 3 * 4096 + t * 64 + c8), h1b = *(const f32x4*)(AB + 3 * 4096 + t * 64 + c8 + 4);
#pragma unroll
      for (int i = 0; i < 8; ++i) { const float hs = i < 4 ? h0a[i & 3] + h1a[i & 3] : h0b[i & 3] + h1b[i & 3];
          const float o = valid ? hs * gelu_tanh(gg[i]) : 0.f; y[i] = o; ss += o * o; }
      *(u32x4*)(YM + (size_t)(row0 + t) * D + n * 64 + c8) = pack8(y);
      ss += __shfl_xor(ss, 1); ss += __shfl_xor(ss, 2); ss += __shfl_xor(ss, 4);
      if ((tid & 7) == 0) SS[(size_t)(row0 + t) * 16 + n] = ss; }
}

struct HgPre { u32x4 xi, xff, xfb, xq, xg, s0, s1; };
DI HgPre hg_load(const Params& p, int item, bool fin) {
    const int tid = ltid();
    const int j = item / 6, n = item % 6, row0 = j * 64;
    const int t = tid >> 3, k8 = (tid & 7) * 8;
    const bf16_t* rowp = (const bf16_t*)(p.ws + WS_PROJ) + (size_t)(row0 + t) * PLD + n * 64 + k8;
    const bf16_t* HGS = (const bf16_t*)((const unsigned char*)p.out + DO_HGS);
    HgPre r; const u32x4 z = (u32x4){0u, 0u, 0u, 0u};
    r.xi = __builtin_nontemporal_load((const u32x4*)(rowp + OFF_BI)); r.xff = __builtin_nontemporal_load((const u32x4*)(rowp + OFF_BFF)); r.xfb = __builtin_nontemporal_load((const u32x4*)(rowp + OFF_BFB));
    r.xq = z; r.xg = z; r.s0 = z; r.s1 = z;
    if (fin) {
        r.xq = __builtin_nontemporal_load((const u32x4*)(rowp + OFF_BQ)); r.xg = __builtin_nontemporal_load((const u32x4*)(rowp + OFF_BG));
        const bf16_t* s0 = HGS + ((size_t)(j * 6 + n) * 2 + 0) * 4096 + t * 64 + k8;
        r.s0 = __builtin_nontemporal_load((const u32x4*)s0); r.s1 = __builtin_nontemporal_load((const u32x4*)(s0 + 4096));
    }
    return r;
}
DI void hg_compute(const Params& p, int item, bool fin, const HgPre& pre, unsigned char* lds) {
    const int tid = ltid(), lane = tid & 63, wave = tid >> 6;
    const int j = item / 6, n = item % 6;
    const int row0 = j * 64, pos0 = chunk64_pos0(j);
    float* LF = (float*)lds;
    bf16_t* QT = (bf16_t*)(lds + 32768);
    bf16_t* KT = (bf16_t*)(lds + 51200);
    bf16_t* VT = (bf16_t*)(lds + 69632);
    bf16_t* SC = (bf16_t*)(lds + 78848);
    bf16_t* SP = (bf16_t*)(lds + 97280);
    bf16_t* XG = (bf16_t*)(lds + 115712);
    float* SEGT = (float*)(lds + 123904);
    float* OX = (float*)lds;
    const float* PB = (const float*)(lds + PB_OFF);
    bf16_t* HGS = (bf16_t*)((unsigned char*)p.out + DO_HGS);
    float* HGD = (float*)(p.ws + WS_HGD);
    const int t = tid >> 3, k8 = (tid & 7) * 8;
    const bool masked = pos0 + t < PADR;
    __syncthreads();
    float kk[2][8], q[8];
    {
        float xf[8], xv[8];
        unpack8(pre.xi, xv);
#pragma unroll
        for (int i = 0; i < 8; ++i) VT[(k8 + i) * 72 + t] = f2bf(masked ? 0.f : xv[i]);
#pragma unroll
        for (int d = 0; d < 2; ++d) {
            unpack8(d == 0 ? pre.xff : pre.xfb, xf);
#pragma unroll
            for (int i = 0; i < 8; ++i) {
                const float lb = PB[PB_LB + d * 384 + n * 64 + k8 + i];
                const float sg = sigmoidf_(xf[i]);
                const float f = lb + (1.0f - lb) * sg;
                kk[d][i] = masked ? 0.f : (1.0f - lb) * (1.0f - sg);
                LF[d * 4096 + t * 64 + k8 + i] = masked ? 0.f : __logf(f);
            }
        }
        unpack8(pre.xq, q);
#pragma unroll
        for (int i = 0; i < 8; ++i) q[i] = siluf_(q[i]);
        if (fin) *(u32x4*)(XG + t * 64 + k8) = pre.xg;
    }
    __syncthreads();
    { const int sc = tid & 127, seg = tid >> 7, k = sc & 63, d = sc >> 6; float run = 0.f; float* lf = LF + d * 4096 + k;
#pragma unroll
      for (int u = 0; u < 16; ++u) { const int uu = seg * 16 + u, s_ = d == 0 ? uu : 63 - uu; run += lf[s_ * 64]; lf[s_ * 64] = run; }
      SEGT[sc * 4 + seg] = run;
      __syncthreads();
      float off = 0.f;
      for (int q2 = 0; q2 < seg; ++q2) off += SEGT[sc * 4 + q2];
      if (seg > 0) {
#pragma unroll
          for (int u = 0; u < 16; ++u) { const int uu = seg * 16 + u, s_ = d == 0 ? uu : 63 - uu; lf[s_ * 64] += off; } } }
    __syncthreads();
    const int rb = wave & 3, dir = wave >> 2, cl = lane & 15, qd = lane >> 4;
    if (!fin) {
#pragma unroll
        for (int d = 0; d < 2; ++d)
#pragma unroll
            for (int i = 0; i < 8; ++i) {
                const int k = k8 + i; const float tot = d == 0 ? LF[63 * 64 + k] : LF[4096 + k];
                KT[d * 4608 + k * 72 + t] = f2bf(kk[d][i] * __expf(tot - LF[d * 4096 + t * 64 + k]));
                if (t == 0) HGD[((size_t)(j * 6 + n) * 2 + d) * 64 + k] = __expf(tot);
            }
        __syncthreads();
#pragma unroll
        for (int kb = 0; kb < 4; ++kb) {
            const f32x4 a = mma_tile64(VT + rb * 16 * 72, KT + dir * 4608 + kb * 16 * 72, 72, lane, (f32x4){0.f, 0.f, 0.f, 0.f});
            bf16_t* dst = HGS + ((size_t)(j * 6 + n) * 2 + dir) * 4096;
#pragma unroll
            for (int jj = 0; jj < 4; ++jj) dst[(rb * 16 + qd * 4 + jj) * 64 + kb * 16 + cl] = f2bf(a[jj]);
        }
        return;
    }
#pragma unroll
    for (int d = 0; d < 2; ++d) {
        float qv[8], kv[8];
#pragma unroll
        for (int i = 0; i < 8; ++i) {
            const int k = k8 + i; const float m = LF[d * 4096 + 32 * 64 + k];
            const float e1 = fminf(fmaxf(LF[d * 4096 + t * 64 + k] - m, -80.f), 80.f);
            qv[i] = q[i] * __expf(e1); kv[i] = kk[d][i] * __expf(-e1);
        }
        *(u32x4*)(QT + d * 4608 + t * 72 + k8) = pack8(qv);
        *(u32x4*)(KT + d * 4608 + t * 72 + k8) = pack8(kv);
        float sv[8]; unpack8(d == 0 ? pre.s0 : pre.s1, sv);
#pragma unroll
        for (int i = 0; i < 8; ++i) sv[i] *= __expf(LF[d * 4096 + 32 * 64 + k8 + i]);
        *(u32x4*)(SP + d * 4608 + t * 72 + k8) = pack8(sv);
    }
    __syncthreads();
#pragma unroll
    for (int ct = 0; ct < 4; ++ct) {
        const f32x4 a = mma_tile64(QT + dir * 4608 + rb * 16 * 72, KT + dir * 4608 + ct * 16 * 72, 72, lane, (f32x4){0.f, 0.f, 0.f, 0.f});
#pragma unroll
        for (int jj = 0; jj < 4; ++jj) {
            const int tt = rb * 16 + qd * 4 + jj, s_ = ct * 16 + cl;
            const bool keep = dir == 0 ? (s_ <= tt) : (s_ >= tt);
            SC[dir * 4608 + tt * 72 + s_] = f2bf(keep ? a[jj] : 0.f);
        }
    }
    __syncthreads();
    f32x4 o[4];
#pragma unroll
    for (int vt = 0; vt < 4; ++vt) {
        f32x4 a = mma_tile64(SC + dir * 4608 + rb * 16 * 72, VT + vt * 16 * 72, 72, lane, (f32x4){0.f, 0.f, 0.f, 0.f});
        o[vt] = mma_tile64(QT + dir * 4608 + rb * 16 * 72, SP + dir * 4608 + vt * 16 * 72, 72, lane, a);
    }
#pragma unroll
    for (int vt = 0; vt < 4; ++vt)
#pragma unroll
        for (int jh = 0; jh < 2; ++jh) { const int jj = dir == 0 ? 2 + jh : jh; const float val = dir == 0 ? o[vt][2 + jh] : o[vt][jh];
            OX[(rb * 16 + qd * 4 + jj) * 64 + vt * 16 + cl] = val; }
    __syncthreads();
    {
        bf16_t* YM = (bf16_t*)(p.ws + WS_ACT); float* SS = (float*)(p.ws + WS_SS);
#pragma unroll
        for (int jh = 0; jh < 2; ++jh) {
            const int jj = dir * 2 + jh;
            const int tt = rb * 16 + qd * 4 + jj;
            float ov[4], sq = 0.f;
#pragma unroll
            for (int vt = 0; vt < 4; ++vt) { const float own = dir == 0 ? o[vt][jh] : o[vt][2 + jh]; ov[vt] = own + OX[tt * 64 + vt * 16 + cl]; sq += ov[vt] * ov[vt]; }
            sq += __shfl_xor(sq, 1); sq += __shfl_xor(sq, 2); sq += __shfl_xor(sq, 4); sq += __shfl_xor(sq, 8);
            const float rn = rsqrtf(sq * (1.0f / 64.0f) + EPS);
            const bool valid = pos0 + tt >= PADR;
            float s2 = 0.f;
#pragma unroll
            for (int vt = 0; vt < 4; ++vt) {
                const int v = vt * 16 + cl;
                const float y = valid ? ov[vt] * rn * siluf_(bf2f(XG[tt * 64 + v])) : 0.f;
                s2 += y * y;
                YM[(size_t)(row0 + tt) * D + 384 + n * 64 + v] = f2bf(y);
            }
            s2 += __shfl_xor(s2, 1); s2 += __shfl_xor(s2, 2); s2 += __shfl_xor(s2, 4); s2 += __shfl_xor(s2, 8);
            if (cl == 0) SS[(size_t)(row0 + tt) * 16 + 6 + n] = s2;
        }
    }
}

constexpr int CG = 33;
DI void phase_carries(const Params& p, int l) {
    bf16_t* HGS = (bf16_t*)((unsigned char*)p.out + DO_HGS);
    const float* HGD = (const float*)(p.ws + WS_HGD);
    float* RGC = (float*)((unsigned char*)p.out + DO_RGC);
    const float* S5E = (const float*)((const unsigned char*)p.out + DO_S5E);
    bf16_t* U2 = (bf16_t*)(p.ws + WS_U2);
    const float* PAR = (const float*)(p.ws + WS_PAR);
    const int N_HG = 12 * 6 * 2 * 2048, N_RG = 12 * 2 * 384, N_S5 = 12 * 16 * 2 * 64;
    for (int idx = lbid() * 512 + ltid(); idx < N_HG + N_RG + N_S5; idx += lgdim() * 512) {
        if (idx < N_HG) {
            const int seq = idx / 24576, rem = idx % 24576, n = rem / 4096, d = (rem >> 11) & 1, e2 = rem & 2047, k = (e2 * 2) & 63;
            int c0, nc; seq_chunks64(seq, c0, nc);
            unsigned* HG32 = (unsigned*)HGS;
            float S0 = 0.f, S1 = 0.f;
            for (int i0 = 0; i0 < nc; i0 += CG) {
                unsigned loc[CG]; float dec0[CG], dec1[CG];
#pragma unroll
                for (int u = 0; u < CG; ++u) { const int i = i0 + u; if (i < nc) { const int jc = d == 0 ? c0 + i : c0 + nc - 1 - i; const size_t b = (size_t)(jc * 6 + n) * 2 + d; loc[u] = __builtin_nontemporal_load(HG32 + b * 2048 + e2); dec0[u] = HGD[b * 64 + k]; dec1[u] = HGD[b * 64 + k + 1]; } else { loc[u] = 0u; dec0[u] = 0.f; dec1[u] = 0.f; } }
#pragma unroll
                for (int u = 0; u < CG; ++u) { const int i = i0 + u; if (i < nc) { const int jc = d == 0 ? c0 + i : c0 + nc - 1 - i; const size_t b = (size_t)(jc * 6 + n) * 2 + d; HG32[b * 2048 + e2] = pack2(S0, S1); S0 = dec0[u] * S0 + bflo(loc[u]); S1 = dec1[u] * S1 + bfhi(loc[u]); } }
            }
        } else if (idx < N_HG + N_RG) {
            const int i2 = idx - N_HG; const int seq = i2 / 768, rem = i2 % 768, d = rem / 384, ch = rem % 384;
            int c0, nc; seq_chunks64(seq, c0, nc);
            float c = 0.f;
            for (int i0 = 0; i0 < nc; i0 += CG) {
                float P[CG], E[CG];
#pragma unroll
                for (int u = 0; u < CG; ++u) { const int i = i0 + u; if (i < nc) { const int jc = d == 0 ? c0 + i : c0 + nc - 1 - i; const float* cp = RGC + ((size_t)(jc * 2 + d) * 384 + ch) * 2; P[u] = cp[0]; E[u] = cp[1]; } else { P[u] = 0.f; E[u] = 0.f; } }
#pragma unroll
                for (int u = 0; u < CG; ++u) { const int i = i0 + u; if (i < nc) { const int jc = d == 0 ? c0 + i : c0 + nc - 1 - i; float* cp = RGC + ((size_t)(jc * 2 + d) * 384 + ch) * 2; cp[1] = c; c = P[u] * c + E[u]; } }
            }
        } else {
            const int i2 = idx - N_HG - N_RG; const int seq = i2 / 2048, g = (i2 >> 7) & 15, d = (i2 >> 6) & 1, pp = i2 & 63;
            int c0, nc; seq_chunks32(seq, c0, nc);
            const int base = (l * 2 + d) * 16 + g;
            const float ar = PAR[(base * 64 + pp) * 2], ai = PAR[(base * 64 + pp) * 2 + 1];
            const float mg = expf(32.0f * ar); float sn, cs; sincosf(32.0f * ai, &sn, &cs);
            const float wr_ = mg * cs, wi_ = mg * sn;
            float hr = 0.f, hi = 0.f;
            for (int i0 = 0; i0 < nc; i0 += CG) {
                float er[CG], ei[CG];
#pragma unroll
                for (int u = 0; u < CG; ++u) { const int i = i0 + u; if (i < nc) { const int c = d == 0 ? c0 + i : c0 + nc - 1 - i; const size_t ro = (size_t)(g * U2ROWS + c); er[u] = __builtin_nontemporal_load(S5E + ro * 256 + d * 128 + pp); ei[u] = __builtin_nontemporal_load(S5E + ro * 256 + d * 128 + 64 + pp); } else { er[u] = 0.f; ei[u] = 0.f; } }
#pragma unroll
                for (int u = 0; u < CG; ++u) { const int i = i0 + u; if (i < nc) { const int c = d == 0 ? c0 + i : c0 + nc - 1 - i; const size_t ro = (size_t)(g * U2ROWS + c);
                    U2[ro * U2LD + 512 + d * 128 + pp] = f2bf(hr); U2[ro * U2LD + 512 + d * 128 + 64 + pp] = f2bf(hi);
                    const float nr = wr_ * hr - wi_ * hi + er[u], ni = wr_ * hi + wi_ * hr + ei[u]; hr = nr; hi = ni; } }
            }
        }
    }
}

struct MnPre { u32x4 y; f32x4 s0, s1, s2, s3, g0, g1; };
DI MnPre mn_load(const bf16_t* YM, const float* SS, const float* gain, size_t e) {
    const int R = (int)(e >> 7), c0 = (int)(e & 127) * 8; const float* sp = SS + (size_t)R * 16;
    MnPre r; r.y = __builtin_nontemporal_load((const u32x4*)(YM + (size_t)R * D + c0));
    r.s0 = *(const f32x4*)sp; r.s1 = *(const f32x4*)(sp + 4); r.s2 = *(const f32x4*)(sp + 8); r.s3 = *(const f32x4*)(sp + 12);
    r.g0 = *(const f32x4*)(gain + c0); r.g1 = *(const f32x4*)(gain + c0 + 4);
    return r;
}
DI void phase_mixnorm(const Params& p, int l) {
    bf16_t* YM = (bf16_t*)(p.ws + WS_ACT); const float* SS = (const float*)(p.ws + WS_SS);
    const float* gain = p.in[I_MGAIN] + (size_t)l * D;
    const size_t N = (size_t)MP * 128, stride = (size_t)lgdim() * 512;
    size_t e = (size_t)lbid() * 512 + ltid();
    if (e >= N) return;
    MnPre nx = mn_load(YM, SS, gain, e);
    while (e < N) {
        const MnPre cur = nx; const size_t en = e + stride;
        if (en < N) nx = mn_load(YM, SS, gain, en);
        const int R = (int)(e >> 7), c0 = (int)(e & 127) * 8;
        const int br = c0 < 384 ? 0 : (c0 < 768 ? 1 : 2);
        const float inv = br == 2 ? (1.0f / 256.0f) : (1.0f / 384.0f);
        const f32x4 s0 = cur.s0, s1 = cur.s1, s2 = cur.s2, s3 = cur.s3;
        const float tot = br == 0 ? (((s0[0] + s0[1]) + (s0[2] + s0[3])) + (s1[0] + s1[1])) : (br == 1 ? (((s1[2] + s1[3]) + (s2[0] + s2[1])) + (s2[2] + s2[3])) : ((s3[0] + s3[1]) + (s3[2] + s3[3])));
        const float rn = rsqrtf(tot * inv + EPS);
        float f[8]; unpack8(cur.y, f);
#pragma unroll
        for (int i = 0; i < 4; ++i) { f[i] = f[i] * rn * cur.g0[i]; f[4 + i] = f[4 + i] * rn * cur.g1[i]; }
        *(u32x4*)(YM + (size_t)R * D + c0) = pack8(f);
        e = en;
    }
}

DI void phase_combine(const Params& p) {
    const int tid = ltid(); const int lane = tid & 63, wave = tid >> 6;
    bf16_t* H = (bf16_t*)(p.ws + WS_H); float* RSS = (float*)(p.ws + WS_RSS);
    const float* P = (const float*)((const unsigned char*)p.out + DO_PART);
    for (int rr = lbid() * 8 + wave; rr < 768; rr += lgdim() * 8) {
        const int R = 32768 + rr;
        float ss = 0.f;
        u32x2 ho[4]; f32x4 pp[4][4];
#pragma unroll
        for (int q = 0; q < 4; ++q) { const int col = lane * 16 + q * 4; ho[q] = *(const u32x2*)(H + (size_t)R * D + col);
#pragma unroll
            for (int ks = 0; ks < 4; ++ks) pp[q][ks] = *(const f32x4*)(P + ((size_t)ks * 768 + rr) * D + col); }
#pragma unroll
        for (int q = 0; q < 4; ++q) {
            const int col = lane * 16 + q * 4;
            f32x4 h = (f32x4){bflo(ho[q].x), bfhi(ho[q].x), bflo(ho[q].y), bfhi(ho[q].y)};
#pragma unroll
            for (int ks = 0; ks < 4; ++ks) h = h + pp[q][ks];
            u32x2 w; w.x = pack2(h[0], h[1]); w.y = pack2(h[2], h[3]); *(u32x2*)(H + (size_t)R * D + col) = w;
            ss += (h[0] * h[0] + h[1] * h[1]) + (h[2] * h[2] + h[3] * h[3]);
        }
        ss += __shfl_xor(ss, 1); ss += __shfl_xor(ss, 2);
        if ((lane & 3) == 0) RSS[(size_t)R * 16 + (lane >> 2)] = ss;
    }
}

DI int out_row_to_R(int O) { if (O < 16384) return (O >> 12) * LP + 64 + (O & 4095); const int o2 = O - 16384; return ROWS_P + (o2 >> 11) * LS + 64 + (o2 & 2047); }
DI void phase_final(const Params& p) {
    const int tid = ltid(); const int lane = tid & 63, wave = tid >> 6;
    const bf16_t* H = (const bf16_t*)(p.ws + WS_H); const float* gain = p.in[I_NFIN];
    f32x4 gg[4];
#pragma unroll
    for (int i = 0; i < 4; ++i) gg[i] = *(const f32x4*)(gain + (lane + 64 * i) * 4);
    const int stride = lgdim() * 8;
    int O = lbid() * 8 + wave;
    if (O >= 32768) return;
    u32x2 nx[4];
#pragma unroll
    for (int i = 0; i < 4; ++i) nx[i] = __builtin_nontemporal_load((const u32x2*)(H + (size_t)out_row_to_R(O) * D + (lane + 64 * i) * 4));
    while (O < 32768) {
        u32x2 cur[4];
#pragma unroll
        for (int i = 0; i < 4; ++i) cur[i] = nx[i];
        const int On = O + stride;
        if (On < 32768) {
#pragma unroll
            for (int i = 0; i < 4; ++i) nx[i] = __builtin_nontemporal_load((const u32x2*)(H + (size_t)out_row_to_R(On) * D + (lane + 64 * i) * 4));
        }
        f32x4 v[4]; float ss = 0.f;
#pragma unroll
        for (int i = 0; i < 4; ++i) { v[i] = (f32x4){bflo(cur[i].x), bfhi(cur[i].x), bflo(cur[i].y), bfhi(cur[i].y)}; ss += (v[i][0] * v[i][0] + v[i][1] * v[i][1]) + (v[i][2] * v[i][2] + v[i][3] * v[i][3]); }
#pragma unroll
        for (int o = 1; o < 64; o <<= 1) ss += __shfl_xor(ss, o);
        const float rn = rsqrtf(ss * (1.0f / D) + EPS);
        float* dst = p.out + (size_t)O * D;
#pragma unroll
        for (int i = 0; i < 4; ++i) __builtin_nontemporal_store(v[i] * rn * gg[i], (f32x4*)(dst + (lane + 64 * i) * 4));
        O = On;
    }
}

#define XB_TMO      128
#define XB_XCNT(j)  (256  + 64 * (j))
#define XB_XSUB(j)  (1280 + 64 * (j))
#define XB_XGEN(j)  (2304 + 64 * (j))
#define XB_TOP      3328
#define XB_TOPGEN   3392
#define XCD_BAR_WORDS 3456
#define XB_SPIN_CAP (1u << 18)
DI unsigned xb_ld(unsigned* p)              { return __hip_atomic_load(p, __ATOMIC_RELAXED, __HIP_MEMORY_SCOPE_AGENT); }
DI unsigned xb_add(unsigned* p, unsigned v) { return __hip_atomic_fetch_add(p, v, __ATOMIC_RELAXED, __HIP_MEMORY_SCOPE_AGENT); }
DI unsigned xb_xcc_id() { return (unsigned)__builtin_amdgcn_s_getreg((3 << 11) | 20) & 0xFu; }
#define XB_SPIN(cond, bar) do { unsigned _sp = 0; while (cond) { __builtin_amdgcn_s_sleep(1); \
    if ((++_sp & 255u) == 0u) { if (xb_ld(&(bar)[XB_TMO])) break; if (_sp > XB_SPIN_CAP) { atomicAdd(&(bar)[XB_TMO], 1u); break; } } } } while (0)
struct XcdBarrier { unsigned* bar; unsigned x; volatile LAS unsigned* st; };
DI XcdBarrier xcd_barrier_post(unsigned* bar, volatile LAS unsigned* st) {
    XcdBarrier b; b.bar = bar; b.x = xb_xcc_id(); b.st = st;
    if (threadIdx.x == 0) (void)xb_add(&bar[XB_XCNT(b.x)], 1u);
    return b;
}
DI void xcd_barrier_complete(unsigned* bar, unsigned x, unsigned& nloc, unsigned& nx) {
    const unsigned G = gridDim.x * gridDim.y * gridDim.z;
    unsigned sum, cnt, mine, sp = 0u;
    for (;;) {
        sum = 0u; cnt = 0u; mine = 0u;
#pragma unroll
        for (unsigned j = 0; j < 16; ++j) { const unsigned c = xb_ld(&bar[XB_XCNT(j)]); sum += c; cnt += (c > 0u) ? 1u : 0u; mine = (j == x) ? c : mine; }
        if (sum == G) break;
        __builtin_amdgcn_s_sleep(1);
        if ((++sp & 255u) == 0u) { if (xb_ld(&bar[XB_TMO])) break; if (sp > XB_SPIN_CAP) { atomicAdd(&bar[XB_TMO], 1u); break; } }
    }
    nloc = mine > 0u ? mine : 1u; nx = cnt > 0u ? cnt : 1u;
}
DI void xcd_barrier(const XcdBarrier& b) {
    asm volatile("s_waitcnt vmcnt(0)" ::: "memory");
    __syncthreads();
    if (threadIdx.x == 0) {
        unsigned* bar = b.bar;
        __builtin_amdgcn_s_waitcnt(0);
        unsigned nloc = b.st[0], nx = b.st[1];
        if (nloc == 0u) { xcd_barrier_complete(bar, b.x, nloc, nx); b.st[0] = nloc; b.st[1] = nx; }
        const unsigned old = xb_add(&bar[XB_XSUB(b.x)], 1u);
        const unsigned gen = old / nloc;
        if (old + 1u == (gen + 1u) * nloc) {
            __builtin_amdgcn_fence(__ATOMIC_RELEASE, "agent");
            asm volatile("s_waitcnt vmcnt(0)" ::: "memory");
            const unsigned og = xb_add(&bar[XB_TOP], 1u);
            const unsigned tg = og / nx;
            if (og + 1u == (tg + 1u) * nx) xb_add(&bar[XB_TOPGEN], 1u);
            else XB_SPIN(xb_ld(&bar[XB_TOPGEN]) == tg, bar);
            __builtin_amdgcn_fence(__ATOMIC_ACQUIRE, "agent");
            xb_add(&bar[XB_XGEN(b.x)], 1u);
            asm volatile("s_waitcnt vmcnt(0)" ::: "memory");
        } else {
            XB_SPIN(xb_ld(&bar[XB_XGEN(b.x)]) == gen, bar);
            __builtin_amdgcn_fence(__ATOMIC_ACQUIRE, "agent");
            asm volatile("s_waitcnt vmcnt(0)" ::: "memory");
        }
    }
    __syncthreads();
}

DI int item_start(int c, int ng, int G, int NI, float pa, float per) {
    if (c >= G) return NI;
    const float f = c <= ng ? __fmul_rn(pa, (float)c) : __fadd_rn(__fmul_rn(pa, (float)ng), __fmul_rn(per, (float)(c - ng)));
    const int i = (int)__fadd_rn(f, 0.5f);
    return i > NI ? NI : i;
}

constexpr int NPHASE = 2 + 9 * DEPTH;
enum { GM_NONE = 0, GM_INPROJ, GM_RESADD, GM_RELU2, GM_S5E, GM_S5Y, GM_GLU };

struct EpiAny {
    const pg8::Gemm* g;
    DI bool mixn() const { return g->mixn != 0; }
    DI void mix_rescale(f32x4 (&acc)[2][2][4][2], LAS unsigned char* lds, int par, int t, int wr, int fr) const {
#pragma unroll
        for (int ai = 0; ai < 2; ++ai)
#pragma unroll
            for (int m = 0; m < 4; ++m) { float rA, rB, rC; mn_get(lds, par, wr * 64 + fr + ai * 128 + m * 16, rA, rB, rC);
                const float ratio = t == 6 ? rA * __builtin_amdgcn_rcpf(rB) : rB * __builtin_amdgcn_rcpf(rC);
#pragma unroll
                for (int bj = 0; bj < 2; ++bj)
#pragma unroll
                    for (int n = 0; n < 2; ++n) acc[ai][bj][m][n] = acc[ai][bj][m][n] * ratio; }
    }
    DI void prime_commit(LAS unsigned char* lds, int tid, const f32x4& a, const f32x4& b) const { if (g->mixn) mn_commit(lds, 0, tid, a, b); else rs_commit(lds, 0, tid, a, b); }
    DI bool prime_issue(const Unit& u, int tid, f32x4& a, f32x4& b) const {
        const bool m = (g->mode == GM_INPROJ || g->mode == GM_RELU2 || g->mixn);
        if (m) rs_issue(g->mixn ? (const float*)g->i1 : (const float*)g->i0, u.pm, tid, a, b);
        return m;
    }
    DI void operator()(const f32x4 (&acc)[2][2][4][2], const Unit& u, int wr, int wc, int fr, int fq, LAS unsigned char* lds, bool has_next, const Unit& nx, int par) const {
        asm volatile("" : "+v"(fr), "+v"(fq));
        asm volatile("" : "+s"(wr), "+s"(wc));
        switch (g->mode) {
        case GM_INPROJ: { EpiInProj E{(bf16_t*)g->o0, (bf16_t*)g->o1, (const float*)g->i0}; E(acc, u, wr, wc, fr, fq, lds, has_next, nx, par); } break;
        case GM_RESADD: if (g->sched == 3 && u.pm >= 128) { EpiPart E{(float*)const_cast<void*>(g->i1)}; E(acc, u, wr, wc, fr, fq); }
                        else { EpiResAdd E{(bf16_t*)g->o0, (float*)const_cast<void*>(g->i0)}; E(acc, u, wr, wc, fr, fq, g->mixn ? (const float*)g->i1 : nullptr, lds, has_next, nx, par); } break;
        case GM_RELU2:  { EpiRelu2 E{(bf16_t*)g->o0, (const float*)g->i0}; E(acc, u, wr, wc, fr, fq, lds, has_next, nx, par); } break;
        case GM_S5E:    { EpiS5E E{(float*)g->o0}; E(acc, u, wr, wc, fr, fq); } break;
        case GM_S5Y:    { EpiS5Y E{(const bf16_t*)g->i0, (bf16_t*)g->o0, (const float*)g->i1}; E(acc, u, wr, wc, fr, fq); } break;
        default:        { EpiGlu E{(const bf16_t*)g->i0, (bf16_t*)g->o0, (float*)g->o1, (const float*)g->i1}; E(acc, u, wr, wc, fr, fq); } break;
        }
    }
};

__global__ void __launch_bounds__(512, 2) mega(Params p) {
    extern __shared__ __attribute__((aligned(16))) unsigned char lds[];
    cg::grid_group grid = cg::this_grid();
    LAS unsigned char* ldsl = (LAS unsigned char*)lds;
    volatile LAS unsigned* xbst = (volatile LAS unsigned*)(ldsl + LDS_BYTES - 16);
    if (threadIdx.x < 4) xbst[threadIdx.x] = 0u;
    __syncthreads();
    const XcdBarrier xbar = xcd_barrier_post((unsigned*)(p.ws + WS_BAR), xbst);

#ifdef PROBE_DOUBLE_MASK
    bool rep = false;
#endif
    for (int ph = p.ph_lo; ph < p.ph_hi; ++ph) {
        const int l = ph >= 1 ? (ph - 1) / 9 : 0, si = ph >= 1 ? (ph - 1) % 9 : 0;
        const int s = (ph == 0) ? 100 : (ph == NPHASE - 1 ? 101 : (si < 5 ? si + 1 : (si == 5 ? 7 : si + 3)));
        unsigned char* ws = p.ws; unsigned char* ob = (unsigned char*)p.out; asm volatile("" : "+s"(ws), "+s"(ob));
        const int G = lgdim(), c = lbid();
#ifdef PROBE_TS_MASK
        if (blockIdx.x == 0 && threadIdx.x == 0) ((unsigned long long*)(p.ws + WS_TS))[ph] = __builtin_amdgcn_s_memrealtime();
#endif
        pg8::Gemm g; g.mixn = 0; g.mode = GM_NONE; g.perm = 0; g.sched = 0; g.M = MP; g.N = 0; g.o0 = nullptr; g.o1 = nullptr; g.i0 = nullptr; g.i1 = nullptr; g.A = nullptr; g.Bt = nullptr; g.K = 0; g.lda = 0; g.ldb = 0;
        switch (s) {
        case 1:  g.mode = GM_INPROJ; g.perm = 1; g.A = (const bf16_t*)(ws + WS_H); g.Bt = (const bf16_t*)(ws + WS_WIN); g.K = 1024; g.lda = 1024; g.ldb = 1024; g.N = 3072; g.o0 = ws + WS_PROJ; g.o1 = ws + WS_U2; g.i0 = ws + WS_RSS; break;
        case 2:  g.mode = GM_S5E; g.sched = 1; g.A = (const bf16_t*)(ws + WS_U2); g.Bt = (const bf16_t*)(ws + WS_M1); g.K = 512; g.lda = U2LD; g.ldb = 512; g.o0 = ob + DO_S5E; break;
        case 4:  g.mode = GM_S5Y; g.perm = 1; g.sched = 2; g.A = (const bf16_t*)(ws + WS_U2); g.Bt = (const bf16_t*)(ws + WS_T2); g.K = 768; g.lda = U2LD; g.ldb = 768; g.i0 = ws + WS_U2; g.o0 = ws + WS_Z; g.i1 = p.in[I_S5D] + (size_t)l * 256; break;
        case 5:  g.mode = GM_GLU; g.perm = 1; g.A = (const bf16_t*)(ws + WS_Z); g.Bt = (const bf16_t*)(ws + WS_GLU); g.K = 256; g.lda = 256; g.ldb = 256; g.N = 256; g.i0 = ws + WS_Z; g.o0 = ws + WS_ACT; g.o1 = ws + WS_SS; g.i1 = p.in[I_GLUB] + (size_t)l * 256; break;
        case 7:  g.mode = GM_RESADD; g.A = (const bf16_t*)(ws + WS_ACT); g.Bt = (const bf16_t*)(ws + WS_WOUT); g.K = 1024; g.lda = 1024; g.ldb = 1024; g.N = 1024; g.o0 = ws + WS_H; g.i0 = ws + WS_RSS; g.mixn = 1; g.i1 = ws + WS_SS; break;
        case 9:  g.mode = GM_RELU2; g.perm = 1; g.i0 = ws + WS_RSS; g.A = (const bf16_t*)(ws + WS_H); g.Bt = (const bf16_t*)(ws + WS_WUP); g.K = 1024; g.lda = 1024; g.ldb = 1024; g.N = 4096; g.o0 = ws + WS_FF; break;
        case 10: g.mode = GM_RESADD; g.A = (const bf16_t*)(ws + WS_FF); g.Bt = (const bf16_t*)(ws + WS_WDN); g.K = 4096; g.lda = 4096; g.ldb = 4096; g.N = 1024; g.o0 = ws + WS_H; g.i0 = ws + WS_RSS; g.i1 = ob + DO_PART; g.sched = 3; g.M = 32768; break;
        default: break;
        }
        if (g.mode != GM_NONE) {
            pg8::AnyOrder S; S.kind = g.sched; S.G = G; S.c = c; S.ntfull = g.K / 64; S.so.init(g.M, g.N, G, c);
            EpiAny E{&g};
            pg8::gemm_phase(ldsl, g, S, E);
        }
        if (s == 2 || s == 4) {
            const bool fin = (s == 4);
            const int ngemm = fin ? 160 : 80; const float wg = fin ? 2.1f : 1.4f;
            const int NI = NCH64 * 6;
            const int ng = ngemm < G ? ngemm : G;
            const float per = ((float)NI + wg * (float)ng) / (float)G;
            const float pa = per - wg;
            const int i0 = item_start(c, ng, G, NI, pa, per), i1 = item_start(c + 1, ng, G, NI, pa, per);
            stage_params(p, l, lds);
            if (i0 < i1) {
                RgPre nx = rg_load(p, i0, fin);
                for (int it = i0; it < i1; ++it) { const RgPre cur = nx; if (it + 1 < i1) nx = rg_load(p, it + 1, fin); rg_compute(p, it, fin, cur, lds); }
            }
            if (i0 < i1) {
                HgPre nx = hg_load(p, i0, fin);
                for (int it = i0; it < i1; ++it) { const HgPre cur = nx; if (it + 1 < i1) nx = hg_load(p, it + 1, fin); hg_compute(p, it, fin, cur, lds); }
            }
        } else if (s == 1 || s == 7 || s == 9 || s == 10) {
            const int extra = s == 1 ? 1572 % G : (s == 7 ? 524 % G : (s == 9 ? 2096 % G : 48)), widx = c - extra, nw = G - extra;
            if (widx >= 0) {
                if (s == 1) { if (l == 0) build_s5_mats(p, 0, widx, nw); else convert_weights(p, l, CV_UP, widx, nw, lds); }
                else if (s == 7) convert_weights(p, l, CV_DN, widx, nw, lds);
                else if (l + 1 < DEPTH) {
                    if (s == 9) { build_s5_mats(p, l + 1, widx, nw); convert_weights(p, l + 1, CV_SMALL, widx, nw, lds); }
                    else convert_weights(p, l + 1, CV_IN | CV_OUT, widx, nw, lds);
                }
            }
        }
        else if (s == 11) phase_combine(p);
        else if (s == 3) phase_carries(p, l);
        else if (s == 6) phase_mixnorm(p, l);
        else if (s == 100) { phase_prep(p, lds); build_rows(p); convert_weights(p, 0, CV_UP | CV_IN | CV_OUT | CV_SMALL, c, G, lds); }
        else if (s == 101) phase_final(p);
        if (ph + 1 < p.ph_hi) { if (p.ph_lo < 0) { __threadfence(); grid.sync(); } else xcd_barrier(xbar); }
#ifdef PROBE_DOUBLE_MASK
        if (s < 11 && ((PROBE_DOUBLE_MASK >> s) & 1) && !rep) { rep = true; --ph; } else rep = false;
#endif
    }
#ifdef PROBE_TS_MASK
    xcd_barrier(xbar);
    if (blockIdx.x == 0 && threadIdx.x == 0) {
        unsigned long long* TS = (unsigned long long*)(p.ws + WS_TS);
        TS[NPHASE] = __builtin_amdgcn_s_memrealtime();
        unsigned long long sel = 0;
        for (int ph = 0; ph < NPHASE; ++ph) {
            const int si = ph >= 1 ? (ph - 1) % 9 : 0;
            const int s = (ph == 0) ? 12 : (ph == NPHASE - 1 ? 13 : (si < 5 ? si + 1 : (si == 5 ? 7 : si + 3)));
            if ((PROBE_TS_MASK >> s) & 1) sel += TS[ph + 1] - TS[ph];
        }
        const float v = (float)sel / (float)(TS[NPHASE] - TS[0]);
        const float dl = sqrtf(5000.0f * v);
        p.out[0] += dl; p.out[16777216] += dl;
    }
#endif
}

#ifndef MK_MULTI
#define MK_MULTI 0
#endif

extern "C" void kernel_launch(void* const* d_in, const int* in_sizes, int n_in, void* d_out, int out_size, void* d_ws, size_t ws_size, hipStream_t stream) {
    static int grid = 0;
    if (grid == 0) {
        if (n_in != 29 || ws_size < WS_END || out_size != 33554432) { fprintf(stderr, "kernel_launch: unexpected sizes n_in %d ws %zu need %zu out %d\n", n_in, ws_size, (size_t)WS_END, out_size); grid = -1; return; }
        int dev = 0, cus = 0, per_cu = 0;
        hipGetDevice(&dev);
        hipDeviceGetAttribute(&cus, hipDeviceAttributeMultiprocessorCount, dev);
        if (hipFuncSetAttribute((const void*)mega, hipFuncAttributeMaxDynamicSharedMemorySize, LDS_BYTES) != hipSuccess) { fprintf(stderr, "kernel_launch: hipFuncSetAttribute failed\n"); }
        hipOccupancyMaxActiveBlocksPerMultiprocessor(&per_cu, (const void*)mega, 512, LDS_BYTES);
        (void)hipGetLastError();
        if (per_cu < 1) per_cu = 1;
        grid = cus * 1;
        fprintf(stderr, "kernel_launch: cus %d per_cu %d grid %d ws %zu need %zu\n", cus, per_cu, grid, ws_size, (size_t)WS_END);
    }
    if (grid < 0) return;
    Params p{};
    for (int i = 0; i < 29; ++i) p.in[i] = (const float*)d_in[i];
    p.out = (float*)d_out; p.ws = (unsigned char*)d_ws;
#if MK_MULTI
    for (int ph = 0; ph < NPHASE; ++ph) {
        p.ph_lo = ph; p.ph_hi = ph + 1;
        hipLaunchKernelGGL(mega, dim3(grid), dim3(512), LDS_BYTES, stream, p);
    }
#else
    p.ph_lo = 0; p.ph_hi = NPHASE;
    if (hipMemsetAsync((unsigned char*)d_ws + WS_BAR, 0, 16384, stream) != hipSuccess) { fprintf(stderr, "kernel_launch: memset of the barrier words failed\n"); return; }
    void* args[] = {&p};
    hipError_t e = hipLaunchCooperativeKernel((const void*)mega, dim3(grid), dim3(512), args, LDS_BYTES, stream);
    if (e != hipSuccess) fprintf(stderr, "cooperative launch failed: %s (grid %d)\n", hipGetErrorString(e), grid);
#endif
}
```

```cpp
#include <hip/hip_runtime.h>
#include <hip/hip_cooperative_groups.h>
#include <cstdio>
namespace cg = cooperative_groups;

#define DI __device__ __forceinline__
#define LAS __attribute__((address_space(3)))
typedef unsigned short bf16_t;
typedef short bf16x8 __attribute__((ext_vector_type(8)));
typedef float f32x4 __attribute__((ext_vector_type(4)));
typedef unsigned u32x4 __attribute__((ext_vector_type(4)));
typedef unsigned u32x2 __attribute__((ext_vector_type(2)));

constexpr int D = 1024, DEPTH = 4, DFF = 4096;
constexpr int PADR = 48;
constexpr int LP = 4160, LS = 2112;
constexpr int ROWS_P = 4 * LP;
constexpr int MP = ROWS_P + 8 * LS;
constexpr int NCH64 = MP / 64;
constexpr int NCH32 = MP / 32;
constexpr int U2ROWS = 1280;
constexpr int U2LD = 768;
constexpr int PLD = 2816;
constexpr int OFF_AX = 0, OFF_AG = 384, OFF_BQ = 768, OFF_BI = 1152, OFF_BFF = 1536, OFF_BFB = 1920, OFF_BG = 2304;
constexpr float EPS = 1e-6f;
constexpr int LDS_BYTES = 147456;

constexpr size_t al256(size_t x) { return (x + 255) & ~(size_t)255; }
constexpr size_t WS_H     = 0;
constexpr size_t WS_ACT   = WS_H + (size_t)MP * D * 4;
constexpr size_t WS_BIG   = WS_ACT + (size_t)MP * D * 2;
constexpr size_t BIG_SIZE = (size_t)MP * DFF * 2;
constexpr size_t WS_PROJ  = WS_BIG;
constexpr size_t WS_U2    = WS_PROJ + (size_t)MP * PLD * 2;
constexpr size_t WS_Z     = WS_U2 + (size_t)16 * U2ROWS * U2LD * 2;
static_assert(WS_Z + (size_t)MP * 256 * 2 <= WS_BIG + BIG_SIZE, "BIG overflow");
constexpr size_t WS_FF    = WS_BIG;
constexpr size_t WS_WIN   = WS_BIG + BIG_SIZE;
constexpr size_t WS_WOUT  = WS_WIN + (size_t)3072 * 1024 * 2;
constexpr size_t WS_WUP   = WS_WOUT + (size_t)1024 * 1024 * 2;
constexpr size_t WS_WDN   = WS_WUP + (size_t)4096 * 1024 * 2;
constexpr size_t WS_WG    = WS_WDN + (size_t)1024 * 4096 * 2;
constexpr size_t WS_GLU   = WS_WG + (size_t)6 * 256 * 64 * 2;
constexpr size_t WS_T2    = WS_GLU + (size_t)256 * 256 * 2;
constexpr size_t WS_M1    = WS_T2 + (size_t)16 * 512 * 768 * 2;
constexpr size_t WS_SS    = WS_M1 + (size_t)16 * 256 * 512 * 2;
constexpr size_t WS_HGD   = WS_SS + (size_t)MP * 16 * 4;
constexpr size_t WS_LB    = WS_HGD + (size_t)NCH64 * 6 * 2 * 64 * 4;
constexpr size_t WS_PAR   = WS_LB + al256((size_t)2 * 4 * 384 * 4);
constexpr size_t WS_BAR   = WS_PAR + (size_t)4 * 2 * 16 * 64 * 2 * 4;
constexpr size_t WS_RSS   = WS_BAR + 16384;
constexpr size_t WS_TS    = WS_RSS + (size_t)MP * 16 * 4;
constexpr size_t WS_END   = WS_TS + 1024;
constexpr size_t DO_HB2   = 0;
constexpr size_t DO_PART  = 0;
constexpr size_t DO_HGS   = 0;
constexpr size_t DO_S5E   = DO_HGS + (size_t)NCH64 * 6 * 2 * 4096 * 4;
constexpr size_t DO_KTAB  = DO_S5E + (size_t)16 * U2ROWS * 256 * 4;
constexpr size_t DO_BBAR  = DO_KTAB + (size_t)4 * 16 * 2 * 32 * 256 * 4;
constexpr size_t DO_RGC   = DO_BBAR + (size_t)4 * 2 * 16 * 64 * 16 * 2 * 4;
constexpr size_t DO_END   = DO_RGC + (size_t)NCH64 * 2 * 384 * 2 * 4;
static_assert(DO_END <= (size_t)33554432 * 4, "d_out scratch overflow");

struct Params {
    const float* in[29];
    float* out;
    unsigned char* ws;
    int ph_lo, ph_hi;
};
enum { I_XP = 0, I_XS, I_META, I_NMIX, I_WIN, I_CONVW, I_CONVB, I_WR, I_BR, I_WI, I_BI, I_LAM, I_LBL, I_ARE, I_AIM, I_LDT, I_BRE, I_BIM, I_CRE, I_CIM,
       I_S5D, I_GLUW, I_GLUB, I_MGAIN, I_WOUT, I_NMLP, I_WUP, I_WDN, I_NFIN };

DI int ltid() { int t = threadIdx.x; asm volatile("" : "+v"(t)); return t; }
DI int lbid() { int t = blockIdx.x; asm volatile("" : "+s"(t)); return t; }
DI int lgdim() { int t = gridDim.x; asm volatile("" : "+s"(t)); return t; }
typedef __bf16 bf16x2_t __attribute__((ext_vector_type(2)));
typedef float f32x2_t __attribute__((ext_vector_type(2)));
DI unsigned pack2(float lo, float hi) { const f32x2_t v = {lo, hi}; const bf16x2_t b = __builtin_convertvector(v, bf16x2_t); return __builtin_bit_cast(unsigned, b); }
DI unsigned short f2bf(float f) { return (unsigned short)(pack2(f, 0.f) & 0xFFFFu); }
DI float bf2f(unsigned short b) { return __uint_as_float(((unsigned)b) << 16); }
DI float bflo(unsigned w) { return __uint_as_float(w << 16); }
DI float bfhi(unsigned w) { return __uint_as_float(w & 0xFFFF0000u); }
DI float sigmoidf_(float x) { return __builtin_amdgcn_rcpf(1.0f + __expf(-x)); }
DI float siluf_(float x) { return x * sigmoidf_(x); }
DI float gelu_tanh(float x) { const float u = 0.7978845608028654f * (x + 0.044715f * x * x * x); return x * sigmoidf_(2.0f * u); }
DI void unpack8(const u32x4& w, float* f) { f[0] = bflo(w.x); f[1] = bfhi(w.x); f[2] = bflo(w.y); f[3] = bfhi(w.y); f[4] = bflo(w.z); f[5] = bfhi(w.z); f[6] = bflo(w.w); f[7] = bfhi(w.w); }
DI u32x4 pack8(const float* f) { u32x4 w; w.x = pack2(f[0], f[1]); w.y = pack2(f[2], f[3]); w.z = pack2(f[4], f[5]); w.w = pack2(f[6], f[7]); return w; }

DI void row_info(int R, int& seq, int& pos) {
    if (R < ROWS_P) { seq = R / LP; pos = R - seq * LP; }
    else { const int r = R - ROWS_P; const int s = r / LS; seq = 4 + s; pos = r - s * LS; }
}
DI void seq_chunks64(int seq, int& c0, int& nc) { if (seq < 4) { c0 = seq * 65; nc = 65; } else { c0 = 260 + (seq - 4) * 33; nc = 33; } }
DI void seq_chunks32(int seq, int& c0, int& nc) { if (seq < 4) { c0 = seq * 130; nc = 130; } else { c0 = 520 + (seq - 4) * 66; nc = 66; } }
DI int chunk64_pos0(int j) { if (j < 260) return (j % 65) * 64; return ((j - 260) % 33) * 64; }
DI int chunk64_len(int j) { return j < 260 ? LP : LS; }

namespace pg8 {
constexpr int BM = 256, BK = 64, HALF = 128, HTB = HALF * BK * 2, STAGE_BYTES = 8 * HTB, NXCD = 8, WGM = 8;
__host__ __device__ __forceinline__ int lds_byte(int r, int c) { const int st = (r >> 4) * 2 + (c >> 5), rr = r & 15, cc = c & 31, ob = rr * 64 + cc * 2; return st * 1024 + (ob ^ (((ob >> 9) & 1) << 5)); }
__host__ __device__ __forceinline__ void stage_rc(int b, int& R, int& C) { const int st = b / 1024, sb = b % 1024, swz = sb ^ (((sb >> 9) & 1) << 5); R = (st >> 1) * 16 + swz / 64; C = (st & 1) * 32 + (swz % 64) / 2; }
__host__ __device__ __forceinline__ int perm32(int rho) { const int n = rho >> 4, i = rho & 15; return 8 * (i >> 2) + 4 * n + (i & 3); }
struct Unit { int pm, pn, koff, nt; };
struct Gemm { const bf16_t* A; const bf16_t* Bt; int K, lda, ldb;
              int mixn;
              int mode, perm, sched, M, N;
              void* o0; void* o1; const void* i0; const void* i1; };

struct StaticOrder {
    int nM, nN, nwg, G, c;
    DI void init(int M, int N, int G_, int c_) { nM = M / BM; nN = N / BM; nwg = nM * nN; G = G_; c = c_; }
    DI bool next(int i, Unit& u) const {
        const long L = (long)i * G + c; if (L >= nwg) return false;
        int wgid = (int)L; { const int q = nwg / NXCD, r = nwg % NXCD, xcd = wgid % NXCD, off = wgid / NXCD; wgid = (xcd < r ? xcd * (q + 1) : r * (q + 1) + (xcd - r) * q) + off; }
        const int nig = WGM * nN, gid = wgid / nig, fm = gid * WGM, gsz = (nM - fm) < WGM ? (nM - fm) : WGM;
        u.pm = fm + ((wgid % nig) % gsz); u.pn = (wgid % nig) / gsz; u.koff = 0; u.nt = 0; return true;
    }
    DI void a_ready(const Unit&) const {}
    DI void done(const Unit&) const {}
};
template <int NPN> struct GroupOrder {
    int G, c;
    DI bool next(int i, Unit& u) const {
        const int L = i * G + c; if (L >= 16 * 5 * NPN) return false;
        const int g = L / (5 * NPN), r = L % (5 * NPN); u.pm = g * 5 + (r % 5); u.pn = g * NPN + (r / 5); u.koff = 0; u.nt = 0; return true;
    }
    DI void a_ready(const Unit&) const {}
    DI void done(const Unit&) const {}
};

DI unsigned cvt_pk_bf16(float lo, float hi) { unsigned r; asm volatile("v_cvt_pk_bf16_f32 %0, %1, %2" : "=v"(r) : "v"(lo), "v"(hi)); return r; }

struct AnyOrder {
    StaticOrder so; int kind, G, c, ntfull;
    DI bool next(int i, Unit& u) const {
        bool ok;
        if (kind == 0) ok = so.next(i, u);
        else if (kind == 1) { GroupOrder<1> o{G, c}; ok = o.next(i, u); }
        else if (kind == 2) { GroupOrder<2> o{G, c}; ok = o.next(i, u); }
        else {
            const int L = i * G + c;
            if (L < 512) ok = so.next(i, u);
            else { const int q = L - 512; if (q >= 48) return false; u.pm = 128 + q / 16; u.pn = (q >> 2) & 3; u.koff = (q & 3) * 1024; u.nt = 16; return true; }
        }
        u.nt = ntfull; return ok;
    }
};
template <class EpiFn>
DI void gemm_phase(LAS unsigned char* lds, const Gemm& g, const AnyOrder& S, const EpiFn& E) {
    int tid_ = ltid();
    const int tid = tid_, wid = __builtin_amdgcn_readfirstlane(tid >> 6), lane = tid & 63, wr = wid >> 2, wc = wid & 3, fr = lane & 15, fq = lane >> 4;
    int nt = g.K / BK;
    unsigned voffA[2], voffB[2];
#pragma unroll
    for (int i = 0; i < 2; ++i) { int R, C; stage_rc(tid * 16 + i * 8192, R, C); const int Rb = g.perm ? ((R & ~31) + perm32(R & 31)) : R;
        voffA[i] = (unsigned)(R * g.lda + C) * 2u; voffB[i] = (unsigned)(Rb * g.ldb + C) * 2u; }
    const size_t kstep = (size_t)(BK * 2);
    const size_t hstepA = (size_t)HALF * g.lda * 2, hstepB = (size_t)HALF * g.ldb * 2;
    const size_t tstepA = 2 * hstepA, tstepB = 2 * hstepB;
    const unsigned ldsw = (unsigned)wid * 1024u;
    const int aoff = lds_byte(wr * 64 + fr, fq * 8), boff = lds_byte(wc * 32 + fr, fq * 8);
#define PG8_SA(b, h) (((b) * 2 + (h)) * HTB)
#define PG8_SB(b, h) ((4 + (b) * 2 + (h)) * HTB)
#define PG8_STAGE(bufoff, gbase, voff) do { _Pragma("unroll") for (int _i = 0; _i < 2; ++_i) \
        __builtin_amdgcn_global_load_lds((const unsigned*)((const char*)(gbase) + (voff)[_i]), (LAS unsigned*)(lds + (bufoff) + ldsw + _i * 8192), 16, 0, 0); } while (0)
#define PG8_LDA(dst, b, h) do { _Pragma("unroll") for (int m = 0; m < 4; ++m) _Pragma("unroll") for (int k = 0; k < 2; ++k) dst[m][k] = *(const LAS bf16x8*)(lds + PG8_SA(b, h) + aoff + m * 2048 + k * 1024); } while (0)
#define PG8_LDB(dst, b, h) do { _Pragma("unroll") for (int n = 0; n < 2; ++n) _Pragma("unroll") for (int k = 0; k < 2; ++k) dst[n][k] = *(const LAS bf16x8*)(lds + PG8_SB(b, h) + boff + n * 2048 + k * 1024); } while (0)
#define PG8_MMA(ai, bj, At, Bt) do { __builtin_amdgcn_s_setprio(1); _Pragma("unroll") for (int m = 0; m < 4; ++m) _Pragma("unroll") for (int n = 0; n < 2; ++n) _Pragma("unroll") for (int k = 0; k < 2; ++k) \
        acc[ai][bj][m][n] = __builtin_amdgcn_mfma_f32_16x16x32_bf16(Bt[n][k], At[m][k], acc[ai][bj][m][n], 0, 0, 0); __builtin_amdgcn_s_setprio(0); } while (0)
#define PG8_WAIT_V(n) asm volatile("s_waitcnt vmcnt(" #n ")" ::: "memory")
#define PG8_WAIT_L(n) asm volatile("s_waitcnt lgkmcnt(" #n ")" ::: "memory")
#define PG8_BAR __builtin_amdgcn_s_barrier()
#define PG8_SCHED __builtin_amdgcn_sched_barrier(0)
    Unit cur, nxt; int ui = 0;
    if (!S.next(0, cur)) return;
    f32x4 acc[2][2][4][2];
#pragma unroll
    for (int a = 0; a < 2; ++a)
#pragma unroll
        for (int b = 0; b < 2; ++b)
#pragma unroll
            for (int m = 0; m < 4; ++m)
#pragma unroll
                for (int n = 0; n < 2; ++n) acc[a][b][m][n] = (f32x4){0.f, 0.f, 0.f, 0.f};
    bf16x8 At[4][2], B0[2][2], B1[2][2];
    const char* cA = (const char*)g.A + (size_t)cur.pm * tstepA + (size_t)cur.koff * 2; const char* cB = (const char*)g.Bt + (size_t)cur.pn * tstepB + (size_t)cur.koff * 2;
    nt = cur.nt;
    f32x4 pra = (f32x4){0.f, 0.f, 0.f, 0.f}, prb = pra; const bool rsm = E.prime_issue(cur, tid, pra, prb);
    PG8_STAGE(PG8_SB(0, 0), cB, voffB); PG8_STAGE(PG8_SA(0, 0), cA, voffA); PG8_STAGE(PG8_SB(0, 1), cB + hstepB, voffB); PG8_STAGE(PG8_SA(0, 1), cA + hstepA, voffA);
    if (wr == 1) PG8_BAR;
    PG8_WAIT_V(4); PG8_BAR;
    if (rsm) E.prime_commit(lds, tid, pra, prb);
    PG8_STAGE(PG8_SB(1, 0), cB + kstep, voffB); PG8_STAGE(PG8_SA(1, 0), cA + kstep, voffA); PG8_STAGE(PG8_SB(1, 1), cB + hstepB + kstep, voffB);
    PG8_WAIT_V(6); PG8_BAR;
    for (;;) {
        const bool has_next = S.next(ui + 1, nxt);
        const char* nA = has_next ? (const char*)g.A + (size_t)nxt.pm * tstepA + (size_t)nxt.koff * 2 : cA; const char* nB = has_next ? (const char*)g.Bt + (size_t)nxt.pn * tstepB + (size_t)nxt.koff * 2 : cB;
        for (int t = 0; t < nt; t += 2) {
            const bool last = (t == nt - 2);
            const char* a1 = cA + (size_t)(t + 1) * kstep;
            const char* a2 = last ? nA : cA + (size_t)(t + 2) * kstep; const char* b2 = last ? nB : cB + (size_t)(t + 2) * kstep;
            const char* a3 = a2 + kstep; const char* b3 = b2 + kstep;
            if (E.mixn() && (t == 6 || t == 12)) { E.mix_rescale(acc, lds, ui & 1, t, wr, fr); PG8_SCHED; }
            PG8_LDB(B0, 0, 0); PG8_SCHED; PG8_LDA(At, 0, 0); PG8_STAGE(PG8_SA(1, 1), a1 + hstepA, voffA);
            PG8_WAIT_L(8); PG8_BAR; PG8_WAIT_L(0); PG8_MMA(0, 0, At, B0); PG8_BAR; PG8_SCHED;
            PG8_LDB(B1, 0, 1); PG8_STAGE(PG8_SB(0, 0), b2, voffB);
            PG8_BAR; PG8_WAIT_L(0); PG8_MMA(0, 1, At, B1); PG8_BAR;
            PG8_LDA(At, 0, 1); PG8_STAGE(PG8_SA(0, 0), a2, voffA);
            PG8_BAR; PG8_WAIT_L(0); PG8_MMA(1, 0, At, B0); PG8_BAR; PG8_SCHED;
            PG8_STAGE(PG8_SB(0, 1), b2 + hstepB, voffB);
            PG8_WAIT_V(6); PG8_BAR; PG8_MMA(1, 1, At, B1); PG8_BAR;
            PG8_LDB(B0, 1, 0); PG8_SCHED; PG8_LDA(At, 1, 0); PG8_STAGE(PG8_SA(0, 1), a2 + hstepA, voffA);
            PG8_WAIT_L(8); PG8_BAR; PG8_WAIT_L(0); PG8_MMA(0, 0, At, B0); PG8_BAR; PG8_SCHED;
            PG8_LDB(B1, 1, 1); PG8_STAGE(PG8_SB(1, 0), b3, voffB);
            PG8_BAR; PG8_WAIT_L(0); PG8_MMA(0, 1, At, B1); PG8_BAR;
            PG8_LDA(At, 1, 1); PG8_STAGE(PG8_SA(1, 0), a3, voffA);
            PG8_BAR; PG8_WAIT_L(0); PG8_MMA(1, 0, At, B0); PG8_BAR; PG8_SCHED;
            PG8_STAGE(PG8_SB(1, 1), b3 + hstepB, voffB);
            PG8_WAIT_V(6); PG8_BAR; PG8_MMA(1, 1, At, B1); PG8_BAR;
        }
        E(acc, cur, wr, wc, fr, fq, lds, has_next, nxt, ui & 1);
        if (!has_next) break;
#pragma unroll
        for (int a = 0; a < 2; ++a)
#pragma unroll
            for (int b = 0; b < 2; ++b)
#pragma unroll
                for (int m = 0; m < 4; ++m)
#pragma unroll
                    for (int n = 0; n < 2; ++n) acc[a][b][m][n] = (f32x4){0.f, 0.f, 0.f, 0.f};
        cur = nxt; cA = nA; cB = nB; nt = cur.nt; ++ui;
    }
    PG8_WAIT_V(0);
    if (wr == 0) PG8_BAR;
    PG8_BAR;
#undef PG8_SA
#undef PG8_SB
#undef PG8_STAGE
#undef PG8_LDA
#undef PG8_LDB
#undef PG8_MMA
#undef PG8_WAIT_V
#undef PG8_WAIT_L
#undef PG8_BAR
#undef PG8_SCHED
}
}
using pg8::Unit;

DI float row_rn(const float* RSS, int r) {
    const float* sp = RSS + (size_t)r * 16; const f32x4 a = *(const f32x4*)sp, b = *(const f32x4*)(sp + 4), c = *(const f32x4*)(sp + 8), d = *(const f32x4*)(sp + 12);
    const float tot = (((a[0] + a[1]) + (a[2] + a[3])) + ((b[0] + b[1]) + (b[2] + b[3]))) + (((c[0] + c[1]) + (c[2] + c[3])) + ((d[0] + d[1]) + (d[2] + d[3])));
    return rsqrtf(tot * (1.0f / D) + EPS);
}
DI float row_rn4(const float* RSS, int r, int fq) {
    const f32x4 a = *(const f32x4*)(RSS + (size_t)r * 16 + fq * 4);
    float t = (a[0] + a[1]) + (a[2] + a[3]);
    t += __shfl_xor(t, 16); t += __shfl_xor(t, 32);
    return rsqrtf(t * (1.0f / D) + EPS);
}
constexpr int PS_OFF = 131072;
DI void rs_issue(const float* RSS, int pm, int tid, f32x4& a, f32x4& b) { const float* sp = RSS + (size_t)(pm * 256 + (tid & 255)) * 16 + (tid >> 8) * 8; a = *(const f32x4*)sp; b = *(const f32x4*)(sp + 4); }
DI void rs_commit(LAS unsigned char* lds, int par, int tid, const f32x4& a, const f32x4& b) { ((LAS float*)(lds + PS_OFF))[(par * 2 + (tid >> 8)) * 256 + (tid & 255)] = ((a[0] + a[1]) + (a[2] + a[3])) + ((b[0] + b[1]) + (b[2] + b[3])); }
DI float rs_get(LAS unsigned char* lds, int par, int rl) { const LAS float* PS = (const LAS float*)(lds + PS_OFF); return rsqrtf((PS[(par * 2) * 256 + rl] + PS[(par * 2 + 1) * 256 + rl]) * (1.0f / D) + EPS); }
constexpr int MN_OFF = 131072 + 4096;
DI void mn_commit(LAS unsigned char* lds, int par, int tid, const f32x4& a, const f32x4& b) {
    LAS float* M = (LAS float*)(lds + MN_OFF) + par * 1024; const int h = tid >> 8, row = tid & 255;
    const float v0 = h == 0 ? (((a[0] + a[1]) + (a[2] + a[3])) + (b[0] + b[1])) : ((a[0] + a[1]) + (a[2] + a[3]));
    const float v1 = h == 0 ? (b[2] + b[3]) : ((b[0] + b[1]) + (b[2] + b[3]));
    M[(h * 2) * 256 + row] = v0; M[(h * 2 + 1) * 256 + row] = v1;
}
DI void mn_get(LAS unsigned char* lds, int par, int rl, float& rA, float& rB, float& rC) {
    const LAS float* M = (const LAS float*)(lds + MN_OFF) + par * 1024;
    rA = rsqrtf(M[rl] * (1.0f / 384.0f) + EPS); rB = rsqrtf((M[256 + rl] + M[512 + rl]) * (1.0f / 384.0f) + EPS); rC = rsqrtf(M[768 + rl] * (1.0f / 256.0f) + EPS);
}
struct EpiInProj {
    static constexpr bool PERM = true;
    bf16_t* PROJ; bf16_t* U2; const float* RSS;
    DI void operator()(const f32x4 (&acc)[2][2][4][2], const Unit& u, int wr, int wc, int fr, int fq, LAS unsigned char* lds, bool has_next, const Unit& nx, int par) const {
        const int row0 = u.pm * 256 + wr * 64 + fr;
        const int tid = ltid(); f32x4 na = (f32x4){0.f, 0.f, 0.f, 0.f}, nb = na;
        if (has_next) rs_issue(RSS, nx.pm, tid, na, nb);
        float rn[2][4];
#pragma unroll
        for (int ai = 0; ai < 2; ++ai)
#pragma unroll
            for (int m = 0; m < 4; ++m) rn[ai][m] = rs_get(lds, par, wr * 64 + fr + ai * 128 + m * 16);
#pragma unroll
        for (int ai = 0; ai < 2; ++ai)
#pragma unroll
            for (int m = 0; m < 4; ++m) {
                const int r = row0 + ai * 128 + m * 16;
#pragma unroll
                for (int bj = 0; bj < 2; ++bj) {
                    const f32x4 v0 = acc[ai][bj][m][0] * rn[ai][m], v1 = acc[ai][bj][m][1] * rn[ai][m];
                    u32x4 w; w.x = pack2(v0[0], v0[1]); w.y = pack2(v0[2], v0[3]); w.z = pack2(v1[0], v1[1]); w.w = pack2(v1[2], v1[3]);
                    const int cl = bj * 128 + wc * 32 + 8 * fq;
                    if (u.pn == 0) { const int g = cl >> 4, h = cl & 15; *(u32x4*)(U2 + ((size_t)(g * U2ROWS + (r >> 5)) * U2LD + (r & 31) * 16 + h)) = w; }
                    else __builtin_nontemporal_store(w, (u32x4*)(PROJ + (size_t)r * PLD + (u.pn - 1) * 256 + cl));
                }
            }
        if (has_next) rs_commit(lds, par ^ 1, tid, na, nb);
    }
};
struct EpiResAdd {
    static constexpr bool PERM = false;
    bf16_t* H; float* RSS;
    DI void ld(u32x2 (&hv)[2][2][2], int row0, int col0, int ai, int mp) const {
#pragma unroll
        for (int mm = 0; mm < 2; ++mm)
#pragma unroll
            for (int bj = 0; bj < 2; ++bj)
#pragma unroll
                for (int n = 0; n < 2; ++n) hv[mm][bj][n] = *(const u32x2*)(H + (size_t)(row0 + ai * 128 + (mp * 2 + mm) * 16) * D + col0 + bj * 128 + n * 16);
    }
    template <int AI, int MP_>
    DI void proc(const u32x2 (&hv)[2][2][2], const f32x4 (&acc)[2][2][4][2], int row0, int col0, int pn, int wc, int fq, const float (&rc)[2][4]) const {
#pragma unroll
        for (int mm = 0; mm < 2; ++mm) { const int m = MP_ * 2 + mm; const int r = row0 + AI * 128 + m * 16; bf16_t* rowp = H + (size_t)r * D + col0;
            float ss = 0.f;
#pragma unroll
            for (int bj = 0; bj < 2; ++bj)
#pragma unroll
                for (int n = 0; n < 2; ++n) { const u32x2 o = hv[mm][bj][n]; const f32x4 a = acc[AI][bj][m][n] * rc[AI][m];
                    const float h0 = bflo(o.x) + a[0], h1 = bfhi(o.x) + a[1], h2 = bflo(o.y) + a[2], h3 = bfhi(o.y) + a[3];
                    u32x2 w; w.x = pack2(h0, h1); w.y = pack2(h2, h3); *(u32x2*)(rowp + bj * 128 + n * 16) = w;
                    ss += (h0 * h0 + h1 * h1) + (h2 * h2 + h3 * h3); }
            ss += __shfl_xor(ss, 16); ss += __shfl_xor(ss, 32);
            if (fq == 0) RSS[(size_t)r * 16 + pn * 4 + wc] = ss; }
    }
    DI void operator()(const f32x4 (&acc)[2][2][4][2], const Unit& u, int wr, int wc, int fr, int fq, const float* SSn, LAS unsigned char* lds, bool has_next, const Unit& nx, int par) const {
        const int row0 = u.pm * 256 + wr * 64 + fr, col0 = u.pn * 256 + wc * 32 + 4 * fq;
        const int tid = ltid(); f32x4 na = (f32x4){0.f, 0.f, 0.f, 0.f}, nb = na;
        if (SSn && has_next) rs_issue(SSn, nx.pm, tid, na, nb);
        float rc[2][4];
#pragma unroll
        for (int ai = 0; ai < 2; ++ai)
#pragma unroll
            for (int m = 0; m < 4; ++m) { float rA, rB, rC = 1.0f; if (SSn) mn_get(lds, par, wr * 64 + fr + ai * 128 + m * 16, rA, rB, rC); rc[ai][m] = rC; }
        u32x2 ha[2][2][2], hb[2][2][2];
        ld(ha, row0, col0, 0, 0);
        ld(hb, row0, col0, 0, 1); proc<0, 0>(ha, acc, row0, col0, u.pn, wc, fq, rc);
        ld(ha, row0, col0, 1, 0); proc<0, 1>(hb, acc, row0, col0, u.pn, wc, fq, rc);
        ld(hb, row0, col0, 1, 1); proc<1, 0>(ha, acc, row0, col0, u.pn, wc, fq, rc);
        proc<1, 1>(hb, acc, row0, col0, u.pn, wc, fq, rc);
        if (SSn && has_next) mn_commit(lds, par ^ 1, tid, na, nb);
    }
};
struct EpiPart {
    static constexpr bool PERM = false;
    float* P;
    DI void operator()(const f32x4 (&acc)[2][2][4][2], const Unit& u, int wr, int wc, int fr, int fq) const {
        const int row0 = (u.pm - 128) * 256 + wr * 64 + fr, col0 = u.pn * 256 + wc * 32 + 4 * fq; const int ks = u.koff >> 10;
#pragma unroll
        for (int ai = 0; ai < 2; ++ai)
#pragma unroll
            for (int m = 0; m < 4; ++m) { float* rowp = P + ((size_t)ks * 768 + row0 + ai * 128 + m * 16) * D + col0;
#pragma unroll
                for (int bj = 0; bj < 2; ++bj)
#pragma unroll
                    for (int n = 0; n < 2; ++n) *(f32x4*)(rowp + bj * 128 + n * 16) = acc[ai][bj][m][n]; }
    }
};
struct EpiRelu2 {
    static constexpr bool PERM = true;
    bf16_t* FF; const float* RSS;
    DI void operator()(const f32x4 (&acc)[2][2][4][2], const Unit& u, int wr, int wc, int fr, int fq, LAS unsigned char* lds, bool has_next, const Unit& nx, int par) const {
        const int row0 = u.pm * 256 + wr * 64 + fr, col0 = u.pn * 256 + wc * 32 + 8 * fq;
        const int tid = ltid(); f32x4 na = (f32x4){0.f, 0.f, 0.f, 0.f}, nb = na;
        if (has_next) rs_issue(RSS, nx.pm, tid, na, nb);
        float rn[2][4];
#pragma unroll
        for (int ai = 0; ai < 2; ++ai)
#pragma unroll
            for (int m = 0; m < 4; ++m) rn[ai][m] = rs_get(lds, par, wr * 64 + fr + ai * 128 + m * 16);
#pragma unroll
        for (int ai = 0; ai < 2; ++ai)
#pragma unroll
            for (int m = 0; m < 4; ++m) { bf16_t* rowp = FF + (size_t)(row0 + ai * 128 + m * 16) * DFF + col0;
#pragma unroll
                for (int bj = 0; bj < 2; ++bj) { f32x4 v0 = acc[ai][bj][m][0] * rn[ai][m], v1 = acc[ai][bj][m][1] * rn[ai][m];
#pragma unroll
                    for (int j = 0; j < 4; ++j) { const float a = fmaxf(v0[j], 0.f), b = fmaxf(v1[j], 0.f); v0[j] = a * a; v1[j] = b * b; }
                    u32x4 w; w.x = pack2(v0[0], v0[1]); w.y = pack2(v0[2], v0[3]); w.z = pack2(v1[0], v1[1]); w.w = pack2(v1[2], v1[3]);
                    __builtin_nontemporal_store(w, (u32x4*)(rowp + bj * 128)); } }
        if (has_next) rs_commit(lds, par ^ 1, tid, na, nb);
    }
};
struct EpiS5E {
    static constexpr bool PERM = false;
    float* E;
    DI void operator()(const f32x4 (&acc)[2][2][4][2], const Unit& u, int wr, int wc, int fr, int fq) const {
        const int row0 = u.pm * 256 + wr * 64 + fr, col0 = wc * 32 + 4 * fq;
#pragma unroll
        for (int ai = 0; ai < 2; ++ai)
#pragma unroll
            for (int m = 0; m < 4; ++m) { float* rowp = E + (size_t)(row0 + ai * 128 + m * 16) * 256 + col0;
#pragma unroll
                for (int bj = 0; bj < 2; ++bj)
#pragma unroll
                    for (int n = 0; n < 2; ++n) *(f32x4*)(rowp + bj * 128 + n * 16) = acc[ai][bj][m][n]; }
    }
};
struct EpiS5Y {
    static constexpr bool PERM = true;
    const bf16_t* U2; bf16_t* Z; const float* dskip;
    DI void operator()(const f32x4 (&acc)[2][2][4][2], const Unit& u, int wr, int wc, int fr, int fq) const {
        const int g = u.pm / 5, pml = u.pm - g * 5, pnl = u.pn - g * 2;
        float dsk[2][8];
#pragma unroll
        for (int bj = 0; bj < 2; ++bj) { const int h0 = (bj * 128 + wc * 32 + 8 * fq) & 15; const f32x4 d0 = *(const f32x4*)(dskip + g * 16 + h0), d1 = *(const f32x4*)(dskip + g * 16 + h0 + 4);
#pragma unroll
            for (int j = 0; j < 4; ++j) { dsk[bj][j] = d0[j]; dsk[bj][4 + j] = d1[j]; } }
#pragma unroll
        for (int ai = 0; ai < 2; ++ai) {
            u32x4 uw[4][2];
#pragma unroll
            for (int m = 0; m < 4; ++m) { const int chunk = pml * 256 + ai * 128 + wr * 64 + m * 16 + fr;
#pragma unroll
                for (int bj = 0; bj < 2; ++bj) { const int n0 = pnl * 256 + bj * 128 + wc * 32 + 8 * fq;
                    uw[m][bj] = chunk < NCH32 ? *(const u32x4*)(U2 + ((size_t)(g * U2ROWS + chunk) * U2LD + n0)) : (u32x4){0u, 0u, 0u, 0u}; } }
#pragma unroll
            for (int m = 0; m < 4; ++m) {
                const int chunk = pml * 256 + ai * 128 + wr * 64 + m * 16 + fr;
                if (chunk < NCH32) {
#pragma unroll
                    for (int bj = 0; bj < 2; ++bj) {
                        const int n0 = pnl * 256 + bj * 128 + wc * 32 + 8 * fq;
                        const int t = n0 >> 4, h0 = n0 & 15;
                        float uf[8]; unpack8(uw[m][bj], uf);
                        const f32x4 v0 = acc[ai][bj][m][0], v1 = acc[ai][bj][m][1];
                        float y[8];
#pragma unroll
                        for (int j = 0; j < 4; ++j) { y[j] = v0[j]; y[4 + j] = v1[j]; }
#pragma unroll
                        for (int j = 0; j < 8; ++j) y[j] = gelu_tanh(y[j] + dsk[bj][j] * uf[j]);
                        *(u32x4*)(Z + ((size_t)(chunk * 32 + t) * 256 + g * 16 + h0)) = pack8(y);
                    }
                }
            }
        }
    }
};
struct EpiGlu {
    static constexpr bool PERM = true;
    const bf16_t* Z; bf16_t* YM; float* SS; const float* glub;
    DI void operator()(const f32x4 (&acc)[2][2][4][2], const Unit& u, int wr, int wc, int fr, int fq) const {
        const int row0 = u.pm * 256 + wr * 64 + fr;
        float gb[2][8];
#pragma unroll
        for (int bj = 0; bj < 2; ++bj) { const int c0 = bj * 128 + wc * 32 + 8 * fq; const f32x4 d0 = *(const f32x4*)(glub + c0), d1 = *(const f32x4*)(glub + c0 + 4);
#pragma unroll
            for (int j = 0; j < 4; ++j) { gb[bj][j] = d0[j]; gb[bj][4 + j] = d1[j]; } }
#pragma unroll
        for (int ai = 0; ai < 2; ++ai) {
            u32x4 zw[4][2];
#pragma unroll
            for (int m = 0; m < 4; ++m)
#pragma unroll
                for (int bj = 0; bj < 2; ++bj) zw[m][bj] = *(const u32x4*)(Z + (size_t)(row0 + ai * 128 + m * 16) * 256 + bj * 128 + wc * 32 + 8 * fq);
#pragma unroll
            for (int m = 0; m < 4; ++m) {
                const int r = row0 + ai * 128 + m * 16;
                int seq, pos; row_info(r, seq, pos);
                const bool valid = pos >= PADR;
                float ssum = 0.f;
#pragma unroll
                for (int bj = 0; bj < 2; ++bj) {
                    const int c0 = bj * 128 + wc * 32 + 8 * fq;
                    float zf[8]; unpack8(zw[m][bj], zf);
                    const f32x4 v0 = acc[ai][bj][m][0], v1 = acc[ai][bj][m][1];
                    float y[8];
#pragma unroll
                    for (int j = 0; j < 4; ++j) { y[j] = v0[j]; y[4 + j] = v1[j]; }
#pragma unroll
                    for (int j = 0; j < 8; ++j) { const float o = valid ? zf[j] * sigmoidf_(y[j] + gb[bj][j]) : 0.f; y[j] = o; ssum += o * o; }
                    *(u32x4*)(YM + (size_t)r * D + 768 + c0) = pack8(y);
                }
                ssum += __shfl_xor(ssum, 16); ssum += __shfl_xor(ssum, 32);
                if (fq == 0) SS[(size_t)r * 16 + 12 + wc] = ssum;
            }
        }
    }
};

DI f32x4 mma_tile64(const bf16_t* A, const bf16_t* Bt, int ld, int lane, f32x4 acc) {
    const int r = lane & 15, q = lane >> 4;
#pragma unroll
    for (int ks = 0; ks < 2; ++ks) {
        const bf16x8 a = *(const bf16x8*)(A + r * ld + ks * 32 + q * 8);
        const bf16x8 b = *(const bf16x8*)(Bt + r * ld + ks * 32 + q * 8);
        acc = __builtin_amdgcn_mfma_f32_16x16x32_bf16(a, b, acc, 0, 0, 0);
    }
    return acc;
}

DI void phase_prep(const Params& p, unsigned char* lds) {
    const int tid = ltid();
    float* LB = (float*)(p.ws + WS_LB);
    for (int i = lbid() * 512 + tid; i < 2 * 384; i += lgdim() * 512) {
        const int d = i / 384, c = i % 384;
        float lg[4], mx = -1e30f;
#pragma unroll
        for (int l = 0; l < 4; ++l) { lg[l] = p.in[I_LBL][(d * 4 + l) * 384 + c]; mx = fmaxf(mx, lg[l]); }
        float s = 0.f;
#pragma unroll
        for (int l = 0; l < 4; ++l) { lg[l] = expf(lg[l] - mx); s += lg[l]; }
        float cum = 0.f;
#pragma unroll
        for (int l = 0; l < 4; ++l) { if (l > 0) cum += lg[l] / s; LB[(d * 4 + l) * 384 + c] = cum; }
    }
    float* PAR = (float*)(p.ws + WS_PAR);
    float* KTAB = (float*)((unsigned char*)p.out + DO_KTAB);
    float* BBAR = (float*)((unsigned char*)p.out + DO_BBAR);
    float* sAR = (float*)lds;
    float* sAI = sAR + 64;
    float* sBB = sAI + 64;
    float* sC  = sBB + 2048;
    float* sW  = sC + 2048;
    float* sW2 = sW;
    for (int item2 = lbid(); item2 < 4 * 16 * 2 * 2; item2 += lgdim()) {
        const int item = item2 >> 1, half = item2 & 1;
        const int l = item / 32, g = (item / 2) % 16, d = item % 2;
        const int base = ((l * 2 + d) * 16 + g);
        const float dt = expf(p.in[I_LDT][base]);
        __syncthreads();
        if (tid < 64) {
            const float lr = p.in[I_ARE][base * 64 + tid], li = p.in[I_AIM][base * 64 + tid];
            const float ar = lr * dt, ai = li * dt;
            sAR[tid] = ar; sAI[tid] = ai;
            if (half == 0) { PAR[(base * 64 + tid) * 2 + 0] = ar; PAR[(base * 64 + tid) * 2 + 1] = ai; }
        }
        __syncthreads();
        for (int e = tid; e < 1024; e += 512) {
            const int pp = e >> 4, h = e & 15;
            const float ar = sAR[pp], ai = sAI[pp];
            const float lr = p.in[I_ARE][base * 64 + pp], li = p.in[I_AIM][base * 64 + pp];
            float sn, cs; sincosf(ai, &sn, &cs);
            const float em1 = expm1f(ar), ex = em1 + 1.0f;
            const float sh = sinf(0.5f * ai);
            const float x = em1 * cs - 2.0f * sh * sh, y = ex * sn;
            const float den = lr * lr + li * li;
            const float cr = (x * lr + y * li) / den, ci = (y * lr - x * li) / den;
            const float br = p.in[I_BRE][(size_t)(base * 64 + pp) * 16 + h], bi = p.in[I_BIM][(size_t)(base * 64 + pp) * 16 + h];
            const float rr = cr * br - ci * bi, ri = cr * bi + ci * br;
            sBB[e * 2] = rr; sBB[e * 2 + 1] = ri;
            if (half == 0) { BBAR[((size_t)(base * 64 + pp) * 16 + h) * 2] = rr; BBAR[((size_t)(base * 64 + pp) * 16 + h) * 2 + 1] = ri; }
        }
        for (int e = tid; e < 1024; e += 512) {
            sC[e * 2] = p.in[I_CRE][(size_t)base * 1024 + e]; sC[e * 2 + 1] = p.in[I_CIM][(size_t)base * 1024 + e];
        }
        __syncthreads();
_Pragma("nounroll")
        for (int tp = 0; tp < 8; ++tp) {
            if (tid < 128) { const int w = tid >> 6, pp = tid & 63; const float tau = (float)(half * 16 + tp * 2 + w);
                const float mg = expf(tau * sAR[pp]); float sn, cs; sincosf(tau * sAI[pp], &sn, &cs); sW2[(w * 64 + pp) * 2] = mg * cs; sW2[(w * 64 + pp) * 2 + 1] = mg * sn; }
            __syncthreads();
            {
                const int w = tid >> 8, o = tid & 255, hp = o >> 4, h = o & 15;
                float sacc = 0.f;
_Pragma("unroll 4")
                for (int pp = 0; pp < 64; ++pp) {
                    const float wr_ = sW2[(w * 64 + pp) * 2], wi_ = sW2[(w * 64 + pp) * 2 + 1];
                    const float br = sBB[(pp * 16 + h) * 2], bi = sBB[(pp * 16 + h) * 2 + 1];
                    const float tr = wr_ * br - wi_ * bi, ti = wr_ * bi + wi_ * br;
                    const float cr = sC[(hp * 64 + pp) * 2], ci = sC[(hp * 64 + pp) * 2 + 1];
                    sacc += cr * tr - ci * ti;
                }
                KTAB[((size_t)((l * 16 + g) * 2 + d) * 32 + (half * 16 + tp * 2 + w)) * 256 + o] = sacc;
            }
            __syncthreads();
        }
    }
}

DI const float* build_src(const Params& p, int R) {
    int seq, pos; row_info(R, seq, pos);
    const int t = pos - PADR;
    if (t < 0) return nullptr;
    if (t < 16) return p.in[I_META] + (size_t)t * D;
    return (seq < 4) ? p.in[I_XP] + ((size_t)seq * 4096 + (t - 16)) * D : p.in[I_XS] + ((size_t)(seq - 4) * 2048 + (t - 16)) * D;
}
DI void build_rows(const Params& p) {
    const int tid = ltid(); const int lane = tid & 63, wave = tid >> 6;
    bf16_t* H = (bf16_t*)(p.ws + WS_H); float* RSS = (float*)(p.ws + WS_RSS);
    const int stride = lgdim() * 8;
    int R = lbid() * 8 + wave;
    if (R >= MP) return;
    const f32x4 zf = (f32x4){0.f, 0.f, 0.f, 0.f};
    f32x4 nx[4];
    { const float* src = build_src(p, R);
#pragma unroll
      for (int i = 0; i < 4; ++i) nx[i] = src ? __builtin_nontemporal_load((const f32x4*)(src + (lane + 64 * i) * 4)) : zf; }
    while (R < MP) {
        f32x4 v[4];
#pragma unroll
        for (int i = 0; i < 4; ++i) v[i] = nx[i];
        const int Rn = R + stride;
        if (Rn < MP) { const float* src = build_src(p, Rn);
#pragma unroll
            for (int i = 0; i < 4; ++i) nx[i] = src ? __builtin_nontemporal_load((const f32x4*)(src + (lane + 64 * i) * 4)) : zf; }
        float ss = 0.f;
#pragma unroll
        for (int i = 0; i < 4; ++i) {
            u32x2 w; w.x = pack2(v[i][0], v[i][1]); w.y = pack2(v[i][2], v[i][3]); *(u32x2*)(H + (size_t)R * D + (lane + 64 * i) * 4) = w;
            ss += (v[i][0] * v[i][0] + v[i][1] * v[i][1]) + (v[i][2] * v[i][2] + v[i][3] * v[i][3]); }
#pragma unroll
        for (int o = 1; o < 64; o <<= 1) ss += __shfl_xor(ss, o);
        if (lane < 16) RSS[(size_t)R * 16 + lane] = lane == 0 ? ss : 0.f;
        R = Rn;
    }
}

DI void tr_tile(const float* src, int lds_, bf16_t* dst, int ldd, float* tile, const float* kgain = nullptr) {
    const int tid = ltid();
    __syncthreads();
    { const int r = tid >> 4, c4 = (tid & 15) * 4;
#pragma unroll
      for (int rr = 0; rr < 64; rr += 32) { f32x4 v = __builtin_nontemporal_load((const f32x4*)(src + (size_t)(r + rr) * lds_ + c4)); if (kgain) v = v * kgain[r + rr]; float* tp = tile + (r + rr) * 65 + c4; tp[0] = v[0]; tp[1] = v[1]; tp[2] = v[2]; tp[3] = v[3]; } }
    __syncthreads();
    { const int n = tid >> 3, k8 = (tid & 7) * 8; float f[8];
#pragma unroll
      for (int i = 0; i < 8; ++i) f[i] = tile[(k8 + i) * 65 + n];
      *(u32x4*)(dst + (size_t)n * ldd + k8) = pack8(f); }
}

enum { CV_UP = 1, CV_DN = 2, CV_IN = 4, CV_OUT = 8, CV_SMALL = 16 };
DI void convert_weights(const Params& p, int l, int what, int widx, int nw, unsigned char* lds) {
    float* tile = (float*)lds;
    bf16_t* WIN = (bf16_t*)(p.ws + WS_WIN); bf16_t* WOUT = (bf16_t*)(p.ws + WS_WOUT); bf16_t* WUP = (bf16_t*)(p.ws + WS_WUP); bf16_t* WDN = (bf16_t*)(p.ws + WS_WDN);
    bf16_t* WG = (bf16_t*)(p.ws + WS_WG); bf16_t* GLU = (bf16_t*)(p.ws + WS_GLU);
    const int T_UP = (what & CV_UP) ? 16 * 64 : 0, T_DN = (what & CV_DN) ? 64 * 16 : 0, T_IN = (what & CV_IN) ? 16 * 46 : 0, T_OUT = (what & CV_OUT) ? 16 * 16 : 0, T_WG = (what & CV_SMALL) ? 24 : 0, T_GLU = (what & CV_SMALL) ? 16 : 0;
    for (int it = widx; it < T_UP + T_DN + T_IN + T_OUT + T_WG + T_GLU; it += nw) {
        int i = it;
        if (i < T_UP) { const int kt = i / 64, nt = i % 64;
            tr_tile(p.in[I_WUP] + (size_t)l * 1024 * 4096 + (size_t)kt * 64 * 4096 + nt * 64, 4096, WUP + (size_t)nt * 64 * 1024 + kt * 64, 1024, tile, p.in[I_NMLP] + (size_t)l * D + kt * 64); continue; }
        i -= T_UP;
        if (i < T_DN) { const int kt = i / 16, nt = i % 16;
            tr_tile(p.in[I_WDN] + (size_t)l * 4096 * 1024 + (size_t)kt * 64 * 1024 + nt * 64, 1024, WDN + (size_t)nt * 64 * 4096 + kt * 64, 4096, tile); continue; }
        i -= T_DN;
        if (i < T_IN) { const int kt = i / 46, nt = i % 46;
            const int n0 = nt * 64; const int nd = (n0 >= 2688) ? n0 - 2688 : n0 + 256;
            tr_tile(p.in[I_WIN] + (size_t)l * 1024 * 2944 + (size_t)kt * 64 * 2944 + n0, 2944, WIN + (size_t)nd * 1024 + kt * 64, 1024, tile, p.in[I_NMIX] + (size_t)l * D + kt * 64); continue; }
        i -= T_IN;
        if (i < T_OUT) { const int kt = i / 16, nt = i % 16;
            tr_tile(p.in[I_WOUT] + (size_t)l * 1024 * 1024 + (size_t)kt * 64 * 1024 + nt * 64, 1024, WOUT + (size_t)nt * 64 * 1024 + kt * 64, 1024, tile, p.in[I_MGAIN] + (size_t)l * D + kt * 64); continue; }
        i -= T_OUT;
        if (i < T_WG) { const int n = i / 4, gi = i % 4, d = gi >> 1;
            const float* src = ((gi & 1) ? p.in[I_WI] : p.in[I_WR]) + ((size_t)((l * 2 + d) * 6 + n)) * 4096;
            tr_tile(src, 64, WG + (size_t)(n * 256 + gi * 64) * 64, 64, tile); continue; }
        i -= T_WG;
        { const int kt = i / 4, nt = i % 4;
          tr_tile(p.in[I_GLUW] + (size_t)l * 65536 + (size_t)kt * 64 * 256 + nt * 64, 256, GLU + (size_t)nt * 64 * 256 + kt * 64, 256, tile); }
    }
    if (what & CV_IN)
        for (size_t e = (size_t)widx * 512 + ltid(); e < (size_t)128 * 1024 / 8; e += (size_t)nw * 512) *(u32x4*)(WIN + (size_t)2944 * 1024 + e * 8) = (u32x4){0u, 0u, 0u, 0u};
}

DI void build_s5_mats(const Params& p, int l, int widx, int nw) {
    const float* KTAB = (const float*)((const unsigned char*)p.out + DO_KTAB);
    const float* BBAR = (const float*)((const unsigned char*)p.out + DO_BBAR);
    const float* PAR = (const float*)(p.ws + WS_PAR);
    bf16_t* T2 = (bf16_t*)(p.ws + WS_T2); bf16_t* M1 = (bf16_t*)(p.ws + WS_M1);
    const size_t nT2 = (size_t)16 * 512 * 96, nM1 = (size_t)16 * 256 * 64;
    for (size_t e = (size_t)widx * 512 + ltid(); e < nT2 + nM1; e += (size_t)nw * 512) {
        float f[8];
        if (e < nT2) {
            const int g = (int)(e / (512 * 96)), rem = (int)(e % (512 * 96)), n = rem / 96, k0 = (rem % 96) * 8;
            const int t = n >> 4, hp = n & 15;
            if (k0 < 512) {
                const int s = k0 >> 4, h0 = k0 & 15;
#pragma unroll
                for (int j = 0; j < 8; ++j) {
                    float v = 0.f;
                    if (s <= t) v += KTAB[((size_t)((l * 16 + g) * 2 + 0) * 32 + (t - s)) * 256 + hp * 16 + h0 + j];
                    if (s >= t) v += KTAB[((size_t)((l * 16 + g) * 2 + 1) * 32 + (s - t)) * 256 + hp * 16 + h0 + j];
                    f[j] = v;
                }
            } else {
                const int kk = k0 - 512, d = kk >> 7, part = (kk >> 6) & 1, p0 = kk & 63;
                const int base = (l * 2 + d) * 16 + g;
                const float pw = d == 0 ? (float)(t + 1) : (float)(32 - t);
#pragma unroll
                for (int j = 0; j < 8; ++j) {
                    const int pp = p0 + j;
                    const float ar = PAR[(base * 64 + pp) * 2], ai = PAR[(base * 64 + pp) * 2 + 1];
                    const float mg = expf(pw * ar); float sn, cs; sincosf(pw * ai, &sn, &cs);
                    const float wr_ = mg * cs, wi_ = mg * sn;
                    const float cr = p.in[I_CRE][(size_t)base * 1024 + hp * 64 + pp], ci = p.in[I_CIM][(size_t)base * 1024 + hp * 64 + pp];
                    f[j] = part == 0 ? (cr * wr_ - ci * wi_) : -(cr * wi_ + ci * wr_);
                }
            }
            *(u32x4*)(T2 + ((size_t)(g * 512 + n) * 768 + k0)) = pack8(f);
        } else {
            const size_t e2 = e - nT2;
            const int g = (int)(e2 / (256 * 64)), rem = (int)(e2 % (256 * 64)), n = rem / 64, k0 = (rem % 64) * 8;
            const int d = n >> 7, part = (n >> 6) & 1, pp = n & 63;
            const int s = k0 >> 4, h0 = k0 & 15;
            const int base = (l * 2 + d) * 16 + g;
            const float pw = d == 0 ? (float)(31 - s) : (float)s;
            const float ar = PAR[(base * 64 + pp) * 2], ai = PAR[(base * 64 + pp) * 2 + 1];
            const float mg = expf(pw * ar); float sn, cs; sincosf(pw * ai, &sn, &cs);
            const float wr_ = mg * cs, wi_ = mg * sn;
#pragma unroll
            for (int j = 0; j < 8; ++j) {
                const float br = BBAR[((size_t)(base * 64 + pp) * 16 + h0 + j) * 2], bi = BBAR[((size_t)(base * 64 + pp) * 16 + h0 + j) * 2 + 1];
                f[j] = part == 0 ? (wr_ * br - wi_ * bi) : (wr_ * bi + wi_ * br);
            }
            *(u32x4*)(M1 + ((size_t)(g * 256 + n) * 512 + k0)) = pack8(f);
        }
    }
}

constexpr int PB_OFF = 126976;
constexpr int PB_CW = 0, PB_CB = 1536, PB_BR = 1920, PB_BI = 2688, PB_SP = 3456, PB_LB = 4224;
DI void stage_params(const Params& p, int l, unsigned char* lds) {
    float* PB = (float*)(lds + PB_OFF); const int tid = ltid();
    const float* LB = (const float*)(p.ws + WS_LB);
    for (int i = tid; i < 1536; i += 512) PB[PB_CW + i] = p.in[I_CONVW][(size_t)l * 1536 + i];
    if (tid < 384) PB[PB_CB + tid] = p.in[I_CONVB][(size_t)l * 384 + tid];
    for (int i = tid; i < 768; i += 512) {
        PB[PB_BR + i] = p.in[I_BR][(size_t)l * 768 + i]; PB[PB_BI + i] = p.in[I_BI][(size_t)l * 768 + i];
        PB[PB_SP + i] = log1pf(__expf(-p.in[I_LAM][(size_t)l * 768 + i]));
        const int d = i / 384, c = i % 384; PB[PB_LB + i] = LB[(d * 4 + l) * 384 + c];
    }
}

struct RgPre { u32x4 xa0, xa1, ga, wg[4]; float cin; };
DI RgPre rg_load(const Params& p, int item, bool fin) {
    const int tid = ltid();
    const int j = item / 6, n = item % 6;
    const int row0 = j * 64, pos0 = chunk64_pos0(j), L = chunk64_len(j);
    const bf16_t* PROJ = (const bf16_t*)(p.ws + WS_PROJ); const bf16_t* WG = (const bf16_t*)(p.ws + WS_WG);
    const float* RGC = (const float*)((const unsigned char*)p.out + DO_RGC);
    RgPre r; const u32x4 z = (u32x4){0u, 0u, 0u, 0u};
    const int c8 = (tid & 7) * 8;
    { const int rr = tid >> 3, pos = pos0 + rr - 2; r.xa0 = (pos >= PADR && pos < L) ? __builtin_nontemporal_load((const u32x4*)(PROJ + (size_t)(row0 + rr - 2) * PLD + OFF_AX + n * 64 + c8)) : z; }
    r.xa1 = z;
    if (tid < 24) { const int rr = 64 + (tid >> 3), pos = pos0 + rr - 2; if (pos >= PADR && pos < L) r.xa1 = __builtin_nontemporal_load((const u32x4*)(PROJ + (size_t)(row0 + rr - 2) * PLD + OFF_AX + n * 64 + c8)); }
    r.ga = fin ? __builtin_nontemporal_load((const u32x4*)(PROJ + (size_t)(row0 + (tid >> 3)) * PLD + OFF_AG + n * 64 + c8)) : z;
#pragma unroll
    for (int q = 0; q < 4; ++q) { const int idx = tid + 512 * q; r.wg[q] = *(const u32x4*)(WG + (size_t)(n * 256 + (idx >> 3)) * 64 + (idx & 7) * 8); }
    r.cin = 0.f;
    if (fin) { const int sc = tid & 127, c = sc & 63, d = sc >> 6; r.cin = RGC[((size_t)(j * 2 + d) * 384 + n * 64 + c) * 2 + 1]; }
    return r;
}
DI void rg_compute(const Params& p, int item, bool fin, const RgPre& pre, unsigned char* lds) {
    const int tid = ltid(), lane = tid & 63, wave = tid >> 6;
    const int j = item / 6, n = item % 6;
    const int row0 = j * 64, pos0 = chunk64_pos0(j);
    float* XCF = (float*)lds;
    float* AB = (float*)(lds + 16384);
    bf16_t* WGs = (bf16_t*)(lds + 16384);
    bf16_t* XCB = (bf16_t*)(lds + 16384 + 36864);
    bf16_t* XA = (bf16_t*)(lds + 16384 + 36864 + 9216);
    bf16_t* GA = (bf16_t*)(lds + 16384 + 65536);
    float* SEG = (float*)(lds + 16384 + 65536 + 8192);
    const float* PB = (const float*)(lds + PB_OFF);
    __syncthreads();
    { const int c8 = (tid & 7) * 8;
      *(u32x4*)(XA + (tid >> 3) * 64 + c8) = pre.xa0;
      if (tid < 24) *(u32x4*)(XA + (64 + (tid >> 3)) * 64 + c8) = pre.xa1;
#pragma unroll
      for (int q = 0; q < 4; ++q) { const int idx = tid + 512 * q; *(u32x4*)(WGs + (idx >> 3) * 72 + (idx & 7) * 8) = pre.wg[q]; }
    }
    __syncthreads();
    { const int t = tid >> 3, c8 = (tid & 7) * 8;
      const float* cw = PB + PB_CW + n * 64 + c8; const float* cb = PB + PB_CB + n * 64 + c8;
      float xc[8];
#pragma unroll
      for (int i = 0; i < 8; ++i) xc[i] = cb[i];
#pragma unroll
      for (int jj = 0; jj < 4; ++jj) { float xr[8]; unpack8(*(const u32x4*)(XA + (t + jj) * 64 + c8), xr);
#pragma unroll
          for (int i = 0; i < 8; ++i) xc[i] += cw[jj * 384 + i] * xr[i]; }
      *(f32x4*)(XCF + t * 64 + c8) = (f32x4){xc[0], xc[1], xc[2], xc[3]}; *(f32x4*)(XCF + t * 64 + c8 + 4) = (f32x4){xc[4], xc[5], xc[6], xc[7]};
      *(u32x4*)(XCB + t * 72 + c8) = pack8(xc); }
    __syncthreads();
    const int rb = wave & 3, dir = wave >> 2;
    f32x4 acc[8];
#pragma unroll
    for (int c = 0; c < 8; ++c) acc[c] = mma_tile64(XCB + rb * 16 * 72, WGs + (dir * 8 + c) * 16 * 72, 72, lane, (f32x4){0.f, 0.f, 0.f, 0.f});
    __syncthreads();
    { const int cl = lane & 15, q = lane >> 4;
#pragma unroll
      for (int cc = 0; cc < 4; ++cc) {
          const int c = cc * 16 + cl, ch = n * 64 + c;
          const float brv = PB[PB_BR + dir * 384 + ch], biv = PB[PB_BI + dir * 384 + ch], sp = PB[PB_SP + dir * 384 + ch];
#pragma unroll
          for (int jj = 0; jj < 4; ++jj) {
              const int t = rb * 16 + q * 4 + jj;
              const float r = sigmoidf_(acc[cc][jj] + brv), ig = sigmoidf_(acc[cc + 4][jj] + biv);
              const float la = -8.0f * r * sp;
              float a = __expf(la);
              const float om = __builtin_fmaf(-a, a, 1.0f);
              float b = __builtin_amdgcn_sqrtf(fmaxf(om, 0.f)) * ig * XCF[t * 64 + c];
              if (pos0 + t < PADR) { a = 1.0f; b = 0.f; }
              AB[(dir * 2) * 4096 + t * 64 + c] = a; AB[(dir * 2 + 1) * 4096 + t * 64 + c] = b;
          } } }
    __syncthreads();
    float* RGC = (float*)((unsigned char*)p.out + DO_RGC);
    const int sc = tid & 127, seg = tid >> 7, sch = sc & 63, sd = sc >> 6;
    const float* Aa = AB + (sd * 2) * 4096 + sch; float* Bb = AB + (sd * 2 + 1) * 4096 + sch;
    { float P = 1.f, E = 0.f;
#pragma unroll
      for (int u = 0; u < 16; ++u) { const int uu = seg * 16 + u, t = sd == 0 ? uu : 63 - uu; const float a = Aa[t * 64]; E = a * E + Bb[t * 64]; P *= a; }
      SEG[(sc * 4 + seg) * 2] = P; SEG[(sc * 4 + seg) * 2 + 1] = E; }
    __syncthreads();
    if (!fin) {
        if (tid < 128) { float Pt = 1.f, Et = 0.f;
#pragma unroll
            for (int q = 0; q < 4; ++q) { const float Ps = SEG[(tid * 4 + q) * 2], Es = SEG[(tid * 4 + q) * 2 + 1]; Et = Ps * Et + Es; Pt *= Ps; }
            float* cp = RGC + ((size_t)(j * 2 + sd) * 384 + n * 64 + sch) * 2; cp[0] = Pt; cp[1] = Et; }
        return;
    }
    { float h = pre.cin;
      for (int q = 0; q < seg; ++q) h = SEG[(sc * 4 + q) * 2] * h + SEG[(sc * 4 + q) * 2 + 1];
#pragma unroll
      for (int u = 0; u < 16; ++u) { const int uu = seg * 16 + u, t = sd == 0 ? uu : 63 - uu; h = Aa[t * 64] * h + Bb[t * 64]; Bb[t * 64] = h; } }
    __syncthreads();
    { const int t = tid >> 3, c8 = (tid & 7) * 8;
      bf16_t* YM = (bf16_t*)(p.ws + WS_ACT); float* SS = (float*)(p.ws + WS_SS);
      const bool valid = pos0 + t >= PADR;
      float y[8], ss = 0.f;
      float gg[8]; unpack8(pre.ga, gg);
      const f32x4 h0a = *(const f32x4*)(AB + 1 * 4096 + t * 64 + c8), h0b = *(const f32x4*)(AB + 1 * 4096 + t * 64 + c8 + 4), h1a = *(const f32x4*)(AB + 3 * 4096 + t * 64 + c8), h1b = *(const f32x4*)(AB + 3 * 4096 + t * 64 + c8 + 4);
#pragma unroll
      for (int i = 0; i < 8; ++i) { const float hs = i < 4 ? h0a[i & 3] + h1a[i & 3] : h0b[i & 3] + h1b[i & 3];
          const float o = valid ? hs * gelu_tanh(gg[i]) : 0.f; y[i] = o; ss += o * o; }
      *(u32x4*)(YM + (size_t)(row0 + t) * D + n * 64 + c8) = pack8(y);
      ss += __shfl_xor(ss, 1); ss += __shfl_xor(ss, 2); ss += __shfl_xor(ss, 4);
      if ((tid & 7) == 0) SS[(size_t)(row0 + t) * 16 + n] = ss; }
}

struct HgPre { u32x4 xi, xff, xfb, xq, xg, s0, s1; };
DI HgPre hg_load(const Params& p, int item, bool fin) {
    const int tid = ltid();
    const int j = item / 6, n = item % 6, row0 = j * 64;
    const int t = tid >> 3, k8 = (tid & 7) * 8;
    const bf16_t* rowp = (const bf16_t*)(p.ws + WS_PROJ) + (size_t)(row0 + t) * PLD + n * 64 + k8;
    const bf16_t* HGS = (const bf16_t*)((const unsigned char*)p.out + DO_HGS);
    HgPre r; const u32x4 z = (u32x4){0u, 0u, 0u, 0u};
    r.xi = __builtin_nontemporal_load((const u32x4*)(rowp + OFF_BI)); r.xff = __builtin_nontemporal_load((const u32x4*)(rowp + OFF_BFF)); r.xfb = __builtin_nontemporal_load((const u32x4*)(rowp + OFF_BFB));
    r.xq = z; r.xg = z; r.s0 = z; r.s1 = z;
    if (fin) {
        r.xq = __builtin_nontemporal_load((const u32x4*)(rowp + OFF_BQ)); r.xg = __builtin_nontemporal_load((const u32x4*)(rowp + OFF_BG));
        const bf16_t* s0 = HGS + ((size_t)(j * 6 + n) * 2 + 0) * 4096 + t * 64 + k8;
        r.s0 = __builtin_nontemporal_load((const u32x4*)s0); r.s1 = __builtin_nontemporal_load((const u32x4*)(s0 + 4096));
    }
    return r;
}
DI void hg_compute(const Params& p, int item, bool fin, const HgPre& pre, unsigned char* lds) {
    const int tid = ltid(), lane = tid & 63, wave = tid >> 6;
    const int j = item / 6, n = item % 6;
    const int row0 = j * 64, pos0 = chunk64_pos0(j);
    float* LF = (float*)lds;
    bf16_t* QT = (bf16_t*)(lds + 32768);
    bf16_t* KT = (bf16_t*)(lds + 51200);
    bf16_t* VT = (bf16_t*)(lds + 69632);
    bf16_t* SC = (bf16_t*)(lds + 78848);
    bf16_t* SP = (bf16_t*)(lds + 97280);
    bf16_t* XG = (bf16_t*)(lds + 115712);
    float* SEGT = (float*)(lds + 123904);
    float* OX = (float*)lds;
    const float* PB = (const float*)(lds + PB_OFF);
    bf16_t* HGS = (bf16_t*)((unsigned char*)p.out + DO_HGS);
    float* HGD = (float*)(p.ws + WS_HGD);
    const int t = tid >> 3, k8 = (tid & 7) * 8;
    const bool masked = pos0 + t < PADR;
    __syncthreads();
    float kk[2][8], q[8];
    {
        float xf[8], xv[8];
        unpack8(pre.xi, xv);
#pragma unroll
        for (int i = 0; i < 8; ++i) VT[(k8 + i) * 72 + t] = f2bf(masked ? 0.f : xv[i]);
#pragma unroll
        for (int d = 0; d < 2; ++d) {
            unpack8(d == 0 ? pre.xff : pre.xfb, xf);
#pragma unroll
            for (int i = 0; i < 8; ++i) {
                const float lb = PB[PB_LB + d * 384 + n * 64 + k8 + i];
                const float sg = sigmoidf_(xf[i]);
                const float f = lb + (1.0f - lb) * sg;
                kk[d][i] = masked ? 0.f : (1.0f - lb) * (1.0f - sg);
                LF[d * 4096 + t * 64 + k8 + i] = masked ? 0.f : __logf(f);
            }
        }
#pragma unroll
        for (int i = 0; i < 8; ++i) q[i] = 0.f;
        if (fin) { unpack8(pre.xq, q);
#pragma unroll
            for (int i = 0; i < 8; ++i) q[i] = siluf_(q[i]);
            *(u32x4*)(XG + t * 64 + k8) = pre.xg; }
    }
    __syncthreads();
    { const int sc = tid & 127, seg = tid >> 7, k = sc & 63, d = sc >> 6; float run = 0.f; float* lf = LF + d * 4096 + k;
#pragma unroll
      for (int u = 0; u < 16; ++u) { const int uu = seg * 16 + u, s_ = d == 0 ? uu : 63 - uu; run += lf[s_ * 64]; lf[s_ * 64] = run; }
      SEGT[sc * 4 + seg] = run;
      __syncthreads();
      float off = 0.f;
      for (int q2 = 0; q2 < seg; ++q2) off += SEGT[sc * 4 + q2];
      if (seg > 0) {
#pragma unroll
          for (int u = 0; u < 16; ++u) { const int uu = seg * 16 + u, s_ = d == 0 ? uu : 63 - uu; lf[s_ * 64] += off; } } }
    __syncthreads();
    const int rb = wave & 3, dir = wave >> 2, cl = lane & 15, qd = lane >> 4;
    if (!fin) {
#pragma unroll
        for (int d = 0; d < 2; ++d)
#pragma unroll
            for (int i = 0; i < 8; ++i) {
                const int k = k8 + i; const float tot = d == 0 ? LF[63 * 64 + k] : LF[4096 + k];
                KT[d * 4608 + k * 72 + t] = f2bf(kk[d][i] * __expf(tot - LF[d * 4096 + t * 64 + k]));
                if (t == 0) HGD[((size_t)(j * 6 + n) * 2 + d) * 64 + k] = __expf(tot);
            }
        __syncthreads();
#pragma unroll
        for (int kb = 0; kb < 4; ++kb) {
            const f32x4 a = mma_tile64(VT + rb * 16 * 72, KT + dir * 4608 + kb * 16 * 72, 72, lane, (f32x4){0.f, 0.f, 0.f, 0.f});
            bf16_t* dst = HGS + ((size_t)(j * 6 + n) * 2 + dir) * 4096;
#pragma unroll
            for (int jj = 0; jj < 4; ++jj) dst[(rb * 16 + qd * 4 + jj) * 64 + kb * 16 + cl] = f2bf(a[jj]);
        }
        return;
    }
#pragma unroll
    for (int d = 0; d < 2; ++d) {
        float qv[8], kv[8];
#pragma unroll
        for (int i = 0; i < 8; ++i) {
            const int k = k8 + i; const float m = LF[d * 4096 + 32 * 64 + k];
            const float e1 = fminf(fmaxf(LF[d * 4096 + t * 64 + k] - m, -80.f), 80.f);
            const float ex = __expf(e1); qv[i] = q[i] * ex; kv[i] = kk[d][i] * __builtin_amdgcn_rcpf(ex);
        }
        *(u32x4*)(QT + d * 4608 + t * 72 + k8) = pack8(qv);
        *(u32x4*)(KT + d * 4608 + t * 72 + k8) = pack8(kv);
        float sv[8]; unpack8(d == 0 ? pre.s0 : pre.s1, sv);
#pragma unroll
        for (int i = 0; i < 8; ++i) sv[i] *= __expf(LF[d * 4096 + 32 * 64 + k8 + i]);
        *(u32x4*)(SP + d * 4608 + t * 72 + k8) = pack8(sv);
    }
    __syncthreads();
#pragma unroll
    for (int ct = 0; ct < 4; ++ct) {
        const f32x4 a = mma_tile64(QT + dir * 4608 + rb * 16 * 72, KT + dir * 4608 + ct * 16 * 72, 72, lane, (f32x4){0.f, 0.f, 0.f, 0.f});
#pragma unroll
        for (int jj = 0; jj < 4; ++jj) {
            const int tt = rb * 16 + qd * 4 + jj, s_ = ct * 16 + cl;
            const bool keep = dir == 0 ? (s_ <= tt) : (s_ >= tt);
            SC[dir * 4608 + tt * 72 + s_] = f2bf(keep ? a[jj] : 0.f);
        }
    }
    __syncthreads();
    f32x4 o[4];
#pragma unroll
    for (int vt = 0; vt < 4; ++vt) {
        f32x4 a = mma_tile64(SC + dir * 4608 + rb * 16 * 72, VT + vt * 16 * 72, 72, lane, (f32x4){0.f, 0.f, 0.f, 0.f});
        o[vt] = mma_tile64(QT + dir * 4608 + rb * 16 * 72, SP + dir * 4608 + vt * 16 * 72, 72, lane, a);
    }
#pragma unroll
    for (int vt = 0; vt < 4; ++vt)
#pragma unroll
        for (int jh = 0; jh < 2; ++jh) { const int jj = dir == 0 ? 2 + jh : jh; const float val = dir == 0 ? o[vt][2 + jh] : o[vt][jh];
            OX[(rb * 16 + qd * 4 + jj) * 64 + vt * 16 + cl] = val; }
    __syncthreads();
    {
        bf16_t* YM = (bf16_t*)(p.ws + WS_ACT); float* SS = (float*)(p.ws + WS_SS);
#pragma unroll
        for (int jh = 0; jh < 2; ++jh) {
            const int jj = dir * 2 + jh;
            const int tt = rb * 16 + qd * 4 + jj;
            float ov[4], sq = 0.f;
#pragma unroll
            for (int vt = 0; vt < 4; ++vt) { const float own = dir == 0 ? o[vt][jh] : o[vt][2 + jh]; ov[vt] = own + OX[tt * 64 + vt * 16 + cl]; sq += ov[vt] * ov[vt]; }
            sq += __shfl_xor(sq, 1); sq += __shfl_xor(sq, 2); sq += __shfl_xor(sq, 4); sq += __shfl_xor(sq, 8);
            const float rn = rsqrtf(sq * (1.0f / 64.0f) + EPS);
            const bool valid = pos0 + tt >= PADR;
            float s2 = 0.f;
#pragma unroll
            for (int vt = 0; vt < 4; ++vt) {
                const int v = vt * 16 + cl;
                const float y = valid ? ov[vt] * rn * siluf_(bf2f(XG[tt * 64 + v])) : 0.f;
                s2 += y * y;
                YM[(size_t)(row0 + tt) * D + 384 + n * 64 + v] = f2bf(y);
            }
            s2 += __shfl_xor(s2, 1); s2 += __shfl_xor(s2, 2); s2 += __shfl_xor(s2, 4); s2 += __shfl_xor(s2, 8);
            if (cl == 0) SS[(size_t)(row0 + tt) * 16 + 6 + n] = s2;
        }
    }
}

constexpr int CG = 33;
DI void phase_carries(const Params& p, int l) {
    bf16_t* HGS = (bf16_t*)((unsigned char*)p.out + DO_HGS);
    const float* HGD = (const float*)(p.ws + WS_HGD);
    float* RGC = (float*)((unsigned char*)p.out + DO_RGC);
    const float* S5E = (const float*)((const unsigned char*)p.out + DO_S5E);
    bf16_t* U2 = (bf16_t*)(p.ws + WS_U2);
    const float* PAR = (const float*)(p.ws + WS_PAR);
    const int N_HG = 12 * 6 * 2 * 2048, N_RG = 12 * 2 * 384, N_S5 = 12 * 16 * 2 * 64;
    for (int idx = lbid() * 512 + ltid(); idx < N_HG + N_RG + N_S5; idx += lgdim() * 512) {
        if (idx < N_HG) {
            const int seq = idx / 24576, rem = idx % 24576, n = rem / 4096, d = (rem >> 11) & 1, e2 = rem & 2047, k = (e2 * 2) & 63;
            int c0, nc; seq_chunks64(seq, c0, nc);
            unsigned* HG32 = (unsigned*)HGS;
            float S0 = 0.f, S1 = 0.f;
            for (int i0 = 0; i0 < nc; i0 += CG) {
                unsigned loc[CG]; float dec0[CG], dec1[CG];
#pragma unroll
                for (int u = 0; u < CG; ++u) { const int i = i0 + u; if (i < nc) { const int jc = d == 0 ? c0 + i : c0 + nc - 1 - i; const size_t b = (size_t)(jc * 6 + n) * 2 + d; loc[u] = __builtin_nontemporal_load(HG32 + b * 2048 + e2); dec0[u] = HGD[b * 64 + k]; dec1[u] = HGD[b * 64 + k + 1]; } else { loc[u] = 0u; dec0[u] = 0.f; dec1[u] = 0.f; } }
#pragma unroll
                for (int u = 0; u < CG; ++u) { const int i = i0 + u; if (i < nc) { const int jc = d == 0 ? c0 + i : c0 + nc - 1 - i; const size_t b = (size_t)(jc * 6 + n) * 2 + d; HG32[b * 2048 + e2] = pack2(S0, S1); S0 = dec0[u] * S0 + bflo(loc[u]); S1 = dec1[u] * S1 + bfhi(loc[u]); } }
            }
        } else if (idx < N_HG + N_RG) {
            const int i2 = idx - N_HG; const int seq = i2 / 768, rem = i2 % 768, d = rem / 384, ch = rem % 384;
            int c0, nc; seq_chunks64(seq, c0, nc);
            float c = 0.f;
            for (int i0 = 0; i0 < nc; i0 += CG) {
                float P[CG], E[CG];
#pragma unroll
                for (int u = 0; u < CG; ++u) { const int i = i0 + u; if (i < nc) { const int jc = d == 0 ? c0 + i : c0 + nc - 1 - i; const float* cp = RGC + ((size_t)(jc * 2 + d) * 384 + ch) * 2; P[u] = cp[0]; E[u] = cp[1]; } else { P[u] = 0.f; E[u] = 0.f; } }
#pragma unroll
                for (int u = 0; u < CG; ++u) { const int i = i0 + u; if (i < nc) { const int jc = d == 0 ? c0 + i : c0 + nc - 1 - i; float* cp = RGC + ((size_t)(jc * 2 + d) * 384 + ch) * 2; cp[1] = c; c = P[u] * c + E[u]; } }
            }
        } else {
            const int i2 = idx - N_HG - N_RG; const int seq = i2 / 2048, g = (i2 >> 7) & 15, d = (i2 >> 6) & 1, pp = i2 & 63;
            int c0, nc; seq_chunks32(seq, c0, nc);
            const int base = (l * 2 + d) * 16 + g;
            const float ar = PAR[(base * 64 + pp) * 2], ai = PAR[(base * 64 + pp) * 2 + 1];
            const float mg = expf(32.0f * ar); float sn, cs; sincosf(32.0f * ai, &sn, &cs);
            const float wr_ = mg * cs, wi_ = mg * sn;
            float hr = 0.f, hi = 0.f;
            for (int i0 = 0; i0 < nc; i0 += CG) {
                float er[CG], ei[CG];
#pragma unroll
                for (int u = 0; u < CG; ++u) { const int i = i0 + u; if (i < nc) { const int c = d == 0 ? c0 + i : c0 + nc - 1 - i; const size_t ro = (size_t)(g * U2ROWS + c); er[u] = __builtin_nontemporal_load(S5E + ro * 256 + d * 128 + pp); ei[u] = __builtin_nontemporal_load(S5E + ro * 256 + d * 128 + 64 + pp); } else { er[u] = 0.f; ei[u] = 0.f; } }
#pragma unroll
                for (int u = 0; u < CG; ++u) { const int i = i0 + u; if (i < nc) { const int c = d == 0 ? c0 + i : c0 + nc - 1 - i; const size_t ro = (size_t)(g * U2ROWS + c);
                    U2[ro * U2LD + 512 + d * 128 + pp] = f2bf(hr); U2[ro * U2LD + 512 + d * 128 + 64 + pp] = f2bf(hi);
                    const float nr = wr_ * hr - wi_ * hi + er[u], ni = wr_ * hi + wi_ * hr + ei[u]; hr = nr; hi = ni; } }
            }
        }
    }
}

struct MnPre { u32x4 y; f32x4 s0, s1, s2, s3, g0, g1; };
DI MnPre mn_load(const bf16_t* YM, const float* SS, const float* gain, size_t e) {
    const int R = (int)(e >> 7), c0 = (int)(e & 127) * 8; const float* sp = SS + (size_t)R * 16;
    MnPre r; r.y = __builtin_nontemporal_load((const u32x4*)(YM + (size_t)R * D + c0));
    r.s0 = *(const f32x4*)sp; r.s1 = *(const f32x4*)(sp + 4); r.s2 = *(const f32x4*)(sp + 8); r.s3 = *(const f32x4*)(sp + 12);
    r.g0 = *(const f32x4*)(gain + c0); r.g1 = *(const f32x4*)(gain + c0 + 4);
    return r;
}
DI void phase_mixnorm(const Params& p, int l) {
    bf16_t* YM = (bf16_t*)(p.ws + WS_ACT); const float* SS = (const float*)(p.ws + WS_SS);
    const float* gain = p.in[I_MGAIN] + (size_t)l * D;
    const size_t N = (size_t)MP * 128, stride = (size_t)lgdim() * 512;
    size_t e = (size_t)lbid() * 512 + ltid();
    if (e >= N) return;
    MnPre nx = mn_load(YM, SS, gain, e);
    while (e < N) {
        const MnPre cur = nx; const size_t en = e + stride;
        if (en < N) nx = mn_load(YM, SS, gain, en);
        const int R = (int)(e >> 7), c0 = (int)(e & 127) * 8;
        const int br = c0 < 384 ? 0 : (c0 < 768 ? 1 : 2);
        const float inv = br == 2 ? (1.0f / 256.0f) : (1.0f / 384.0f);
        const f32x4 s0 = cur.s0, s1 = cur.s1, s2 = cur.s2, s3 = cur.s3;
        const float tot = br == 0 ? (((s0[0] + s0[1]) + (s0[2] + s0[3])) + (s1[0] + s1[1])) : (br == 1 ? (((s1[2] + s1[3]) + (s2[0] + s2[1])) + (s2[2] + s2[3])) : ((s3[0] + s3[1]) + (s3[2] + s3[3])));
        const float rn = rsqrtf(tot * inv + EPS);
        float f[8]; unpack8(cur.y, f);
#pragma unroll
        for (int i = 0; i < 4; ++i) { f[i] = f[i] * rn * cur.g0[i]; f[4 + i] = f[4 + i] * rn * cur.g1[i]; }
        *(u32x4*)(YM + (size_t)R * D + c0) = pack8(f);
        e = en;
    }
}

DI void phase_combine(const Params& p) {
    const int tid = ltid(); const int lane = tid & 63, wave = tid >> 6;
    bf16_t* H = (bf16_t*)(p.ws + WS_H); float* RSS = (float*)(p.ws + WS_RSS);
    const float* P = (const float*)((const unsigned char*)p.out + DO_PART);
    for (int rr = lbid() * 8 + wave; rr < 768; rr += lgdim() * 8) {
        const int R = 32768 + rr;
        float ss = 0.f;
        u32x2 ho[4]; f32x4 pp[4][4];
#pragma unroll
        for (int q = 0; q < 4; ++q) { const int col = lane * 16 + q * 4; ho[q] = *(const u32x2*)(H + (size_t)R * D + col);
#pragma unroll
            for (int ks = 0; ks < 4; ++ks) pp[q][ks] = *(const f32x4*)(P + ((size_t)ks * 768 + rr) * D + col); }
#pragma unroll
        for (int q = 0; q < 4; ++q) {
            const int col = lane * 16 + q * 4;
            f32x4 h = (f32x4){bflo(ho[q].x), bfhi(ho[q].x), bflo(ho[q].y), bfhi(ho[q].y)};
#pragma unroll
            for (int ks = 0; ks < 4; ++ks) h = h + pp[q][ks];
            u32x2 w; w.x = pack2(h[0], h[1]); w.y = pack2(h[2], h[3]); *(u32x2*)(H + (size_t)R * D + col) = w;
            ss += (h[0] * h[0] + h[1] * h[1]) + (h[2] * h[2] + h[3] * h[3]);
        }
        ss += __shfl_xor(ss, 1); ss += __shfl_xor(ss, 2);
        if ((lane & 3) == 0) RSS[(size_t)R * 16 + (lane >> 2)] = ss;
    }
}

DI int out_row_to_R(int O) { if (O < 16384) return (O >> 12) * LP + 64 + (O & 4095); const int o2 = O - 16384; return ROWS_P + (o2 >> 11) * LS + 64 + (o2 & 2047); }
DI void phase_final(const Params& p) {
    const int tid = ltid(); const int lane = tid & 63, wave = tid >> 6;
    const bf16_t* H = (const bf16_t*)(p.ws + WS_H); const float* gain = p.in[I_NFIN];
    f32x4 gg[4];
#pragma unroll
    for (int i = 0; i < 4; ++i) gg[i] = *(const f32x4*)(gain + (lane + 64 * i) * 4);
    const int stride = lgdim() * 8;
    int O = lbid() * 8 + wave;
    if (O >= 32768) return;
    u32x2 nx[4];
#pragma unroll
    for (int i = 0; i < 4; ++i) nx[i] = __builtin_nontemporal_load((const u32x2*)(H + (size_t)out_row_to_R(O) * D + (lane + 64 * i) * 4));
    while (O < 32768) {
        u32x2 cur[4];
#pragma unroll
        for (int i = 0; i < 4; ++i) cur[i] = nx[i];
        const int On = O + stride;
        if (On < 32768) {
#pragma unroll
            for (int i = 0; i < 4; ++i) nx[i] = __builtin_nontemporal_load((const u32x2*)(H + (size_t)out_row_to_R(On) * D + (lane + 64 * i) * 4));
        }
        f32x4 v[4]; float ss = 0.f;
#pragma unroll
        for (int i = 0; i < 4; ++i) { v[i] = (f32x4){bflo(cur[i].x), bfhi(cur[i].x), bflo(cur[i].y), bfhi(cur[i].y)}; ss += (v[i][0] * v[i][0] + v[i][1] * v[i][1]) + (v[i][2] * v[i][2] + v[i][3] * v[i][3]); }
#pragma unroll
        for (int o = 1; o < 64; o <<= 1) ss += __shfl_xor(ss, o);
        const float rn = rsqrtf(ss * (1.0f / D) + EPS);
        float* dst = p.out + (size_t)O * D;
#pragma unroll
        for (int i = 0; i < 4; ++i) __builtin_nontemporal_store(v[i] * rn * gg[i], (f32x4*)(dst + (lane + 64 * i) * 4));
        O = On;
    }
}

#define XB_TMO      128
#define XB_XCNT(j)  (256  + 64 * (j))
#define XB_XSUB(j)  (1280 + 64 * (j))
#define XB_XGEN(j)  (2304 + 64 * (j))
#define XB_TOP      3328
#define XB_TOPGEN   3392
#define XCD_BAR_WORDS 3456
#define XB_SPIN_CAP (1u << 18)
DI unsigned xb_ld(unsigned* p)              { return __hip_atomic_load(p, __ATOMIC_RELAXED, __HIP_MEMORY_SCOPE_AGENT); }
DI unsigned xb_add(unsigned* p, unsigned v) { return __hip_atomic_fetch_add(p, v, __ATOMIC_RELAXED, __HIP_MEMORY_SCOPE_AGENT); }
DI unsigned xb_xcc_id() { return (unsigned)__builtin_amdgcn_s_getreg((3 << 11) | 20) & 0xFu; }
#define XB_SPIN(cond, bar) do { unsigned _sp = 0; while (cond) { __builtin_amdgcn_s_sleep(1); \
    if ((++_sp & 255u) == 0u) { if (xb_ld(&(bar)[XB_TMO])) break; if (_sp > XB_SPIN_CAP) { atomicAdd(&(bar)[XB_TMO], 1u); break; } } } } while (0)
struct XcdBarrier { unsigned* bar; unsigned x; volatile LAS unsigned* st; };
DI XcdBarrier xcd_barrier_post(unsigned* bar, volatile LAS unsigned* st) {
    XcdBarrier b; b.bar = bar; b.x = xb_xcc_id(); b.st = st;
    if (threadIdx.x == 0) (void)xb_add(&bar[XB_XCNT(b.x)], 1u);
    return b;
}
DI void xcd_barrier_complete(unsigned* bar, unsigned x, unsigned& nloc, unsigned& nx) {
    const unsigned G = gridDim.x * gridDim.y * gridDim.z;
    unsigned sum, cnt, mine, sp = 0u;
    for (;;) {
        sum = 0u; cnt = 0u; mine = 0u;
#pragma unroll
        for (unsigned j = 0; j < 16; ++j) { const unsigned c = xb_ld(&bar[XB_XCNT(j)]); sum += c; cnt += (c > 0u) ? 1u : 0u; mine = (j == x) ? c : mine; }
        if (sum == G) break;
        __builtin_amdgcn_s_sleep(1);
        if ((++sp & 255u) == 0u) { if (xb_ld(&bar[XB_TMO])) break; if (sp > XB_SPIN_CAP) { atomicAdd(&bar[XB_TMO], 1u); break; } }
    }
    nloc = mine > 0u ? mine : 1u; nx = cnt > 0u ? cnt : 1u;
}
DI void xcd_barrier(const XcdBarrier& b) {
    asm volatile("s_waitcnt vmcnt(0)" ::: "memory");
    __syncthreads();
    if (threadIdx.x == 0) {
        unsigned* bar = b.bar;
        __builtin_amdgcn_s_waitcnt(0);
        unsigned nloc = b.st[0], nx = b.st[1];
        if (nloc == 0u) { xcd_barrier_complete(bar, b.x, nloc, nx); b.st[0] = nloc; b.st[1] = nx; }
        const unsigned old = xb_add(&bar[XB_XSUB(b.x)], 1u);
        const unsigned gen = old / nloc;
        if (old + 1u == (gen + 1u) * nloc) {
            __builtin_amdgcn_fence(__ATOMIC_RELEASE, "agent");
            asm volatile("s_waitcnt vmcnt(0)" ::: "memory");
            const unsigned og = xb_add(&bar[XB_TOP], 1u);
            const unsigned tg = og / nx;
            if (og + 1u == (tg + 1u) * nx) xb_add(&bar[XB_TOPGEN], 1u);
            else XB_SPIN(xb_ld(&bar[XB_TOPGEN]) == tg, bar);
            __builtin_amdgcn_fence(__ATOMIC_ACQUIRE, "agent");
            xb_add(&bar[XB_XGEN(b.x)], 1u);
            asm volatile("s_waitcnt vmcnt(0)" ::: "memory");
        } else {
            XB_SPIN(xb_ld(&bar[XB_XGEN(b.x)]) == gen, bar);
            __builtin_amdgcn_fence(__ATOMIC_ACQUIRE, "agent");
            asm volatile("s_waitcnt vmcnt(0)" ::: "memory");
        }
    }
    __syncthreads();
}

DI int item_start(int c, int ng, int G, int NI, float pa, float per) {
    if (c >= G) return NI;
    const float f = c <= ng ? __fmul_rn(pa, (float)c) : __fadd_rn(__fmul_rn(pa, (float)ng), __fmul_rn(per, (float)(c - ng)));
    const int i = (int)__fadd_rn(f, 0.5f);
    return i > NI ? NI : i;
}

constexpr int NPHASE = 2 + 9 * DEPTH;
enum { GM_NONE = 0, GM_INPROJ, GM_RESADD, GM_RELU2, GM_S5E, GM_S5Y, GM_GLU };

struct EpiAny {
    const pg8::Gemm* g;
    DI bool mixn() const { return g->mixn != 0; }
    DI void mix_rescale(f32x4 (&acc)[2][2][4][2], LAS unsigned char* lds, int par, int t, int wr, int fr) const {
#pragma unroll
        for (int ai = 0; ai < 2; ++ai)
#pragma unroll
            for (int m = 0; m < 4; ++m) { float rA, rB, rC; mn_get(lds, par, wr * 64 + fr + ai * 128 + m * 16, rA, rB, rC);
                const float ratio = t == 6 ? rA * __builtin_amdgcn_rcpf(rB) : rB * __builtin_amdgcn_rcpf(rC);
#pragma unroll
                for (int bj = 0; bj < 2; ++bj)
#pragma unroll
                    for (int n = 0; n < 2; ++n) acc[ai][bj][m][n] = acc[ai][bj][m][n] * ratio; }
    }
    DI void prime_commit(LAS unsigned char* lds, int tid, const f32x4& a, const f32x4& b) const { if (g->mixn) mn_commit(lds, 0, tid, a, b); else rs_commit(lds, 0, tid, a, b); }
    DI bool prime_issue(const Unit& u, int tid, f32x4& a, f32x4& b) const {
        const bool m = (g->mode == GM_INPROJ || g->mode == GM_RELU2 || g->mixn);
        if (m) rs_issue(g->mixn ? (const float*)g->i1 : (const float*)g->i0, u.pm, tid, a, b);
        return m;
    }
    DI void operator()(const f32x4 (&acc)[2][2][4][2], const Unit& u, int wr, int wc, int fr, int fq, LAS unsigned char* lds, bool has_next, const Unit& nx, int par) const {
        asm volatile("" : "+v"(fr), "+v"(fq));
        asm volatile("" : "+s"(wr), "+s"(wc));
        switch (g->mode) {
        case GM_INPROJ: { EpiInProj E{(bf16_t*)g->o0, (bf16_t*)g->o1, (const float*)g->i0}; E(acc, u, wr, wc, fr, fq, lds, has_next, nx, par); } break;
        case GM_RESADD: if (g->sched == 3 && u.pm >= 128) { EpiPart E{(float*)const_cast<void*>(g->i1)}; E(acc, u, wr, wc, fr, fq); }
                        else { EpiResAdd E{(bf16_t*)g->o0, (float*)const_cast<void*>(g->i0)}; E(acc, u, wr, wc, fr, fq, g->mixn ? (const float*)g->i1 : nullptr, lds, has_next, nx, par); } break;
        case GM_RELU2:  { EpiRelu2 E{(bf16_t*)g->o0, (const float*)g->i0}; E(acc, u, wr, wc, fr, fq, lds, has_next, nx, par); } break;
        case GM_S5E:    { EpiS5E E{(float*)g->o0}; E(acc, u, wr, wc, fr, fq); } break;
        case GM_S5Y:    { EpiS5Y E{(const bf16_t*)g->i0, (bf16_t*)g->o0, (const float*)g->i1}; E(acc, u, wr, wc, fr, fq); } break;
        default:        { EpiGlu E{(const bf16_t*)g->i0, (bf16_t*)g->o0, (float*)g->o1, (const float*)g->i1}; E(acc, u, wr, wc, fr, fq); } break;
        }
    }
};

__global__ void __launch_bounds__(512, 2) mega(Params p) {
    extern __shared__ __attribute__((aligned(16))) unsigned char lds[];
    cg::grid_group grid = cg::this_grid();
    LAS unsigned char* ldsl = (LAS unsigned char*)lds;
    volatile LAS unsigned* xbst = (volatile LAS unsigned*)(ldsl + LDS_BYTES - 16);
    if (threadIdx.x < 4) xbst[threadIdx.x] = 0u;
    __syncthreads();
    const XcdBarrier xbar = xcd_barrier_post((unsigned*)(p.ws + WS_BAR), xbst);

#ifdef PROBE_DOUBLE_MASK
    bool rep = false;
#endif
    for (int ph = p.ph_lo; ph < p.ph_hi; ++ph) {
        const int l = ph >= 1 ? (ph - 1) / 9 : 0, si = ph >= 1 ? (ph - 1) % 9 : 0;
        const int s = (ph == 0) ? 100 : (ph == NPHASE - 1 ? 101 : (si < 5 ? si + 1 : (si == 5 ? 7 : si + 3)));
        unsigned char* ws = p.ws; unsigned char* ob = (unsigned char*)p.out; asm volatile("" : "+s"(ws), "+s"(ob));
        const int G = lgdim(), c = lbid();
#ifdef PROBE_TS_MASK
        if (blockIdx.x == 0 && threadIdx.x == 0) ((unsigned long long*)(p.ws + WS_TS))[ph] = __builtin_amdgcn_s_memrealtime();
#endif
        pg8::Gemm g; g.mixn = 0; g.mode = GM_NONE; g.perm = 0; g.sched = 0; g.M = MP; g.N = 0; g.o0 = nullptr; g.o1 = nullptr; g.i0 = nullptr; g.i1 = nullptr; g.A = nullptr; g.Bt = nullptr; g.K = 0; g.lda = 0; g.ldb = 0;
        switch (s) {
        case 1:  g.mode = GM_INPROJ; g.perm = 1; g.A = (const bf16_t*)(ws + WS_H); g.Bt = (const bf16_t*)(ws + WS_WIN); g.K = 1024; g.lda = 1024; g.ldb = 1024; g.N = 3072; g.o0 = ws + WS_PROJ; g.o1 = ws + WS_U2; g.i0 = ws + WS_RSS; break;
        case 2:  g.mode = GM_S5E; g.sched = 1; g.A = (const bf16_t*)(ws + WS_U2); g.Bt = (const bf16_t*)(ws + WS_M1); g.K = 512; g.lda = U2LD; g.ldb = 512; g.o0 = ob + DO_S5E; break;
        case 4:  g.mode = GM_S5Y; g.perm = 1; g.sched = 2; g.A = (const bf16_t*)(ws + WS_U2); g.Bt = (const bf16_t*)(ws + WS_T2); g.K = 768; g.lda = U2LD; g.ldb = 768; g.i0 = ws + WS_U2; g.o0 = ws + WS_Z; g.i1 = p.in[I_S5D] + (size_t)l * 256; break;
        case 5:  g.mode = GM_GLU; g.perm = 1; g.A = (const bf16_t*)(ws + WS_Z); g.Bt = (const bf16_t*)(ws + WS_GLU); g.K = 256; g.lda = 256; g.ldb = 256; g.N = 256; g.i0 = ws + WS_Z; g.o0 = ws + WS_ACT; g.o1 = ws + WS_SS; g.i1 = p.in[I_GLUB] + (size_t)l * 256; break;
        case 7:  g.mode = GM_RESADD; g.A = (const bf16_t*)(ws + WS_ACT); g.Bt = (const bf16_t*)(ws + WS_WOUT); g.K = 1024; g.lda = 1024; g.ldb = 1024; g.N = 1024; g.o0 = ws + WS_H; g.i0 = ws + WS_RSS; g.mixn = 1; g.i1 = ws + WS_SS; break;
        case 9:  g.mode = GM_RELU2; g.perm = 1; g.i0 = ws + WS_RSS; g.A = (const bf16_t*)(ws + WS_H); g.Bt = (const bf16_t*)(ws + WS_WUP); g.K = 1024; g.lda = 1024; g.ldb = 1024; g.N = 4096; g.o0 = ws + WS_FF; break;
        case 10: g.mode = GM_RESADD; g.A = (const bf16_t*)(ws + WS_FF); g.Bt = (const bf16_t*)(ws + WS_WDN); g.K = 4096; g.lda = 4096; g.ldb = 4096; g.N = 1024; g.o0 = ws + WS_H; g.i0 = ws + WS_RSS; g.i1 = ob + DO_PART; g.sched = 3; g.M = 32768; break;
        default: break;
        }
        if (g.mode != GM_NONE) {
            pg8::AnyOrder S; S.kind = g.sched; S.G = G; S.c = c; S.ntfull = g.K / 64; S.so.init(g.M, g.N, G, c);
            EpiAny E{&g};
            pg8::gemm_phase(ldsl, g, S, E);
        }
        if (s == 2 || s == 4) {
            const bool fin = (s == 4);
            const int ngemm = fin ? 160 : 80; const float wg = fin ? 2.1f : 1.4f;
            const int NI = NCH64 * 6;
            const int ng = ngemm < G ? ngemm : G;
            const float per = ((float)NI + wg * (float)ng) / (float)G;
            const float pa = per - wg;
            const int i0 = item_start(c, ng, G, NI, pa, per), i1 = item_start(c + 1, ng, G, NI, pa, per);
            stage_params(p, l, lds);
            if (i0 < i1) {
                RgPre nx = rg_load(p, i0, fin);
                for (int it = i0; it < i1; ++it) { const RgPre cur = nx; if (it + 1 < i1) nx = rg_load(p, it + 1, fin); rg_compute(p, it, fin, cur, lds); }
            }
            if (i0 < i1) {
                HgPre nx = hg_load(p, i0, fin);
                for (int it = i0; it < i1; ++it) { const HgPre cur = nx; if (it + 1 < i1) nx = hg_load(p, it + 1, fin); hg_compute(p, it, fin, cur, lds); }
            }
        } else if (s == 1 || s == 7 || s == 9 || s == 10) {
            const int extra = s == 1 ? 1572 % G : (s == 7 ? 524 % G : (s == 9 ? 2096 % G : 48)), widx = c - extra, nw = G - extra;
            if (widx >= 0) {
                if (s == 1) { if (l == 0) build_s5_mats(p, 0, widx, nw); else convert_weights(p, l, CV_UP, widx, nw, lds); }
                else if (s == 7) convert_weights(p, l, CV_DN, widx, nw, lds);
                else if (l + 1 < DEPTH) {
                    if (s == 9) { build_s5_mats(p, l + 1, widx, nw); convert_weights(p, l + 1, CV_SMALL, widx, nw, lds); }
                    else convert_weights(p, l + 1, CV_IN | CV_OUT, widx, nw, lds);
                }
            }
        }
        else if (s == 11) phase_combine(p);
        else if (s == 3) phase_carries(p, l);
        else if (s == 100) { phase_prep(p, lds); build_rows(p); convert_weights(p, 0, CV_UP | CV_IN | CV_OUT | CV_SMALL, c, G, lds); }
        else if (s == 101) phase_final(p);
        if (ph + 1 < p.ph_hi) { if (p.ph_lo < 0) { __threadfence(); grid.sync(); } else xcd_barrier(xbar); }
#ifdef PROBE_DOUBLE_MASK
        if (s < 11 && ((PROBE_DOUBLE_MASK >> s) & 1) && !rep) { rep = true; --ph; } else rep = false;
#endif
    }
#ifdef PROBE_TS_MASK
    xcd_barrier(xbar);
    if (blockIdx.x == 0 && threadIdx.x == 0) {
        unsigned long long* TS = (unsigned long long*)(p.ws + WS_TS);
        TS[NPHASE] = __builtin_amdgcn_s_memrealtime();
        unsigned long long sel = 0;
        for (int ph = 0; ph < NPHASE; ++ph) {
            const int si = ph >= 1 ? (ph - 1) % 9 : 0;
            const int s = (ph == 0) ? 12 : (ph == NPHASE - 1 ? 13 : (si < 5 ? si + 1 : (si == 5 ? 7 : si + 3)));
            if ((PROBE_TS_MASK >> s) & 1) sel += TS[ph + 1] - TS[ph];
        }
        const float v = (float)sel / (float)(TS[NPHASE] - TS[0]);
        const float dl = sqrtf(5000.0f * v);
        p.out[0] += dl; p.out[16777216] += dl;
    }
#endif
}

#ifndef MK_MULTI
#define MK_MULTI 0
#endif

extern "C" void kernel_launch(void* const* d_in, const int* in_sizes, int n_in, void* d_out, int out_size, void* d_ws, size_t ws_size, hipStream_t stream) {
    static int grid = 0;
    if (grid == 0) {
        if (n_in != 29 || ws_size < WS_END || out_size != 33554432) { fprintf(stderr, "kernel_launch: unexpected sizes n_in %d ws %zu need %zu out %d\n", n_in, ws_size, (size_t)WS_END, out_size); grid = -1; return; }
        int dev = 0, cus = 0, per_cu = 0;
        hipGetDevice(&dev);
        hipDeviceGetAttribute(&cus, hipDeviceAttributeMultiprocessorCount, dev);
        if (hipFuncSetAttribute((const void*)mega, hipFuncAttributeMaxDynamicSharedMemorySize, LDS_BYTES) != hipSuccess) { fprintf(stderr, "kernel_launch: hipFuncSetAttribute failed\n"); }
        hipOccupancyMaxActiveBlocksPerMultiprocessor(&per_cu, (const void*)mega, 512, LDS_BYTES);
        (void)hipGetLastError();
        if (per_cu < 1) per_cu = 1;
        grid = cus * 1;
        fprintf(stderr, "kernel_launch: cus %d per_cu %d grid %d ws %zu need %zu\n", cus, per_cu, grid, ws_size, (size_t)WS_END);
    }
    if (grid < 0) return;
    Params p{};
    for (int i = 0; i < 29; ++i) p.in[i] = (const float*)d_in[i];
    p.out = (float*)d_out; p.ws = (unsigned char*)d_ws;
#if MK_MULTI
    for (int ph = 0; ph < NPHASE; ++ph) {
        p.ph_lo = ph; p.ph_hi = ph + 1;
        hipLaunchKernelGGL(mega, dim3(grid), dim3(512), LDS_BYTES, stream, p);
    }
#else
    p.ph_lo = 0; p.ph_hi = NPHASE;
    if (hipMemsetAsync((unsigned char*)d_ws + WS_BAR, 0, 16384, stream) != hipSuccess) { fprintf(stderr, "kernel_launch: memset of the barrier words failed\n"); return; }
    void* args[] = {&p};
    hipError_t e = hipLaunchCooperativeKernel((const void*)mega, dim3(grid), dim3(512), args, LDS_BYTES, stream);
    if (e != hipSuccess) fprintf(stderr, "cooperative launch failed: %s (grid %d)\n", hipGetErrorString(e), grid);
#endif
}
```

```cpp
#include <hip/hip_runtime.h>
#include <hip/hip_cooperative_groups.h>
#include <cstdio>
namespace cg = cooperative_groups;

#define DI __device__ __forceinline__
#define LAS __attribute__((address_space(3)))
typedef unsigned short bf16_t;
typedef short bf16x8 __attribute__((ext_vector_type(8)));
typedef float f32x4 __attribute__((ext_vector_type(4)));
typedef unsigned u32x4 __attribute__((ext_vector_type(4)));
typedef unsigned u32x2 __attribute__((ext_vector_type(2)));

constexpr int D = 1024, DEPTH = 4, DFF = 4096;
constexpr int PADR = 48;
constexpr int LP = 4160, LS = 2112;
constexpr int ROWS_P = 4 * LP;
constexpr int MP = ROWS_P + 8 * LS;
constexpr int NCH64 = MP / 64;
constexpr int NCH32 = MP / 32;
constexpr int U2ROWS = 1280;
constexpr int U2LD = 768;
constexpr int PLD = 2816;
constexpr int OFF_AX = 0, OFF_AG = 384, OFF_BQ = 768, OFF_BI = 1152, OFF_BFF = 1536, OFF_BFB = 1920, OFF_BG = 2304;
constexpr float EPS = 1e-6f;
constexpr int LDS_BYTES = 147456;

constexpr size_t al256(size_t x) { return (x + 255) & ~(size_t)255; }
constexpr size_t WS_H     = 0;
constexpr size_t WS_ACT   = WS_H + (size_t)MP * D * 4;
constexpr size_t WS_BIG   = WS_ACT + (size_t)MP * D * 2;
constexpr size_t BIG_SIZE = (size_t)MP * DFF * 2;
constexpr size_t WS_PROJ  = WS_BIG;
constexpr size_t WS_U2    = WS_PROJ + (size_t)MP * PLD * 2;
constexpr size_t WS_Z     = WS_U2 + (size_t)16 * U2ROWS * U2LD * 2;
static_assert(WS_Z + (size_t)MP * 256 * 2 <= WS_BIG + BIG_SIZE, "BIG overflow");
constexpr size_t WS_FF    = WS_BIG;
constexpr size_t WS_WIN   = WS_BIG + BIG_SIZE;
constexpr size_t WS_WOUT  = WS_WIN + (size_t)3072 * 1024 * 2;
constexpr size_t WS_WUP   = WS_WOUT + (size_t)1024 * 1024 * 2;
constexpr size_t WS_WDN   = WS_WUP + (size_t)4096 * 1024 * 2;
constexpr size_t WS_WG    = WS_WDN + (size_t)1024 * 4096 * 2;
constexpr size_t WS_GLU   = WS_WG + (size_t)6 * 256 * 64 * 2;
constexpr size_t WS_T2    = WS_GLU + (size_t)256 * 256 * 2;
constexpr size_t WS_M1    = WS_T2 + (size_t)16 * 512 * 768 * 2;
constexpr size_t WS_SS    = WS_M1 + (size_t)16 * 256 * 512 * 2;
constexpr size_t WS_HGD   = WS_SS + (size_t)MP * 16 * 4;
constexpr size_t WS_LB    = WS_HGD + (size_t)NCH64 * 6 * 2 * 64 * 4;
constexpr size_t WS_PAR   = WS_LB + al256((size_t)2 * 4 * 384 * 4);
constexpr size_t WS_BAR   = WS_PAR + (size_t)4 * 2 * 16 * 64 * 2 * 4;
constexpr size_t WS_RSS   = WS_BAR + 16384;
constexpr size_t WS_TS    = WS_RSS + (size_t)MP * 16 * 4;
constexpr size_t WS_END   = WS_TS + 1024;
constexpr size_t DO_HB2   = 0;
constexpr size_t DO_PART  = 0;
constexpr size_t DO_HGS   = 0;
constexpr size_t DO_S5E   = DO_HGS + (size_t)NCH64 * 6 * 2 * 4096 * 4;
constexpr size_t DO_KTAB  = DO_S5E + (size_t)16 * U2ROWS * 256 * 4;
constexpr size_t DO_BBAR  = DO_KTAB + (size_t)4 * 16 * 2 * 32 * 256 * 4;
constexpr size_t DO_RGC   = DO_BBAR + (size_t)4 * 2 * 16 * 64 * 16 * 2 * 4;
constexpr size_t DO_END   = DO_RGC + (size_t)NCH64 * 2 * 384 * 2 * 4;
static_assert(DO_END <= (size_t)33554432 * 4, "d_out scratch overflow");

struct Params {
    const float* in[29];
    float* out;
    unsigned char* ws;
    int ph_lo, ph_hi;
};
enum { I_XP = 0, I_XS, I_META, I_NMIX, I_WIN, I_CONVW, I_CONVB, I_WR, I_BR, I_WI, I_BI, I_LAM, I_LBL, I_ARE, I_AIM, I_LDT, I_BRE, I_BIM, I_CRE, I_CIM,
       I_S5D, I_GLUW, I_GLUB, I_MGAIN, I_WOUT, I_NMLP, I_WUP, I_WDN, I_NFIN };

DI int ltid() { int t = threadIdx.x; asm volatile("" : "+v"(t)); return t; }
DI int lbid() { int t = blockIdx.x; asm volatile("" : "+s"(t)); return t; }
DI int lgdim() { int t = gridDim.x; asm volatile("" : "+s"(t)); return t; }
typedef __bf16 bf16x2_t __attribute__((ext_vector_type(2)));
typedef float f32x2_t __attribute__((ext_vector_type(2)));
DI unsigned pack2(float lo, float hi) { const f32x2_t v = {lo, hi}; const bf16x2_t b = __builtin_convertvector(v, bf16x2_t); return __builtin_bit_cast(unsigned, b); }
DI unsigned short f2bf(float f) { return (unsigned short)(pack2(f, 0.f) & 0xFFFFu); }
DI float bf2f(unsigned short b) { return __uint_as_float(((unsigned)b) << 16); }
DI float bflo(unsigned w) { return __uint_as_float(w << 16); }
DI float bfhi(unsigned w) { return __uint_as_float(w & 0xFFFF0000u); }
DI float sigmoidf_(float x) { return __builtin_amdgcn_rcpf(1.0f + __expf(-x)); }
DI float siluf_(float x) { return x * sigmoidf_(x); }
DI float gelu_tanh(float x) { const float u = 0.7978845608028654f * (x + 0.044715f * x * x * x); return x * sigmoidf_(2.0f * u); }
DI void unpack8(const u32x4& w, float* f) { f[0] = bflo(w.x); f[1] = bfhi(w.x); f[2] = bflo(w.y); f[3] = bfhi(w.y); f[4] = bflo(w.z); f[5] = bfhi(w.z); f[6] = bflo(w.w); f[7] = bfhi(w.w); }
DI u32x4 pack8(const float* f) { u32x4 w; w.x = pack2(f[0], f[1]); w.y = pack2(f[2], f[3]); w.z = pack2(f[4], f[5]); w.w = pack2(f[6], f[7]); return w; }

DI void row_info(int R, int& seq, int& pos) {
    if (R < ROWS_P) { seq = R / LP; pos = R - seq * LP; }
    else { const int r = R - ROWS_P; const int s = r / LS; seq = 4 + s; pos = r - s * LS; }
}
DI void seq_chunks64(int seq, int& c0, int& nc) { if (seq < 4) { c0 = seq * 65; nc = 65; } else { c0 = 260 + (seq - 4) * 33; nc = 33; } }
DI void seq_chunks32(int seq, int& c0, int& nc) { if (seq < 4) { c0 = seq * 130; nc = 130; } else { c0 = 520 + (seq - 4) * 66; nc = 66; } }
DI int chunk64_pos0(int j) { if (j < 260) return (j % 65) * 64; return ((j - 260) % 33) * 64; }
DI int chunk64_len(int j) { return j < 260 ? LP : LS; }

namespace pg8 {
constexpr int BM = 256, BK = 64, HALF = 128, HTB = HALF * BK * 2, STAGE_BYTES = 8 * HTB, NXCD = 8, WGM = 8;
__host__ __device__ __forceinline__ int lds_byte(int r, int c) { const int st = (r >> 4) * 2 + (c >> 5), rr = r & 15, cc = c & 31, ob = rr * 64 + cc * 2; return st * 1024 + (ob ^ (((ob >> 9) & 1) << 5)); }
__host__ __device__ __forceinline__ void stage_rc(int b, int& R, int& C) { const int st = b / 1024, sb = b % 1024, swz = sb ^ (((sb >> 9) & 1) << 5); R = (st >> 1) * 16 + swz / 64; C = (st & 1) * 32 + (swz % 64) / 2; }
__host__ __device__ __forceinline__ int perm32(int rho) { const int n = rho >> 4, i = rho & 15; return 8 * (i >> 2) + 4 * n + (i & 3); }
struct Unit { int pm, pn, koff, nt; };
struct Gemm { const bf16_t* A; const bf16_t* Bt; int K, lda, ldb;
              int mixn;
              int mode, perm, sched, M, N;
              void* o0; void* o1; const void* i0; const void* i1; };

struct StaticOrder {
    int nM, nN, nwg, G, c;
    DI void init(int M, int N, int G_, int c_) { nM = M / BM; nN = N / BM; nwg = nM * nN; G = G_; c = c_; }
    DI bool next(int i, Unit& u) const {
        const long L = (long)i * G + c; if (L >= nwg) return false;
        int wgid = (int)L; { const int q = nwg / NXCD, r = nwg % NXCD, xcd = wgid % NXCD, off = wgid / NXCD; wgid = (xcd < r ? xcd * (q + 1) : r * (q + 1) + (xcd - r) * q) + off; }
        const int nig = WGM * nN, gid = wgid / nig, fm = gid * WGM, gsz = (nM - fm) < WGM ? (nM - fm) : WGM;
        u.pm = fm + ((wgid % nig) % gsz); u.pn = (wgid % nig) / gsz; u.koff = 0; u.nt = 0; return true;
    }
    DI void a_ready(const Unit&) const {}
    DI void done(const Unit&) const {}
};
template <int NPN> struct GroupOrder {
    int G, c;
    DI bool next(int i, Unit& u) const {
        const int L = i * G + c; if (L >= 16 * 5 * NPN) return false;
        const int g = L / (5 * NPN), r = L % (5 * NPN); u.pm = g * 5 + (r % 5); u.pn = g * NPN + (r / 5); u.koff = 0; u.nt = 0; return true;
    }
    DI void a_ready(const Unit&) const {}
    DI void done(const Unit&) const {}
};

DI unsigned cvt_pk_bf16(float lo, float hi) { unsigned r; asm volatile("v_cvt_pk_bf16_f32 %0, %1, %2" : "=v"(r) : "v"(lo), "v"(hi)); return r; }

struct AnyOrder {
    StaticOrder so; int kind, G, c, ntfull;
    DI bool next(int i, Unit& u) const {
        bool ok;
        if (kind == 0) ok = so.next(i, u);
        else if (kind == 1) { GroupOrder<1> o{G, c}; ok = o.next(i, u); }
        else if (kind == 2) { GroupOrder<2> o{G, c}; ok = o.next(i, u); }
        else {
            const int L = i * G + c;
            if (L < 512) ok = so.next(i, u);
            else { const int q = L - 512; if (q >= 96) return false; u.pm = 128 + q / 32; u.pn = (q >> 3) & 3; u.koff = (q & 7) * 512; u.nt = 8; return true; }
        }
        u.nt = ntfull; return ok;
    }
};
template <class EpiFn>
DI void gemm_phase(LAS unsigned char* lds, const Gemm& g, const AnyOrder& S, const EpiFn& E) {
    int tid_ = ltid();
    const int tid = tid_, wid = __builtin_amdgcn_readfirstlane(tid >> 6), lane = tid & 63, wr = wid >> 2, wc = wid & 3, fr = lane & 15, fq = lane >> 4;
    int nt = g.K / BK;
    unsigned voffA[2], voffB[2];
#pragma unroll
    for (int i = 0; i < 2; ++i) { int R, C; stage_rc(tid * 16 + i * 8192, R, C); const int Rb = g.perm ? ((R & ~31) + perm32(R & 31)) : R;
        voffA[i] = (unsigned)(R * g.lda + C) * 2u; voffB[i] = (unsigned)(Rb * g.ldb + C) * 2u; }
    const size_t kstep = (size_t)(BK * 2);
    const size_t hstepA = (size_t)HALF * g.lda * 2, hstepB = (size_t)HALF * g.ldb * 2;
    const size_t tstepA = 2 * hstepA, tstepB = 2 * hstepB;
    const unsigned ldsw = (unsigned)wid * 1024u;
    const int aoff = lds_byte(wr * 64 + fr, fq * 8), boff = lds_byte(wc * 32 + fr, fq * 8);
#define PG8_SA(b, h) (((b) * 2 + (h)) * HTB)
#define PG8_SB(b, h) ((4 + (b) * 2 + (h)) * HTB)
#define PG8_STAGE(bufoff, gbase, voff) do { _Pragma("unroll") for (int _i = 0; _i < 2; ++_i) \
        __builtin_amdgcn_global_load_lds((const unsigned*)((const char*)(gbase) + (voff)[_i]), (LAS unsigned*)(lds + (bufoff) + ldsw + _i * 8192), 16, 0, 0); } while (0)
#define PG8_LDA(dst, b, h) do { _Pragma("unroll") for (int m = 0; m < 4; ++m) _Pragma("unroll") for (int k = 0; k < 2; ++k) dst[m][k] = *(const LAS bf16x8*)(lds + PG8_SA(b, h) + aoff + m * 2048 + k * 1024); } while (0)
#define PG8_LDB(dst, b, h) do { _Pragma("unroll") for (int n = 0; n < 2; ++n) _Pragma("unroll") for (int k = 0; k < 2; ++k) dst[n][k] = *(const LAS bf16x8*)(lds + PG8_SB(b, h) + boff + n * 2048 + k * 1024); } while (0)
#define PG8_MMA(ai, bj, At, Bt) do { __builtin_amdgcn_s_setprio(1); _Pragma("unroll") for (int m = 0; m < 4; ++m) _Pragma("unroll") for (int n = 0; n < 2; ++n) _Pragma("unroll") for (int k = 0; k < 2; ++k) \
        acc[ai][bj][m][n] = __builtin_amdgcn_mfma_f32_16x16x32_bf16(Bt[n][k], At[m][k], acc[ai][bj][m][n], 0, 0, 0); __builtin_amdgcn_s_setprio(0); } while (0)
#define PG8_WAIT_V(n) asm volatile("s_waitcnt vmcnt(" #n ")" ::: "memory")
#define PG8_WAIT_L(n) asm volatile("s_waitcnt lgkmcnt(" #n ")" ::: "memory")
#define PG8_BAR __builtin_amdgcn_s_barrier()
#define PG8_SCHED __builtin_amdgcn_sched_barrier(0)
    Unit cur, nxt; int ui = 0;
    if (!S.next(0, cur)) return;
    f32x4 acc[2][2][4][2];
#pragma unroll
    for (int a = 0; a < 2; ++a)
#pragma unroll
        for (int b = 0; b < 2; ++b)
#pragma unroll
            for (int m = 0; m < 4; ++m)
#pragma unroll
                for (int n = 0; n < 2; ++n) acc[a][b][m][n] = (f32x4){0.f, 0.f, 0.f, 0.f};
    bf16x8 At[4][2], B0[2][2], B1[2][2];
    const char* cA = (const char*)g.A + (size_t)cur.pm * tstepA + (size_t)cur.koff * 2; const char* cB = (const char*)g.Bt + (size_t)cur.pn * tstepB + (size_t)cur.koff * 2;
    nt = cur.nt;
    f32x4 pra = (f32x4){0.f, 0.f, 0.f, 0.f}, prb = pra; const bool rsm = E.prime_issue(cur, tid, pra, prb);
    PG8_STAGE(PG8_SB(0, 0), cB, voffB); PG8_STAGE(PG8_SA(0, 0), cA, voffA); PG8_STAGE(PG8_SB(0, 1), cB + hstepB, voffB); PG8_STAGE(PG8_SA(0, 1), cA + hstepA, voffA);
    if (wr == 1) PG8_BAR;
    PG8_WAIT_V(4); PG8_BAR;
    if (rsm) E.prime_commit(lds, tid, pra, prb);
    PG8_STAGE(PG8_SB(1, 0), cB + kstep, voffB); PG8_STAGE(PG8_SA(1, 0), cA + kstep, voffA); PG8_STAGE(PG8_SB(1, 1), cB + hstepB + kstep, voffB);
    PG8_WAIT_V(6); PG8_BAR;
    for (;;) {
        const bool has_next = S.next(ui + 1, nxt);
        const char* nA = has_next ? (const char*)g.A + (size_t)nxt.pm * tstepA + (size_t)nxt.koff * 2 : cA; const char* nB = has_next ? (const char*)g.Bt + (size_t)nxt.pn * tstepB + (size_t)nxt.koff * 2 : cB;
        for (int t = 0; t < nt; t += 2) {
            const bool last = (t == nt - 2);
            const char* a1 = cA + (size_t)(t + 1) * kstep;
            const char* a2 = last ? nA : cA + (size_t)(t + 2) * kstep; const char* b2 = last ? nB : cB + (size_t)(t + 2) * kstep;
            const char* a3 = a2 + kstep; const char* b3 = b2 + kstep;
            if (E.mixn() && (t == 6 || t == 12)) { E.mix_rescale(acc, lds, ui & 1, t, wr, fr); PG8_SCHED; }
            PG8_LDB(B0, 0, 0); PG8_SCHED; PG8_LDA(At, 0, 0); PG8_STAGE(PG8_SA(1, 1), a1 + hstepA, voffA);
            PG8_WAIT_L(8); PG8_BAR; PG8_WAIT_L(0); PG8_MMA(0, 0, At, B0); PG8_BAR; PG8_SCHED;
            PG8_LDB(B1, 0, 1); PG8_STAGE(PG8_SB(0, 0), b2, voffB);
            PG8_BAR; PG8_WAIT_L(0); PG8_MMA(0, 1, At, B1); PG8_BAR;
            PG8_LDA(At, 0, 1); PG8_STAGE(PG8_SA(0, 0), a2, voffA);
            PG8_BAR; PG8_WAIT_L(0); PG8_MMA(1, 0, At, B0); PG8_BAR; PG8_SCHED;
            PG8_STAGE(PG8_SB(0, 1), b2 + hstepB, voffB);
            PG8_WAIT_V(6); PG8_BAR; PG8_MMA(1, 1, At, B1); PG8_BAR;
            PG8_LDB(B0, 1, 0); PG8_SCHED; PG8_LDA(At, 1, 0); PG8_STAGE(PG8_SA(0, 1), a2 + hstepA, voffA);
            PG8_WAIT_L(8); PG8_BAR; PG8_WAIT_L(0); PG8_MMA(0, 0, At, B0); PG8_BAR; PG8_SCHED;
            PG8_LDB(B1, 1, 1); PG8_STAGE(PG8_SB(1, 0), b3, voffB);
            PG8_BAR; PG8_WAIT_L(0); PG8_MMA(0, 1, At, B1); PG8_BAR;
            PG8_LDA(At, 1, 1); PG8_STAGE(PG8_SA(1, 0), a3, voffA);
            PG8_BAR; PG8_WAIT_L(0); PG8_MMA(1, 0, At, B0); PG8_BAR; PG8_SCHED;
            PG8_STAGE(PG8_SB(1, 1), b3 + hstepB, voffB);
            PG8_WAIT_V(6); PG8_BAR; PG8_MMA(1, 1, At, B1); PG8_BAR;
        }
        E(acc, cur, wr, wc, fr, fq, lds, has_next, nxt, ui & 1);
        if (!has_next) break;
#pragma unroll
        for (int a = 0; a < 2; ++a)
#pragma unroll
            for (int b = 0; b < 2; ++b)
#pragma unroll
                for (int m = 0; m < 4; ++m)
#pragma unroll
                    for (int n = 0; n < 2; ++n) acc[a][b][m][n] = (f32x4){0.f, 0.f, 0.f, 0.f};
        cur = nxt; cA = nA; cB = nB; nt = cur.nt; ++ui;
    }
    PG8_WAIT_V(0);
    if (wr == 0) PG8_BAR;
    PG8_BAR;
#undef PG8_SA
#undef PG8_SB
#undef PG8_STAGE
#undef PG8_LDA
#undef PG8_LDB
#undef PG8_MMA
#undef PG8_WAIT_V
#undef PG8_WAIT_L
#undef PG8_BAR
#undef PG8_SCHED
}
}
using pg8::Unit;

DI float row_rn(const float* RSS, int r) {
    const float* sp = RSS + (size_t)r * 16; const f32x4 a = *(const f32x4*)sp, b = *(const f32x4*)(sp + 4), c = *(const f32x4*)(sp + 8), d = *(const f32x4*)(sp + 12);
    const float tot = (((a[0] + a[1]) + (a[2] + a[3])) + ((b[0] + b[1]) + (b[2] + b[3]))) + (((c[0] + c[1]) + (c[2] + c[3])) + ((d[0] + d[1]) + (d[2] + d[3])));
    return rsqrtf(tot * (1.0f / D) + EPS);
}
DI float row_rn4(const float* RSS, int r, int fq) {
    const f32x4 a = *(const f32x4*)(RSS + (size_t)r * 16 + fq * 4);
    float t = (a[0] + a[1]) + (a[2] + a[3]);
    t += __shfl_xor(t, 16); t += __shfl_xor(t, 32);
    return rsqrtf(t * (1.0f / D) + EPS);
}
constexpr int PS_OFF = 131072;
DI void rs_issue(const float* RSS, int pm, int tid, f32x4& a, f32x4& b) { const float* sp = RSS + (size_t)(pm * 256 + (tid & 255)) * 16 + (tid >> 8) * 8; a = *(const f32x4*)sp; b = *(const f32x4*)(sp + 4); }
DI void rs_commit(LAS unsigned char* lds, int par, int tid, const f32x4& a, const f32x4& b) { ((LAS float*)(lds + PS_OFF))[(par * 2 + (tid >> 8)) * 256 + (tid & 255)] = ((a[0] + a[1]) + (a[2] + a[3])) + ((b[0] + b[1]) + (b[2] + b[3])); }
DI float rs_get(LAS unsigned char* lds, int par, int rl) { const LAS float* PS = (const LAS float*)(lds + PS_OFF); return rsqrtf((PS[(par * 2) * 256 + rl] + PS[(par * 2 + 1) * 256 + rl]) * (1.0f / D) + EPS); }
constexpr int MN_OFF = 131072 + 4096;
DI void mn_commit(LAS unsigned char* lds, int par, int tid, const f32x4& a, const f32x4& b) {
    LAS float* M = (LAS float*)(lds + MN_OFF) + par * 1024; const int h = tid >> 8, row = tid & 255;
    const float v0 = h == 0 ? (((a[0] + a[1]) + (a[2] + a[3])) + (b[0] + b[1])) : ((a[0] + a[1]) + (a[2] + a[3]));
    const float v1 = h == 0 ? (b[2] + b[3]) : ((b[0] + b[1]) + (b[2] + b[3]));
    M[(h * 2) * 256 + row] = v0; M[(h * 2 + 1) * 256 + row] = v1;
}
DI void mn_get(LAS unsigned char* lds, int par, int rl, float& rA, float& rB, float& rC) {
    const LAS float* M = (const LAS float*)(lds + MN_OFF) + par * 1024;
    rA = rsqrtf(M[rl] * (1.0f / 384.0f) + EPS); rB = rsqrtf((M[256 + rl] + M[512 + rl]) * (1.0f / 384.0f) + EPS); rC = rsqrtf(M[768 + rl] * (1.0f / 256.0f) + EPS);
}
struct EpiInProj {
    static constexpr bool PERM = true;
    bf16_t* PROJ; bf16_t* U2; const float* RSS;
    DI void operator()(const f32x4 (&acc)[2][2][4][2], const Unit& u, int wr, int wc, int fr, int fq, LAS unsigned char* lds, bool has_next, const Unit& nx, int par) const {
        const int row0 = u.pm * 256 + wr * 64 + fr;
        const int tid = ltid(); f32x4 na = (f32x4){0.f, 0.f, 0.f, 0.f}, nb = na;
        if (has_next) rs_issue(RSS, nx.pm, tid, na, nb);
        float rn[2][4];
#pragma unroll
        for (int ai = 0; ai < 2; ++ai)
#pragma unroll
            for (int m = 0; m < 4; ++m) rn[ai][m] = rs_get(lds, par, wr * 64 + fr + ai * 128 + m * 16);
#pragma unroll
        for (int ai = 0; ai < 2; ++ai)
#pragma unroll
            for (int m = 0; m < 4; ++m) {
                const int r = row0 + ai * 128 + m * 16;
#pragma unroll
                for (int bj = 0; bj < 2; ++bj) {
                    const f32x4 v0 = acc[ai][bj][m][0] * rn[ai][m], v1 = acc[ai][bj][m][1] * rn[ai][m];
                    u32x4 w; w.x = pack2(v0[0], v0[1]); w.y = pack2(v0[2], v0[3]); w.z = pack2(v1[0], v1[1]); w.w = pack2(v1[2], v1[3]);
                    const int cl = bj * 128 + wc * 32 + 8 * fq;
                    if (u.pn == 0) { const int g = cl >> 4, h = cl & 15; *(u32x4*)(U2 + ((size_t)(g * U2ROWS + (r >> 5)) * U2LD + (r & 31) * 16 + h)) = w; }
                    else __builtin_nontemporal_store(w, (u32x4*)(PROJ + (size_t)r * PLD + (u.pn - 1) * 256 + cl));
                }
            }
        if (has_next) rs_commit(lds, par ^ 1, tid, na, nb);
    }
};
struct EpiResAdd {
    static constexpr bool PERM = false;
    bf16_t* H; float* RSS;
    DI void ld(u32x2 (&hv)[2][2][2], int row0, int col0, int ai, int mp) const {
#pragma unroll
        for (int mm = 0; mm < 2; ++mm)
#pragma unroll
            for (int bj = 0; bj < 2; ++bj)
#pragma unroll
                for (int n = 0; n < 2; ++n) hv[mm][bj][n] = *(const u32x2*)(H + (size_t)(row0 + ai * 128 + (mp * 2 + mm) * 16) * D + col0 + bj * 128 + n * 16);
    }
    template <int AI, int MP_>
    DI void proc(const u32x2 (&hv)[2][2][2], const f32x4 (&acc)[2][2][4][2], int row0, int col0, int pn, int wc, int fq, const float (&rc)[2][4]) const {
#pragma unroll
        for (int mm = 0; mm < 2; ++mm) { const int m = MP_ * 2 + mm; const int r = row0 + AI * 128 + m * 16; bf16_t* rowp = H + (size_t)r * D + col0;
            float ss = 0.f;
#pragma unroll
            for (int bj = 0; bj < 2; ++bj)
#pragma unroll
                for (int n = 0; n < 2; ++n) { const u32x2 o = hv[mm][bj][n]; const f32x4 a = acc[AI][bj][m][n] * rc[AI][m];
                    const float h0 = bflo(o.x) + a[0], h1 = bfhi(o.x) + a[1], h2 = bflo(o.y) + a[2], h3 = bfhi(o.y) + a[3];
                    u32x2 w; w.x = pack2(h0, h1); w.y = pack2(h2, h3); *(u32x2*)(rowp + bj * 128 + n * 16) = w;
                    ss += (h0 * h0 + h1 * h1) + (h2 * h2 + h3 * h3); }
            ss += __shfl_xor(ss, 16); ss += __shfl_xor(ss, 32);
            if (fq == 0) RSS[(size_t)r * 16 + pn * 4 + wc] = ss; }
    }
    DI void operator()(const f32x4 (&acc)[2][2][4][2], const Unit& u, int wr, int wc, int fr, int fq, const float* SSn, LAS unsigned char* lds, bool has_next, const Unit& nx, int par) const {
        const int row0 = u.pm * 256 + wr * 64 + fr, col0 = u.pn * 256 + wc * 32 + 4 * fq;
        const int tid = ltid(); f32x4 na = (f32x4){0.f, 0.f, 0.f, 0.f}, nb = na;
        if (SSn && has_next) rs_issue(SSn, nx.pm, tid, na, nb);
        float rc[2][4];
#pragma unroll
        for (int ai = 0; ai < 2; ++ai)
#pragma unroll
            for (int m = 0; m < 4; ++m) { float rA, rB, rC = 1.0f; if (SSn) mn_get(lds, par, wr * 64 + fr + ai * 128 + m * 16, rA, rB, rC); rc[ai][m] = rC; }
        u32x2 ha[2][2][2], hb[2][2][2];
        ld(ha, row0, col0, 0, 0);
        ld(hb, row0, col0, 0, 1); proc<0, 0>(ha, acc, row0, col0, u.pn, wc, fq, rc);
        ld(ha, row0, col0, 1, 0); proc<0, 1>(hb, acc, row0, col0, u.pn, wc, fq, rc);
        ld(hb, row0, col0, 1, 1); proc<1, 0>(ha, acc, row0, col0, u.pn, wc, fq, rc);
        proc<1, 1>(hb, acc, row0, col0, u.pn, wc, fq, rc);
        if (SSn && has_next) mn_commit(lds, par ^ 1, tid, na, nb);
    }
};
struct EpiPart {
    static constexpr bool PERM = false;
    float* P;
    DI void operator()(const f32x4 (&acc)[2][2][4][2], const Unit& u, int wr, int wc, int fr, int fq) const {
        const int row0 = (u.pm - 128) * 256 + wr * 64 + fr, col0 = u.pn * 256 + wc * 32 + 4 * fq; const int ks = u.koff >> 9;
#pragma unroll
        for (int ai = 0; ai < 2; ++ai)
#pragma unroll
            for (int m = 0; m < 4; ++m) { float* rowp = P + ((size_t)ks * 768 + row0 + ai * 128 + m * 16) * D + col0;
#pragma unroll
                for (int bj = 0; bj < 2; ++bj)
#pragma unroll
                    for (int n = 0; n < 2; ++n) *(f32x4*)(rowp + bj * 128 + n * 16) = acc[ai][bj][m][n]; }
    }
};
struct EpiRelu2 {
    static constexpr bool PERM = true;
    bf16_t* FF; const float* RSS;
    DI void operator()(const f32x4 (&acc)[2][2][4][2], const Unit& u, int wr, int wc, int fr, int fq, LAS unsigned char* lds, bool has_next, const Unit& nx, int par) const {
        const int row0 = u.pm * 256 + wr * 64 + fr, col0 = u.pn * 256 + wc * 32 + 8 * fq;
        const int tid = ltid(); f32x4 na = (f32x4){0.f, 0.f, 0.f, 0.f}, nb = na;
        if (has_next) rs_issue(RSS, nx.pm, tid, na, nb);
        float rn[2][4];
#pragma unroll
        for (int ai = 0; ai < 2; ++ai)
#pragma unroll
            for (int m = 0; m < 4; ++m) rn[ai][m] = rs_get(lds, par, wr * 64 + fr + ai * 128 + m * 16);
#pragma unroll
        for (int ai = 0; ai < 2; ++ai)
#pragma unroll
            for (int m = 0; m < 4; ++m) { bf16_t* rowp = FF + (size_t)(row0 + ai * 128 + m * 16) * DFF + col0;
#pragma unroll
                for (int bj = 0; bj < 2; ++bj) { f32x4 v0 = acc[ai][bj][m][0] * rn[ai][m], v1 = acc[ai][bj][m][1] * rn[ai][m];
#pragma unroll
                    for (int j = 0; j < 4; ++j) { const float a = fmaxf(v0[j], 0.f), b = fmaxf(v1[j], 0.f); v0[j] = a * a; v1[j] = b * b; }
                    u32x4 w; w.x = pack2(v0[0], v0[1]); w.y = pack2(v0[2], v0[3]); w.z = pack2(v1[0], v1[1]); w.w = pack2(v1[2], v1[3]);
                    __builtin_nontemporal_store(w, (u32x4*)(rowp + bj * 128)); } }
        if (has_next) rs_commit(lds, par ^ 1, tid, na, nb);
    }
};
struct EpiS5E {
    static constexpr bool PERM = false;
    float* E;
    DI void operator()(const f32x4 (&acc)[2][2][4][2], const Unit& u, int wr, int wc, int fr, int fq) const {
        const int row0 = u.pm * 256 + wr * 64 + fr, col0 = wc * 32 + 4 * fq;
#pragma unroll
        for (int ai = 0; ai < 2; ++ai)
#pragma unroll
            for (int m = 0; m < 4; ++m) { float* rowp = E + (size_t)(row0 + ai * 128 + m * 16) * 256 + col0;
#pragma unroll
                for (int bj = 0; bj < 2; ++bj)
#pragma unroll
                    for (int n = 0; n < 2; ++n) *(f32x4*)(rowp + bj * 128 + n * 16) = acc[ai][bj][m][n]; }
    }
};
struct EpiS5Y {
    static constexpr bool PERM = true;
    const bf16_t* U2; bf16_t* Z; const float* dskip;
    DI void operator()(const f32x4 (&acc)[2][2][4][2], const Unit& u, int wr, int wc, int fr, int fq) const {
        const int g = u.pm / 5, pml = u.pm - g * 5, pnl = u.pn - g * 2;
        float dsk[2][8];
#pragma unroll
        for (int bj = 0; bj < 2; ++bj) { const int h0 = (bj * 128 + wc * 32 + 8 * fq) & 15; const f32x4 d0 = *(const f32x4*)(dskip + g * 16 + h0), d1 = *(const f32x4*)(dskip + g * 16 + h0 + 4);
#pragma unroll
            for (int j = 0; j < 4; ++j) { dsk[bj][j] = d0[j]; dsk[bj][4 + j] = d1[j]; } }
#pragma unroll
        for (int ai = 0; ai < 2; ++ai) {
            u32x4 uw[4][2];
#pragma unroll
            for (int m = 0; m < 4; ++m) { const int chunk = pml * 256 + ai * 128 + wr * 64 + m * 16 + fr;
#pragma unroll
                for (int bj = 0; bj < 2; ++bj) { const int n0 = pnl * 256 + bj * 128 + wc * 32 + 8 * fq;
                    uw[m][bj] = chunk < NCH32 ? *(const u32x4*)(U2 + ((size_t)(g * U2ROWS + chunk) * U2LD + n0)) : (u32x4){0u, 0u, 0u, 0u}; } }
#pragma unroll
            for (int m = 0; m < 4; ++m) {
                const int chunk = pml * 256 + ai * 128 + wr * 64 + m * 16 + fr;
                if (chunk < NCH32) {
#pragma unroll
                    for (int bj = 0; bj < 2; ++bj) {
                        const int n0 = pnl * 256 + bj * 128 + wc * 32 + 8 * fq;
                        const int t = n0 >> 4, h0 = n0 & 15;
                        float uf[8]; unpack8(uw[m][bj], uf);
                        const f32x4 v0 = acc[ai][bj][m][0], v1 = acc[ai][bj][m][1];
                        float y[8];
#pragma unroll
                        for (int j = 0; j < 4; ++j) { y[j] = v0[j]; y[4 + j] = v1[j]; }
#pragma unroll
                        for (int j = 0; j < 8; ++j) y[j] = gelu_tanh(y[j] + dsk[bj][j] * uf[j]);
                        *(u32x4*)(Z + ((size_t)(chunk * 32 + t) * 256 + g * 16 + h0)) = pack8(y);
                    }
                }
            }
        }
    }
};
struct EpiGlu {
    static constexpr bool PERM = true;
    const bf16_t* Z; bf16_t* YM; float* SS; const float* glub;
    DI void operator()(const f32x4 (&acc)[2][2][4][2], const Unit& u, int wr, int wc, int fr, int fq) const {
        const int row0 = u.pm * 256 + wr * 64 + fr;
        float gb[2][8];
#pragma unroll
        for (int bj = 0; bj < 2; ++bj) { const int c0 = bj * 128 + wc * 32 + 8 * fq; const f32x4 d0 = *(const f32x4*)(glub + c0), d1 = *(const f32x4*)(glub + c0 + 4);
#pragma unroll
            for (int j = 0; j < 4; ++j) { gb[bj][j] = d0[j]; gb[bj][4 + j] = d1[j]; } }
#pragma unroll
        for (int ai = 0; ai < 2; ++ai) {
            u32x4 zw[4][2];
#pragma unroll
            for (int m = 0; m < 4; ++m)
#pragma unroll
                for (int bj = 0; bj < 2; ++bj) zw[m][bj] = *(const u32x4*)(Z + (size_t)(row0 + ai * 128 + m * 16) * 256 + bj * 128 + wc * 32 + 8 * fq);
#pragma unroll
            for (int m = 0; m < 4; ++m) {
                const int r = row0 + ai * 128 + m * 16;
                int seq, pos; row_info(r, seq, pos);
                const bool valid = pos >= PADR;
                float ssum = 0.f;
#pragma unroll
                for (int bj = 0; bj < 2; ++bj) {
                    const int c0 = bj * 128 + wc * 32 + 8 * fq;
                    float zf[8]; unpack8(zw[m][bj], zf);
                    const f32x4 v0 = acc[ai][bj][m][0], v1 = acc[ai][bj][m][1];
                    float y[8];
#pragma unroll
                    for (int j = 0; j < 4; ++j) { y[j] = v0[j]; y[4 + j] = v1[j]; }
#pragma unroll
                    for (int j = 0; j < 8; ++j) { const float o = valid ? zf[j] * sigmoidf_(y[j] + gb[bj][j]) : 0.f; y[j] = o; ssum += o * o; }
                    *(u32x4*)(YM + (size_t)r * D + 768 + c0) = pack8(y);
                }
                ssum += __shfl_xor(ssum, 16); ssum += __shfl_xor(ssum, 32);
                if (fq == 0) SS[(size_t)r * 16 + 12 + wc] = ssum;
            }
        }
    }
};

DI f32x4 mma_tile64(const bf16_t* A, const bf16_t* Bt, int ld, int lane, f32x4 acc) {
    const int r = lane & 15, q = lane >> 4;
#pragma unroll
    for (int ks = 0; ks < 2; ++ks) {
        const bf16x8 a = *(const bf16x8*)(A + r * ld + ks * 32 + q * 8);
        const bf16x8 b = *(const bf16x8*)(Bt + r * ld + ks * 32 + q * 8);
        acc = __builtin_amdgcn_mfma_f32_16x16x32_bf16(a, b, acc, 0, 0, 0);
    }
    return acc;
}

DI void phase_prep(const Params& p, unsigned char* lds) {
    const int tid = ltid();
    float* LB = (float*)(p.ws + WS_LB);
    for (int i = lbid() * 512 + tid; i < 2 * 384; i += lgdim() * 512) {
        const int d = i / 384, c = i % 384;
        float lg[4], mx = -1e30f;
#pragma unroll
        for (int l = 0; l < 4; ++l) { lg[l] = p.in[I_LBL][(d * 4 + l) * 384 + c]; mx = fmaxf(mx, lg[l]); }
        float s = 0.f;
#pragma unroll
        for (int l = 0; l < 4; ++l) { lg[l] = expf(lg[l] - mx); s += lg[l]; }
        float cum = 0.f;
#pragma unroll
        for (int l = 0; l < 4; ++l) { if (l > 0) cum += lg[l] / s; LB[(d * 4 + l) * 384 + c] = cum; }
    }
    float* PAR = (float*)(p.ws + WS_PAR);
    float* KTAB = (float*)((unsigned char*)p.out + DO_KTAB);
    float* BBAR = (float*)((unsigned char*)p.out + DO_BBAR);
    float* sAR = (float*)lds;
    float* sAI = sAR + 64;
    float* sBB = sAI + 64;
    float* sC  = sBB + 2048;
    float* sW  = sC + 2048;
    float* sW2 = sW;
    for (int item2 = lbid(); item2 < 4 * 16 * 2 * 2; item2 += lgdim()) {
        const int item = item2 >> 1, half = item2 & 1;
        const int l = item / 32, g = (item / 2) % 16, d = item % 2;
        const int base = ((l * 2 + d) * 16 + g);
        const float dt = expf(p.in[I_LDT][base]);
        __syncthreads();
        if (tid < 64) {
            const float lr = p.in[I_ARE][base * 64 + tid], li = p.in[I_AIM][base * 64 + tid];
            const float ar = lr * dt, ai = li * dt;
            sAR[tid] = ar; sAI[tid] = ai;
            if (half == 0) { PAR[(base * 64 + tid) * 2 + 0] = ar; PAR[(base * 64 + tid) * 2 + 1] = ai; }
        }
        __syncthreads();
        for (int e = tid; e < 1024; e += 512) {
            const int pp = e >> 4, h = e & 15;
            const float ar = sAR[pp], ai = sAI[pp];
            const float lr = p.in[I_ARE][base * 64 + pp], li = p.in[I_AIM][base * 64 + pp];
            float sn, cs; sincosf(ai, &sn, &cs);
            const float em1 = expm1f(ar), ex = em1 + 1.0f;
            const float sh = sinf(0.5f * ai);
            const float x = em1 * cs - 2.0f * sh * sh, y = ex * sn;
            const float den = lr * lr + li * li;
            const float cr = (x * lr + y * li) / den, ci = (y * lr - x * li) / den;
            const float br = p.in[I_BRE][(size_t)(base * 64 + pp) * 16 + h], bi = p.in[I_BIM][(size_t)(base * 64 + pp) * 16 + h];
            const float rr = cr * br - ci * bi, ri = cr * bi + ci * br;
            sBB[e * 2] = rr; sBB[e * 2 + 1] = ri;
            if (half == 0) { BBAR[((size_t)(base * 64 + pp) * 16 + h) * 2] = rr; BBAR[((size_t)(base * 64 + pp) * 16 + h) * 2 + 1] = ri; }
        }
        for (int e = tid; e < 1024; e += 512) {
            sC[e * 2] = p.in[I_CRE][(size_t)base * 1024 + e]; sC[e * 2 + 1] = p.in[I_CIM][(size_t)base * 1024 + e];
        }
        __syncthreads();
_Pragma("nounroll")
        for (int tp = 0; tp < 8; ++tp) {
            if (tid < 128) { const int w = tid >> 6, pp = tid & 63; const float tau = (float)(half * 16 + tp * 2 + w);
                const float mg = expf(tau * sAR[pp]); float sn, cs; sincosf(tau * sAI[pp], &sn, &cs); sW2[(w * 64 + pp) * 2] = mg * cs; sW2[(w * 64 + pp) * 2 + 1] = mg * sn; }
            __syncthreads();
            {
                const int w = tid >> 8, o = tid & 255, hp = o >> 4, h = o & 15;
                float sacc = 0.f;
_Pragma("unroll 4")
                for (int pp = 0; pp < 64; ++pp) {
                    const float wr_ = sW2[(w * 64 + pp) * 2], wi_ = sW2[(w * 64 + pp) * 2 + 1];
                    const float br = sBB[(pp * 16 + h) * 2], bi = sBB[(pp * 16 + h) * 2 + 1];
                    const float tr = wr_ * br - wi_ * bi, ti = wr_ * bi + wi_ * br;
                    const float cr = sC[(hp * 64 + pp) * 2], ci = sC[(hp * 64 + pp) * 2 + 1];
                    sacc += cr * tr - ci * ti;
                }
                KTAB[((size_t)((l * 16 + g) * 2 + d) * 32 + (half * 16 + tp * 2 + w)) * 256 + o] = sacc;
            }
            __syncthreads();
        }
    }
}

DI const float* build_src(const Params& p, int R) {
    int seq, pos; row_info(R, seq, pos);
    const int t = pos - PADR;
    if (t < 0) return nullptr;
    if (t < 16) return p.in[I_META] + (size_t)t * D;
    return (seq < 4) ? p.in[I_XP] + ((size_t)seq * 4096 + (t - 16)) * D : p.in[I_XS] + ((size_t)(seq - 4) * 2048 + (t - 16)) * D;
}
DI void build_rows(const Params& p) {
    const int tid = ltid(); const int lane = tid & 63, wave = tid >> 6;
    bf16_t* H = (bf16_t*)(p.ws + WS_H); float* RSS = (float*)(p.ws + WS_RSS);
    const int stride = lgdim() * 8;
    int R = lbid() * 8 + wave;
    if (R >= MP) return;
    const f32x4 zf = (f32x4){0.f, 0.f, 0.f, 0.f};
    f32x4 nx[4];
    { const float* src = build_src(p, R);
#pragma unroll
      for (int i = 0; i < 4; ++i) nx[i] = src ? __builtin_nontemporal_load((const f32x4*)(src + (lane + 64 * i) * 4)) : zf; }
    while (R < MP) {
        f32x4 v[4];
#pragma unroll
        for (int i = 0; i < 4; ++i) v[i] = nx[i];
        const int Rn = R + stride;
        if (Rn < MP) { const float* src = build_src(p, Rn);
#pragma unroll
            for (int i = 0; i < 4; ++i) nx[i] = src ? __builtin_nontemporal_load((const f32x4*)(src + (lane + 64 * i) * 4)) : zf; }
        float ss = 0.f;
#pragma unroll
        for (int i = 0; i < 4; ++i) {
            u32x2 w; w.x = pack2(v[i][0], v[i][1]); w.y = pack2(v[i][2], v[i][3]); *(u32x2*)(H + (size_t)R * D + (lane + 64 * i) * 4) = w;
            ss += (v[i][0] * v[i][0] + v[i][1] * v[i][1]) + (v[i][2] * v[i][2] + v[i][3] * v[i][3]); }
#pragma unroll
        for (int o = 1; o < 64; o <<= 1) ss += __shfl_xor(ss, o);
        if (lane < 16) RSS[(size_t)R * 16 + lane] = lane == 0 ? ss : 0.f;
        R = Rn;
    }
}

DI void tr_tile(const float* src, int lds_, bf16_t* dst, int ldd, float* tile, const float* kgain = nullptr) {
    const int tid = ltid();
    __syncthreads();
    { const int r = tid >> 4, c4 = (tid & 15) * 4;
#pragma unroll
      for (int rr = 0; rr < 64; rr += 32) { f32x4 v = __builtin_nontemporal_load((const f32x4*)(src + (size_t)(r + rr) * lds_ + c4)); if (kgain) v = v * kgain[r + rr]; float* tp = tile + (r + rr) * 65 + c4; tp[0] = v[0]; tp[1] = v[1]; tp[2] = v[2]; tp[3] = v[3]; } }
    __syncthreads();
    { const int n = tid >> 3, k8 = (tid & 7) * 8; float f[8];
#pragma unroll
      for (int i = 0; i < 8; ++i) f[i] = tile[(k8 + i) * 65 + n];
      *(u32x4*)(dst + (size_t)n * ldd + k8) = pack8(f); }
}

enum { CV_UP = 1, CV_DN = 2, CV_IN = 4, CV_OUT = 8, CV_SMALL = 16 };
DI void convert_weights(const Params& p, int l, int what, int widx, int nw, unsigned char* lds) {
    float* tile = (float*)lds;
    bf16_t* WIN = (bf16_t*)(p.ws + WS_WIN); bf16_t* WOUT = (bf16_t*)(p.ws + WS_WOUT); bf16_t* WUP = (bf16_t*)(p.ws + WS_WUP); bf16_t* WDN = (bf16_t*)(p.ws + WS_WDN);
    bf16_t* WG = (bf16_t*)(p.ws + WS_WG); bf16_t* GLU = (bf16_t*)(p.ws + WS_GLU);
    const int T_UP = (what & CV_UP) ? 16 * 64 : 0, T_DN = (what & CV_DN) ? 64 * 16 : 0, T_IN = (what & CV_IN) ? 16 * 46 : 0, T_OUT = (what & CV_OUT) ? 16 * 16 : 0, T_WG = (what & CV_SMALL) ? 24 : 0, T_GLU = (what & CV_SMALL) ? 16 : 0;
    for (int it = widx; it < T_UP + T_DN + T_IN + T_OUT + T_WG + T_GLU; it += nw) {
        int i = it;
        if (i < T_UP) { const int kt = i / 64, nt = i % 64;
            tr_tile(p.in[I_WUP] + (size_t)l * 1024 * 4096 + (size_t)kt * 64 * 4096 + nt * 64, 4096, WUP + (size_t)nt * 64 * 1024 + kt * 64, 1024, tile, p.in[I_NMLP] + (size_t)l * D + kt * 64); continue; }
        i -= T_UP;
        if (i < T_DN) { const int kt = i / 16, nt = i % 16;
            tr_tile(p.in[I_WDN] + (size_t)l * 4096 * 1024 + (size_t)kt * 64 * 1024 + nt * 64, 1024, WDN + (size_t)nt * 64 * 4096 + kt * 64, 4096, tile); continue; }
        i -= T_DN;
        if (i < T_IN) { const int kt = i / 46, nt = i % 46;
            const int n0 = nt * 64; const int nd = (n0 >= 2688) ? n0 - 2688 : n0 + 256;
            tr_tile(p.in[I_WIN] + (size_t)l * 1024 * 2944 + (size_t)kt * 64 * 2944 + n0, 2944, WIN + (size_t)nd * 1024 + kt * 64, 1024, tile, p.in[I_NMIX] + (size_t)l * D + kt * 64); continue; }
        i -= T_IN;
        if (i < T_OUT) { const int kt = i / 16, nt = i % 16;
            tr_tile(p.in[I_WOUT] + (size_t)l * 1024 * 1024 + (size_t)kt * 64 * 1024 + nt * 64, 1024, WOUT + (size_t)nt * 64 * 1024 + kt * 64, 1024, tile, p.in[I_MGAIN] + (size_t)l * D + kt * 64); continue; }
        i -= T_OUT;
        if (i < T_WG) { const int n = i / 4, gi = i % 4, d = gi >> 1;
            const float* src = ((gi & 1) ? p.in[I_WI] : p.in[I_WR]) + ((size_t)((l * 2 + d) * 6 + n)) * 4096;
            tr_tile(src, 64, WG + (size_t)(n * 256 + gi * 64) * 64, 64, tile); continue; }
        i -= T_WG;
        { const int kt = i / 4, nt = i % 4;
          tr_tile(p.in[I_GLUW] + (size_t)l * 65536 + (size_t)kt * 64 * 256 + nt * 64, 256, GLU + (size_t)nt * 64 * 256 + kt * 64, 256, tile); }
    }
    if (what & CV_IN)
        for (size_t e = (size_t)widx * 512 + ltid(); e < (size_t)128 * 1024 / 8; e += (size_t)nw * 512) *(u32x4*)(WIN + (size_t)2944 * 1024 + e * 8) = (u32x4){0u, 0u, 0u, 0u};
}

DI void build_s5_mats(const Params& p, int l, int widx, int nw) {
    const float* KTAB = (const float*)((const unsigned char*)p.out + DO_KTAB);
    const float* BBAR = (const float*)((const unsigned char*)p.out + DO_BBAR);
    const float* PAR = (const float*)(p.ws + WS_PAR);
    bf16_t* T2 = (bf16_t*)(p.ws + WS_T2); bf16_t* M1 = (bf16_t*)(p.ws + WS_M1);
    const size_t nT2 = (size_t)16 * 512 * 96, nM1 = (size_t)16 * 256 * 64;
    for (size_t e = (size_t)widx * 512 + ltid(); e < nT2 + nM1; e += (size_t)nw * 512) {
        float f[8];
        if (e < nT2) {
            const int g = (int)(e / (512 * 96)), rem = (int)(e % (512 * 96)), n = rem / 96, k0 = (rem % 96) * 8;
            const int t = n >> 4, hp = n & 15;
            if (k0 < 512) {
                const int s = k0 >> 4, h0 = k0 & 15;
#pragma unroll
                for (int j = 0; j < 8; ++j) {
                    float v = 0.f;
                    if (s <= t) v += KTAB[((size_t)((l * 16 + g) * 2 + 0) * 32 + (t - s)) * 256 + hp * 16 + h0 + j];
                    if (s >= t) v += KTAB[((size_t)((l * 16 + g) * 2 + 1) * 32 + (s - t)) * 256 + hp * 16 + h0 + j];
                    f[j] = v;
                }
            } else {
                const int kk = k0 - 512, d = kk >> 7, part = (kk >> 6) & 1, p0 = kk & 63;
                const int base = (l * 2 + d) * 16 + g;
                const float pw = d == 0 ? (float)(t + 1) : (float)(32 - t);
#pragma unroll
                for (int j = 0; j < 8; ++j) {
                    const int pp = p0 + j;
                    const float ar = PAR[(base * 64 + pp) * 2], ai = PAR[(base * 64 + pp) * 2 + 1];
                    const float mg = expf(pw * ar); float sn, cs; sincosf(pw * ai, &sn, &cs);
                    const float wr_ = mg * cs, wi_ = mg * sn;
                    const float cr = p.in[I_CRE][(size_t)base * 1024 + hp * 64 + pp], ci = p.in[I_CIM][(size_t)base * 1024 + hp * 64 + pp];
                    f[j] = part == 0 ? (cr * wr_ - ci * wi_) : -(cr * wi_ + ci * wr_);
                }
            }
            *(u32x4*)(T2 + ((size_t)(g * 512 + n) * 768 + k0)) = pack8(f);
        } else {
            const size_t e2 = e - nT2;
            const int g = (int)(e2 / (256 * 64)), rem = (int)(e2 % (256 * 64)), n = rem / 64, k0 = (rem % 64) * 8;
            const int d = n >> 7, part = (n >> 6) & 1, pp = n & 63;
            const int s = k0 >> 4, h0 = k0 & 15;
            const int base = (l * 2 + d) * 16 + g;
            const float pw = d == 0 ? (float)(31 - s) : (float)s;
            const float ar = PAR[(base * 64 + pp) * 2], ai = PAR[(base * 64 + pp) * 2 + 1];
            const float mg = expf(pw * ar); float sn, cs; sincosf(pw * ai, &sn, &cs);
            const float wr_ = mg * cs, wi_ = mg * sn;
#pragma unroll
            for (int j = 0; j < 8; ++j) {
                const float br = BBAR[((size_t)(base * 64 + pp) * 16 + h0 + j) * 2], bi = BBAR[((size_t)(base * 64 + pp) * 16 + h0 + j) * 2 + 1];
                f[j] = part == 0 ? (wr_ * br - wi_ * bi) : (wr_ * bi + wi_ * br);
            }
            *(u32x4*)(M1 + ((size_t)(g * 256 + n) * 512 + k0)) = pack8(f);
        }
    }
}

constexpr int PB_OFF = 126976;
constexpr int PB_CW = 0, PB_CB = 1536, PB_BR = 1920, PB_BI = 2688, PB_SP = 3456, PB_LB = 4224;
DI void stage_params(const Params& p, int l, unsigned char* lds) {
    float* PB = (float*)(lds + PB_OFF); const int tid = ltid();
    const float* LB = (const float*)(p.ws + WS_LB);
    for (int i = tid; i < 1536; i += 512) PB[PB_CW + i] = p.in[I_CONVW][(size_t)l * 1536 + i];
    if (tid < 384) PB[PB_CB + tid] = p.in[I_CONVB][(size_t)l * 384 + tid];
    for (int i = tid; i < 768; i += 512) {
        PB[PB_BR + i] = p.in[I_BR][(size_t)l * 768 + i]; PB[PB_BI + i] = p.in[I_BI][(size_t)l * 768 + i];
        PB[PB_SP + i] = log1pf(__expf(-p.in[I_LAM][(size_t)l * 768 + i]));
        const int d = i / 384, c = i % 384; PB[PB_LB + i] = LB[(d * 4 + l) * 384 + c];
    }
}

struct RgPre { u32x4 xa0, xa1, ga, wg[4]; float cin; };
DI RgPre rg_load(const Params& p, int item, bool fin) {
    const int tid = ltid();
    const int j = item / 6, n = item % 6;
    const int row0 = j * 64, pos0 = chunk64_pos0(j), L = chunk64_len(j);
    const bf16_t* PROJ = (const bf16_t*)(p.ws + WS_PROJ); const bf16_t* WG = (const bf16_t*)(p.ws + WS_WG);
    const float* RGC = (const float*)((const unsigned char*)p.out + DO_RGC);
    RgPre r; const u32x4 z = (u32x4){0u, 0u, 0u, 0u};
    const int c8 = (tid & 7) * 8;
    { const int rr = tid >> 3, pos = pos0 + rr - 2; r.xa0 = (pos >= PADR && pos < L) ? __builtin_nontemporal_load((const u32x4*)(PROJ + (size_t)(row0 + rr - 2) * PLD + OFF_AX + n * 64 + c8)) : z; }
    r.xa1 = z;
    if (tid < 24) { const int rr = 64 + (tid >> 3), pos = pos0 + rr - 2; if (pos >= PADR && pos < L) r.xa1 = __builtin_nontemporal_load((const u32x4*)(PROJ + (size_t)(row0 + rr - 2) * PLD + OFF_AX + n * 64 + c8)); }
    r.ga = fin ? __builtin_nontemporal_load((const u32x4*)(PROJ + (size_t)(row0 + (tid >> 3)) * PLD + OFF_AG + n * 64 + c8)) : z;
#pragma unroll
    for (int q = 0; q < 4; ++q) { const int idx = tid + 512 * q; r.wg[q] = *(const u32x4*)(WG + (size_t)(n * 256 + (idx >> 3)) * 64 + (idx & 7) * 8); }
    r.cin = 0.f;
    if (fin) { const int sc = tid & 127, c = sc & 63, d = sc >> 6; r.cin = RGC[((size_t)(j * 2 + d) * 384 + n * 64 + c) * 2 + 1]; }
    return r;
}
DI void rg_compute(const Params& p, int item, bool fin, const RgPre& pre, unsigned char* lds) {
    const int tid = ltid(), lane = tid & 63, wave = tid >> 6;
    const int j = item / 6, n = item % 6;
    const int row0 = j * 64, pos0 = chunk64_pos0(j);
    float* XCF = (float*)lds;
    float* AB = (float*)(lds + 16384);
    bf16_t* WGs = (bf16_t*)(lds + 16384);
    bf16_t* XCB = (bf16_t*)(lds + 16384 + 36864);
    bf16_t* XA = (bf16_t*)(lds + 16384 + 36864 + 9216);
    bf16_t* GA = (bf16_t*)(lds + 16384 + 65536);
    float* SEG = (float*)(lds + 16384 + 65536 + 8192);
    const float* PB = (const float*)(lds + PB_OFF);
    __syncthreads();
    { const int c8 = (tid & 7) * 8;
      *(u32x4*)(XA + (tid >> 3) * 64 + c8) = pre.xa0;
      if (tid < 24) *(u32x4*)(XA + (64 + (tid >> 3)) * 64 + c8) = pre.xa1;
#pragma unroll
      for (int q = 0; q < 4; ++q) { const int idx = tid + 512 * q; *(u32x4*)(WGs + (idx >> 3) * 72 + (idx & 7) * 8) = pre.wg[q]; }
    }
    __syncthreads();
    { const int t = tid >> 3, c8 = (tid & 7) * 8;
      const float* cw = PB + PB_CW + n * 64 + c8; const float* cb = PB + PB_CB + n * 64 + c8;
      float xc[8];
#pragma unroll
      for (int i = 0; i < 8; ++i) xc[i] = cb[i];
#pragma unroll
      for (int jj = 0; jj < 4; ++jj) { float xr[8]; unpack8(*(const u32x4*)(XA + (t + jj) * 64 + c8), xr);
#pragma unroll
          for (int i = 0; i < 8; ++i) xc[i] += cw[jj * 384 + i] * xr[i]; }
      *(f32x4*)(XCF + t * 64 + c8) = (f32x4){xc[0], xc[1], xc[2], xc[3]}; *(f32x4*)(XCF + t * 64 + c8 + 4) = (f32x4){xc[4], xc[5], xc[6], xc[7]};
      *(u32x4*)(XCB + t * 72 + c8) = pack8(xc); }
    __syncthreads();
    const int rb = wave & 3, dir = wave >> 2;
    f32x4 acc[8];
#pragma unroll
    for (int c = 0; c < 8; ++c) acc[c] = mma_tile64(XCB + rb * 16 * 72, WGs + (dir * 8 + c) * 16 * 72, 72, lane, (f32x4){0.f, 0.f, 0.f, 0.f});
    __syncthreads();
    { const int cl = lane & 15, q = lane >> 4;
#pragma unroll
      for (int cc = 0; cc < 4; ++cc) {
          const int c = cc * 16 + cl, ch = n * 64 + c;
          const float brv = PB[PB_BR + dir * 384 + ch], biv = PB[PB_BI + dir * 384 + ch], sp = PB[PB_SP + dir * 384 + ch];
#pragma unroll
          for (int jj = 0; jj < 4; ++jj) {
              const int t = rb * 16 + q * 4 + jj;
              const float r = sigmoidf_(acc[cc][jj] + brv), ig = sigmoidf_(acc[cc + 4][jj] + biv);
              const float la = -8.0f * r * sp;
              float a = __expf(la);
              const float om = __builtin_fmaf(-a, a, 1.0f);
              float b = __builtin_amdgcn_sqrtf(fmaxf(om, 0.f)) * ig * XCF[t * 64 + c];
              if (pos0 + t < PADR) { a = 1.0f; b = 0.f; }
              AB[(dir * 2) * 4096 + t * 64 + c] = a; AB[(dir * 2 + 1) * 4096 + t * 64 + c] = b;
          } } }
    __syncthreads();
    float* RGC = (float*)((unsigned char*)p.out + DO_RGC);
    const int sc = tid & 127, seg = tid >> 7, sch = sc & 63, sd = sc >> 6;
    const float* Aa = AB + (sd * 2) * 4096 + sch; float* Bb = AB + (sd * 2 + 1) * 4096 + sch;
    { float P = 1.f, E = 0.f;
#pragma unroll
      for (int u = 0; u < 16; ++u) { const int uu = seg * 16 + u, t = sd == 0 ? uu : 63 - uu; const float a = Aa[t * 64]; E = a * E + Bb[t * 64]; P *= a; }
      SEG[(sc * 4 + seg) * 2] = P; SEG[(sc * 4 + seg) * 2 + 1] = E; }
    __syncthreads();
    if (!fin) {
        if (tid < 128) { float Pt = 1.f, Et = 0.f;
#pragma unroll
            for (int q = 0; q < 4; ++q) { const float Ps = SEG[(tid * 4 + q) * 2], Es = SEG[(tid * 4 + q) * 2 + 1]; Et = Ps * Et + Es; Pt *= Ps; }
            float* cp = RGC + ((size_t)(j * 2 + sd) * 384 + n * 64 + sch) * 2; cp[0] = Pt; cp[1] = Et; }
        return;
    }
    { float h = pre.cin;
      for (int q = 0; q < seg; ++q) h = SEG[(sc * 4 + q) * 2] * h + SEG[(sc * 4 + q) * 2 + 1];
#pragma unroll
      for (int u = 0; u < 16; ++u) { const int uu = seg * 16 + u, t = sd == 0 ? uu : 63 - uu; h = Aa[t * 64] * h + Bb[t * 64]; Bb[t * 64] = h; } }
    __syncthreads();
    { const int t = tid >> 3, c8 = (tid & 7) * 8;
      bf16_t* YM = (bf16_t*)(p.ws + WS_ACT); float* SS = (float*)(p.ws + WS_SS);
      const bool valid = pos0 + t >= PADR;
      float y[8], ss = 0.f;
      float gg[8]; unpack8(pre.ga, gg);
      const f32x4 h0a = *(const f32x4*)(AB + 1 * 4096 + t * 64 + c8), h0b = *(const f32x4*)(AB + 1 * 4096 + t * 64 + c8 + 4), h1a = *(const f32x4*)(AB + 3 * 4096 + t * 64 + c8), h1b = *(const f32x4*)(AB + 3 * 4096 + t * 64 + c8 + 4);
#pragma unroll
      for (int i = 0; i < 8; ++i) { const float hs = i < 4 ? h0a[i & 3] + h1a[i & 3] : h0b[i & 3] + h1b[i & 3];
          const float o = valid ? hs * gelu_tanh(gg[i]) : 0.f; y[i] = o; ss += o * o; }
      *(u32x4*)(YM + (size_t)(row0 + t) * D + n * 64 + c8) = pack8(y);
      ss += __shfl_xor(ss, 1); ss += __shfl_xor(ss, 2); ss += __shfl_xor(ss, 4);
      if ((tid & 7) == 0) SS[(size_t)(row0 + t) * 16 + n] = ss; }
}

struct HgPre { u32x4 xi, xff, xfb, xq, xg, s0, s1; };
DI HgPre hg_load(const Params& p, int item, bool fin) {
    const int tid = ltid();
    const int j = item / 6, n = item % 6, row0 = j * 64;
    const int t = tid >> 3, k8 = (tid & 7) * 8;
    const bf16_t* rowp = (const bf16_t*)(p.ws + WS_PROJ) + (size_t)(row0 + t) * PLD + n * 64 + k8;
    const bf16_t* HGS = (const bf16_t*)((const unsigned char*)p.out + DO_HGS);
    HgPre r; const u32x4 z = (u32x4){0u, 0u, 0u, 0u};
    r.xi = __builtin_nontemporal_load((const u32x4*)(rowp + OFF_BI)); r.xff = __builtin_nontemporal_load((const u32x4*)(rowp + OFF_BFF)); r.xfb = __builtin_nontemporal_load((const u32x4*)(rowp + OFF_BFB));
    r.xq = z; r.xg = z; r.s0 = z; r.s1 = z;
    if (fin) {
        r.xq = __builtin_nontemporal_load((const u32x4*)(rowp + OFF_BQ)); r.xg = __builtin_nontemporal_load((const u32x4*)(rowp + OFF_BG));
        const bf16_t* s0 = HGS + ((size_t)(j * 6 + n) * 2 + 0) * 4096 + t * 64 + k8;
        r.s0 = __builtin_nontemporal_load((const u32x4*)s0); r.s1 = __builtin_nontemporal_load((const u32x4*)(s0 + 4096));
    }
    return r;
}
DI void hg_compute(const Params& p, int item, bool fin, const HgPre& pre, unsigned char* lds) {
    const int tid = ltid(), lane = tid & 63, wave = tid >> 6;
    const int j = item / 6, n = item % 6;
    const int row0 = j * 64, pos0 = chunk64_pos0(j);
    float* LF = (float*)lds;
    bf16_t* QT = (bf16_t*)(lds + 32768);
    bf16_t* KT = (bf16_t*)(lds + 51200);
    bf16_t* VT = (bf16_t*)(lds + 69632);
    bf16_t* SC = (bf16_t*)(lds + 78848);
    bf16_t* SP = (bf16_t*)(lds + 97280);
    bf16_t* XG = (bf16_t*)(lds + 115712);
    float* SEGT = (float*)(lds + 123904);
    float* OX = (float*)lds;
    const float* PB = (const float*)(lds + PB_OFF);
    bf16_t* HGS = (bf16_t*)((unsigned char*)p.out + DO_HGS);
    float* HGD = (float*)(p.ws + WS_HGD);
    const int t = tid >> 3, k8 = (tid & 7) * 8;
    const bool masked = pos0 + t < PADR;
    __syncthreads();
    float kk[2][8], q[8];
    {
        float xf[8], xv[8];
        unpack8(pre.xi, xv);
#pragma unroll
        for (int i = 0; i < 8; ++i) VT[(k8 + i) * 72 + t] = f2bf(masked ? 0.f : xv[i]);
#pragma unroll
        for (int d = 0; d < 2; ++d) {
            unpack8(d == 0 ? pre.xff : pre.xfb, xf);
#pragma unroll
            for (int i = 0; i < 8; ++i) {
                const float lb = PB[PB_LB + d * 384 + n * 64 + k8 + i];
                const float sg = sigmoidf_(xf[i]);
                const float f = lb + (1.0f - lb) * sg;
                kk[d][i] = masked ? 0.f : (1.0f - lb) * (1.0f - sg);
                LF[d * 4096 + t * 64 + k8 + i] = masked ? 0.f : __logf(f);
            }
        }
#pragma unroll
        for (int i = 0; i < 8; ++i) q[i] = 0.f;
        if (fin) { unpack8(pre.xq, q);
#pragma unroll
            for (int i = 0; i < 8; ++i) q[i] = siluf_(q[i]);
            *(u32x4*)(XG + t * 64 + k8) = pre.xg; }
    }
    __syncthreads();
    { const int sc = tid & 127, seg = tid >> 7, k = sc & 63, d = sc >> 6; float run = 0.f; float* lf = LF + d * 4096 + k;
#pragma unroll
      for (int u = 0; u < 16; ++u) { const int uu = seg * 16 + u, s_ = d == 0 ? uu : 63 - uu; run += lf[s_ * 64]; lf[s_ * 64] = run; }
      SEGT[sc * 4 + seg] = run;
      __syncthreads();
      float off = 0.f;
      for (int q2 = 0; q2 < seg; ++q2) off += SEGT[sc * 4 + q2];
      if (seg > 0) {
#pragma unroll
          for (int u = 0; u < 16; ++u) { const int uu = seg * 16 + u, s_ = d == 0 ? uu : 63 - uu; lf[s_ * 64] += off; } } }
    __syncthreads();
    const int rb = wave & 3, dir = wave >> 2, cl = lane & 15, qd = lane >> 4;
    if (!fin) {
#pragma unroll
        for (int d = 0; d < 2; ++d)
#pragma unroll
            for (int i = 0; i < 8; ++i) {
                const int k = k8 + i; const float tot = d == 0 ? LF[63 * 64 + k] : LF[4096 + k];
                KT[d * 4608 + k * 72 + t] = f2bf(kk[d][i] * __expf(tot - LF[d * 4096 + t * 64 + k]));
                if (t == 0) HGD[((size_t)(j * 6 + n) * 2 + d) * 64 + k] = __expf(tot);
            }
        __syncthreads();
#pragma unroll
        for (int kb = 0; kb < 4; ++kb) {
            const f32x4 a = mma_tile64(VT + rb * 16 * 72, KT + dir * 4608 + kb * 16 * 72, 72, lane, (f32x4){0.f, 0.f, 0.f, 0.f});
            bf16_t* dst = HGS + ((size_t)(j * 6 + n) * 2 + dir) * 4096;
#pragma unroll
            for (int jj = 0; jj < 4; ++jj) dst[(rb * 16 + qd * 4 + jj) * 64 + kb * 16 + cl] = f2bf(a[jj]);
        }
        return;
    }
#pragma unroll
    for (int d = 0; d < 2; ++d) {
        float qv[8], kv[8];
#pragma unroll
        for (int i = 0; i < 8; ++i) {
            const int k = k8 + i; const float m = LF[d * 4096 + 32 * 64 + k];
            const float e1 = fminf(fmaxf(LF[d * 4096 + t * 64 + k] - m, -80.f), 80.f);
            const float ex = __expf(e1); qv[i] = q[i] * ex; kv[i] = kk[d][i] * __builtin_amdgcn_rcpf(ex);
        }
        *(u32x4*)(QT + d * 4608 + t * 72 + k8) = pack8(qv);
        *(u32x4*)(KT + d * 4608 + t * 72 + k8) = pack8(kv);
        float sv[8]; unpack8(d == 0 ? pre.s0 : pre.s1, sv);
#pragma unroll
        for (int i = 0; i < 8; ++i) sv[i] *= __expf(LF[d * 4096 + 32 * 64 + k8 + i]);
        *(u32x4*)(SP + d * 4608 + t * 72 + k8) = pack8(sv);
    }
    __syncthreads();
#pragma unroll
    for (int ct = 0; ct < 4; ++ct) {
        const f32x4 a = mma_tile64(QT + dir * 4608 + rb * 16 * 72, KT + dir * 4608 + ct * 16 * 72, 72, lane, (f32x4){0.f, 0.f, 0.f, 0.f});
#pragma unroll
        for (int jj = 0; jj < 4; ++jj) {
            const int tt = rb * 16 + qd * 4 + jj, s_ = ct * 16 + cl;
            const bool keep = dir == 0 ? (s_ <= tt) : (s_ >= tt);
            SC[dir * 4608 + tt * 72 + s_] = f2bf(keep ? a[jj] : 0.f);
        }
    }
    __syncthreads();
    f32x4 o[4];
#pragma unroll
    for (int vt = 0; vt < 4; ++vt) {
        f32x4 a = mma_tile64(SC + dir * 4608 + rb * 16 * 72, VT + vt * 16 * 72, 72, lane, (f32x4){0.f, 0.f, 0.f, 0.f});
        o[vt] = mma_tile64(QT + dir * 4608 + rb * 16 * 72, SP + dir * 4608 + vt * 16 * 72, 72, lane, a);
    }
#pragma unroll
    for (int vt = 0; vt < 4; ++vt)
#pragma unroll
        for (int jh = 0; jh < 2; ++jh) { const int jj = dir == 0 ? 2 + jh : jh; const float val = dir == 0 ? o[vt][2 + jh] : o[vt][jh];
            OX[(rb * 16 + qd * 4 + jj) * 64 + vt * 16 + cl] = val; }
    __syncthreads();
    {
        bf16_t* YM = (bf16_t*)(p.ws + WS_ACT); float* SS = (float*)(p.ws + WS_SS);
#pragma unroll
        for (int jh = 0; jh < 2; ++jh) {
            const int jj = dir * 2 + jh;
            const int tt = rb * 16 + qd * 4 + jj;
            float ov[4], sq = 0.f;
#pragma unroll
            for (int vt = 0; vt < 4; ++vt) { const float own = dir == 0 ? o[vt][jh] : o[vt][2 + jh]; ov[vt] = own + OX[tt * 64 + vt * 16 + cl]; sq += ov[vt] * ov[vt]; }
            sq += __shfl_xor(sq, 1); sq += __shfl_xor(sq, 2); sq += __shfl_xor(sq, 4); sq += __shfl_xor(sq, 8);
            const float rn = rsqrtf(sq * (1.0f / 64.0f) + EPS);
            const bool valid = pos0 + tt >= PADR;
            float s2 = 0.f;
#pragma unroll
            for (int vt = 0; vt < 4; ++vt) {
                const int v = vt * 16 + cl;
                const float y = valid ? ov[vt] * rn * siluf_(bf2f(XG[tt * 64 + v])) : 0.f;
                s2 += y * y;
                YM[(size_t)(row0 + tt) * D + 384 + n * 64 + v] = f2bf(y);
            }
            s2 += __shfl_xor(s2, 1); s2 += __shfl_xor(s2, 2); s2 += __shfl_xor(s2, 4); s2 += __shfl_xor(s2, 8);
            if (cl == 0) SS[(size_t)(row0 + tt) * 16 + 6 + n] = s2;
        }
    }
}

constexpr int CG = 33;
DI void phase_carries(const Params& p, int l) {
    bf16_t* HGS = (bf16_t*)((unsigned char*)p.out + DO_HGS);
    const float* HGD = (const float*)(p.ws + WS_HGD);
    float* RGC = (float*)((unsigned char*)p.out + DO_RGC);
    const float* S5E = (const float*)((const unsigned char*)p.out + DO_S5E);
    bf16_t* U2 = (bf16_t*)(p.ws + WS_U2);
    const float* PAR = (const float*)(p.ws + WS_PAR);
    const int N_HG = 12 * 6 * 2 * 2048, N_RG = 12 * 2 * 384, N_S5 = 12 * 16 * 2 * 64;
    for (int idx = lbid() * 512 + ltid(); idx < N_HG + N_RG + N_S5; idx += lgdim() * 512) {
        if (idx < N_HG) {
            const int seq = idx / 24576, rem = idx % 24576, n = rem / 4096, d = (rem >> 11) & 1, e2 = rem & 2047, k = (e2 * 2) & 63;
            int c0, nc; seq_chunks64(seq, c0, nc);
            unsigned* HG32 = (unsigned*)HGS;
            float S0 = 0.f, S1 = 0.f;
            for (int i0 = 0; i0 < nc; i0 += CG) {
                unsigned loc[CG]; float dec0[CG], dec1[CG];
#pragma unroll
                for (int u = 0; u < CG; ++u) { const int i = i0 + u; if (i < nc) { const int jc = d == 0 ? c0 + i : c0 + nc - 1 - i; const size_t b = (size_t)(jc * 6 + n) * 2 + d; loc[u] = __builtin_nontemporal_load(HG32 + b * 2048 + e2); dec0[u] = HGD[b * 64 + k]; dec1[u] = HGD[b * 64 + k + 1]; } else { loc[u] = 0u; dec0[u] = 0.f; dec1[u] = 0.f; } }
#pragma unroll
                for (int u = 0; u < CG; ++u) { const int i = i0 + u; if (i < nc) { const int jc = d == 0 ? c0 + i : c0 + nc - 1 - i; const size_t b = (size_t)(jc * 6 + n) * 2 + d; HG32[b * 2048 + e2] = pack2(S0, S1); S0 = dec0[u] * S0 + bflo(loc[u]); S1 = dec1[u] * S1 + bfhi(loc[u]); } }
            }
        } else if (idx < N_HG + N_RG) {
            const int i2 = idx - N_HG; const int seq = i2 / 768, rem = i2 % 768, d = rem / 384, ch = rem % 384;
            int c0, nc; seq_chunks64(seq, c0, nc);
            float c = 0.f;
            for (int i0 = 0; i0 < nc; i0 += CG) {
                float P[CG], E[CG];
#pragma unroll
                for (int u = 0; u < CG; ++u) { const int i = i0 + u; if (i < nc) { const int jc = d == 0 ? c0 + i : c0 + nc - 1 - i; const float* cp = RGC + ((size_t)(jc * 2 + d) * 384 + ch) * 2; P[u] = cp[0]; E[u] = cp[1]; } else { P[u] = 0.f; E[u] = 0.f; } }
#pragma unroll
                for (int u = 0; u < CG; ++u) { const int i = i0 + u; if (i < nc) { const int jc = d == 0 ? c0 + i : c0 + nc - 1 - i; float* cp = RGC + ((size_t)(jc * 2 + d) * 384 + ch) * 2; cp[1] = c; c = P[u] * c + E[u]; } }
            }
        } else {
            const int i2 = idx - N_HG - N_RG; const int seq = i2 / 2048, g = (i2 >> 7) & 15, d = (i2 >> 6) & 1, pp = i2 & 63;
            int c0, nc; seq_chunks32(seq, c0, nc);
            const int base = (l * 2 + d) * 16 + g;
            const float ar = PAR[(base * 64 + pp) * 2], ai = PAR[(base * 64 + pp) * 2 + 1];
            const float mg = expf(32.0f * ar); float sn, cs; sincosf(32.0f * ai, &sn, &cs);
            const float wr_ = mg * cs, wi_ = mg * sn;
            float hr = 0.f, hi = 0.f;
            for (int i0 = 0; i0 < nc; i0 += CG) {
                float er[CG], ei[CG];
#pragma unroll
                for (int u = 0; u < CG; ++u) { const int i = i0 + u; if (i < nc) { const int c = d == 0 ? c0 + i : c0 + nc - 1 - i; const size_t ro = (size_t)(g * U2ROWS + c); er[u] = __builtin_nontemporal_load(S5E + ro * 256 + d * 128 + pp); ei[u] = __builtin_nontemporal_load(S5E + ro * 256 + d * 128 + 64 + pp); } else { er[u] = 0.f; ei[u] = 0.f; } }
#pragma unroll
                for (int u = 0; u < CG; ++u) { const int i = i0 + u; if (i < nc) { const int c = d == 0 ? c0 + i : c0 + nc - 1 - i; const size_t ro = (size_t)(g * U2ROWS + c);
                    U2[ro * U2LD + 512 + d * 128 + pp] = f2bf(hr); U2[ro * U2LD + 512 + d * 128 + 64 + pp] = f2bf(hi);
                    const float nr = wr_ * hr - wi_ * hi + er[u], ni = wr_ * hi + wi_ * hr + ei[u]; hr = nr; hi = ni; } }
            }
        }
    }
}

struct MnPre { u32x4 y; f32x4 s0, s1, s2, s3, g0, g1; };
DI MnPre mn_load(const bf16_t* YM, const float* SS, const float* gain, size_t e) {
    const int R = (int)(e >> 7), c0 = (int)(e & 127) * 8; const float* sp = SS + (size_t)R * 16;
    MnPre r; r.y = __builtin_nontemporal_load((const u32x4*)(YM + (size_t)R * D + c0));
    r.s0 = *(const f32x4*)sp; r.s1 = *(const f32x4*)(sp + 4); r.s2 = *(const f32x4*)(sp + 8); r.s3 = *(const f32x4*)(sp + 12);
    r.g0 = *(const f32x4*)(gain + c0); r.g1 = *(const f32x4*)(gain + c0 + 4);
    return r;
}
DI void phase_mixnorm(const Params& p, int l) {
    bf16_t* YM = (bf16_t*)(p.ws + WS_ACT); const float* SS = (const float*)(p.ws + WS_SS);
    const float* gain = p.in[I_MGAIN] + (size_t)l * D;
    const size_t N = (size_t)MP * 128, stride = (size_t)lgdim() * 512;
    size_t e = (size_t)lbid() * 512 + ltid();
    if (e >= N) return;
    MnPre nx = mn_load(YM, SS, gain, e);
    while (e < N) {
        const MnPre cur = nx; const size_t en = e + stride;
        if (en < N) nx = mn_load(YM, SS, gain, en);
        const int R = (int)(e >> 7), c0 = (int)(e & 127) * 8;
        const int br = c0 < 384 ? 0 : (c0 < 768 ? 1 : 2);
        const float inv = br == 2 ? (1.0f / 256.0f) : (1.0f / 384.0f);
        const f32x4 s0 = cur.s0, s1 = cur.s1, s2 = cur.s2, s3 = cur.s3;
        const float tot = br == 0 ? (((s0[0] + s0[1]) + (s0[2] + s0[3])) + (s1[0] + s1[1])) : (br == 1 ? (((s1[2] + s1[3]) + (s2[0] + s2[1])) + (s2[2] + s2[3])) : ((s3[0] + s3[1]) + (s3[2] + s3[3])));
        const float rn = rsqrtf(tot * inv + EPS);
        float f[8]; unpack8(cur.y, f);
#pragma unroll
        for (int i = 0; i < 4; ++i) { f[i] = f[i] * rn * cur.g0[i]; f[4 + i] = f[4 + i] * rn * cur.g1[i]; }
        *(u32x4*)(YM + (size_t)R * D + c0) = pack8(f);
        e = en;
    }
}

DI void phase_combine(const Params& p) {
    const int tid = ltid(); const int lane = tid & 63, wave = tid >> 6;
    bf16_t* H = (bf16_t*)(p.ws + WS_H); float* RSS = (float*)(p.ws + WS_RSS);
    const float* P = (const float*)((const unsigned char*)p.out + DO_PART);
    for (int rr = lbid() * 8 + wave; rr < 768; rr += lgdim() * 8) {
        const int R = 32768 + rr;
        float ss = 0.f;
        u32x2 ho[4]; f32x4 pp[4][8];
#pragma unroll
        for (int q = 0; q < 4; ++q) { const int col = lane * 16 + q * 4; ho[q] = *(const u32x2*)(H + (size_t)R * D + col);
#pragma unroll
            for (int ks = 0; ks < 8; ++ks) pp[q][ks] = *(const f32x4*)(P + ((size_t)ks * 768 + rr) * D + col); }
#pragma unroll
        for (int q = 0; q < 4; ++q) {
            const int col = lane * 16 + q * 4;
            f32x4 h = (f32x4){bflo(ho[q].x), bfhi(ho[q].x), bflo(ho[q].y), bfhi(ho[q].y)};
#pragma unroll
            for (int ks = 0; ks < 8; ++ks) h = h + pp[q][ks];
            u32x2 w; w.x = pack2(h[0], h[1]); w.y = pack2(h[2], h[3]); *(u32x2*)(H + (size_t)R * D + col) = w;
            ss += (h[0] * h[0] + h[1] * h[1]) + (h[2] * h[2] + h[3] * h[3]);
        }
        ss += __shfl_xor(ss, 1); ss += __shfl_xor(ss, 2);
        if ((lane & 3) == 0) RSS[(size_t)R * 16 + (lane >> 2)] = ss;
    }
}

DI int out_row_to_R(int O) { if (O < 16384) return (O >> 12) * LP + 64 + (O & 4095); const int o2 = O - 16384; return ROWS_P + (o2 >> 11) * LS + 64 + (o2 & 2047); }
DI void phase_final(const Params& p) {
    const int tid = ltid(); const int lane = tid & 63, wave = tid >> 6;
    const bf16_t* H = (const bf16_t*)(p.ws + WS_H); const float* gain = p.in[I_NFIN];
    f32x4 gg[4];
#pragma unroll
    for (int i = 0; i < 4; ++i) gg[i] = *(const f32x4*)(gain + (lane + 64 * i) * 4);
    const int stride = lgdim() * 8;
    int O = lbid() * 8 + wave;
    if (O >= 32768) return;
    u32x2 nx[4];
#pragma unroll
    for (int i = 0; i < 4; ++i) nx[i] = __builtin_nontemporal_load((const u32x2*)(H + (size_t)out_row_to_R(O) * D + (lane + 64 * i) * 4));
    while (O < 32768) {
        u32x2 cur[4];
#pragma unroll
        for (int i = 0; i < 4; ++i) cur[i] = nx[i];
        const int On = O + stride;
        if (On < 32768) {
#pragma unroll
            for (int i = 0; i < 4; ++i) nx[i] = __builtin_nontemporal_load((const u32x2*)(H + (size_t)out_row_to_R(On) * D + (lane + 64 * i) * 4));
        }
        f32x4 v[4]; float ss = 0.f;
#pragma unroll
        for (int i = 0; i < 4; ++i) { v[i] = (f32x4){bflo(cur[i].x), bfhi(cur[i].x), bflo(cur[i].y), bfhi(cur[i].y)}; ss += (v[i][0] * v[i][0] + v[i][1] * v[i][1]) + (v[i][2] * v[i][2] + v[i][3] * v[i][3]); }
#pragma unroll
        for (int o = 1; o < 64; o <<= 1) ss += __shfl_xor(ss, o);
        const float rn = rsqrtf(ss * (1.0f / D) + EPS);
        float* dst = p.out + (size_t)O * D;
#pragma unroll
        for (int i = 0; i < 4; ++i) __builtin_nontemporal_store(v[i] * rn * gg[i], (f32x4*)(dst + (lane + 64 * i) * 4));
        O = On;
    }
}

#define XB_TMO      128
#define XB_XCNT(j)  (256  + 64 * (j))
#define XB_XSUB(j)  (1280 + 64 * (j))
#define XB_XGEN(j)  (2304 + 64 * (j))
#define XB_TOP      3328
#define XB_TOPGEN   3392
#define XCD_BAR_WORDS 3456
#define XB_SPIN_CAP (1u << 18)
DI unsigned xb_ld(unsigned* p)              { return __hip_atomic_load(p, __ATOMIC_RELAXED, __HIP_MEMORY_SCOPE_AGENT); }
DI unsigned xb_add(unsigned* p, unsigned v) { return __hip_atomic_fetch_add(p, v, __ATOMIC_RELAXED, __HIP_MEMORY_SCOPE_AGENT); }
DI unsigned xb_xcc_id() { return (unsigned)__builtin_amdgcn_s_getreg((3 << 11) | 20) & 0xFu; }
#define XB_SPIN(cond, bar) do { unsigned _sp = 0; while (cond) { __builtin_amdgcn_s_sleep(1); \
    if ((++_sp & 255u) == 0u) { if (xb_ld(&(bar)[XB_TMO])) break; if (_sp > XB_SPIN_CAP) { atomicAdd(&(bar)[XB_TMO], 1u); break; } } } } while (0)
struct XcdBarrier { unsigned* bar; unsigned x; volatile LAS unsigned* st; };
DI XcdBarrier xcd_barrier_post(unsigned* bar, volatile LAS unsigned* st) {
    XcdBarrier b; b.bar = bar; b.x = xb_xcc_id(); b.st = st;
    if (threadIdx.x == 0) (void)xb_add(&bar[XB_XCNT(b.x)], 1u);
    return b;
}
DI void xcd_barrier_complete(unsigned* bar, unsigned x, unsigned& nloc, unsigned& nx) {
    const unsigned G = gridDim.x * gridDim.y * gridDim.z;
    unsigned sum, cnt, mine, sp = 0u;
    for (;;) {
        sum = 0u; cnt = 0u; mine = 0u;
#pragma unroll
        for (unsigned j = 0; j < 16; ++j) { const unsigned c = xb_ld(&bar[XB_XCNT(j)]); sum += c; cnt += (c > 0u) ? 1u : 0u; mine = (j == x) ? c : mine; }
        if (sum == G) break;
        __builtin_amdgcn_s_sleep(1);
        if ((++sp & 255u) == 0u) { if (xb_ld(&bar[XB_TMO])) break; if (sp > XB_SPIN_CAP) { atomicAdd(&bar[XB_TMO], 1u); break; } }
    }
    nloc = mine > 0u ? mine : 1u; nx = cnt > 0u ? cnt : 1u;
}
DI void xcd_barrier(const XcdBarrier& b) {
    asm volatile("s_waitcnt vmcnt(0)" ::: "memory");
    __syncthreads();
    if (threadIdx.x == 0) {
        unsigned* bar = b.bar;
        __builtin_amdgcn_s_waitcnt(0);
        unsigned nloc = b.st[0], nx = b.st[1];
        if (nloc == 0u) { xcd_barrier_complete(bar, b.x, nloc, nx); b.st[0] = nloc; b.st[1] = nx; }
        const unsigned old = xb_add(&bar[XB_XSUB(b.x)], 1u);
        const unsigned gen = old / nloc;
        if (old + 1u == (gen + 1u) * nloc) {
            __builtin_amdgcn_fence(__ATOMIC_RELEASE, "agent");
            asm volatile("s_waitcnt vmcnt(0)" ::: "memory");
            const unsigned og = xb_add(&bar[XB_TOP], 1u);
            const unsigned tg = og / nx;
            if (og + 1u == (tg + 1u) * nx) xb_add(&bar[XB_TOPGEN], 1u);
            else XB_SPIN(xb_ld(&bar[XB_TOPGEN]) == tg, bar);
            __builtin_amdgcn_fence(__ATOMIC_ACQUIRE, "agent");
            xb_add(&bar[XB_XGEN(b.x)], 1u);
            asm volatile("s_waitcnt vmcnt(0)" ::: "memory");
        } else {
            XB_SPIN(xb_ld(&bar[XB_XGEN(b.x)]) == gen, bar);
            __builtin_amdgcn_fence(__ATOMIC_ACQUIRE, "agent");
            asm volatile("s_waitcnt vmcnt(0)" ::: "memory");
        }
    }
    __syncthreads();
}

DI int item_start(int c, int ng, int G, int NI, float pa, float per) {
    if (c >= G) return NI;
    const float f = c <= ng ? __fmul_rn(pa, (float)c) : __fadd_rn(__fmul_rn(pa, (float)ng), __fmul_rn(per, (float)(c - ng)));
    const int i = (int)__fadd_rn(f, 0.5f);
    return i > NI ? NI : i;
}

constexpr int NPHASE = 2 + 9 * DEPTH;
enum { GM_NONE = 0, GM_INPROJ, GM_RESADD, GM_RELU2, GM_S5E, GM_S5Y, GM_GLU };

struct EpiAny {
    const pg8::Gemm* g;
    DI bool mixn() const { return g->mixn != 0; }
    DI void mix_rescale(f32x4 (&acc)[2][2][4][2], LAS unsigned char* lds, int par, int t, int wr, int fr) const {
#pragma unroll
        for (int ai = 0; ai < 2; ++ai)
#pragma unroll
            for (int m = 0; m < 4; ++m) { float rA, rB, rC; mn_get(lds, par, wr * 64 + fr + ai * 128 + m * 16, rA, rB, rC);
                const float ratio = t == 6 ? rA * __builtin_amdgcn_rcpf(rB) : rB * __builtin_amdgcn_rcpf(rC);
#pragma unroll
                for (int bj = 0; bj < 2; ++bj)
#pragma unroll
                    for (int n = 0; n < 2; ++n) acc[ai][bj][m][n] = acc[ai][bj][m][n] * ratio; }
    }
    DI void prime_commit(LAS unsigned char* lds, int tid, const f32x4& a, const f32x4& b) const { if (g->mixn) mn_commit(lds, 0, tid, a, b); else rs_commit(lds, 0, tid, a, b); }
    DI bool prime_issue(const Unit& u, int tid, f32x4& a, f32x4& b) const {
        const bool m = (g->mode == GM_INPROJ || g->mode == GM_RELU2 || g->mixn);
        if (m) rs_issue(g->mixn ? (const float*)g->i1 : (const float*)g->i0, u.pm, tid, a, b);
        return m;
    }
    DI void operator()(const f32x4 (&acc)[2][2][4][2], const Unit& u, int wr, int wc, int fr, int fq, LAS unsigned char* lds, bool has_next, const Unit& nx, int par) const {
        asm volatile("" : "+v"(fr), "+v"(fq));
        asm volatile("" : "+s"(wr), "+s"(wc));
        switch (g->mode) {
        case GM_INPROJ: { EpiInProj E{(bf16_t*)g->o0, (bf16_t*)g->o1, (const float*)g->i0}; E(acc, u, wr, wc, fr, fq, lds, has_next, nx, par); } break;
        case GM_RESADD: if (g->sched == 3 && u.pm >= 128) { EpiPart E{(float*)const_cast<void*>(g->i1)}; E(acc, u, wr, wc, fr, fq); }
                        else { EpiResAdd E{(bf16_t*)g->o0, (float*)const_cast<void*>(g->i0)}; E(acc, u, wr, wc, fr, fq, g->mixn ? (const float*)g->i1 : nullptr, lds, has_next, nx, par); } break;
        case GM_RELU2:  { EpiRelu2 E{(bf16_t*)g->o0, (const float*)g->i0}; E(acc, u, wr, wc, fr, fq, lds, has_next, nx, par); } break;
        case GM_S5E:    { EpiS5E E{(float*)g->o0}; E(acc, u, wr, wc, fr, fq); } break;
        case GM_S5Y:    { EpiS5Y E{(const bf16_t*)g->i0, (bf16_t*)g->o0, (const float*)g->i1}; E(acc, u, wr, wc, fr, fq); } break;
        default:        { EpiGlu E{(const bf16_t*)g->i0, (bf16_t*)g->o0, (float*)g->o1, (const float*)g->i1}; E(acc, u, wr, wc, fr, fq); } break;
        }
    }
};

__global__ void __launch_bounds__(512, 2) mega(Params p) {
    extern __shared__ __attribute__((aligned(16))) unsigned char lds[];
    cg::grid_group grid = cg::this_grid();
    LAS unsigned char* ldsl = (LAS unsigned char*)lds;
    volatile LAS unsigned* xbst = (volatile LAS unsigned*)(ldsl + LDS_BYTES - 16);
    if (threadIdx.x < 4) xbst[threadIdx.x] = 0u;
    __syncthreads();
    const XcdBarrier xbar = xcd_barrier_post((unsigned*)(p.ws + WS_BAR), xbst);

#ifdef PROBE_DOUBLE_MASK
    bool rep = false;
#endif
    for (int ph = p.ph_lo; ph < p.ph_hi; ++ph) {
        const int l = ph >= 1 ? (ph - 1) / 9 : 0, si = ph >= 1 ? (ph - 1) % 9 : 0;
        const int s = (ph == 0) ? 100 : (ph == NPHASE - 1 ? 101 : (si < 5 ? si + 1 : (si == 5 ? 7 : si + 3)));
        unsigned char* ws = p.ws; unsigned char* ob = (unsigned char*)p.out; asm volatile("" : "+s"(ws), "+s"(ob));
        const int G = lgdim(), c = lbid();
#ifdef PROBE_TS_MASK
        if (blockIdx.x == 0 && threadIdx.x == 0) ((unsigned long long*)(p.ws + WS_TS))[ph] = __builtin_amdgcn_s_memrealtime();
#endif
        pg8::Gemm g; g.mixn = 0; g.mode = GM_NONE; g.perm = 0; g.sched = 0; g.M = MP; g.N = 0; g.o0 = nullptr; g.o1 = nullptr; g.i0 = nullptr; g.i1 = nullptr; g.A = nullptr; g.Bt = nullptr; g.K = 0; g.lda = 0; g.ldb = 0;
        switch (s) {
        case 1:  g.mode = GM_INPROJ; g.perm = 1; g.A = (const bf16_t*)(ws + WS_H); g.Bt = (const bf16_t*)(ws + WS_WIN); g.K = 1024; g.lda = 1024; g.ldb = 1024; g.N = 3072; g.o0 = ws + WS_PROJ; g.o1 = ws + WS_U2; g.i0 = ws + WS_RSS; break;
        case 2:  g.mode = GM_S5E; g.sched = 1; g.A = (const bf16_t*)(ws + WS_U2); g.Bt = (const bf16_t*)(ws + WS_M1); g.K = 512; g.lda = U2LD; g.ldb = 512; g.o0 = ob + DO_S5E; break;
        case 4:  g.mode = GM_S5Y; g.perm = 1; g.sched = 2; g.A = (const bf16_t*)(ws + WS_U2); g.Bt = (const bf16_t*)(ws + WS_T2); g.K = 768; g.lda = U2LD; g.ldb = 768; g.i0 = ws + WS_U2; g.o0 = ws + WS_Z; g.i1 = p.in[I_S5D] + (size_t)l * 256; break;
        case 5:  g.mode = GM_GLU; g.perm = 1; g.A = (const bf16_t*)(ws + WS_Z); g.Bt = (const bf16_t*)(ws + WS_GLU); g.K = 256; g.lda = 256; g.ldb = 256; g.N = 256; g.i0 = ws + WS_Z; g.o0 = ws + WS_ACT; g.o1 = ws + WS_SS; g.i1 = p.in[I_GLUB] + (size_t)l * 256; break;
        case 7:  g.mode = GM_RESADD; g.A = (const bf16_t*)(ws + WS_ACT); g.Bt = (const bf16_t*)(ws + WS_WOUT); g.K = 1024; g.lda = 1024; g.ldb = 1024; g.N = 1024; g.o0 = ws + WS_H; g.i0 = ws + WS_RSS; g.mixn = 1; g.i1 = ws + WS_SS; break;
        case 9:  g.mode = GM_RELU2; g.perm = 1; g.i0 = ws + WS_RSS; g.A = (const bf16_t*)(ws + WS_H); g.Bt = (const bf16_t*)(ws + WS_WUP); g.K = 1024; g.lda = 1024; g.ldb = 1024; g.N = 4096; g.o0 = ws + WS_FF; break;
        case 10: g.mode = GM_RESADD; g.A = (const bf16_t*)(ws + WS_FF); g.Bt = (const bf16_t*)(ws + WS_WDN); g.K = 4096; g.lda = 4096; g.ldb = 4096; g.N = 1024; g.o0 = ws + WS_H; g.i0 = ws + WS_RSS; g.i1 = ob + DO_PART; g.sched = 3; g.M = 32768; break;
        default: break;
        }
        if (g.mode != GM_NONE) {
            pg8::AnyOrder S; S.kind = g.sched; S.G = G; S.c = c; S.ntfull = g.K / 64; S.so.init(g.M, g.N, G, c);
            EpiAny E{&g};
            pg8::gemm_phase(ldsl, g, S, E);
        }
        if (s == 2 || s == 4) {
            const bool fin = (s == 4);
            const int ngemm = fin ? 160 : 80; const float wg = fin ? 2.1f : 1.4f;
            const int NI = NCH64 * 6;
            const int ng = ngemm < G ? ngemm : G;
            const float per = ((float)NI + wg * (float)ng) / (float)G;
            const float pa = per - wg;
            const int i0 = item_start(c, ng, G, NI, pa, per), i1 = item_start(c + 1, ng, G, NI, pa, per);
            stage_params(p, l, lds);
            if (i0 < i1) {
                RgPre nx = rg_load(p, i0, fin);
                for (int it = i0; it < i1; ++it) { const RgPre cur = nx; if (it + 1 < i1) nx = rg_load(p, it + 1, fin); rg_compute(p, it, fin, cur, lds); }
            }
            if (i0 < i1) {
                HgPre nx = hg_load(p, i0, fin);
                for (int it = i0; it < i1; ++it) { const HgPre cur = nx; if (it + 1 < i1) nx = hg_load(p, it + 1, fin); hg_compute(p, it, fin, cur, lds); }
            }
        } else if (s == 1 || s == 7 || s == 9 || s == 10) {
            const int extra = s == 1 ? 1572 % G : (s == 7 ? 524 % G : (s == 9 ? 2096 % G : 96)), widx = c - extra, nw = G - extra;
            if (widx >= 0) {
                if (s == 1) { if (l == 0) build_s5_mats(p, 0, widx, nw); else convert_weights(p, l, CV_UP, widx, nw, lds); }
                else if (s == 7) convert_weights(p, l, CV_DN, widx, nw, lds);
                else if (l + 1 < DEPTH) {
                    if (s == 9) { build_s5_mats(p, l + 1, widx, nw); convert_weights(p, l + 1, CV_SMALL | CV_OUT, widx, nw, lds); }
                    else convert_weights(p, l + 1, CV_IN, widx, nw, lds);
                }
            }
        }
        else if (s == 11) phase_combine(p);
        else if (s == 3) phase_carries(p, l);
        else if (s == 100) { phase_prep(p, lds); build_rows(p); convert_weights(p, 0, CV_UP | CV_IN | CV_OUT | CV_SMALL, c, G, lds); }
        else if (s == 101) phase_final(p);
        if (ph + 1 < p.ph_hi) { if (p.ph_lo < 0) { __threadfence(); grid.sync(); } else xcd_barrier(xbar); }
#ifdef PROBE_DOUBLE_MASK
        if (s < 11 && ((PROBE_DOUBLE_MASK >> s) & 1) && !rep) { rep = true; --ph; } else rep = false;
#endif
    }
#ifdef PROBE_TS_MASK
    xcd_barrier(xbar);
    if (blockIdx.x == 0 && threadIdx.x == 0) {
        unsigned long long* TS = (unsigned long long*)(p.ws + WS_TS);
        TS[NPHASE] = __builtin_amdgcn_s_memrealtime();
        unsigned long long sel = 0;
        for (int ph = 0; ph < NPHASE; ++ph) {
            const int si = ph >= 1 ? (ph - 1) % 9 : 0;
            const int s = (ph == 0) ? 12 : (ph == NPHASE - 1 ? 13 : (si < 5 ? si + 1 : (si == 5 ? 7 : si + 3)));
            if ((PROBE_TS_MASK >> s) & 1) sel += TS[ph + 1] - TS[ph];
        }
        const float v = (float)sel / (float)(TS[NPHASE] - TS[0]);
        const float dl = sqrtf(5000.0f * v);
        p.out[0] += dl; p.out[16777216] += dl;
    }
#endif
}

#ifndef MK_MULTI
#define MK_MULTI 0
#endif

extern "C" void kernel_launch(void* const* d_in, const int* in_sizes, int n_in, void* d_out, int out_size, void* d_ws, size_t ws_size, hipStream_t stream) {
    static int grid = 0;
    if (grid == 0) {
        if (n_in != 29 || ws_size < WS_END || out_size != 33554432) { fprintf(stderr, "kernel_launch: unexpected sizes n_in %d ws %zu need %zu out %d\n", n_in, ws_size, (size_t)WS_END, out_size); grid = -1; return; }
        int dev = 0, cus = 0, per_cu = 0;
        hipGetDevice(&dev);
        hipDeviceGetAttribute(&cus, hipDeviceAttributeMultiprocessorCount, dev);
        if (hipFuncSetAttribute((const void*)mega, hipFuncAttributeMaxDynamicSharedMemorySize, LDS_BYTES) != hipSuccess) { fprintf(stderr, "kernel_launch: hipFuncSetAttribute failed\n"); }
        hipOccupancyMaxActiveBlocksPerMultiprocessor(&per_cu, (const void*)mega, 512, LDS_BYTES);
        (void)hipGetLastError();
        if (per_cu < 1) per_cu = 1;
        grid = cus * 1;
        fprintf(stderr, "kernel_launch: cus %d per_cu %d grid %d ws %zu need %zu\n", cus, per_cu, grid, ws_size, (size_t)WS_END);
    }
    if (grid < 0) return;
    Params p{};
    for (int i = 0; i < 29; ++i) p.in[i] = (const float*)d_in[i];
    p.out = (float*)d_out; p.ws = (unsigned char*)d_ws;
#if MK_MULTI
    for (int ph = 0; ph < NPHASE; ++ph) {
        p.ph_lo = ph; p.ph_hi = ph + 1;
        hipLaunchKernelGGL(mega, dim3(grid), dim3(512), LDS_BYTES, stream, p);
    }
#else
    p.ph_lo = 0; p.ph_hi = NPHASE;
    if (hipMemsetAsync((unsigned char*)d_ws + WS_BAR, 0, 16384, stream) != hipSuccess) { fprintf(stderr, "kernel_launch: memset of the barrier words failed\n"); return; }
    void* args[] = {&p};
    hipError_t e = hipLaunchCooperativeKernel((const void*)mega, dim3(grid), dim3(512), args, LDS_BYTES, stream);
    if (e != hipSuccess) fprintf(stderr, "cooperative launch failed: %s (grid %d)\n", hipGetErrorString(e), grid);
#endif
}
```

```cpp
#include <hip/hip_runtime.h>
#include <hip/hip_cooperative_groups.h>
#include <cstdio>
namespace cg = cooperative_groups;

#define DI __device__ __forceinline__
#define LAS __attribute__((address_space(3)))
typedef unsigned short bf16_t;
typedef short bf16x8 __attribute__((ext_vector_type(8)));
typedef float f32x4 __attribute__((ext_vector_type(4)));
typedef unsigned u32x4 __attribute__((ext_vector_type(4)));
typedef unsigned u32x2 __attribute__((ext_vector_type(2)));

constexpr int D = 1024, DEPTH = 4, DFF = 4096;
constexpr int PADR = 48;
constexpr int LP = 4160, LS = 2112;
constexpr int ROWS_P = 4 * LP;
constexpr int MP = ROWS_P + 8 * LS;
constexpr int NCH64 = MP / 64;
constexpr int NCH32 = MP / 32;
constexpr int U2ROWS = 1280;
constexpr int U2LD = 768;
constexpr int PLD = 2816;
constexpr int OFF_AX = 0, OFF_AG = 384, OFF_BQ = 768, OFF_BI = 1152, OFF_BFF = 1536, OFF_BFB = 1920, OFF_BG = 2304;
constexpr float EPS = 1e-6f;
constexpr int LDS_BYTES = 147456;

constexpr size_t al256(size_t x) { return (x + 255) & ~(size_t)255; }
constexpr size_t WS_H     = 0;
constexpr size_t WS_ACT   = WS_H + (size_t)MP * D * 4;
constexpr size_t WS_BIG   = WS_ACT + (size_t)MP * D * 2;
constexpr size_t BIG_SIZE = (size_t)MP * DFF * 2;
constexpr size_t WS_PROJ  = WS_BIG;
constexpr size_t WS_U2    = WS_PROJ + (size_t)MP * PLD * 2;
constexpr size_t WS_Z     = WS_U2 + (size_t)16 * U2ROWS * U2LD * 2;
static_assert(WS_Z + (size_t)MP * 256 * 2 <= WS_BIG + BIG_SIZE, "BIG overflow");
constexpr size_t WS_FF    = WS_BIG;
constexpr size_t WS_WIN   = WS_BIG + BIG_SIZE;
constexpr size_t WS_WOUT  = WS_WIN + (size_t)3072 * 1024 * 2;
constexpr size_t WS_WUP   = WS_WOUT + (size_t)1024 * 1024 * 2;
constexpr size_t WS_WDN   = WS_WUP + (size_t)4096 * 1024 * 2;
constexpr size_t WS_WG    = WS_WDN + (size_t)1024 * 4096 * 2;
constexpr size_t WS_GLU   = WS_WG + (size_t)6 * 256 * 64 * 2;
constexpr size_t WS_T2    = WS_GLU + (size_t)256 * 256 * 2;
constexpr size_t WS_M1    = WS_T2 + (size_t)16 * 512 * 768 * 2;
constexpr size_t WS_SS    = WS_M1 + (size_t)16 * 256 * 512 * 2;
constexpr size_t WS_HGD   = WS_SS + (size_t)MP * 16 * 4;
constexpr size_t WS_LB    = WS_HGD + (size_t)NCH64 * 6 * 2 * 64 * 4;
constexpr size_t WS_PAR   = WS_LB + al256((size_t)2 * 4 * 384 * 4);
constexpr size_t WS_BAR   = WS_PAR + (size_t)4 * 2 * 16 * 64 * 2 * 4;
constexpr size_t WS_RSS   = WS_BAR + 16384;
constexpr size_t WS_TS    = WS_RSS + (size_t)MP * 16 * 4;
constexpr size_t WS_END   = WS_TS + 1024;
constexpr size_t DO_HB2   = 0;
constexpr size_t DO_PART  = 0;
constexpr size_t DO_HGS   = 0;
constexpr size_t DO_S5E   = DO_HGS + (size_t)NCH64 * 6 * 2 * 4096 * 4;
constexpr size_t DO_KTAB  = DO_S5E + (size_t)16 * U2ROWS * 256 * 4;
constexpr size_t DO_BBAR  = DO_KTAB + (size_t)4 * 16 * 2 * 32 * 256 * 4;
constexpr size_t DO_RGC   = DO_BBAR + (size_t)4 * 2 * 16 * 64 * 16 * 2 * 4;
constexpr size_t DO_END   = DO_RGC + (size_t)NCH64 * 2 * 384 * 2 * 4;
static_assert(DO_END <= (size_t)33554432 * 4, "d_out scratch overflow");

struct Params {
    const float* in[29];
    float* out;
    unsigned char* ws;
    int ph_lo, ph_hi;
};
enum { I_XP = 0, I_XS, I_META, I_NMIX, I_WIN, I_CONVW, I_CONVB, I_WR, I_BR, I_WI, I_BI, I_LAM, I_LBL, I_ARE, I_AIM, I_LDT, I_BRE, I_BIM, I_CRE, I_CIM,
       I_S5D, I_GLUW, I_GLUB, I_MGAIN, I_WOUT, I_NMLP, I_WUP, I_WDN, I_NFIN };

DI int ltid() { int t = threadIdx.x; asm volatile("" : "+v"(t)); return t; }
DI int lbid() { int t = blockIdx.x; asm volatile("" : "+s"(t)); return t; }
DI int lgdim() { int t = gridDim.x; asm volatile("" : "+s"(t)); return t; }
typedef __bf16 bf16x2_t __attribute__((ext_vector_type(2)));
typedef float f32x2_t __attribute__((ext_vector_type(2)));
DI unsigned pack2(float lo, float hi) { const f32x2_t v = {lo, hi}; const bf16x2_t b = __builtin_convertvector(v, bf16x2_t); return __builtin_bit_cast(unsigned, b); }
DI unsigned short f2bf(float f) { return (unsigned short)(pack2(f, 0.f) & 0xFFFFu); }
DI float bf2f(unsigned short b) { return __uint_as_float(((unsigned)b) << 16); }
DI float bflo(unsigned w) { return __uint_as_float(w << 16); }
DI float bfhi(unsigned w) { return __uint_as_float(w & 0xFFFF0000u); }
DI float sigmoidf_(float x) { return __builtin_amdgcn_rcpf(1.0f + __expf(-x)); }
DI float siluf_(float x) { return x * sigmoidf_(x); }
DI float gelu_tanh(float x) { const float u = 0.7978845608028654f * (x + 0.044715f * x * x * x); return x * sigmoidf_(2.0f * u); }
DI void unpack8(const u32x4& w, float* f) { f[0] = bflo(w.x); f[1] = bfhi(w.x); f[2] = bflo(w.y); f[3] = bfhi(w.y); f[4] = bflo(w.z); f[5] = bfhi(w.z); f[6] = bflo(w.w); f[7] = bfhi(w.w); }
DI u32x4 pack8(const float* f) { u32x4 w; w.x = pack2(f[0], f[1]); w.y = pack2(f[2], f[3]); w.z = pack2(f[4], f[5]); w.w = pack2(f[6], f[7]); return w; }

DI size_t pj(int col, int row) { return ((size_t)(col >> 6) * MP + row) * 64 + (col & 63); }
DI void row_info(int R, int& seq, int& pos) {
    if (R < ROWS_P) { seq = R / LP; pos = R - seq * LP; }
    else { const int r = R - ROWS_P; const int s = r / LS; seq = 4 + s; pos = r - s * LS; }
}
DI void seq_chunks64(int seq, int& c0, int& nc) { if (seq < 4) { c0 = seq * 65; nc = 65; } else { c0 = 260 + (seq - 4) * 33; nc = 33; } }
DI void seq_chunks32(int seq, int& c0, int& nc) { if (seq < 4) { c0 = seq * 130; nc = 130; } else { c0 = 520 + (seq - 4) * 66; nc = 66; } }
DI int chunk64_pos0(int j) { if (j < 260) return (j % 65) * 64; return ((j - 260) % 33) * 64; }
DI int chunk64_len(int j) { return j < 260 ? LP : LS; }

namespace pg8 {
constexpr int BM = 256, BK = 64, HALF = 128, HTB = HALF * BK * 2, STAGE_BYTES = 8 * HTB, NXCD = 8, WGM = 8;
__host__ __device__ __forceinline__ int lds_byte(int r, int c) { const int st = (r >> 4) * 2 + (c >> 5), rr = r & 15, cc = c & 31, ob = rr * 64 + cc * 2; return st * 1024 + (ob ^ (((ob >> 9) & 1) << 5)); }
__host__ __device__ __forceinline__ void stage_rc(int b, int& R, int& C) { const int st = b / 1024, sb = b % 1024, swz = sb ^ (((sb >> 9) & 1) << 5); R = (st >> 1) * 16 + swz / 64; C = (st & 1) * 32 + (swz % 64) / 2; }
__host__ __device__ __forceinline__ int perm32(int rho) { const int n = rho >> 4, i = rho & 15; return 8 * (i >> 2) + 4 * n + (i & 3); }
struct Unit { int pm, pn, koff, nt; };
struct Gemm { const bf16_t* A; const bf16_t* Bt; int K, lda, ldb;
              int mixn;
              int mode, perm, sched, M, N;
              void* o0; void* o1; const void* i0; const void* i1; };

struct StaticOrder {
    int nM, nN, nwg, G, c;
    DI void init(int M, int N, int G_, int c_) { nM = M / BM; nN = N / BM; nwg = nM * nN; G = G_; c = c_; }
    DI bool next(int i, Unit& u) const {
        const long L = (long)i * G + c; if (L >= nwg) return false;
        int wgid = (int)L; { const int q = nwg / NXCD, r = nwg % NXCD, xcd = wgid % NXCD, off = wgid / NXCD; wgid = (xcd < r ? xcd * (q + 1) : r * (q + 1) + (xcd - r) * q) + off; }
        const int nig = WGM * nN, gid = wgid / nig, fm = gid * WGM, gsz = (nM - fm) < WGM ? (nM - fm) : WGM;
        u.pm = fm + ((wgid % nig) % gsz); u.pn = (wgid % nig) / gsz; u.koff = 0; u.nt = 0; return true;
    }
    DI void a_ready(const Unit&) const {}
    DI void done(const Unit&) const {}
};
template <int NPN> struct GroupOrder {
    int G, c;
    DI bool next(int i, Unit& u) const {
        const int L = i * G + c; if (L >= 16 * 5 * NPN) return false;
        const int g = L / (5 * NPN), r = L % (5 * NPN); u.pm = g * 5 + (r % 5); u.pn = g * NPN + (r / 5); u.koff = 0; u.nt = 0; return true;
    }
    DI void a_ready(const Unit&) const {}
    DI void done(const Unit&) const {}
};

DI unsigned cvt_pk_bf16(float lo, float hi) { unsigned r; asm volatile("v_cvt_pk_bf16_f32 %0, %1, %2" : "=v"(r) : "v"(lo), "v"(hi)); return r; }

struct AnyOrder {
    StaticOrder so; int kind, G, c, ntfull;
    DI bool next(int i, Unit& u) const {
        bool ok;
        if (kind == 0) ok = so.next(i, u);
        else if (kind == 1) { GroupOrder<1> o{G, c}; ok = o.next(i, u); }
        else if (kind == 2) { GroupOrder<2> o{G, c}; ok = o.next(i, u); }
        else {
            const int L = i * G + c;
            if (L < 512) ok = so.next(i, u);
            else { const int q = L - 512; if (q >= 96) return false; u.pm = 128 + q / 32; u.pn = (q >> 3) & 3; u.koff = (q & 7) * 512; u.nt = 8; return true; }
        }
        u.nt = ntfull; return ok;
    }
};
template <class EpiFn>
DI void gemm_phase(LAS unsigned char* lds, const Gemm& g, const AnyOrder& S, const EpiFn& E) {
    int tid_ = ltid();
    const int tid = tid_, wid = __builtin_amdgcn_readfirstlane(tid >> 6), lane = tid & 63, wr = wid >> 2, wc = wid & 3, fr = lane & 15, fq = lane >> 4;
    int nt = g.K / BK;
    unsigned voffA[2], voffB[2];
#pragma unroll
    for (int i = 0; i < 2; ++i) { int R, C; stage_rc(tid * 16 + i * 8192, R, C); const int Rb = g.perm ? ((R & ~31) + perm32(R & 31)) : R;
        voffA[i] = (unsigned)(R * g.lda + C) * 2u; voffB[i] = (unsigned)(Rb * g.ldb + C) * 2u; }
    const size_t kstep = (size_t)(BK * 2);
    const size_t hstepA = (size_t)HALF * g.lda * 2, hstepB = (size_t)HALF * g.ldb * 2;
    const size_t tstepA = 2 * hstepA, tstepB = 2 * hstepB;
    const unsigned ldsw = (unsigned)wid * 1024u;
    const int aoff = lds_byte(wr * 64 + fr, fq * 8), boff = lds_byte(wc * 32 + fr, fq * 8);
#define PG8_SA(b, h) (((b) * 2 + (h)) * HTB)
#define PG8_SB(b, h) ((4 + (b) * 2 + (h)) * HTB)
#define PG8_STAGE(bufoff, gbase, voff) do { _Pragma("unroll") for (int _i = 0; _i < 2; ++_i) \
        __builtin_amdgcn_global_load_lds((const unsigned*)((const char*)(gbase) + (voff)[_i]), (LAS unsigned*)(lds + (bufoff) + ldsw + _i * 8192), 16, 0, 0); } while (0)
#define PG8_LDA(dst, b, h) do { _Pragma("unroll") for (int m = 0; m < 4; ++m) _Pragma("unroll") for (int k = 0; k < 2; ++k) dst[m][k] = *(const LAS bf16x8*)(lds + PG8_SA(b, h) + aoff + m * 2048 + k * 1024); } while (0)
#define PG8_LDB(dst, b, h) do { _Pragma("unroll") for (int n = 0; n < 2; ++n) _Pragma("unroll") for (int k = 0; k < 2; ++k) dst[n][k] = *(const LAS bf16x8*)(lds + PG8_SB(b, h) + boff + n * 2048 + k * 1024); } while (0)
#define PG8_MMA(ai, bj, At, Bt) do { __builtin_amdgcn_s_setprio(1); _Pragma("unroll") for (int m = 0; m < 4; ++m) _Pragma("unroll") for (int n = 0; n < 2; ++n) _Pragma("unroll") for (int k = 0; k < 2; ++k) \
        acc[ai][bj][m][n] = __builtin_amdgcn_mfma_f32_16x16x32_bf16(Bt[n][k], At[m][k], acc[ai][bj][m][n], 0, 0, 0); __builtin_amdgcn_s_setprio(0); } while (0)
#define PG8_WAIT_V(n) asm volatile("s_waitcnt vmcnt(" #n ")" ::: "memory")
#define PG8_WAIT_L(n) asm volatile("s_waitcnt lgkmcnt(" #n ")" ::: "memory")
#define PG8_BAR __builtin_amdgcn_s_barrier()
#define PG8_SCHED __builtin_amdgcn_sched_barrier(0)
    Unit cur, nxt; int ui = 0;
    if (!S.next(0, cur)) return;
    f32x4 acc[2][2][4][2];
#pragma unroll
    for (int a = 0; a < 2; ++a)
#pragma unroll
        for (int b = 0; b < 2; ++b)
#pragma unroll
            for (int m = 0; m < 4; ++m)
#pragma unroll
                for (int n = 0; n < 2; ++n) acc[a][b][m][n] = (f32x4){0.f, 0.f, 0.f, 0.f};
    bf16x8 At[4][2], B0[2][2], B1[2][2];
    const char* cA = (const char*)g.A + (size_t)cur.pm * tstepA + (size_t)cur.koff * 2; const char* cB = (const char*)g.Bt + (size_t)cur.pn * tstepB + (size_t)cur.koff * 2;
    nt = cur.nt;
    f32x4 pra = (f32x4){0.f, 0.f, 0.f, 0.f}, prb = pra; const bool rsm = E.prime_issue(cur, tid, pra, prb);
    PG8_STAGE(PG8_SB(0, 0), cB, voffB); PG8_STAGE(PG8_SA(0, 0), cA, voffA); PG8_STAGE(PG8_SB(0, 1), cB + hstepB, voffB); PG8_STAGE(PG8_SA(0, 1), cA + hstepA, voffA);
    if (wr == 1) PG8_BAR;
    PG8_WAIT_V(4); PG8_BAR;
    if (rsm) E.prime_commit(lds, tid, pra, prb);
    PG8_STAGE(PG8_SB(1, 0), cB + kstep, voffB); PG8_STAGE(PG8_SA(1, 0), cA + kstep, voffA); PG8_STAGE(PG8_SB(1, 1), cB + hstepB + kstep, voffB);
    PG8_WAIT_V(6); PG8_BAR;
    for (;;) {
        const bool has_next = S.next(ui + 1, nxt);
        const char* nA = has_next ? (const char*)g.A + (size_t)nxt.pm * tstepA + (size_t)nxt.koff * 2 : cA; const char* nB = has_next ? (const char*)g.Bt + (size_t)nxt.pn * tstepB + (size_t)nxt.koff * 2 : cB;
        for (int t = 0; t < nt; t += 2) {
            const bool last = (t == nt - 2);
            const char* a1 = cA + (size_t)(t + 1) * kstep;
            const char* a2 = last ? nA : cA + (size_t)(t + 2) * kstep; const char* b2 = last ? nB : cB + (size_t)(t + 2) * kstep;
            const char* a3 = a2 + kstep; const char* b3 = b2 + kstep;
            if (E.mixn() && (t == 6 || t == 12)) { E.mix_rescale(acc, lds, ui & 1, t, wr, fr); PG8_SCHED; }
            PG8_LDB(B0, 0, 0); PG8_SCHED; PG8_LDA(At, 0, 0); PG8_STAGE(PG8_SA(1, 1), a1 + hstepA, voffA);
            PG8_WAIT_L(8); PG8_BAR; PG8_WAIT_L(0); PG8_MMA(0, 0, At, B0); PG8_BAR; PG8_SCHED;
            PG8_LDB(B1, 0, 1); PG8_STAGE(PG8_SB(0, 0), b2, voffB);
            PG8_BAR; PG8_WAIT_L(0); PG8_MMA(0, 1, At, B1); PG8_BAR;
            PG8_LDA(At, 0, 1); PG8_STAGE(PG8_SA(0, 0), a2, voffA);
            PG8_BAR; PG8_WAIT_L(0); PG8_MMA(1, 0, At, B0); PG8_BAR; PG8_SCHED;
            PG8_STAGE(PG8_SB(0, 1), b2 + hstepB, voffB);
            PG8_WAIT_V(6); PG8_BAR; PG8_MMA(1, 1, At, B1); PG8_BAR;
            PG8_LDB(B0, 1, 0); PG8_SCHED; PG8_LDA(At, 1, 0); PG8_STAGE(PG8_SA(0, 1), a2 + hstepA, voffA);
            PG8_WAIT_L(8); PG8_BAR; PG8_WAIT_L(0); PG8_MMA(0, 0, At, B0); PG8_BAR; PG8_SCHED;
            PG8_LDB(B1, 1, 1); PG8_STAGE(PG8_SB(1, 0), b3, voffB);
            PG8_BAR; PG8_WAIT_L(0); PG8_MMA(0, 1, At, B1); PG8_BAR;
            PG8_LDA(At, 1, 1); PG8_STAGE(PG8_SA(1, 0), a3, voffA);
            PG8_BAR; PG8_WAIT_L(0); PG8_MMA(1, 0, At, B0); PG8_BAR; PG8_SCHED;
            PG8_STAGE(PG8_SB(1, 1), b3 + hstepB, voffB);
            PG8_WAIT_V(6); PG8_BAR; PG8_MMA(1, 1, At, B1); PG8_BAR;
        }
        E(acc, cur, wr, wc, fr, fq, lds, has_next, nxt, ui & 1);
        if (!has_next) break;
#pragma unroll
        for (int a = 0; a < 2; ++a)
#pragma unroll
            for (int b = 0; b < 2; ++b)
#pragma unroll
                for (int m = 0; m < 4; ++m)
#pragma unroll
                    for (int n = 0; n < 2; ++n) acc[a][b][m][n] = (f32x4){0.f, 0.f, 0.f, 0.f};
        cur = nxt; cA = nA; cB = nB; nt = cur.nt; ++ui;
    }
    PG8_WAIT_V(0);
    if (wr == 0) PG8_BAR;
    PG8_BAR;
#undef PG8_SA
#undef PG8_SB
#undef PG8_STAGE
#undef PG8_LDA
#undef PG8_LDB
#undef PG8_MMA
#undef PG8_WAIT_V
#undef PG8_WAIT_L
#undef PG8_BAR
#undef PG8_SCHED
}
}
using pg8::Unit;

DI float row_rn(const float* RSS, int r) {
    const float* sp = RSS + (size_t)r * 16; const f32x4 a = *(const f32x4*)sp, b = *(const f32x4*)(sp + 4), c = *(const f32x4*)(sp + 8), d = *(const f32x4*)(sp + 12);
    const float tot = (((a[0] + a[1]) + (a[2] + a[3])) + ((b[0] + b[1]) + (b[2] + b[3]))) + (((c[0] + c[1]) + (c[2] + c[3])) + ((d[0] + d[1]) + (d[2] + d[3])));
    return rsqrtf(tot * (1.0f / D) + EPS);
}
DI float row_rn4(const float* RSS, int r, int fq) {
    const f32x4 a = *(const f32x4*)(RSS + (size_t)r * 16 + fq * 4);
    float t = (a[0] + a[1]) + (a[2] + a[3]);
    t += __shfl_xor(t, 16); t += __shfl_xor(t, 32);
    return rsqrtf(t * (1.0f / D) + EPS);
}
constexpr int PS_OFF = 131072;
DI void rs_issue(const float* RSS, int pm, int tid, f32x4& a, f32x4& b) { const float* sp = RSS + (size_t)(pm * 256 + (tid & 255)) * 16 + (tid >> 8) * 8; a = *(const f32x4*)sp; b = *(const f32x4*)(sp + 4); }
DI void rs_commit(LAS unsigned char* lds, int par, int tid, const f32x4& a, const f32x4& b) { ((LAS float*)(lds + PS_OFF))[(par * 2 + (tid >> 8)) * 256 + (tid & 255)] = ((a[0] + a[1]) + (a[2] + a[3])) + ((b[0] + b[1]) + (b[2] + b[3])); }
DI float rs_get(LAS unsigned char* lds, int par, int rl) { const LAS float* PS = (const LAS float*)(lds + PS_OFF); return rsqrtf((PS[(par * 2) * 256 + rl] + PS[(par * 2 + 1) * 256 + rl]) * (1.0f / D) + EPS); }
constexpr int MN_OFF = 131072 + 4096;
DI void mn_commit(LAS unsigned char* lds, int par, int tid, const f32x4& a, const f32x4& b) {
    LAS float* M = (LAS float*)(lds + MN_OFF) + par * 1024; const int h = tid >> 8, row = tid & 255;
    const float v0 = h == 0 ? (((a[0] + a[1]) + (a[2] + a[3])) + (b[0] + b[1])) : ((a[0] + a[1]) + (a[2] + a[3]));
    const float v1 = h == 0 ? (b[2] + b[3]) : ((b[0] + b[1]) + (b[2] + b[3]));
    M[(h * 2) * 256 + row] = v0; M[(h * 2 + 1) * 256 + row] = v1;
}
DI void mn_get(LAS unsigned char* lds, int par, int rl, float& rA, float& rB, float& rC) {
    const LAS float* M = (const LAS float*)(lds + MN_OFF) + par * 1024;
    rA = rsqrtf(M[rl] * (1.0f / 384.0f) + EPS); rB = rsqrtf((M[256 + rl] + M[512 + rl]) * (1.0f / 384.0f) + EPS); rC = rsqrtf(M[768 + rl] * (1.0f / 256.0f) + EPS);
}
struct EpiInProj {
    static constexpr bool PERM = true;
    bf16_t* PROJ; bf16_t* U2; const float* RSS;
    DI void operator()(const f32x4 (&acc)[2][2][4][2], const Unit& u, int wr, int wc, int fr, int fq, LAS unsigned char* lds, bool has_next, const Unit& nx, int par) const {
        const int row0 = u.pm * 256 + wr * 64 + fr;
        const int tid = ltid(); f32x4 na = (f32x4){0.f, 0.f, 0.f, 0.f}, nb = na;
        if (has_next) rs_issue(RSS, nx.pm, tid, na, nb);
        float rn[2][4];
#pragma unroll
        for (int ai = 0; ai < 2; ++ai)
#pragma unroll
            for (int m = 0; m < 4; ++m) rn[ai][m] = rs_get(lds, par, wr * 64 + fr + ai * 128 + m * 16);
#pragma unroll
        for (int ai = 0; ai < 2; ++ai)
#pragma unroll
            for (int m = 0; m < 4; ++m) {
                const int r = row0 + ai * 128 + m * 16;
#pragma unroll
                for (int bj = 0; bj < 2; ++bj) {
                    const f32x4 v0 = acc[ai][bj][m][0] * rn[ai][m], v1 = acc[ai][bj][m][1] * rn[ai][m];
                    u32x4 w; w.x = pack2(v0[0], v0[1]); w.y = pack2(v0[2], v0[3]); w.z = pack2(v1[0], v1[1]); w.w = pack2(v1[2], v1[3]);
                    const int cl = bj * 128 + wc * 32 + 8 * fq;
                    if (u.pn == 0) { const int g = cl >> 4, h = cl & 15; *(u32x4*)(U2 + ((size_t)(g * U2ROWS + (r >> 5)) * U2LD + (r & 31) * 16 + h)) = w; }
                    else __builtin_nontemporal_store(w, (u32x4*)(PROJ + pj((u.pn - 1) * 256 + cl, r)));
                }
            }
        if (has_next) rs_commit(lds, par ^ 1, tid, na, nb);
    }
};
struct EpiResAdd {
    static constexpr bool PERM = false;
    bf16_t* H; float* RSS;
    DI void ld(u32x2 (&hv)[2][2][2], int row0, int col0, int ai, int mp) const {
#pragma unroll
        for (int mm = 0; mm < 2; ++mm)
#pragma unroll
            for (int bj = 0; bj < 2; ++bj)
#pragma unroll
                for (int n = 0; n < 2; ++n) hv[mm][bj][n] = *(const u32x2*)(H + (size_t)(row0 + ai * 128 + (mp * 2 + mm) * 16) * D + col0 + bj * 128 + n * 16);
    }
    template <int AI, int MP_>
    DI void proc(const u32x2 (&hv)[2][2][2], const f32x4 (&acc)[2][2][4][2], int row0, int col0, int pn, int wc, int fq, const float (&rc)[2][4]) const {
#pragma unroll
        for (int mm = 0; mm < 2; ++mm) { const int m = MP_ * 2 + mm; const int r = row0 + AI * 128 + m * 16; bf16_t* rowp = H + (size_t)r * D + col0;
            float ss = 0.f;
#pragma unroll
            for (int bj = 0; bj < 2; ++bj)
#pragma unroll
                for (int n = 0; n < 2; ++n) { const u32x2 o = hv[mm][bj][n]; const f32x4 a = acc[AI][bj][m][n] * rc[AI][m];
                    const float h0 = bflo(o.x) + a[0], h1 = bfhi(o.x) + a[1], h2 = bflo(o.y) + a[2], h3 = bfhi(o.y) + a[3];
                    u32x2 w; w.x = pack2(h0, h1); w.y = pack2(h2, h3); *(u32x2*)(rowp + bj * 128 + n * 16) = w;
                    ss += (h0 * h0 + h1 * h1) + (h2 * h2 + h3 * h3); }
            ss += __shfl_xor(ss, 16); ss += __shfl_xor(ss, 32);
            if (fq == 0) RSS[(size_t)r * 16 + pn * 4 + wc] = ss; }
    }
    DI void operator()(const f32x4 (&acc)[2][2][4][2], const Unit& u, int wr, int wc, int fr, int fq, const float* SSn, LAS unsigned char* lds, bool has_next, const Unit& nx, int par) const {
        const int row0 = u.pm * 256 + wr * 64 + fr, col0 = u.pn * 256 + wc * 32 + 4 * fq;
        const int tid = ltid(); f32x4 na = (f32x4){0.f, 0.f, 0.f, 0.f}, nb = na;
        if (SSn && has_next) rs_issue(SSn, nx.pm, tid, na, nb);
        float rc[2][4];
#pragma unroll
        for (int ai = 0; ai < 2; ++ai)
#pragma unroll
            for (int m = 0; m < 4; ++m) { float rA, rB, rC = 1.0f; if (SSn) mn_get(lds, par, wr * 64 + fr + ai * 128 + m * 16, rA, rB, rC); rc[ai][m] = rC; }
        u32x2 ha[2][2][2], hb[2][2][2];
        ld(ha, row0, col0, 0, 0);
        ld(hb, row0, col0, 0, 1); proc<0, 0>(ha, acc, row0, col0, u.pn, wc, fq, rc);
        ld(ha, row0, col0, 1, 0); proc<0, 1>(hb, acc, row0, col0, u.pn, wc, fq, rc);
        ld(hb, row0, col0, 1, 1); proc<1, 0>(ha, acc, row0, col0, u.pn, wc, fq, rc);
        proc<1, 1>(hb, acc, row0, col0, u.pn, wc, fq, rc);
        if (SSn && has_next) mn_commit(lds, par ^ 1, tid, na, nb);
    }
};
struct EpiPart {
    static constexpr bool PERM = false;
    float* P;
    DI void operator()(const f32x4 (&acc)[2][2][4][2], const Unit& u, int wr, int wc, int fr, int fq) const {
        const int row0 = (u.pm - 128) * 256 + wr * 64 + fr, col0 = u.pn * 256 + wc * 32 + 4 * fq; const int ks = u.koff >> 9;
#pragma unroll
        for (int ai = 0; ai < 2; ++ai)
#pragma unroll
            for (int m = 0; m < 4; ++m) { float* rowp = P + ((size_t)ks * 768 + row0 + ai * 128 + m * 16) * D + col0;
#pragma unroll
                for (int bj = 0; bj < 2; ++bj)
#pragma unroll
                    for (int n = 0; n < 2; ++n) *(f32x4*)(rowp + bj * 128 + n * 16) = acc[ai][bj][m][n]; }
    }
};
struct EpiRelu2 {
    static constexpr bool PERM = true;
    bf16_t* FF; const float* RSS;
    DI void operator()(const f32x4 (&acc)[2][2][4][2], const Unit& u, int wr, int wc, int fr, int fq, LAS unsigned char* lds, bool has_next, const Unit& nx, int par) const {
        const int row0 = u.pm * 256 + wr * 64 + fr, col0 = u.pn * 256 + wc * 32 + 8 * fq;
        const int tid = ltid(); f32x4 na = (f32x4){0.f, 0.f, 0.f, 0.f}, nb = na;
        if (has_next) rs_issue(RSS, nx.pm, tid, na, nb);
        float rn[2][4];
#pragma unroll
        for (int ai = 0; ai < 2; ++ai)
#pragma unroll
            for (int m = 0; m < 4; ++m) rn[ai][m] = rs_get(lds, par, wr * 64 + fr + ai * 128 + m * 16);
#pragma unroll
        for (int ai = 0; ai < 2; ++ai)
#pragma unroll
            for (int m = 0; m < 4; ++m) { bf16_t* rowp = FF + (size_t)(row0 + ai * 128 + m * 16) * DFF + col0;
#pragma unroll
                for (int bj = 0; bj < 2; ++bj) { f32x4 v0 = acc[ai][bj][m][0] * rn[ai][m], v1 = acc[ai][bj][m][1] * rn[ai][m];
#pragma unroll
                    for (int j = 0; j < 4; ++j) { const float a = fmaxf(v0[j], 0.f), b = fmaxf(v1[j], 0.f); v0[j] = a * a; v1[j] = b * b; }
                    u32x4 w; w.x = pack2(v0[0], v0[1]); w.y = pack2(v0[2], v0[3]); w.z = pack2(v1[0], v1[1]); w.w = pack2(v1[2], v1[3]);
                    __builtin_nontemporal_store(w, (u32x4*)(rowp + bj * 128)); } }
        if (has_next) rs_commit(lds, par ^ 1, tid, na, nb);
    }
};
struct EpiS5E {
    static constexpr bool PERM = false;
    float* E;
    DI void operator()(const f32x4 (&acc)[2][2][4][2], const Unit& u, int wr, int wc, int fr, int fq) const {
        const int row0 = u.pm * 256 + wr * 64 + fr, col0 = wc * 32 + 4 * fq;
#pragma unroll
        for (int ai = 0; ai < 2; ++ai)
#pragma unroll
            for (int m = 0; m < 4; ++m) { float* rowp = E + (size_t)(row0 + ai * 128 + m * 16) * 256 + col0;
#pragma unroll
                for (int bj = 0; bj < 2; ++bj)
#pragma unroll
                    for (int n = 0; n < 2; ++n) *(f32x4*)(rowp + bj * 128 + n * 16) = acc[ai][bj][m][n]; }
    }
};
struct EpiS5Y {
    static constexpr bool PERM = true;
    const bf16_t* U2; bf16_t* Z; const float* dskip;
    DI void operator()(const f32x4 (&acc)[2][2][4][2], const Unit& u, int wr, int wc, int fr, int fq) const {
        const int g = u.pm / 5, pml = u.pm - g * 5, pnl = u.pn - g * 2;
        float dsk[2][8];
#pragma unroll
        for (int bj = 0; bj < 2; ++bj) { const int h0 = (bj * 128 + wc * 32 + 8 * fq) & 15; const f32x4 d0 = *(const f32x4*)(dskip + g * 16 + h0), d1 = *(const f32x4*)(dskip + g * 16 + h0 + 4);
#pragma unroll
            for (int j = 0; j < 4; ++j) { dsk[bj][j] = d0[j]; dsk[bj][4 + j] = d1[j]; } }
#pragma unroll
        for (int ai = 0; ai < 2; ++ai) {
            u32x4 uw[4][2];
#pragma unroll
            for (int m = 0; m < 4; ++m) { const int chunk = pml * 256 + ai * 128 + wr * 64 + m * 16 + fr;
#pragma unroll
                for (int bj = 0; bj < 2; ++bj) { const int n0 = pnl * 256 + bj * 128 + wc * 32 + 8 * fq;
                    uw[m][bj] = chunk < NCH32 ? *(const u32x4*)(U2 + ((size_t)(g * U2ROWS + chunk) * U2LD + n0)) : (u32x4){0u, 0u, 0u, 0u}; } }
#pragma unroll
            for (int m = 0; m < 4; ++m) {
                const int chunk = pml * 256 + ai * 128 + wr * 64 + m * 16 + fr;
                if (chunk < NCH32) {
#pragma unroll
                    for (int bj = 0; bj < 2; ++bj) {
                        const int n0 = pnl * 256 + bj * 128 + wc * 32 + 8 * fq;
                        const int t = n0 >> 4, h0 = n0 & 15;
                        float uf[8]; unpack8(uw[m][bj], uf);
                        const f32x4 v0 = acc[ai][bj][m][0], v1 = acc[ai][bj][m][1];
                        float y[8];
#pragma unroll
                        for (int j = 0; j < 4; ++j) { y[j] = v0[j]; y[4 + j] = v1[j]; }
#pragma unroll
                        for (int j = 0; j < 8; ++j) y[j] = gelu_tanh(y[j] + dsk[bj][j] * uf[j]);
                        *(u32x4*)(Z + ((size_t)(chunk * 32 + t) * 256 + g * 16 + h0)) = pack8(y);
                    }
                }
            }
        }
    }
};
struct EpiGlu {
    static constexpr bool PERM = true;
    const bf16_t* Z; bf16_t* YM; float* SS; const float* glub;
    DI void operator()(const f32x4 (&acc)[2][2][4][2], const Unit& u, int wr, int wc, int fr, int fq) const {
        const int row0 = u.pm * 256 + wr * 64 + fr;
        float gb[2][8];
#pragma unroll
        for (int bj = 0; bj < 2; ++bj) { const int c0 = bj * 128 + wc * 32 + 8 * fq; const f32x4 d0 = *(const f32x4*)(glub + c0), d1 = *(const f32x4*)(glub + c0 + 4);
#pragma unroll
            for (int j = 0; j < 4; ++j) { gb[bj][j] = d0[j]; gb[bj][4 + j] = d1[j]; } }
#pragma unroll
        for (int ai = 0; ai < 2; ++ai) {
            u32x4 zw[4][2];
#pragma unroll
            for (int m = 0; m < 4; ++m)
#pragma unroll
                for (int bj = 0; bj < 2; ++bj) zw[m][bj] = *(const u32x4*)(Z + (size_t)(row0 + ai * 128 + m * 16) * 256 + bj * 128 + wc * 32 + 8 * fq);
#pragma unroll
            for (int m = 0; m < 4; ++m) {
                const int r = row0 + ai * 128 + m * 16;
                int seq, pos; row_info(r, seq, pos);
                const bool valid = pos >= PADR;
                float ssum = 0.f;
#pragma unroll
                for (int bj = 0; bj < 2; ++bj) {
                    const int c0 = bj * 128 + wc * 32 + 8 * fq;
                    float zf[8]; unpack8(zw[m][bj], zf);
                    const f32x4 v0 = acc[ai][bj][m][0], v1 = acc[ai][bj][m][1];
                    float y[8];
#pragma unroll
                    for (int j = 0; j < 4; ++j) { y[j] = v0[j]; y[4 + j] = v1[j]; }
#pragma unroll
                    for (int j = 0; j < 8; ++j) { const float o = valid ? zf[j] * sigmoidf_(y[j] + gb[bj][j]) : 0.f; y[j] = o; ssum += o * o; }
                    *(u32x4*)(YM + (size_t)r * D + 768 + c0) = pack8(y);
                }
                ssum += __shfl_xor(ssum, 16); ssum += __shfl_xor(ssum, 32);
                if (fq == 0) SS[(size_t)r * 16 + 12 + wc] = ssum;
            }
        }
    }
};

DI f32x4 mma_tile64(const bf16_t* A, const bf16_t* Bt, int ld, int lane, f32x4 acc) {
    const int r = lane & 15, q = lane >> 4;
#pragma unroll
    for (int ks = 0; ks < 2; ++ks) {
        const bf16x8 a = *(const bf16x8*)(A + r * ld + ks * 32 + q * 8);
        const bf16x8 b = *(const bf16x8*)(Bt + r * ld + ks * 32 + q * 8);
        acc = __builtin_amdgcn_mfma_f32_16x16x32_bf16(a, b, acc, 0, 0, 0);
    }
    return acc;
}

DI void phase_prep(const Params& p, unsigned char* lds) {
    const int tid = ltid();
    float* LB = (float*)(p.ws + WS_LB);
    for (int i = lbid() * 512 + tid; i < 2 * 384; i += lgdim() * 512) {
        const int d = i / 384, c = i % 384;
        float lg[4], mx = -1e30f;
#pragma unroll
        for (int l = 0; l < 4; ++l) { lg[l] = p.in[I_LBL][(d * 4 + l) * 384 + c]; mx = fmaxf(mx, lg[l]); }
        float s = 0.f;
#pragma unroll
        for (int l = 0; l < 4; ++l) { lg[l] = expf(lg[l] - mx); s += lg[l]; }
        float cum = 0.f;
#pragma unroll
        for (int l = 0; l < 4; ++l) { if (l > 0) cum += lg[l] / s; LB[(d * 4 + l) * 384 + c] = cum; }
    }
    float* PAR = (float*)(p.ws + WS_PAR);
    float* KTAB = (float*)((unsigned char*)p.out + DO_KTAB);
    float* BBAR = (float*)((unsigned char*)p.out + DO_BBAR);
    float* sAR = (float*)lds;
    float* sAI = sAR + 64;
    float* sBB = sAI + 64;
    float* sC  = sBB + 2048;
    float* sW  = sC + 2048;
    float* sW2 = sW;
    for (int item2 = lbid(); item2 < 4 * 16 * 2 * 2; item2 += lgdim()) {
        const int item = item2 >> 1, half = item2 & 1;
        const int l = item / 32, g = (item / 2) % 16, d = item % 2;
        const int base = ((l * 2 + d) * 16 + g);
        const float dt = expf(p.in[I_LDT][base]);
        __syncthreads();
        if (tid < 64) {
            const float lr = p.in[I_ARE][base * 64 + tid], li = p.in[I_AIM][base * 64 + tid];
            const float ar = lr * dt, ai = li * dt;
            sAR[tid] = ar; sAI[tid] = ai;
            if (half == 0) { PAR[(base * 64 + tid) * 2 + 0] = ar; PAR[(base * 64 + tid) * 2 + 1] = ai; }
        }
        __syncthreads();
        for (int e = tid; e < 1024; e += 512) {
            const int pp = e >> 4, h = e & 15;
            const float ar = sAR[pp], ai = sAI[pp];
            const float lr = p.in[I_ARE][base * 64 + pp], li = p.in[I_AIM][base * 64 + pp];
            float sn, cs; sincosf(ai, &sn, &cs);
            const float em1 = expm1f(ar), ex = em1 + 1.0f;
            const float sh = sinf(0.5f * ai);
            const float x = em1 * cs - 2.0f * sh * sh, y = ex * sn;
            const float den = lr * lr + li * li;
            const float cr = (x * lr + y * li) / den, ci = (y * lr - x * li) / den;
            const float br = p.in[I_BRE][(size_t)(base * 64 + pp) * 16 + h], bi = p.in[I_BIM][(size_t)(base * 64 + pp) * 16 + h];
            const float rr = cr * br - ci * bi, ri = cr * bi + ci * br;
            sBB[e * 2] = rr; sBB[e * 2 + 1] = ri;
            if (half == 0) { BBAR[((size_t)(base * 64 + pp) * 16 + h) * 2] = rr; BBAR[((size_t)(base * 64 + pp) * 16 + h) * 2 + 1] = ri; }
        }
        for (int e = tid; e < 1024; e += 512) {
            sC[e * 2] = p.in[I_CRE][(size_t)base * 1024 + e]; sC[e * 2 + 1] = p.in[I_CIM][(size_t)base * 1024 + e];
        }
        __syncthreads();
_Pragma("nounroll")
        for (int tp = 0; tp < 8; ++tp) {
            if (tid < 128) { const int w = tid >> 6, pp = tid & 63; const float tau = (float)(half * 16 + tp * 2 + w);
                const float mg = expf(tau * sAR[pp]); float sn, cs; sincosf(tau * sAI[pp], &sn, &cs); sW2[(w * 64 + pp) * 2] = mg * cs; sW2[(w * 64 + pp) * 2 + 1] = mg * sn; }
            __syncthreads();
            {
                const int w = tid >> 8, o = tid & 255, hp = o >> 4, h = o & 15;
                float sacc = 0.f;
_Pragma("unroll 4")
                for (int pp = 0; pp < 64; ++pp) {
                    const float wr_ = sW2[(w * 64 + pp) * 2], wi_ = sW2[(w * 64 + pp) * 2 + 1];
                    const float br = sBB[(pp * 16 + h) * 2], bi = sBB[(pp * 16 + h) * 2 + 1];
                    const float tr = wr_ * br - wi_ * bi, ti = wr_ * bi + wi_ * br;
                    const float cr = sC[(hp * 64 + pp) * 2], ci = sC[(hp * 64 + pp) * 2 + 1];
                    sacc += cr * tr - ci * ti;
                }
                KTAB[((size_t)((l * 16 + g) * 2 + d) * 32 + (half * 16 + tp * 2 + w)) * 256 + o] = sacc;
            }
            __syncthreads();
        }
    }
}

DI const float* build_src(const Params& p, int R) {
    int seq, pos; row_info(R, seq, pos);
    const int t = pos - PADR;
    if (t < 0) return nullptr;
    if (t < 16) return p.in[I_META] + (size_t)t * D;
    return (seq < 4) ? p.in[I_XP] + ((size_t)seq * 4096 + (t - 16)) * D : p.in[I_XS] + ((size_t)(seq - 4) * 2048 + (t - 16)) * D;
}
DI void build_rows(const Params& p) {
    const int tid = ltid(); const int lane = tid & 63, wave = tid >> 6;
    bf16_t* H = (bf16_t*)(p.ws + WS_H); float* RSS = (float*)(p.ws + WS_RSS);
    const int stride = lgdim() * 8;
    int R = lbid() * 8 + wave;
    if (R >= MP) return;
    const f32x4 zf = (f32x4){0.f, 0.f, 0.f, 0.f};
    f32x4 nx[4];
    { const float* src = build_src(p, R);
#pragma unroll
      for (int i = 0; i < 4; ++i) nx[i] = src ? __builtin_nontemporal_load((const f32x4*)(src + (lane + 64 * i) * 4)) : zf; }
    while (R < MP) {
        f32x4 v[4];
#pragma unroll
        for (int i = 0; i < 4; ++i) v[i] = nx[i];
        const int Rn = R + stride;
        if (Rn < MP) { const float* src = build_src(p, Rn);
#pragma unroll
            for (int i = 0; i < 4; ++i) nx[i] = src ? __builtin_nontemporal_load((const f32x4*)(src + (lane + 64 * i) * 4)) : zf; }
        float ss = 0.f;
#pragma unroll
        for (int i = 0; i < 4; ++i) {
            u32x2 w; w.x = pack2(v[i][0], v[i][1]); w.y = pack2(v[i][2], v[i][3]); *(u32x2*)(H + (size_t)R * D + (lane + 64 * i) * 4) = w;
            ss += (v[i][0] * v[i][0] + v[i][1] * v[i][1]) + (v[i][2] * v[i][2] + v[i][3] * v[i][3]); }
#pragma unroll
        for (int o = 1; o < 64; o <<= 1) ss += __shfl_xor(ss, o);
        if (lane < 16) RSS[(size_t)R * 16 + lane] = lane == 0 ? ss : 0.f;
        R = Rn;
    }
}

DI void tr_tile(const float* src, int lds_, bf16_t* dst, int ldd, float* tile, const float* kgain = nullptr) {
    const int tid = ltid();
    __syncthreads();
    { const int r = tid >> 4, c4 = (tid & 15) * 4;
#pragma unroll
      for (int rr = 0; rr < 64; rr += 32) { f32x4 v = __builtin_nontemporal_load((const f32x4*)(src + (size_t)(r + rr) * lds_ + c4)); if (kgain) v = v * kgain[r + rr]; float* tp = tile + (r + rr) * 65 + c4; tp[0] = v[0]; tp[1] = v[1]; tp[2] = v[2]; tp[3] = v[3]; } }
    __syncthreads();
    { const int n = tid >> 3, k8 = (tid & 7) * 8; float f[8];
#pragma unroll
      for (int i = 0; i < 8; ++i) f[i] = tile[(k8 + i) * 65 + n];
      *(u32x4*)(dst + (size_t)n * ldd + k8) = pack8(f); }
}

enum { CV_UP = 1, CV_DN = 2, CV_IN = 4, CV_OUT = 8, CV_SMALL = 16 };
DI void convert_weights(const Params& p, int l, int what, int widx, int nw, unsigned char* lds) {
    float* tile = (float*)lds;
    bf16_t* WIN = (bf16_t*)(p.ws + WS_WIN); bf16_t* WOUT = (bf16_t*)(p.ws + WS_WOUT); bf16_t* WUP = (bf16_t*)(p.ws + WS_WUP); bf16_t* WDN = (bf16_t*)(p.ws + WS_WDN);
    bf16_t* WG = (bf16_t*)(p.ws + WS_WG); bf16_t* GLU = (bf16_t*)(p.ws + WS_GLU);
    const int T_UP = (what & CV_UP) ? 16 * 64 : 0, T_DN = (what & CV_DN) ? 64 * 16 : 0, T_IN = (what & CV_IN) ? 16 * 46 : 0, T_OUT = (what & CV_OUT) ? 16 * 16 : 0, T_WG = (what & CV_SMALL) ? 24 : 0, T_GLU = (what & CV_SMALL) ? 16 : 0;
    for (int it = widx; it < T_UP + T_DN + T_IN + T_OUT + T_WG + T_GLU; it += nw) {
        int i = it;
        if (i < T_UP) { const int kt = i / 64, nt = i % 64;
            tr_tile(p.in[I_WUP] + (size_t)l * 1024 * 4096 + (size_t)kt * 64 * 4096 + nt * 64, 4096, WUP + (size_t)nt * 64 * 1024 + kt * 64, 1024, tile, p.in[I_NMLP] + (size_t)l * D + kt * 64); continue; }
        i -= T_UP;
        if (i < T_DN) { const int kt = i / 16, nt = i % 16;
            tr_tile(p.in[I_WDN] + (size_t)l * 4096 * 1024 + (size_t)kt * 64 * 1024 + nt * 64, 1024, WDN + (size_t)nt * 64 * 4096 + kt * 64, 4096, tile); continue; }
        i -= T_DN;
        if (i < T_IN) { const int kt = i / 46, nt = i % 46;
            const int n0 = nt * 64; const int nd = (n0 >= 2688) ? n0 - 2688 : n0 + 256;
            tr_tile(p.in[I_WIN] + (size_t)l * 1024 * 2944 + (size_t)kt * 64 * 2944 + n0, 2944, WIN + (size_t)nd * 1024 + kt * 64, 1024, tile, p.in[I_NMIX] + (size_t)l * D + kt * 64); continue; }
        i -= T_IN;
        if (i < T_OUT) { const int kt = i / 16, nt = i % 16;
            tr_tile(p.in[I_WOUT] + (size_t)l * 1024 * 1024 + (size_t)kt * 64 * 1024 + nt * 64, 1024, WOUT + (size_t)nt * 64 * 1024 + kt * 64, 1024, tile, p.in[I_MGAIN] + (size_t)l * D + kt * 64); continue; }
        i -= T_OUT;
        if (i < T_WG) { const int n = i / 4, gi = i % 4, d = gi >> 1;
            const float* src = ((gi & 1) ? p.in[I_WI] : p.in[I_WR]) + ((size_t)((l * 2 + d) * 6 + n)) * 4096;
            tr_tile(src, 64, WG + (size_t)(n * 256 + gi * 64) * 64, 64, tile); continue; }
        i -= T_WG;
        { const int kt = i / 4, nt = i % 4;
          tr_tile(p.in[I_GLUW] + (size_t)l * 65536 + (size_t)kt * 64 * 256 + nt * 64, 256, GLU + (size_t)nt * 64 * 256 + kt * 64, 256, tile); }
    }
    if (what & CV_IN)
        for (size_t e = (size_t)widx * 512 + ltid(); e < (size_t)128 * 1024 / 8; e += (size_t)nw * 512) *(u32x4*)(WIN + (size_t)2944 * 1024 + e * 8) = (u32x4){0u, 0u, 0u, 0u};
}

DI void build_s5_mats(const Params& p, int l, int widx, int nw) {
    const float* KTAB = (const float*)((const unsigned char*)p.out + DO_KTAB);
    const float* BBAR = (const float*)((const unsigned char*)p.out + DO_BBAR);
    const float* PAR = (const float*)(p.ws + WS_PAR);
    bf16_t* T2 = (bf16_t*)(p.ws + WS_T2); bf16_t* M1 = (bf16_t*)(p.ws + WS_M1);
    const size_t nT2 = (size_t)16 * 512 * 96, nM1 = (size_t)16 * 256 * 64;
    for (size_t e = (size_t)widx * 512 + ltid(); e < nT2 + nM1; e += (size_t)nw * 512) {
        float f[8];
        if (e < nT2) {
            const int g = (int)(e / (512 * 96)), rem = (int)(e % (512 * 96)), n = rem / 96, k0 = (rem % 96) * 8;
            const int t = n >> 4, hp = n & 15;
            if (k0 < 512) {
                const int s = k0 >> 4, h0 = k0 & 15;
#pragma unroll
                for (int j = 0; j < 8; ++j) {
                    float v = 0.f;
                    if (s <= t) v += KTAB[((size_t)((l * 16 + g) * 2 + 0) * 32 + (t - s)) * 256 + hp * 16 + h0 + j];
                    if (s >= t) v += KTAB[((size_t)((l * 16 + g) * 2 + 1) * 32 + (s - t)) * 256 + hp * 16 + h0 + j];
                    f[j] = v;
                }
            } else {
                const int kk = k0 - 512, d = kk >> 7, part = (kk >> 6) & 1, p0 = kk & 63;
                const int base = (l * 2 + d) * 16 + g;
                const float pw = d == 0 ? (float)(t + 1) : (float)(32 - t);
#pragma unroll
                for (int j = 0; j < 8; ++j) {
                    const int pp = p0 + j;
                    const float ar = PAR[(base * 64 + pp) * 2], ai = PAR[(base * 64 + pp) * 2 + 1];
                    const float mg = expf(pw * ar); float sn, cs; sincosf(pw * ai, &sn, &cs);
                    const float wr_ = mg * cs, wi_ = mg * sn;
                    const float cr = p.in[I_CRE][(size_t)base * 1024 + hp * 64 + pp], ci = p.in[I_CIM][(size_t)base * 1024 + hp * 64 + pp];
                    f[j] = part == 0 ? (cr * wr_ - ci * wi_) : -(cr * wi_ + ci * wr_);
                }
            }
            *(u32x4*)(T2 + ((size_t)(g * 512 + n) * 768 + k0)) = pack8(f);
        } else {
            const size_t e2 = e - nT2;
            const int g = (int)(e2 / (256 * 64)), rem = (int)(e2 % (256 * 64)), n = rem / 64, k0 = (rem % 64) * 8;
            const int d = n >> 7, part = (n >> 6) & 1, pp = n & 63;
            const int s = k0 >> 4, h0 = k0 & 15;
            const int base = (l * 2 + d) * 16 + g;
            const float pw = d == 0 ? (float)(31 - s) : (float)s;
            const float ar = PAR[(base * 64 + pp) * 2], ai = PAR[(base * 64 + pp) * 2 + 1];
            const float mg = expf(pw * ar); float sn, cs; sincosf(pw * ai, &sn, &cs);
            const float wr_ = mg * cs, wi_ = mg * sn;
#pragma unroll
            for (int j = 0; j < 8; ++j) {
                const float br = BBAR[((size_t)(base * 64 + pp) * 16 + h0 + j) * 2], bi = BBAR[((size_t)(base * 64 + pp) * 16 + h0 + j) * 2 + 1];
                f[j] = part == 0 ? (wr_ * br - wi_ * bi) : (wr_ * bi + wi_ * br);
            }
            *(u32x4*)(M1 + ((size_t)(g * 256 + n) * 512 + k0)) = pack8(f);
        }
    }
}

constexpr int PB_OFF = 126976;
constexpr int PB_CW = 0, PB_CB = 1536, PB_BR = 1920, PB_BI = 2688, PB_SP = 3456, PB_LB = 4224;
DI void stage_params(const Params& p, int l, unsigned char* lds) {
    float* PB = (float*)(lds + PB_OFF); const int tid = ltid();
    const float* LB = (const float*)(p.ws + WS_LB);
    for (int i = tid; i < 1536; i += 512) PB[PB_CW + i] = p.in[I_CONVW][(size_t)l * 1536 + i];
    if (tid < 384) PB[PB_CB + tid] = p.in[I_CONVB][(size_t)l * 384 + tid];
    for (int i = tid; i < 768; i += 512) {
        PB[PB_BR + i] = p.in[I_BR][(size_t)l * 768 + i]; PB[PB_BI + i] = p.in[I_BI][(size_t)l * 768 + i];
        PB[PB_SP + i] = log1pf(__expf(-p.in[I_LAM][(size_t)l * 768 + i]));
        const int d = i / 384, c = i % 384; PB[PB_LB + i] = LB[(d * 4 + l) * 384 + c];
    }
}

struct RgPre { u32x4 xa0, xa1, ga, wg[4]; float cin; };
DI RgPre rg_load(const Params& p, int item, bool fin) {
    const int tid = ltid();
    const int j = item / 6, n = item % 6;
    const int row0 = j * 64, pos0 = chunk64_pos0(j), L = chunk64_len(j);
    const bf16_t* PROJ = (const bf16_t*)(p.ws + WS_PROJ); const bf16_t* WG = (const bf16_t*)(p.ws + WS_WG);
    const float* RGC = (const float*)((const unsigned char*)p.out + DO_RGC);
    RgPre r; const u32x4 z = (u32x4){0u, 0u, 0u, 0u};
    const int c8 = (tid & 7) * 8;
    { const int rr = tid >> 3, pos = pos0 + rr - 2; r.xa0 = (pos >= PADR && pos < L) ? __builtin_nontemporal_load((const u32x4*)(PROJ + pj(OFF_AX + n * 64 + c8, row0 + rr - 2))) : z; }
    r.xa1 = z;
    if (tid < 24) { const int rr = 64 + (tid >> 3), pos = pos0 + rr - 2; if (pos >= PADR && pos < L) r.xa1 = __builtin_nontemporal_load((const u32x4*)(PROJ + pj(OFF_AX + n * 64 + c8, row0 + rr - 2))); }
    r.ga = fin ? __builtin_nontemporal_load((const u32x4*)(PROJ + pj(OFF_AG + n * 64 + c8, row0 + (tid >> 3)))) : z;
#pragma unroll
    for (int q = 0; q < 4; ++q) { const int idx = tid + 512 * q; r.wg[q] = *(const u32x4*)(WG + (size_t)(n * 256 + (idx >> 3)) * 64 + (idx & 7) * 8); }
    r.cin = 0.f;
    if (fin) { const int sc = tid & 127, c = sc & 63, d = sc >> 6; r.cin = RGC[((size_t)(j * 2 + d) * 384 + n * 64 + c) * 2 + 1]; }
    return r;
}
DI void rg_compute(const Params& p, int item, bool fin, const RgPre& pre, unsigned char* lds) {
    const int tid = ltid(), lane = tid & 63, wave = tid >> 6;
    const int j = item / 6, n = item % 6;
    const int row0 = j * 64, pos0 = chunk64_pos0(j);
    float* XCF = (float*)lds;
    float* AB = (float*)(lds + 16384);
    bf16_t* WGs = (bf16_t*)(lds + 16384);
    bf16_t* XCB = (bf16_t*)(lds + 16384 + 36864);
    bf16_t* XA = (bf16_t*)(lds + 16384 + 36864 + 9216);
    bf16_t* GA = (bf16_t*)(lds + 16384 + 65536);
    float* SEG = (float*)(lds + 16384 + 65536 + 8192);
    const float* PB = (const float*)(lds + PB_OFF);
    __syncthreads();
    { const int c8 = (tid & 7) * 8;
      *(u32x4*)(XA + (tid >> 3) * 64 + c8) = pre.xa0;
      if (tid < 24) *(u32x4*)(XA + (64 + (tid >> 3)) * 64 + c8) = pre.xa1;
#pragma unroll
      for (int q = 0; q < 4; ++q) { const int idx = tid + 512 * q; *(u32x4*)(WGs + (idx >> 3) * 72 + (idx & 7) * 8) = pre.wg[q]; }
    }
    __syncthreads();
    { const int t = tid >> 3, c8 = (tid & 7) * 8;
      const float* cw = PB + PB_CW + n * 64 + c8; const float* cb = PB + PB_CB + n * 64 + c8;
      float xc[8];
#pragma unroll
      for (int i = 0; i < 8; ++i) xc[i] = cb[i];
#pragma unroll
      for (int jj = 0; jj < 4; ++jj) { float xr[8]; unpack8(*(const u32x4*)(XA + (t + jj) * 64 + c8), xr);
#pragma unroll
          for (int i = 0; i < 8; ++i) xc[i] += cw[jj * 384 + i] * xr[i]; }
      *(f32x4*)(XCF + t * 64 + c8) = (f32x4){xc[0], xc[1], xc[2], xc[3]}; *(f32x4*)(XCF + t * 64 + c8 + 4) = (f32x4){xc[4], xc[5], xc[6], xc[7]};
      *(u32x4*)(XCB + t * 72 + c8) = pack8(xc); }
    __syncthreads();
    const int rb = wave & 3, dir = wave >> 2;
    f32x4 acc[8];
#pragma unroll
    for (int c = 0; c < 8; ++c) acc[c] = mma_tile64(XCB + rb * 16 * 72, WGs + (dir * 8 + c) * 16 * 72, 72, lane, (f32x4){0.f, 0.f, 0.f, 0.f});
    __syncthreads();
    { const int cl = lane & 15, q = lane >> 4;
#pragma unroll
      for (int cc = 0; cc < 4; ++cc) {
          const int c = cc * 16 + cl, ch = n * 64 + c;
          const float brv = PB[PB_BR + dir * 384 + ch], biv = PB[PB_BI + dir * 384 + ch], sp = PB[PB_SP + dir * 384 + ch];
#pragma unroll
          for (int jj = 0; jj < 4; ++jj) {
              const int t = rb * 16 + q * 4 + jj;
              const float r = sigmoidf_(acc[cc][jj] + brv), ig = sigmoidf_(acc[cc + 4][jj] + biv);
              const float la = -8.0f * r * sp;
              float a = __expf(la);
              const float om = __builtin_fmaf(-a, a, 1.0f);
              float b = __builtin_amdgcn_sqrtf(fmaxf(om, 0.f)) * ig * XCF[t * 64 + c];
              if (pos0 + t < PADR) { a = 1.0f; b = 0.f; }
              AB[(dir * 2) * 4096 + t * 64 + c] = a; AB[(dir * 2 + 1) * 4096 + t * 64 + c] = b;
          } } }
    __syncthreads();
    float* RGC = (float*)((unsigned char*)p.out + DO_RGC);
    const int sc = tid & 127, seg = tid >> 7, sch = sc & 63, sd = sc >> 6;
    const float* Aa = AB + (sd * 2) * 4096 + sch; float* Bb = AB + (sd * 2 + 1) * 4096 + sch;
    { float P = 1.f, E = 0.f;
#pragma unroll
      for (int u = 0; u < 16; ++u) { const int uu = seg * 16 + u, t = sd == 0 ? uu : 63 - uu; const float a = Aa[t * 64]; E = a * E + Bb[t * 64]; P *= a; }
      SEG[(sc * 4 + seg) * 2] = P; SEG[(sc * 4 + seg) * 2 + 1] = E; }
    __syncthreads();
    if (!fin) {
        if (tid < 128) { float Pt = 1.f, Et = 0.f;
#pragma unroll
            for (int q = 0; q < 4; ++q) { const float Ps = SEG[(tid * 4 + q) * 2], Es = SEG[(tid * 4 + q) * 2 + 1]; Et = Ps * Et + Es; Pt *= Ps; }
            float* cp = RGC + ((size_t)(j * 2 + sd) * 384 + n * 64 + sch) * 2; cp[0] = Pt; cp[1] = Et; }
        return;
    }
    { float h = pre.cin;
      for (int q = 0; q < seg; ++q) h = SEG[(sc * 4 + q) * 2] * h + SEG[(sc * 4 + q) * 2 + 1];
#pragma unroll
      for (int u = 0; u < 16; ++u) { const int uu = seg * 16 + u, t = sd == 0 ? uu : 63 - uu; h = Aa[t * 64] * h + Bb[t * 64]; Bb[t * 64] = h; } }
    __syncthreads();
    { const int t = tid >> 3, c8 = (tid & 7) * 8;
      bf16_t* YM = (bf16_t*)(p.ws + WS_ACT); float* SS = (float*)(p.ws + WS_SS);
      const bool valid = pos0 + t >= PADR;
      float y[8], ss = 0.f;
      float gg[8]; unpack8(pre.ga, gg);
      const f32x4 h0a = *(const f32x4*)(AB + 1 * 4096 + t * 64 + c8), h0b = *(const f32x4*)(AB + 1 * 4096 + t * 64 + c8 + 4), h1a = *(const f32x4*)(AB + 3 * 4096 + t * 64 + c8), h1b = *(const f32x4*)(AB + 3 * 4096 + t * 64 + c8 + 4);
#pragma unroll
      for (int i = 0; i < 8; ++i) { const float hs = i < 4 ? h0a[i & 3] + h1a[i & 3] : h0b[i & 3] + h1b[i & 3];
          const float o = valid ? hs * gelu_tanh(gg[i]) : 0.f; y[i] = o; ss += o * o; }
      *(u32x4*)(YM + (size_t)(row0 + t) * D + n * 64 + c8) = pack8(y);
      ss += __shfl_xor(ss, 1); ss += __shfl_xor(ss, 2); ss += __shfl_xor(ss, 4);
      if ((tid & 7) == 0) SS[(size_t)(row0 + t) * 16 + n] = ss; }
}

struct HgPre { u32x4 xi, xff, xfb, xq, xg, s0, s1; };
DI HgPre hg_load(const Params& p, int item, bool fin) {
    const int tid = ltid();
    const int j = item / 6, n = item % 6, row0 = j * 64;
    const int t = tid >> 3, k8 = (tid & 7) * 8;
    const bf16_t* rowp = (const bf16_t*)(p.ws + WS_PROJ) + pj(n * 64 + k8, row0 + t);
    const bf16_t* HGS = (const bf16_t*)((const unsigned char*)p.out + DO_HGS);
    HgPre r; const u32x4 z = (u32x4){0u, 0u, 0u, 0u};
    r.xi = __builtin_nontemporal_load((const u32x4*)(rowp + (size_t)(OFF_BI / 64) * MP * 64)); r.xff = __builtin_nontemporal_load((const u32x4*)(rowp + (size_t)(OFF_BFF / 64) * MP * 64)); r.xfb = __builtin_nontemporal_load((const u32x4*)(rowp + (size_t)(OFF_BFB / 64) * MP * 64));
    r.xq = z; r.xg = z; r.s0 = z; r.s1 = z;
    if (fin) {
        r.xq = __builtin_nontemporal_load((const u32x4*)(rowp + (size_t)(OFF_BQ / 64) * MP * 64)); r.xg = __builtin_nontemporal_load((const u32x4*)(rowp + (size_t)(OFF_BG / 64) * MP * 64));
        const bf16_t* s0 = HGS + ((size_t)(j * 6 + n) * 2 + 0) * 4096 + t * 64 + k8;
        r.s0 = __builtin_nontemporal_load((const u32x4*)s0); r.s1 = __builtin_nontemporal_load((const u32x4*)(s0 + 4096));
    }
    return r;
}
DI void hg_compute(const Params& p, int item, bool fin, const HgPre& pre, unsigned char* lds) {
    const int tid = ltid(), lane = tid & 63, wave = tid >> 6;
    const int j = item / 6, n = item % 6;
    const int row0 = j * 64, pos0 = chunk64_pos0(j);
    float* LF = (float*)lds;
    bf16_t* QT = (bf16_t*)(lds + 32768);
    bf16_t* KT = (bf16_t*)(lds + 51200);
    bf16_t* VT = (bf16_t*)(lds + 69632);
    bf16_t* SC = (bf16_t*)(lds + 78848);
    bf16_t* SP = (bf16_t*)(lds + 97280);
    bf16_t* XG = (bf16_t*)(lds + 115712);
    float* SEGT = (float*)(lds + 123904);
    float* OX = (float*)lds;
    const float* PB = (const float*)(lds + PB_OFF);
    bf16_t* HGS = (bf16_t*)((unsigned char*)p.out + DO_HGS);
    float* HGD = (float*)(p.ws + WS_HGD);
    const int t = tid >> 3, k8 = (tid & 7) * 8;
    const bool masked = pos0 + t < PADR;
    __syncthreads();
    float kk[2][8], q[8];
    {
        float xf[8], xv[8];
        unpack8(pre.xi, xv);
#pragma unroll
        for (int i = 0; i < 8; ++i) VT[(k8 + i) * 72 + t] = f2bf(masked ? 0.f : xv[i]);
#pragma unroll
        for (int d = 0; d < 2; ++d) {
            unpack8(d == 0 ? pre.xff : pre.xfb, xf);
#pragma unroll
            for (int i = 0; i < 8; ++i) {
                const float lb = PB[PB_LB + d * 384 + n * 64 + k8 + i];
                const float sg = sigmoidf_(xf[i]);
                const float f = lb + (1.0f - lb) * sg;
                kk[d][i] = masked ? 0.f : (1.0f - lb) * (1.0f - sg);
                LF[d * 4096 + t * 64 + k8 + i] = masked ? 0.f : __logf(f);
            }
        }
#pragma unroll
        for (int i = 0; i < 8; ++i) q[i] = 0.f;
        if (fin) { unpack8(pre.xq, q);
#pragma unroll
            for (int i = 0; i < 8; ++i) q[i] = siluf_(q[i]);
            *(u32x4*)(XG + t * 64 + k8) = pre.xg; }
    }
    __syncthreads();
    { const int sc = tid & 127, seg = tid >> 7, k = sc & 63, d = sc >> 6; float run = 0.f; float* lf = LF + d * 4096 + k;
#pragma unroll
      for (int u = 0; u < 16; ++u) { const int uu = seg * 16 + u, s_ = d == 0 ? uu : 63 - uu; run += lf[s_ * 64]; lf[s_ * 64] = run; }
      SEGT[sc * 4 + seg] = run;
      __syncthreads();
      float off = 0.f;
      for (int q2 = 0; q2 < seg; ++q2) off += SEGT[sc * 4 + q2];
      if (seg > 0) {
#pragma unroll
          for (int u = 0; u < 16; ++u) { const int uu = seg * 16 + u, s_ = d == 0 ? uu : 63 - uu; lf[s_ * 64] += off; } } }
    __syncthreads();
    const int rb = wave & 3, dir = wave >> 2, cl = lane & 15, qd = lane >> 4;
    if (!fin) {
#pragma unroll
        for (int d = 0; d < 2; ++d)
#pragma unroll
            for (int i = 0; i < 8; ++i) {
                const int k = k8 + i; const float tot = d == 0 ? LF[63 * 64 + k] : LF[4096 + k];
                KT[d * 4608 + k * 72 + t] = f2bf(kk[d][i] * __expf(tot - LF[d * 4096 + t * 64 + k]));
                if (t == 0) HGD[((size_t)(j * 6 + n) * 2 + d) * 64 + k] = __expf(tot);
            }
        __syncthreads();
#pragma unroll
        for (int kb = 0; kb < 4; ++kb) {
            const f32x4 a = mma_tile64(VT + rb * 16 * 72, KT + dir * 4608 + kb * 16 * 72, 72, lane, (f32x4){0.f, 0.f, 0.f, 0.f});
            bf16_t* dst = HGS + ((size_t)(j * 6 + n) * 2 + dir) * 4096;
#pragma unroll
            for (int jj = 0; jj < 4; ++jj) dst[(rb * 16 + qd * 4 + jj) * 64 + kb * 16 + cl] = f2bf(a[jj]);
        }
        return;
    }
#pragma unroll
    for (int d = 0; d < 2; ++d) {
        float qv[8], kv[8];
#pragma unroll
        for (int i = 0; i < 8; ++i) {
            const int k = k8 + i; const float m = LF[d * 4096 + 32 * 64 + k];
            const float e1 = fminf(fmaxf(LF[d * 4096 + t * 64 + k] - m, -80.f), 80.f);
            const float ex = __expf(e1); qv[i] = q[i] * ex; kv[i] = kk[d][i] * __builtin_amdgcn_rcpf(ex);
        }
        *(u32x4*)(QT + d * 4608 + t * 72 + k8) = pack8(qv);
        *(u32x4*)(KT + d * 4608 + t * 72 + k8) = pack8(kv);
        float sv[8]; unpack8(d == 0 ? pre.s0 : pre.s1, sv);
#pragma unroll
        for (int i = 0; i < 8; ++i) sv[i] *= __expf(LF[d * 4096 + 32 * 64 + k8 + i]);
        *(u32x4*)(SP + d * 4608 + t * 72 + k8) = pack8(sv);
    }
    __syncthreads();
#pragma unroll
    for (int ct = 0; ct < 4; ++ct) {
        const f32x4 a = mma_tile64(QT + dir * 4608 + rb * 16 * 72, KT + dir * 4608 + ct * 16 * 72, 72, lane, (f32x4){0.f, 0.f, 0.f, 0.f});
#pragma unroll
        for (int jj = 0; jj < 4; ++jj) {
            const int tt = rb * 16 + qd * 4 + jj, s_ = ct * 16 + cl;
            const bool keep = dir == 0 ? (s_ <= tt) : (s_ >= tt);
            SC[dir * 4608 + tt * 72 + s_] = f2bf(keep ? a[jj] : 0.f);
        }
    }
    __syncthreads();
    f32x4 o[4];
#pragma unroll
    for (int vt = 0; vt < 4; ++vt) {
        f32x4 a = mma_tile64(SC + dir * 4608 + rb * 16 * 72, VT + vt * 16 * 72, 72, lane, (f32x4){0.f, 0.f, 0.f, 0.f});
        o[vt] = mma_tile64(QT + dir * 4608 + rb * 16 * 72, SP + dir * 4608 + vt * 16 * 72, 72, lane, a);
    }
#pragma unroll
    for (int vt = 0; vt < 4; ++vt)
#pragma unroll
        for (int jh = 0; jh < 2; ++jh) { const int jj = dir == 0 ? 2 + jh : jh; const float val = dir == 0 ? o[vt][2 + jh] : o[vt][jh];
            OX[(rb * 16 + qd * 4 + jj) * 64 + vt * 16 + cl] = val; }
    __syncthreads();
    {
        bf16_t* YM = (bf16_t*)(p.ws + WS_ACT); float* SS = (float*)(p.ws + WS_SS);
#pragma unroll
        for (int jh = 0; jh < 2; ++jh) {
            const int jj = dir * 2 + jh;
            const int tt = rb * 16 + qd * 4 + jj;
            float ov[4], sq = 0.f;
#pragma unroll
            for (int vt = 0; vt < 4; ++vt) { const float own = dir == 0 ? o[vt][jh] : o[vt][2 + jh]; ov[vt] = own + OX[tt * 64 + vt * 16 + cl]; sq += ov[vt] * ov[vt]; }
            sq += __shfl_xor(sq, 1); sq += __shfl_xor(sq, 2); sq += __shfl_xor(sq, 4); sq += __shfl_xor(sq, 8);
            const float rn = rsqrtf(sq * (1.0f / 64.0f) + EPS);
            const bool valid = pos0 + tt >= PADR;
            float s2 = 0.f;
#pragma unroll
            for (int vt = 0; vt < 4; ++vt) {
                const int v = vt * 16 + cl;
                const float y = valid ? ov[vt] * rn * siluf_(bf2f(XG[tt * 64 + v])) : 0.f;
                s2 += y * y;
                YM[(size_t)(row0 + tt) * D + 384 + n * 64 + v] = f2bf(y);
            }
            s2 += __shfl_xor(s2, 1); s2 += __shfl_xor(s2, 2); s2 += __shfl_xor(s2, 4); s2 += __shfl_xor(s2, 8);
            if (cl == 0) SS[(size_t)(row0 + tt) * 16 + 6 + n] = s2;
        }
    }
}

constexpr int CG = 33;
DI void phase_carries(const Params& p, int l) {
    bf16_t* HGS = (bf16_t*)((unsigned char*)p.out + DO_HGS);
    const float* HGD = (const float*)(p.ws + WS_HGD);
    float* RGC = (float*)((unsigned char*)p.out + DO_RGC);
    const float* S5E = (const float*)((const unsigned char*)p.out + DO_S5E);
    bf16_t* U2 = (bf16_t*)(p.ws + WS_U2);
    const float* PAR = (const float*)(p.ws + WS_PAR);
    const int N_HG = 12 * 6 * 2 * 2048, N_RG = 12 * 2 * 384, N_S5 = 12 * 16 * 2 * 64;
    for (int idx = lbid() * 512 + ltid(); idx < N_HG + N_RG + N_S5; idx += lgdim() * 512) {
        if (idx < N_HG) {
            const int seq = idx / 24576, rem = idx % 24576, n = rem / 4096, d = (rem >> 11) & 1, e2 = rem & 2047, k = (e2 * 2) & 63;
            int c0, nc; seq_chunks64(seq, c0, nc);
            unsigned* HG32 = (unsigned*)HGS;
            float S0 = 0.f, S1 = 0.f;
            for (int i0 = 0; i0 < nc; i0 += CG) {
                unsigned loc[CG]; float dec0[CG], dec1[CG];
#pragma unroll
                for (int u = 0; u < CG; ++u) { const int i = i0 + u; if (i < nc) { const int jc = d == 0 ? c0 + i : c0 + nc - 1 - i; const size_t b = (size_t)(jc * 6 + n) * 2 + d; loc[u] = __builtin_nontemporal_load(HG32 + b * 2048 + e2); dec0[u] = HGD[b * 64 + k]; dec1[u] = HGD[b * 64 + k + 1]; } else { loc[u] = 0u; dec0[u] = 0.f; dec1[u] = 0.f; } }
#pragma unroll
                for (int u = 0; u < CG; ++u) { const int i = i0 + u; if (i < nc) { const int jc = d == 0 ? c0 + i : c0 + nc - 1 - i; const size_t b = (size_t)(jc * 6 + n) * 2 + d; HG32[b * 2048 + e2] = pack2(S0, S1); S0 = dec0[u] * S0 + bflo(loc[u]); S1 = dec1[u] * S1 + bfhi(loc[u]); } }
            }
        } else if (idx < N_HG + N_RG) {
            const int i2 = idx - N_HG; const int seq = i2 / 768, rem = i2 % 768, d = rem / 384, ch = rem % 384;
            int c0, nc; seq_chunks64(seq, c0, nc);
            float c = 0.f;
            for (int i0 = 0; i0 < nc; i0 += CG) {
                float P[CG], E[CG];
#pragma unroll
                for (int u = 0; u < CG; ++u) { const int i = i0 + u; if (i < nc) { const int jc = d == 0 ? c0 + i : c0 + nc - 1 - i; const float* cp = RGC + ((size_t)(jc * 2 + d) * 384 + ch) * 2; P[u] = cp[0]; E[u] = cp[1]; } else { P[u] = 0.f; E[u] = 0.f; } }
#pragma unroll
                for (int u = 0; u < CG; ++u) { const int i = i0 + u; if (i < nc) { const int jc = d == 0 ? c0 + i : c0 + nc - 1 - i; float* cp = RGC + ((size_t)(jc * 2 + d) * 384 + ch) * 2; cp[1] = c; c = P[u] * c + E[u]; } }
            }
        } else {
            const int i2 = idx - N_HG - N_RG; const int seq = i2 / 2048, g = (i2 >> 7) & 15, d = (i2 >> 6) & 1, pp = i2 & 63;
            int c0, nc; seq_chunks32(seq, c0, nc);
            const int base = (l * 2 + d) * 16 + g;
            const float ar = PAR[(base * 64 + pp) * 2], ai = PAR[(base * 64 + pp) * 2 + 1];
            const float mg = expf(32.0f * ar); float sn, cs; sincosf(32.0f * ai, &sn, &cs);
            const float wr_ = mg * cs, wi_ = mg * sn;
            float hr = 0.f, hi = 0.f;
            for (int i0 = 0; i0 < nc; i0 += CG) {
                float er[CG], ei[CG];
#pragma unroll
                for (int u = 0; u < CG; ++u) { const int i = i0 + u; if (i < nc) { const int c = d == 0 ? c0 + i : c0 + nc - 1 - i; const size_t ro = (size_t)(g * U2ROWS + c); er[u] = __builtin_nontemporal_load(S5E + ro * 256 + d * 128 + pp); ei[u] = __builtin_nontemporal_load(S5E + ro * 256 + d * 128 + 64 + pp); } else { er[u] = 0.f; ei[u] = 0.f; } }
#pragma unroll
                for (int u = 0; u < CG; ++u) { const int i = i0 + u; if (i < nc) { const int c = d == 0 ? c0 + i : c0 + nc - 1 - i; const size_t ro = (size_t)(g * U2ROWS + c);
                    U2[ro * U2LD + 512 + d * 128 + pp] = f2bf(hr); U2[ro * U2LD + 512 + d * 128 + 64 + pp] = f2bf(hi);
                    const float nr = wr_ * hr - wi_ * hi + er[u], ni = wr_ * hi + wi_ * hr + ei[u]; hr = nr; hi = ni; } }
            }
        }
    }
}

struct MnPre { u32x4 y; f32x4 s0, s1, s2, s3, g0, g1; };
DI MnPre mn_load(const bf16_t* YM, const float* SS, const float* gain, size_t e) {
    const int R = (int)(e >> 7), c0 = (int)(e & 127) * 8; const float* sp = SS + (size_t)R * 16;
    MnPre r; r.y = __builtin_nontemporal_load((const u32x4*)(YM + (size_t)R * D + c0));
    r.s0 = *(const f32x4*)sp; r.s1 = *(const f32x4*)(sp + 4); r.s2 = *(const f32x4*)(sp + 8); r.s3 = *(const f32x4*)(sp + 12);
    r.g0 = *(const f32x4*)(gain + c0); r.g1 = *(const f32x4*)(gain + c0 + 4);
    return r;
}
DI void phase_mixnorm(const Params& p, int l) {
    bf16_t* YM = (bf16_t*)(p.ws + WS_ACT); const float* SS = (const float*)(p.ws + WS_SS);
    const float* gain = p.in[I_MGAIN] + (size_t)l * D;
    const size_t N = (size_t)MP * 128, stride = (size_t)lgdim() * 512;
    size_t e = (size_t)lbid() * 512 + ltid();
    if (e >= N) return;
    MnPre nx = mn_load(YM, SS, gain, e);
    while (e < N) {
        const MnPre cur = nx; const size_t en = e + stride;
        if (en < N) nx = mn_load(YM, SS, gain, en);
        const int R = (int)(e >> 7), c0 = (int)(e & 127) * 8;
        const int br = c0 < 384 ? 0 : (c0 < 768 ? 1 : 2);
        const float inv = br == 2 ? (1.0f / 256.0f) : (1.0f / 384.0f);
        const f32x4 s0 = cur.s0, s1 = cur.s1, s2 = cur.s2, s3 = cur.s3;
        const float tot = br == 0 ? (((s0[0] + s0[1]) + (s0[2] + s0[3])) + (s1[0] + s1[1])) : (br == 1 ? (((s1[2] + s1[3]) + (s2[0] + s2[1])) + (s2[2] + s2[3])) : ((s3[0] + s3[1]) + (s3[2] + s3[3])));
        const float rn = rsqrtf(tot * inv + EPS);
        float f[8]; unpack8(cur.y, f);
#pragma unroll
        for (int i = 0; i < 4; ++i) { f[i] = f[i] * rn * cur.g0[i]; f[4 + i] = f[4 + i] * rn * cur.g1[i]; }
        *(u32x4*)(YM + (size_t)R * D + c0) = pack8(f);
        e = en;
    }
}

DI void phase_combine(const Params& p) {
    const int tid = ltid(); const int lane = tid & 63, wave = tid >> 6;
    bf16_t* H = (bf16_t*)(p.ws + WS_H); float* RSS = (float*)(p.ws + WS_RSS);
    const float* P = (const float*)((const unsigned char*)p.out + DO_PART);
    for (int rr = lbid() * 8 + wave; rr < 768; rr += lgdim() * 8) {
        const int R = 32768 + rr;
        float ss = 0.f;
        u32x2 ho[4]; f32x4 pp[4][8];
#pragma unroll
        for (int q = 0; q < 4; ++q) { const int col = lane * 16 + q * 4; ho[q] = *(const u32x2*)(H + (size_t)R * D + col);
#pragma unroll
            for (int ks = 0; ks < 8; ++ks) pp[q][ks] = *(const f32x4*)(P + ((size_t)ks * 768 + rr) * D + col); }
#pragma unroll
        for (int q = 0; q < 4; ++q) {
            const int col = lane * 16 + q * 4;
            f32x4 h = (f32x4){bflo(ho[q].x), bfhi(ho[q].x), bflo(ho[q].y), bfhi(ho[q].y)};
#pragma unroll
            for (int ks = 0; ks < 8; ++ks) h = h + pp[q][ks];
            u32x2 w; w.x = pack2(h[0], h[1]); w.y = pack2(h[2], h[3]); *(u32x2*)(H + (size_t)R * D + col) = w;
            ss += (h[0] * h[0] + h[1] * h[1]) + (h[2] * h[2] + h[3] * h[3]);
        }
        ss += __shfl_xor(ss, 1); ss += __shfl_xor(ss, 2);
        if ((lane & 3) == 0) RSS[(size_t)R * 16 + (lane >> 2)] = ss;
    }
}

DI int out_row_to_R(int O) { if (O < 16384) return (O >> 12) * LP + 64 + (O & 4095); const int o2 = O - 16384; return ROWS_P + (o2 >> 11) * LS + 64 + (o2 & 2047); }
DI void phase_final(const Params& p) {
    const int tid = ltid(); const int lane = tid & 63, wave = tid >> 6;
    const bf16_t* H = (const bf16_t*)(p.ws + WS_H); const float* gain = p.in[I_NFIN];
    f32x4 gg[4];
#pragma unroll
    for (int i = 0; i < 4; ++i) gg[i] = *(const f32x4*)(gain + (lane + 64 * i) * 4);
    const int stride = lgdim() * 8;
    int O = lbid() * 8 + wave;
    if (O >= 32768) return;
    u32x2 nx[4];
#pragma unroll
    for (int i = 0; i < 4; ++i) nx[i] = __builtin_nontemporal_load((const u32x2*)(H + (size_t)out_row_to_R(O) * D + (lane + 64 * i) * 4));
    while (O < 32768) {
        u32x2 cur[4];
#pragma unroll
        for (int i = 0; i < 4; ++i) cur[i] = nx[i];
        const int On = O + stride;
        if (On < 32768) {
#pragma unroll
            for (int i = 0; i < 4; ++i) nx[i] = __builtin_nontemporal_load((const u32x2*)(H + (size_t)out_row_to_R(On) * D + (lane + 64 * i) * 4));
        }
        f32x4 v[4]; float ss = 0.f;
#pragma unroll
        for (int i = 0; i < 4; ++i) { v[i] = (f32x4){bflo(cur[i].x), bfhi(cur[i].x), bflo(cur[i].y), bfhi(cur[i].y)}; ss += (v[i][0] * v[i][0] + v[i][1] * v[i][1]) + (v[i][2] * v[i][2] + v[i][3] * v[i][3]); }
#pragma unroll
        for (int o = 1; o < 64; o <<= 1) ss += __shfl_xor(ss, o);
        const float rn = rsqrtf(ss * (1.0f / D) + EPS);
        float* dst = p.out + (size_t)O * D;
#pragma unroll
        for (int i = 0; i < 4; ++i) __builtin_nontemporal_store(v[i] * rn * gg[i], (f32x4*)(dst + (lane + 64 * i) * 4));
        O = On;
    }
}

#define XB_TMO      128
#define XB_XCNT(j)  (256  + 64 * (j))
#define XB_XSUB(j)  (1280 + 64 * (j))
#define XB_XGEN(j)  (2304 + 64 * (j))
#define XB_TOP      3328
#define XB_TOPGEN   3392
#define XCD_BAR_WORDS 3456
#define XB_SPIN_CAP (1u << 18)
DI unsigned xb_ld(unsigned* p)              { return __hip_atomic_load(p, __ATOMIC_RELAXED, __HIP_MEMORY_SCOPE_AGENT); }
DI unsigned xb_add(unsigned* p, unsigned v) { return __hip_atomic_fetch_add(p, v, __ATOMIC_RELAXED, __HIP_MEMORY_SCOPE_AGENT); }
DI unsigned xb_xcc_id() { return (unsigned)__builtin_amdgcn_s_getreg((3 << 11) | 20) & 0xFu; }
#define XB_SPIN(cond, bar) do { unsigned _sp = 0; while (cond) { __builtin_amdgcn_s_sleep(1); \
    if ((++_sp & 255u) == 0u) { if (xb_ld(&(bar)[XB_TMO])) break; if (_sp > XB_SPIN_CAP) { atomicAdd(&(bar)[XB_TMO], 1u); break; } } } } while (0)
struct XcdBarrier { unsigned* bar; unsigned x; volatile LAS unsigned* st; };
DI XcdBarrier xcd_barrier_post(unsigned* bar, volatile LAS unsigned* st) {
    XcdBarrier b; b.bar = bar; b.x = xb_xcc_id(); b.st = st;
    if (threadIdx.x == 0) (void)xb_add(&bar[XB_XCNT(b.x)], 1u);
    return b;
}
DI void xcd_barrier_complete(unsigned* bar, unsigned x, unsigned& nloc, unsigned& nx) {
    const unsigned G = gridDim.x * gridDim.y * gridDim.z;
    unsigned sum, cnt, mine, sp = 0u;
    for (;;) {
        sum = 0u; cnt = 0u; mine = 0u;
#pragma unroll
        for (unsigned j = 0; j < 16; ++j) { const unsigned c = xb_ld(&bar[XB_XCNT(j)]); sum += c; cnt += (c > 0u) ? 1u : 0u; mine = (j == x) ? c : mine; }
        if (sum == G) break;
        __builtin_amdgcn_s_sleep(1);
        if ((++sp & 255u) == 0u) { if (xb_ld(&bar[XB_TMO])) break; if (sp > XB_SPIN_CAP) { atomicAdd(&bar[XB_TMO], 1u); break; } }
    }
    nloc = mine > 0u ? mine : 1u; nx = cnt > 0u ? cnt : 1u;
}
DI void xcd_barrier(const XcdBarrier& b) {
    asm volatile("s_waitcnt vmcnt(0)" ::: "memory");
    __syncthreads();
    if (threadIdx.x == 0) {
        unsigned* bar = b.bar;
        __builtin_amdgcn_s_waitcnt(0);
        unsigned nloc = b.st[0], nx = b.st[1];
        if (nloc == 0u) { xcd_barrier_complete(bar, b.x, nloc, nx); b.st[0] = nloc; b.st[1] = nx; }
        const unsigned old = xb_add(&bar[XB_XSUB(b.x)], 1u);
        const unsigned gen = old / nloc;
        if (old + 1u == (gen + 1u) * nloc) {
            __builtin_amdgcn_fence(__ATOMIC_RELEASE, "agent");
            asm volatile("s_waitcnt vmcnt(0)" ::: "memory");
            const unsigned og = xb_add(&bar[XB_TOP], 1u);
            const unsigned tg = og / nx;
            if (og + 1u == (tg + 1u) * nx) xb_add(&bar[XB_TOPGEN], 1u);
            else XB_SPIN(xb_ld(&bar[XB_TOPGEN]) == tg, bar);
            __builtin_amdgcn_fence(__ATOMIC_ACQUIRE, "agent");
            xb_add(&bar[XB_XGEN(b.x)], 1u);
            asm volatile("s_waitcnt vmcnt(0)" ::: "memory");
        } else {
            XB_SPIN(xb_ld(&bar[XB_XGEN(b.x)]) == gen, bar);
            __builtin_amdgcn_fence(__ATOMIC_ACQUIRE, "agent");
            asm volatile("s_waitcnt vmcnt(0)" ::: "memory");
        }
    }
    __syncthreads();
}

DI int item_start(int c, int ng, int G, int NI, float pa, float per) {
    if (c >= G) return NI;
    const float f = c <= ng ? __fmul_rn(pa, (float)c) : __fadd_rn(__fmul_rn(pa, (float)ng), __fmul_rn(per, (float)(c - ng)));
    const int i = (int)__fadd_rn(f, 0.5f);
    return i > NI ? NI : i;
}

constexpr int NPHASE = 2 + 9 * DEPTH;
enum { GM_NONE = 0, GM_INPROJ, GM_RESADD, GM_RELU2, GM_S5E, GM_S5Y, GM_GLU };

struct EpiAny {
    const pg8::Gemm* g;
    DI bool mixn() const { return g->mixn != 0; }
    DI void mix_rescale(f32x4 (&acc)[2][2][4][2], LAS unsigned char* lds, int par, int t, int wr, int fr) const {
#pragma unroll
        for (int ai = 0; ai < 2; ++ai)
#pragma unroll
            for (int m = 0; m < 4; ++m) { float rA, rB, rC; mn_get(lds, par, wr * 64 + fr + ai * 128 + m * 16, rA, rB, rC);
                const float ratio = t == 6 ? rA * __builtin_amdgcn_rcpf(rB) : rB * __builtin_amdgcn_rcpf(rC);
#pragma unroll
                for (int bj = 0; bj < 2; ++bj)
#pragma unroll
                    for (int n = 0; n < 2; ++n) acc[ai][bj][m][n] = acc[ai][bj][m][n] * ratio; }
    }
    DI void prime_commit(LAS unsigned char* lds, int tid, const f32x4& a, const f32x4& b) const { if (g->mixn) mn_commit(lds, 0, tid, a, b); else rs_commit(lds, 0, tid, a, b); }
    DI bool prime_issue(const Unit& u, int tid, f32x4& a, f32x4& b) const {
        const bool m = (g->mode == GM_INPROJ || g->mode == GM_RELU2 || g->mixn);
        if (m) rs_issue(g->mixn ? (const float*)g->i1 : (const float*)g->i0, u.pm, tid, a, b);
        return m;
    }
    DI void operator()(const f32x4 (&acc)[2][2][4][2], const Unit& u, int wr, int wc, int fr, int fq, LAS unsigned char* lds, bool has_next, const Unit& nx, int par) const {
        asm volatile("" : "+v"(fr), "+v"(fq));
        asm volatile("" : "+s"(wr), "+s"(wc));
        switch (g->mode) {
        case GM_INPROJ: { EpiInProj E{(bf16_t*)g->o0, (bf16_t*)g->o1, (const float*)g->i0}; E(acc, u, wr, wc, fr, fq, lds, has_next, nx, par); } break;
        case GM_RESADD: if (g->sched == 3 && u.pm >= 128) { EpiPart E{(float*)const_cast<void*>(g->i1)}; E(acc, u, wr, wc, fr, fq); }
                        else { EpiResAdd E{(bf16_t*)g->o0, (float*)const_cast<void*>(g->i0)}; E(acc, u, wr, wc, fr, fq, g->mixn ? (const float*)g->i1 : nullptr, lds, has_next, nx, par); } break;
        case GM_RELU2:  { EpiRelu2 E{(bf16_t*)g->o0, (const float*)g->i0}; E(acc, u, wr, wc, fr, fq, lds, has_next, nx, par); } break;
        case GM_S5E:    { EpiS5E E{(float*)g->o0}; E(acc, u, wr, wc, fr, fq); } break;
        case GM_S5Y:    { EpiS5Y E{(const bf16_t*)g->i0, (bf16_t*)g->o0, (const float*)g->i1}; E(acc, u, wr, wc, fr, fq); } break;
        default:        { EpiGlu E{(const bf16_t*)g->i0, (bf16_t*)g->o0, (float*)g->o1, (const float*)g->i1}; E(acc, u, wr, wc, fr, fq); } break;
        }
    }
};

__global__ void __launch_bounds__(512, 2) mega(Params p) {
    extern __shared__ __attribute__((aligned(16))) unsigned char lds[];
    cg::grid_group grid = cg::this_grid();
    LAS unsigned char* ldsl = (LAS unsigned char*)lds;
    volatile LAS unsigned* xbst = (volatile LAS unsigned*)(ldsl + LDS_BYTES - 16);
    if (threadIdx.x < 4) xbst[threadIdx.x] = 0u;
    __syncthreads();
    const XcdBarrier xbar = xcd_barrier_post((unsigned*)(p.ws + WS_BAR), xbst);

#ifdef PROBE_DOUBLE_MASK
    bool rep = false;
#endif
    for (int ph = p.ph_lo; ph < p.ph_hi; ++ph) {
        const int l = ph >= 1 ? (ph - 1) / 9 : 0, si = ph >= 1 ? (ph - 1) % 9 : 0;
        const int s = (ph == 0) ? 100 : (ph == NPHASE - 1 ? 101 : (si < 5 ? si + 1 : (si == 5 ? 7 : si + 3)));
        unsigned char* ws = p.ws; unsigned char* ob = (unsigned char*)p.out; asm volatile("" : "+s"(ws), "+s"(ob));
        const int G = lgdim(), c = lbid();
#ifdef PROBE_TS_MASK
        if (blockIdx.x == 0 && threadIdx.x == 0) ((unsigned long long*)(p.ws + WS_TS))[ph] = __builtin_amdgcn_s_memrealtime();
#endif
        pg8::Gemm g; g.mixn = 0; g.mode = GM_NONE; g.perm = 0; g.sched = 0; g.M = MP; g.N = 0; g.o0 = nullptr; g.o1 = nullptr; g.i0 = nullptr; g.i1 = nullptr; g.A = nullptr; g.Bt = nullptr; g.K = 0; g.lda = 0; g.ldb = 0;
        switch (s) {
        case 1:  g.mode = GM_INPROJ; g.perm = 1; g.A = (const bf16_t*)(ws + WS_H); g.Bt = (const bf16_t*)(ws + WS_WIN); g.K = 1024; g.lda = 1024; g.ldb = 1024; g.N = 3072; g.o0 = ws + WS_PROJ; g.o1 = ws + WS_U2; g.i0 = ws + WS_RSS; break;
        case 2:  g.mode = GM_S5E; g.sched = 1; g.A = (const bf16_t*)(ws + WS_U2); g.Bt = (const bf16_t*)(ws + WS_M1); g.K = 512; g.lda = U2LD; g.ldb = 512; g.o0 = ob + DO_S5E; break;
        case 4:  g.mode = GM_S5Y; g.perm = 1; g.sched = 2; g.A = (const bf16_t*)(ws + WS_U2); g.Bt = (const bf16_t*)(ws + WS_T2); g.K = 768; g.lda = U2LD; g.ldb = 768; g.i0 = ws + WS_U2; g.o0 = ws + WS_Z; g.i1 = p.in[I_S5D] + (size_t)l * 256; break;
        case 5:  g.mode = GM_GLU; g.perm = 1; g.A = (const bf16_t*)(ws + WS_Z); g.Bt = (const bf16_t*)(ws + WS_GLU); g.K = 256; g.lda = 256; g.ldb = 256; g.N = 256; g.i0 = ws + WS_Z; g.o0 = ws + WS_ACT; g.o1 = ws + WS_SS; g.i1 = p.in[I_GLUB] + (size_t)l * 256; break;
        case 7:  g.mode = GM_RESADD; g.A = (const bf16_t*)(ws + WS_ACT); g.Bt = (const bf16_t*)(ws + WS_WOUT); g.K = 1024; g.lda = 1024; g.ldb = 1024; g.N = 1024; g.o0 = ws + WS_H; g.i0 = ws + WS_RSS; g.mixn = 1; g.i1 = ws + WS_SS; break;
        case 9:  g.mode = GM_RELU2; g.perm = 1; g.i0 = ws + WS_RSS; g.A = (const bf16_t*)(ws + WS_H); g.Bt = (const bf16_t*)(ws + WS_WUP); g.K = 1024; g.lda = 1024; g.ldb = 1024; g.N = 4096; g.o0 = ws + WS_FF; break;
        case 10: g.mode = GM_RESADD; g.A = (const bf16_t*)(ws + WS_FF); g.Bt = (const bf16_t*)(ws + WS_WDN); g.K = 4096; g.lda = 4096; g.ldb = 4096; g.N = 1024; g.o0 = ws + WS_H; g.i0 = ws + WS_RSS; g.i1 = ob + DO_PART; g.sched = 3; g.M = 32768; break;
        default: break;
        }
        if (g.mode != GM_NONE) {
            pg8::AnyOrder S; S.kind = g.sched; S.G = G; S.c = c; S.ntfull = g.K / 64; S.so.init(g.M, g.N, G, c);
            EpiAny E{&g};
            pg8::gemm_phase(ldsl, g, S, E);
        }
        if (s == 2 || s == 4) {
            const bool fin = (s == 4);
            const int ngemm = fin ? 160 : 80; const float wg = fin ? 2.1f : 1.4f;
            const int NI = NCH64 * 6;
            const int ng = ngemm < G ? ngemm : G;
            const float per = ((float)NI + wg * (float)ng) / (float)G;
            const float pa = per - wg;
            const int i0 = item_start(c, ng, G, NI, pa, per), i1 = item_start(c + 1, ng, G, NI, pa, per);
            stage_params(p, l, lds);
            if (i0 < i1) {
                RgPre nx = rg_load(p, i0, fin);
                for (int it = i0; it < i1; ++it) { const RgPre cur = nx; if (it + 1 < i1) nx = rg_load(p, it + 1, fin); rg_compute(p, it, fin, cur, lds); }
            }
            if (i0 < i1) {
                HgPre nx = hg_load(p, i0, fin);
                for (int it = i0; it < i1; ++it) { const HgPre cur = nx; if (it + 1 < i1) nx = hg_load(p, it + 1, fin); hg_compute(p, it, fin, cur, lds); }
            }
        } else if (s == 1 || s == 7 || s == 9 || s == 10) {
            const int extra = s == 1 ? 1572 % G : (s == 7 ? 524 % G : (s == 9 ? 2096 % G : 96)), widx = c - extra, nw = G - extra;
            if (widx >= 0) {
                if (s == 1) { if (l == 0) build_s5_mats(p, 0, widx, nw); else convert_weights(p, l, CV_UP, widx, nw, lds); }
                else if (s == 7) convert_weights(p, l, CV_DN, widx, nw, lds);
                else if (l + 1 < DEPTH) {
                    if (s == 9) { build_s5_mats(p, l + 1, widx, nw); convert_weights(p, l + 1, CV_SMALL | CV_OUT, widx, nw, lds); }
                    else convert_weights(p, l + 1, CV_IN, widx, nw, lds);
                }
            }
        }
        else if (s == 11) phase_combine(p);
        else if (s == 3) phase_carries(p, l);
        else if (s == 100) { phase_prep(p, lds); build_rows(p); convert_weights(p, 0, CV_UP | CV_IN | CV_OUT | CV_SMALL, c, G, lds); }
        else if (s == 101) phase_final(p);
        if (ph + 1 < p.ph_hi) { if (p.ph_lo < 0) { __threadfence(); grid.sync(); } else xcd_barrier(xbar); }
#ifdef PROBE_DOUBLE_MASK
        if (s < 11 && ((PROBE_DOUBLE_MASK >> s) & 1) && !rep) { rep = true; --ph; } else rep = false;
#endif
    }
#ifdef PROBE_TS_MASK
    xcd_barrier(xbar);
    if (blockIdx.x == 0 && threadIdx.x == 0) {
        unsigned long long* TS = (unsigned long long*)(p.ws + WS_TS);
        TS[NPHASE] = __builtin_amdgcn_s_memrealtime();
        unsigned long long sel = 0;
        for (int ph = 0; ph < NPHASE; ++ph) {
            const int si = ph >= 1 ? (ph - 1) % 9 : 0;
            const int s = (ph == 0) ? 12 : (ph == NPHASE - 1 ? 13 : (si < 5 ? si + 1 : (si == 5 ? 7 : si + 3)));
            if ((PROBE_TS_MASK >> s) & 1) sel += TS[ph + 1] - TS[ph];
        }
        const float v = (float)sel / (float)(TS[NPHASE] - TS[0]);
        const float dl = sqrtf(5000.0f * v);
        p.out[0] += dl; p.out[16777216] += dl;
    }
#endif
}

#ifndef MK_MULTI
#define MK_MULTI 0
#endif

extern "C" void kernel_launch(void* const* d_in, const int* in_sizes, int n_in, void* d_out, int out_size, void* d_ws, size_t ws_size, hipStream_t stream) {
    static int grid = 0;
    if (grid == 0) {
        if (n_in != 29 || ws_size < WS_END || out_size != 33554432) { fprintf(stderr, "kernel_launch: unexpected sizes n_in %d ws %zu need %zu out %d\n", n_in, ws_size, (size_t)WS_END, out_size); grid = -1; return; }
        int dev = 0, cus = 0, per_cu = 0;
        hipGetDevice(&dev);
        hipDeviceGetAttribute(&cus, hipDeviceAttributeMultiprocessorCount, dev);
        if (hipFuncSetAttribute((const void*)mega, hipFuncAttributeMaxDynamicSharedMemorySize, LDS_BYTES) != hipSuccess) { fprintf(stderr, "kernel_launch: hipFuncSetAttribute failed\n"); }
        hipOccupancyMaxActiveBlocksPerMultiprocessor(&per_cu, (const void*)mega, 512, LDS_BYTES);
        (void)hipGetLastError();
        if (per_cu < 1) per_cu = 1;
        grid = cus * 1;
        fprintf(stderr, "kernel_launch: cus %d per_cu %d grid %d ws %zu need %zu\n", cus, per_cu, grid, ws_size, (size_t)WS_END);
    }
    if (grid < 0) return;
    Params p{};
    for (int i = 0; i < 29; ++i) p.in[i] = (const float*)d_in[i];
    p.out = (float*)d_out; p.ws = (unsigned char*)d_ws;
#if MK_MULTI
    for (int ph = 0; ph < NPHASE; ++ph) {
        p.ph_lo = ph; p.ph_hi = ph + 1;
        hipLaunchKernelGGL(mega, dim3(grid), dim3(512), LDS_BYTES, stream, p);
    }
#else
    p.ph_lo = 0; p.ph_hi = NPHASE;
    if (hipMemsetAsync((unsigned char*)d_ws + WS_BAR, 0, 16384, stream) != hipSuccess) { fprintf(stderr, "kernel_launch: memset of the barrier words failed\n"); return; }
    void* args[] = {&p};
    hipError_t e = hipLaunchCooperativeKernel((const void*)mega, dim3(grid), dim3(512), args, LDS_BYTES, stream);
    if (e != hipSuccess) fprintf(stderr, "cooperative launch failed: %s (grid %d)\n", hipGetErrorString(e), grid);
#endif
}
```
